# Optimizing an MI355X kernel written in HIP

```python
import math
import jax, jax.numpy as jnp
from jax import lax
import numpy as np

D_MODEL = 1024
BATCH = 16
SEQ = 2048
DEPTH = 2

HEAD_DIM = 64
N_HEADS_SB = 8
N_HEADS_MOBA = 8
W_SB = N_HEADS_SB * HEAD_DIM
W_MOBA = N_HEADS_MOBA * HEAD_DIM
N_BRANCH = 2
IN_COLS = 3 * W_SB + 3 * W_MOBA + N_BRANCH * D_MODEL
SB_Q_BLOCK = 128
MOBA_BLOCK = 256
MOBA_TOPK = 3
MOBA_Q_CHUNK = 16
REL_BUCKETS = 32
REL_MAX_DIST = 128
D_FF = 3584
N_EXPERTS = 8
TOP_K = 2
D_FF_EXPERT = 3584
N_DENSE = (DEPTH + 1) // 2
N_MOE = DEPTH // 2
N_MOD = 6
EPS = 1e-6
NEG_INF = -1e30

kernel_name = 'hybrid_stickbreak_moba_moe_block'


def rms_norm(x, g):
    xf = x.astype(jnp.float32)
    y = xf * lax.rsqrt(jnp.mean(xf * xf, axis=-1, keepdims=True) + EPS)
    return (y * g.astype(jnp.float32)).astype(x.dtype)


def rel_bucket(dist):
    max_exact = REL_BUCKETS // 2
    n = jnp.maximum(dist, 0)
    nf = jnp.maximum(n, 1).astype(jnp.float32)
    large = max_exact + (jnp.log(nf / max_exact) / math.log(REL_MAX_DIST / max_exact)
                         * (REL_BUCKETS - max_exact)).astype(jnp.int32)
    large = jnp.minimum(large, REL_BUCKETS - 1)
    return jnp.where(n < max_exact, n, large)


def stick_breaking_attention(q, k, v):
    B, H, S, Dh = q.shape
    nq = S // SB_Q_BLOCK
    scale = Dh ** -0.5
    kpos = jnp.arange(S)
    qb = q.reshape(B, H, nq, SB_Q_BLOCK, Dh).transpose(2, 0, 1, 3, 4)

    def block(args):
        i, qi = args
        qpos = i * SB_Q_BLOCK + jnp.arange(SB_Q_BLOCK)
        z = jnp.einsum('bhqd,bhkd->bhqk', qi, k).astype(jnp.float32) * scale
        mask = kpos[None, :] < qpos[:, None]
        log_1m = jnp.where(mask, -jax.nn.softplus(z), 0.0)
        suffix = lax.cumsum(log_1m, axis=3, reverse=True) - log_1m
        att = jnp.where(mask, jnp.exp(jax.nn.log_sigmoid(z) + suffix), 0.0)
        return jnp.einsum('bhqk,bhkd->bhqd', att.astype(v.dtype), v)

    out = lax.map(block, (jnp.arange(nq), qb))
    return out.transpose(1, 2, 0, 3, 4).reshape(B, H, S, Dh)


def moba_attention(q, k, v, rel_bias):
    B, H, S, Dh = q.shape
    nb = -(-S // MOBA_BLOCK)
    sp = nb * MOBA_BLOCK
    pad = ((0, 0), (0, 0), (0, sp - S), (0, 0))
    kp = jnp.pad(k, pad)
    vp = jnp.pad(v, pad)
    kblk = kp.reshape(B, H, nb, MOBA_BLOCK, Dh)
    vblk = vp.reshape(B, H, nb, MOBA_BLOCK, Dh)
    kmean = jnp.mean(kblk, axis=3)
    n_sel = min(MOBA_TOPK, nb)
    scale = Dh ** -0.5
    nc = S // MOBA_Q_CHUNK
    qc = q.reshape(B, H, nc, MOBA_Q_CHUNK, Dh).transpose(2, 0, 1, 3, 4)
    bidx = jnp.arange(B)[:, None, None, None]
    hidx = jnp.arange(H)[None, :, None, None]
    hidx5 = jnp.arange(H)[None, :, None, None, None]
    blk_off = jnp.arange(MOBA_BLOCK)
    bias_t = rel_bias.T

    def chunk(args):
        i, qi = args
        qpos = i * MOBA_Q_CHUNK + jnp.arange(MOBA_Q_CHUNK)
        own = (i * MOBA_Q_CHUNK) // MOBA_BLOCK
        gate = jnp.einsum('bhqd,bhnd->bhqn', qi, kmean).astype(jnp.float32)
        gate = jnp.where(jnp.arange(nb) < own, gate, NEG_INF)
        _, sel = lax.top_k(gate, n_sel)
        sel_valid = sel < own
        ks = kblk[bidx, hidx, sel]
        vs = vblk[bidx, hidx, sel]
        s_sel = jnp.einsum('bhqd,bhqnkd->bhqnk', qi, ks).astype(jnp.float32) * scale
        spos_sel = sel[..., None] * MOBA_BLOCK + blk_off
        bias_sel = bias_t[hidx5, rel_bucket(qpos[:, None, None] - spos_sel)]
        s_sel = jnp.where(sel_valid[..., None], s_sel + bias_sel.astype(jnp.float32), NEG_INF)
        ko = lax.dynamic_slice_in_dim(kp, own * MOBA_BLOCK, MOBA_BLOCK, axis=2)
        vo = lax.dynamic_slice_in_dim(vp, own * MOBA_BLOCK, MOBA_BLOCK, axis=2)
        s_own = jnp.einsum('bhqd,bhkd->bhqk', qi, ko).astype(jnp.float32) * scale
        dist = qpos[:, None] - (own * MOBA_BLOCK + blk_off)[None, :]
        bias_own = bias_t[:, rel_bucket(dist)]
        s_own = jnp.where(dist >= 0, s_own + bias_own.astype(jnp.float32), NEG_INF)
        logits = jnp.concatenate([s_sel.reshape(B, H, MOBA_Q_CHUNK, n_sel * MOBA_BLOCK), s_own], axis=-1)
        p = jax.nn.softmax(logits, axis=-1).astype(v.dtype)
        p_sel = p[..., :n_sel * MOBA_BLOCK].reshape(B, H, MOBA_Q_CHUNK, n_sel, MOBA_BLOCK)
        p_own = p[..., n_sel * MOBA_BLOCK:]
        return (jnp.einsum('bhqnk,bhqnkd->bhqd', p_sel, vs)
                + jnp.einsum('bhqk,bhkd->bhqd', p_own, vo))

    out = lax.map(chunk, (jnp.arange(nc), qc))
    return out.transpose(1, 2, 0, 3, 4).reshape(B, H, S, Dh)


def hybrid_mixer(h, w_in, w_proj_sb, w_proj_moba, w_out, rel_bias):
    B, S, _ = h.shape
    proj = h @ w_in
    qkv_sb, qkv_moba, gates = jnp.split(proj, [3 * W_SB, 3 * W_SB + 3 * W_MOBA], axis=-1)

    def heads(t, nh):
        return t.reshape(B, S, 3, nh, HEAD_DIM).transpose(2, 0, 3, 1, 4)

    q_a, k_a, v_a = heads(qkv_sb, N_HEADS_SB)
    o_a = stick_breaking_attention(q_a, k_a, v_a)
    o_a = o_a.transpose(0, 2, 1, 3).reshape(B, S, W_SB) @ w_proj_sb
    q_b, k_b, v_b = heads(qkv_moba, N_HEADS_MOBA)
    o_b = moba_attention(q_b, k_b, v_b, rel_bias)
    o_b = o_b.transpose(0, 2, 1, 3).reshape(B, S, W_MOBA) @ w_proj_moba
    g_a, g_b = jnp.split(gates, 2, axis=-1)
    merged = jax.nn.sigmoid(g_a) * o_a + jax.nn.sigmoid(g_b) * o_b
    return merged @ w_out


def swiglu(h, w1, w3, w2):
    return (jax.nn.silu(h @ w1) * (h @ w3)) @ w2


def moe_swiglu(h, w_router, w1, w3, w2):
    logits = (h @ w_router).astype(jnp.float32)
    top_v, top_i = lax.top_k(logits, TOP_K)
    top_w = jax.nn.softmax(top_v, axis=-1)
    combine = jnp.sum(jax.nn.one_hot(top_i, N_EXPERTS, dtype=jnp.float32) * top_w[..., None], axis=-2)
    combine = combine.astype(h.dtype)
    out = jnp.zeros_like(h)
    for e in range(N_EXPERTS):
        out = out + combine[..., e:e + 1] * swiglu(h, w1[e], w3[e], w2[e])
    return out


def modulate_in(x, g_pre, shift, scale):
    return rms_norm(x, g_pre) * (1 + scale[:, None, :]) + shift[:, None, :]


def residual_out(x, y, g_post, gate):
    return x + gate[:, None, :] * rms_norm(y, g_post)


def setup_inputs(seed: int = 0) -> dict:
    key = jax.random.key(seed)
    ks = jax.random.split(key, 20)
    f32 = jnp.float32

    def w(k, shape, fan_in, mult=1.0):
        return jax.random.normal(k, shape, f32) * (mult * fan_in ** -0.5)

    def gain(k, shape):
        return 1.0 + 0.05 * jax.random.normal(k, shape, f32)

    return {
        'x': jax.random.normal(ks[0], (BATCH, SEQ, D_MODEL), f32),
        'c': jax.random.normal(ks[1], (BATCH, D_MODEL), f32),
        'w_mod': w(ks[2], (DEPTH, D_MODEL, N_MOD * D_MODEL), D_MODEL, 0.5),
        'b_mod': 0.01 * jax.random.normal(ks[3], (DEPTH, N_MOD * D_MODEL), f32),
        'g_mix_pre': gain(ks[4], (DEPTH, D_MODEL)),
        'g_mix_post': gain(ks[5], (DEPTH, D_MODEL)),
        'g_ffn_pre': gain(ks[6], (DEPTH, D_MODEL)),
        'g_ffn_post': gain(ks[7], (DEPTH, D_MODEL)),
        'w_in': w(ks[8], (DEPTH, D_MODEL, IN_COLS), D_MODEL),
        'w_proj_sb': w(ks[9], (DEPTH, W_SB, D_MODEL), W_SB),
        'w_proj_moba': w(ks[10], (DEPTH, W_MOBA, D_MODEL), W_MOBA),
        'w_out': w(ks[11], (DEPTH, D_MODEL, D_MODEL), D_MODEL),
        'rel_bias': 0.5 * jax.random.normal(ks[12], (REL_BUCKETS, N_HEADS_MOBA), f32),
        'w1_dense': w(ks[13], (N_DENSE, D_MODEL, D_FF), D_MODEL),
        'w3_dense': w(ks[14], (N_DENSE, D_MODEL, D_FF), D_MODEL),
        'w2_dense': w(ks[15], (N_DENSE, D_FF, D_MODEL), D_FF),
        'w_router': w(ks[16], (N_MOE, D_MODEL, N_EXPERTS), D_MODEL),
        'w1_moe': w(ks[17], (N_MOE, N_EXPERTS, D_MODEL, D_FF_EXPERT), D_MODEL),
        'w3_moe': w(ks[18], (N_MOE, N_EXPERTS, D_MODEL, D_FF_EXPERT), D_MODEL),
        'w2_moe': w(ks[19], (N_MOE, N_EXPERTS, D_FF_EXPERT, D_MODEL), D_FF_EXPERT),
    }


def reference(x, c, w_mod, b_mod, g_mix_pre, g_mix_post, g_ffn_pre, g_ffn_post, w_in, w_proj_sb,
              w_proj_moba, w_out, rel_bias, w1_dense, w3_dense, w2_dense, w_router, w1_moe, w3_moe,
              w2_moe):
    cond = jax.nn.silu(c)
    for l in range(DEPTH):
        mod = cond @ w_mod[l] + b_mod[l]
        sh_mix, sc_mix, gt_mix, sh_ffn, sc_ffn, gt_ffn = jnp.split(mod, N_MOD, axis=-1)
        h = modulate_in(x, g_mix_pre[l], sh_mix, sc_mix)
        y = hybrid_mixer(h, w_in[l], w_proj_sb[l], w_proj_moba[l], w_out[l], rel_bias)
        x = residual_out(x, y, g_mix_post[l], gt_mix)
        h = modulate_in(x, g_ffn_pre[l], sh_ffn, sc_ffn)
        if l % 2 == 0:
            y = swiglu(h, w1_dense[l // 2], w3_dense[l // 2], w2_dense[l // 2])
        else:
            y = moe_swiglu(h, w_router[l // 2], w1_moe[l // 2], w3_moe[l // 2], w2_moe[l // 2])
        x = residual_out(x, y, g_ffn_post[l], gt_ffn)
    return x
```

```cpp
#include <hip/hip_runtime.h>
#include <hip/hip_bf16.h>
#include <cstdio>
#include <cstdint>
#include <cmath>

#ifndef MK_ONE_LAUNCH
#define MK_ONE_LAUNCH 0
#endif
#ifndef MK_SKIP
#define MK_SKIP 0
#endif
#define SK(b) ((MK_SKIP >> (b)) & 1)

#define GAS __attribute__((address_space(1)))
#define LAS __attribute__((address_space(3)))
typedef unsigned short bf16;
typedef unsigned v4u __attribute__((ext_vector_type(4)));
typedef unsigned v2u __attribute__((ext_vector_type(2)));
typedef float f32x4 __attribute__((ext_vector_type(4)));
typedef float f32x2 __attribute__((ext_vector_type(2)));
typedef float f32x16 __attribute__((ext_vector_type(16)));
typedef short bf16x8 __attribute__((ext_vector_type(8)));
typedef short s16x4 __attribute__((ext_vector_type(4)));
typedef GAS unsigned gu32;
#define RLX_AGENT __ATOMIC_RELAXED, __HIP_MEMORY_SCOPE_AGENT
#define LDS_WAIT() asm volatile("s_waitcnt lgkmcnt(0)" ::: "memory")
#define VM_WAIT() asm volatile("s_waitcnt vmcnt(0)" ::: "memory")

constexpr int NB = 16, SEQ = 2048, D = 1024, M = NB * SEQ, NH = 8, HD = 64, WH = 512, INCOLS = 5120, FF = 3584, NE = 8, NMOD = 6 * D;
constexpr float EPS = 1e-6f;
constexpr float LOG2E = 1.4426950408889634f;
constexpr float C2 = 0.125f * LOG2E;
constexpr int NWAVES = 8, NTHREADS = 512;

constexpr size_t MiB = 1u << 20;
constexpr size_t WS_CTL = 0, CTL_ZERO_BYTES = 1 * MiB;
constexpr size_t WS_MOD = 1 * MiB;
constexpr size_t WS_LIST = 2 * MiB;
constexpr size_t WS_TOKW = 3 * MiB;
constexpr size_t WS_WIN = 4 * MiB;
constexpr size_t WS_WPSB = 24 * MiB;
constexpr size_t WS_WPMB = 26 * MiB;
constexpr size_t WS_WOUT = 28 * MiB;
constexpr size_t WS_W13D = 32 * MiB;
constexpr size_t WS_W2D = 46 * MiB;
constexpr size_t WS_W13M = 53 * MiB;
constexpr size_t WS_W2M = 165 * MiB;
constexpr size_t WS_H = 221 * MiB;
constexpr size_t WS_BIG = 285 * MiB;
constexpr size_t WS_END = 605 * MiB;
constexpr size_t PLANE = (size_t)M * WH * 2;
constexpr size_t BIG_QA = 0, BIG_KA = PLANE, BIG_VA = 2 * PLANE, BIG_QB = 3 * PLANE, BIG_KB = 4 * PLANE, BIG_VB = 5 * PLANE, BIG_GA = 6 * PLANE, BIG_GB = 8 * PLANE;
constexpr size_t BIG_Y = 0;
constexpr size_t BIG_ACT = 0, BIG_YF = 224 * MiB;
constexpr int MOE_CHUNK_PANELS = 88, MOE_NCHUNK = 3;
constexpr size_t BIG_HID = 0, BIG_YP = 160 * MiB;
static_assert(BIG_YP + (size_t)M * 2 * D * 2 <= 320 * MiB && (size_t)MOE_CHUNK_PANELS * 256 * FF * 2 <= BIG_YP && BIG_YF + (size_t)M * D * 2 <= 320 * MiB, "BIG map");
constexpr int CW_TMO = 0, CW_CODE = 1, CW_BAR = 4096, CW_CNT = 16384;

constexpr int RING_BYTES = 131072;
constexpr int LDS_TOK = RING_BYTES;
constexpr int LDS_TOK_UNITS = 12;
constexpr int LDS_SEG = LDS_TOK + LDS_TOK_UNITS * 1024;
constexpr int LDS_MISC = LDS_SEG + 128;
constexpr int LDS_BYTES = LDS_MISC + 64;
static_assert(LDS_BYTES <= 160 * 1024, "LDS");

__device__ __forceinline__ unsigned f2bf(float f) { unsigned u = __builtin_bit_cast(unsigned, f); return (u + 0x7fffu + ((u >> 16) & 1u)) >> 16; }
__device__ __forceinline__ unsigned pk2(float lo, float hi) { return f2bf(lo) | (f2bf(hi) << 16); }
__device__ __forceinline__ float bf_lo(unsigned w) { return __builtin_bit_cast(float, w << 16); }
__device__ __forceinline__ float bf_hi(unsigned w) { return __builtin_bit_cast(float, w & 0xffff0000u); }
__device__ __forceinline__ unsigned cvt_pk_bf16(float lo, float hi) { typedef __bf16 bf2 __attribute__((ext_vector_type(2))); f32x2 v = {lo, hi}; bf2 b = __builtin_convertvector(v, bf2); return __builtin_bit_cast(unsigned, b); }
__device__ __forceinline__ float fast_exp2(float x) { return __builtin_amdgcn_exp2f(x); }
__device__ __forceinline__ float fast_log2(float x) { return __builtin_amdgcn_logf(x); }
__device__ __forceinline__ float fast_rcp(float x) { return __builtin_amdgcn_rcpf(x); }
__device__ __forceinline__ int otid() { int t = threadIdx.x; asm volatile("" : "+v"(t)); return t; }
__device__ __forceinline__ float shx(float v, int o, int lane) { return __builtin_bit_cast(float, __builtin_amdgcn_ds_bpermute((lane ^ o) << 2, __builtin_bit_cast(int, v))); }
__device__ __forceinline__ float shl(float v, int src) { return __builtin_bit_cast(float, __builtin_amdgcn_ds_bpermute(src << 2, __builtin_bit_cast(int, v))); }
__device__ __forceinline__ float sigmoidf_(float x) { return fast_rcp(1.0f + fast_exp2(-x * LOG2E)); }

#define XB_TMO      128
#define XB_XCNT(j)  (256  + 64 * (j))
#define XB_XSUB(j)  (1280 + 64 * (j))
#define XB_XGEN(j)  (2304 + 64 * (j))
#define XB_TOP      3328
#define XB_TOPGEN   3392
#define XCD_BAR_WORDS 3456
#define XB_SPIN_CAP (1u << 18)
__device__ __forceinline__ unsigned xb_ld(unsigned* p)              { return __hip_atomic_load(p, __ATOMIC_RELAXED, __HIP_MEMORY_SCOPE_AGENT); }
__device__ __forceinline__ unsigned xb_add(unsigned* p, unsigned v) { return __hip_atomic_fetch_add(p, v, __ATOMIC_RELAXED, __HIP_MEMORY_SCOPE_AGENT); }
__device__ __forceinline__ unsigned xb_xcc_id() { return (unsigned)__builtin_amdgcn_s_getreg((3 << 11) | 20) & 0xFu; }
#define XB_SPIN(cond, bar) do { unsigned _sp = 0; while (cond) { __builtin_amdgcn_s_sleep(1); \
    if ((++_sp & 255u) == 0u) { if (xb_ld(&(bar)[XB_TMO])) break; if (_sp > XB_SPIN_CAP) { atomicAdd(&(bar)[XB_TMO], 1u); break; } } } } while (0)
struct XcdBarrier { unsigned* bar; unsigned x; volatile LAS unsigned* st; };
__device__ __forceinline__ XcdBarrier xcd_barrier_post(unsigned* bar, volatile LAS unsigned* st) {
    XcdBarrier b; b.bar = bar; b.x = xb_xcc_id(); b.st = st;
    if (threadIdx.x == 0) (void)xb_add(&bar[XB_XCNT(b.x)], 1u);
    return b;
}
__device__ __forceinline__ void xcd_barrier_complete(unsigned* bar, unsigned x, unsigned& nloc, unsigned& nx) {
    const unsigned G = gridDim.x * gridDim.y * gridDim.z;
    unsigned sum, cnt, mine, sp = 0u;
    for (;;) {
        sum = 0u; cnt = 0u; mine = 0u;
#pragma unroll
        for (unsigned j = 0; j < 16; ++j) { const unsigned c = xb_ld(&bar[XB_XCNT(j)]); sum += c; cnt += (c > 0u) ? 1u : 0u; mine = (j == x) ? c : mine; }
        if (sum == G) break;
        __builtin_amdgcn_s_sleep(1);
        if ((++sp & 255u) == 0u) { if (xb_ld(&bar[XB_TMO])) break; if (sp > XB_SPIN_CAP) { atomicAdd(&bar[XB_TMO], 1u); break; } }
    }
    nloc = mine > 0u ? mine : 1u; nx = cnt > 0u ? cnt : 1u;
}
__device__ __forceinline__ void xcd_barrier(const XcdBarrier& b) {
    asm volatile("s_waitcnt vmcnt(0)" ::: "memory");
    __syncthreads();
    if (threadIdx.x == 0) {
        unsigned* bar = b.bar;
        __builtin_amdgcn_s_waitcnt(0);
        unsigned nloc = b.st[0], nx = b.st[1];
        if (nloc == 0u) { xcd_barrier_complete(bar, b.x, nloc, nx); b.st[0] = nloc; b.st[1] = nx; }
        const unsigned old = xb_add(&bar[XB_XSUB(b.x)], 1u);
        const unsigned gen = old / nloc;
        if (old + 1u == (gen + 1u) * nloc) {
            __builtin_amdgcn_fence(__ATOMIC_RELEASE, "agent");
            asm volatile("s_waitcnt vmcnt(0)" ::: "memory");
            const unsigned og = xb_add(&bar[XB_TOP], 1u);
            const unsigned tg = og / nx;
            if (og + 1u == (tg + 1u) * nx) xb_add(&bar[XB_TOPGEN], 1u);
            else XB_SPIN(xb_ld(&bar[XB_TOPGEN]) == tg, bar);
            __builtin_amdgcn_fence(__ATOMIC_ACQUIRE, "agent");
            xb_add(&bar[XB_XGEN(b.x)], 1u);
            asm volatile("s_waitcnt vmcnt(0)" ::: "memory");
        } else {
            XB_SPIN(xb_ld(&bar[XB_XGEN(b.x)]) == gen, bar);
            __builtin_amdgcn_fence(__ATOMIC_ACQUIRE, "agent");
            asm volatile("s_waitcnt vmcnt(0)" ::: "memory");
        }
    }
    __syncthreads();
}

namespace pg8 {
constexpr int BM = 256, BK = 64, HALF = 128, HTB = HALF * BK * 2, STAGE_BYTES = 8 * HTB, NXCD = 8, WGM = 8;
__host__ __device__ __forceinline__ int lds_byte(int r, int c) { const int st = (r >> 4) * 2 + (c >> 5), rr = r & 15, cc = c & 31, ob = rr * 64 + cc * 2; return st * 1024 + (ob ^ (((ob >> 9) & 1) << 5)); }
__host__ __device__ __forceinline__ void stage_rc(int b, int& R, int& C) { const int st = b / 1024, sb = b % 1024, swz = sb ^ (((sb >> 9) & 1) << 5); R = (st >> 1) * 16 + swz / 64; C = (st & 1) * 32 + (swz % 64) / 2; }
__host__ __device__ __forceinline__ int perm32(int rho) { const int n = rho >> 4, i = rho & 15; return 8 * (i >> 2) + 4 * n + (i & 3); }
struct Unit { int pm, pn; };
struct StaticOrder {
    int nM, nN, nwg, G, c;
    __host__ __device__ void init(int nM_, int nN_, int G_, int c_) { nM = nM_; nN = nN_; nwg = nM * nN; G = G_; c = c_; }
    __host__ __device__ bool next(int i, Unit& u) const {
        const long L = (long)i * G + c; if (L >= nwg) return false;
        int wgid = (int)L; { const int q = nwg / NXCD, r = nwg % NXCD, xcd = wgid % NXCD, off = wgid / NXCD; wgid = (xcd < r ? xcd * (q + 1) : r * (q + 1) + (xcd - r) * q) + off; }
        const int nig = WGM * nN, gid = wgid / nig, fm = gid * WGM, gsz = (nM - fm) < WGM ? (nM - fm) : WGM;
        u.pm = fm + ((wgid % nig) % gsz); u.pn = (wgid % nig) / gsz; return true;
    }
};
template <class Epi, class Sched, bool ALIGN_EPI>
__device__ __forceinline__ void gemm_phase(LAS unsigned char* lds, const int K, const Sched& S, const Epi& E) {
    const int tid = otid(), wid = __builtin_amdgcn_readfirstlane(tid >> 6), lane = tid & 63, wr = wid >> 2, wc = wid & 3, fr = lane & 15, fq = lane >> 4;
    const int nt = K / BK;
    unsigned voffA[2], voffB[2];
#pragma unroll
    for (int i = 0; i < 2; ++i) { int R, C; stage_rc(tid * 16 + i * 8192, R, C); const int Rb = Epi::PERM ? ((R & ~31) + perm32(R & 31)) : R;
        voffA[i] = (unsigned)(R * K + C) * 2u; voffB[i] = (unsigned)(Rb * K + C) * 2u; }
#define PG8_GVOFF(uix) do { _Pragma("unroll") for (int _h = 0; _h < 2; ++_h) _Pragma("unroll") for (int _i = 0; _i < 2; ++_i) { int R_, C_; stage_rc(tid * 16 + _i * 8192, R_, C_); vg[_h][_i] = S.gvoff((uix), _h * HALF + R_, C_, K); } } while (0)
    const size_t kstep = (size_t)(BK * 2);
    const size_t hstep = (size_t)HALF * K * 2;
    const unsigned ldsw = (unsigned)wid * 1024u;
    const int aoff = lds_byte(wr * 64 + fr, fq * 8), boff = lds_byte(wc * 32 + fr, fq * 8);
#define PG8_SA(b, h) (((b) * 2 + (h)) * HTB)
#define PG8_SB(b, h) ((4 + (b) * 2 + (h)) * HTB)
#define PG8_STAGE(bufoff, gbase, voff) do { _Pragma("unroll") for (int _i = 0; _i < 2; ++_i) \
        __builtin_amdgcn_global_load_lds((const unsigned*)((const char*)(gbase) + (voff)[_i]), (LAS unsigned*)(lds + (bufoff) + ldsw + _i * 8192), 16, 0, 0); } while (0)
#define PG8_STAGE_A(bufoff, kp, h) do { if constexpr (Sched::GATHER) { PG8_STAGE(bufoff, kp, vg[h]); } else { PG8_STAGE(bufoff, (kp) + (h) * hstep, voffA); } } while (0)
#define PG8_LDA(dst, b, h) do { _Pragma("unroll") for (int m = 0; m < 4; ++m) _Pragma("unroll") for (int k = 0; k < 2; ++k) dst[m][k] = *(const LAS bf16x8*)(lds + PG8_SA(b, h) + aoff + m * 2048 + k * 1024); } while (0)
#define PG8_LDB(dst, b, h) do { _Pragma("unroll") for (int n = 0; n < 2; ++n) _Pragma("unroll") for (int k = 0; k < 2; ++k) dst[n][k] = *(const LAS bf16x8*)(lds + PG8_SB(b, h) + boff + n * 2048 + k * 1024); } while (0)
#define PG8_MMA(ai, bj, At, Bt) do { __builtin_amdgcn_s_setprio(1); _Pragma("unroll") for (int m = 0; m < 4; ++m) _Pragma("unroll") for (int n = 0; n < 2; ++n) _Pragma("unroll") for (int k = 0; k < 2; ++k) \
        acc[ai][bj][m][n] = __builtin_amdgcn_mfma_f32_16x16x32_bf16(Bt[n][k], At[m][k], acc[ai][bj][m][n], 0, 0, 0); __builtin_amdgcn_s_setprio(0); } while (0)
#define PG8_WAIT_V(n) asm volatile("s_waitcnt vmcnt(" #n ")" ::: "memory")
#define PG8_WAIT_L(n) asm volatile("s_waitcnt lgkmcnt(" #n ")" ::: "memory")
#define PG8_BAR __builtin_amdgcn_s_barrier()
#define PG8_SCHED __builtin_amdgcn_sched_barrier(0)
    Unit cur, nxt; int ui = 0;
    if (!S.next(0, cur)) return;
    f32x4 acc[2][2][4][2];
#pragma unroll
    for (int a = 0; a < 2; ++a)
#pragma unroll
        for (int b = 0; b < 2; ++b)
#pragma unroll
            for (int m = 0; m < 4; ++m)
#pragma unroll
                for (int n = 0; n < 2; ++n) acc[a][b][m][n] = (f32x4){0.f, 0.f, 0.f, 0.f};
    bf16x8 At[4][2], B0[2][2], B1[2][2];
    unsigned vg[2][2];
    if constexpr (Sched::GATHER) PG8_GVOFF(0);
    const char* cA = S.a_base(cur); const char* cB = S.b_base(cur);
    PG8_STAGE(PG8_SB(0, 0), cB, voffB); PG8_STAGE(PG8_SB(0, 1), cB + hstep, voffB); PG8_STAGE_A(PG8_SA(0, 0), cA, 0); PG8_STAGE_A(PG8_SA(0, 1), cA, 1);
    if (wr == 1) PG8_BAR;
    PG8_WAIT_V(2); PG8_BAR;
    PG8_STAGE(PG8_SB(1, 0), cB + kstep, voffB); PG8_STAGE_A(PG8_SA(1, 0), cA + kstep, 0); PG8_STAGE(PG8_SB(1, 1), cB + hstep + kstep, voffB);
    PG8_WAIT_V(6); PG8_BAR;
    for (;;) {
        const bool has_next = S.next(ui + 1, nxt);
        const char* nA = has_next ? S.a_base(nxt) : cA; const char* nB = has_next ? S.b_base(nxt) : cB;
        for (int t = 0; t < nt; t += 2) {
            const bool last = (t == nt - 2);
            const char* a1 = cA + (size_t)(t + 1) * kstep;
            const char* a2 = last ? nA : cA + (size_t)(t + 2) * kstep; const char* b2 = last ? nB : cB + (size_t)(t + 2) * kstep;
            const char* a3 = a2 + kstep; const char* b3 = b2 + kstep;
            PG8_LDB(B0, 0, 0); PG8_LDB(B1, 0, 1); PG8_SCHED; PG8_LDA(At, 0, 0); PG8_STAGE_A(PG8_SA(1, 1), a1, 1);
            if constexpr (Sched::GATHER) { if (last && has_next) PG8_GVOFF(ui + 1); }
            PG8_WAIT_V(8); PG8_WAIT_L(0); PG8_BAR; PG8_MMA(0, 0, At, B0); PG8_MMA(0, 1, At, B1); PG8_BAR; PG8_SCHED;
            PG8_LDA(At, 0, 1); PG8_STAGE(PG8_SB(0, 0), b2, voffB); PG8_STAGE(PG8_SB(0, 1), b2 + hstep, voffB); PG8_STAGE_A(PG8_SA(0, 0), a2, 0);
            PG8_WAIT_V(8); PG8_WAIT_L(0); PG8_BAR; PG8_MMA(1, 0, At, B0); PG8_MMA(1, 1, At, B1); PG8_BAR; PG8_SCHED;
            PG8_LDB(B0, 1, 0); PG8_LDB(B1, 1, 1); PG8_SCHED; PG8_LDA(At, 1, 0); PG8_STAGE_A(PG8_SA(0, 1), a2, 1);
            PG8_WAIT_V(8); PG8_WAIT_L(0); PG8_BAR; PG8_MMA(0, 0, At, B0); PG8_MMA(0, 1, At, B1); PG8_BAR; PG8_SCHED;
            PG8_LDA(At, 1, 1); PG8_STAGE(PG8_SB(1, 0), b3, voffB); PG8_STAGE(PG8_SB(1, 1), b3 + hstep, voffB); PG8_STAGE_A(PG8_SA(1, 0), a3, 0);
            PG8_WAIT_V(8); PG8_WAIT_L(0); PG8_BAR; PG8_MMA(1, 0, At, B0); PG8_MMA(1, 1, At, B1); PG8_BAR; PG8_SCHED;
        }
        if constexpr (ALIGN_EPI) { if (wr == 0) PG8_BAR; }
        E(acc, cur, ui, wr, wc, fr, fq);
        if (!has_next) break;
#pragma unroll
        for (int a = 0; a < 2; ++a)
#pragma unroll
            for (int b = 0; b < 2; ++b)
#pragma unroll
                for (int m = 0; m < 4; ++m)
#pragma unroll
                    for (int n = 0; n < 2; ++n) acc[a][b][m][n] = (f32x4){0.f, 0.f, 0.f, 0.f};
        cur = nxt; cA = nA; cB = nB; ++ui;
        if constexpr (ALIGN_EPI) { if (wr == 1) PG8_BAR; }
    }
    PG8_WAIT_V(0);
    if constexpr (!ALIGN_EPI) { if (wr == 0) PG8_BAR; }
    PG8_BAR;
#undef PG8_SA
#undef PG8_SB
#undef PG8_STAGE
#undef PG8_STAGE_A
#undef PG8_GVOFF
#undef PG8_LDA
#undef PG8_LDB
#undef PG8_MMA
#undef PG8_WAIT_V
#undef PG8_WAIT_L
#undef PG8_BAR
#undef PG8_SCHED
}

struct SchedPlain : StaticOrder {
    static constexpr bool GATHER = false;
    const char* A; const char* B; size_t tA, tB;
    __device__ __forceinline__ const char* a_base(const Unit& u) const { return A + (size_t)u.pm * tA; }
    __device__ __forceinline__ const char* b_base(const Unit& u) const { return B + (size_t)u.pn * tB; }
    __device__ __forceinline__ unsigned gvoff(int, int, int, int) const { return 0u; }
};
struct SchedMoe : StaticOrder {
    const char* A; const char* B; size_t tA, tB, eB; int panel0; const LAS int* seg; const LAS int* tok;
    __device__ __forceinline__ int expert(const Unit& u) const { const int row = (panel0 + u.pm) * 256; int e = 0;
#pragma unroll
        for (int j = 1; j < NE; ++j) e += (row >= seg[j]) ? 1 : 0;
        return e; }
    __device__ __forceinline__ const char* b_base(const Unit& u) const { return B + (size_t)expert(u) * eB + (size_t)u.pn * tB; }
};
struct SchedMoeUp : SchedMoe {
    static constexpr bool GATHER = true;
    __device__ __forceinline__ const char* a_base(const Unit&) const { return A; }
    __device__ __forceinline__ unsigned gvoff(int ui, int row, int col, int K) const { const int e = tok[ui * 256 + row]; const int t = e < 0 ? 0 : (e >> 1); return (unsigned)(t * K + col) * 2u; }
};
struct SchedMoeDown : SchedMoe {
    static constexpr bool GATHER = false;
    __device__ __forceinline__ const char* a_base(const Unit& u) const { return A + (size_t)u.pm * tA; }
    __device__ __forceinline__ unsigned gvoff(int, int, int, int) const { return 0u; }
};

typedef f32x4 Acc[2][2][4][2];
__device__ __forceinline__ v4u pack8(f32x4 v0, f32x4 v1) { v4u w; w.x = cvt_pk_bf16(v0[0], v0[1]); w.y = cvt_pk_bf16(v0[2], v0[3]); w.z = cvt_pk_bf16(v1[0], v1[1]); w.w = cvt_pk_bf16(v1[2], v1[3]); return w; }
__device__ __forceinline__ void unpack8(v4u w, f32x4& v0, f32x4& v1) { v0 = (f32x4){bf_lo(w.x), bf_hi(w.x), bf_lo(w.y), bf_hi(w.y)}; v1 = (f32x4){bf_lo(w.z), bf_hi(w.z), bf_lo(w.w), bf_hi(w.w)}; }

struct EpiInProj {
    static constexpr bool PERM = true;
    bf16* big;
    __device__ __forceinline__ void operator()(const Acc& acc, const Unit& u, int, int wr, int wc, int fr, int fq) const {
        const int t = u.pn; bf16* base; int ldc, colt; float sc = 1.f;
        if (t < 12) { const int pl = t >> 1; base = big + (size_t)pl * ((size_t)M * WH); ldc = WH; colt = (t & 1) * 256; if (pl == 0 || pl == 3) sc = C2; }
        else { const int g = (t - 12) >> 2; base = big + (size_t)6 * ((size_t)M * WH) + (size_t)g * ((size_t)M * D); ldc = D; colt = ((t - 12) & 3) * 256; }
        const int row0 = u.pm * BM + wr * 64 + fr, col0 = colt + wc * 32 + 8 * fq;
#pragma unroll
        for (int ai = 0; ai < 2; ++ai)
#pragma unroll
            for (int m = 0; m < 4; ++m) { bf16* rowp = base + (size_t)(row0 + ai * HALF + m * 16) * ldc + col0;
#pragma unroll
                for (int bj = 0; bj < 2; ++bj) *(v4u*)(rowp + bj * HALF) = pack8(acc[ai][bj][m][0] * sc, acc[ai][bj][m][1] * sc); }
    }
};
struct EpiBf16 {
    static constexpr bool PERM = true;
    bf16* O; int ldc;
    __device__ __forceinline__ void operator()(const Acc& acc, const Unit& u, int, int wr, int wc, int fr, int fq) const {
        const int row0 = u.pm * BM + wr * 64 + fr, col0 = u.pn * BM + wc * 32 + 8 * fq;
#pragma unroll
        for (int ai = 0; ai < 2; ++ai)
#pragma unroll
            for (int m = 0; m < 4; ++m) { bf16* rowp = O + (size_t)(row0 + ai * HALF + m * 16) * ldc + col0;
#pragma unroll
                for (int bj = 0; bj < 2; ++bj) *(v4u*)(rowp + bj * HALF) = pack8(acc[ai][bj][m][0], acc[ai][bj][m][1]); }
    }
};
template <bool ADD> struct EpiGate {
    static constexpr bool PERM = true;
    const bf16* G; bf16* T;
    __device__ __forceinline__ void operator()(const Acc& acc, const Unit& u, int, int wr, int wc, int fr, int fq) const {
        const int row0 = u.pm * BM + wr * 64 + fr, col0 = u.pn * BM + wc * 32 + 8 * fq;
#pragma unroll
        for (int ai = 0; ai < 2; ++ai)
#pragma unroll
            for (int m = 0; m < 4; ++m) { const size_t off = (size_t)(row0 + ai * HALF + m * 16) * D + col0;
#pragma unroll
                for (int bj = 0; bj < 2; ++bj) { const v4u gw = *(const v4u*)(G + off + bj * HALF); f32x4 g0, g1; unpack8(gw, g0, g1);
                    f32x4 t0 = {0.f, 0.f, 0.f, 0.f}, t1 = {0.f, 0.f, 0.f, 0.f};
                    if (ADD) { const v4u tw = *(const v4u*)(T + off + bj * HALF); unpack8(tw, t0, t1); }
                    f32x4 o0, o1;
#pragma unroll
                    for (int c = 0; c < 4; ++c) { o0[c] = t0[c] + sigmoidf_(g0[c]) * acc[ai][bj][m][0][c]; o1[c] = t1[c] + sigmoidf_(g1[c]) * acc[ai][bj][m][1][c]; }
                    *(v4u*)(T + off + bj * HALF) = pack8(o0, o1); } }
    }
};
struct EpiSwiGLU {
    static constexpr bool PERM = true;
    bf16* O;
    __device__ __forceinline__ void operator()(const Acc& acc, const Unit& u, int, int wr, int wc, int fr, int fq) const {
        const int row0 = u.pm * BM + wr * 64 + fr, col0 = u.pn * HALF + wc * 32 + 8 * fq;
#pragma unroll
        for (int ai = 0; ai < 2; ++ai)
#pragma unroll
            for (int m = 0; m < 4; ++m) { f32x4 o0, o1;
#pragma unroll
                for (int c = 0; c < 4; ++c) { const float a = acc[ai][0][m][0][c], b = acc[ai][0][m][1][c]; o0[c] = a * sigmoidf_(a) * acc[ai][1][m][0][c]; o1[c] = b * sigmoidf_(b) * acc[ai][1][m][1][c]; }
                *(v4u*)(O + (size_t)(row0 + ai * HALF + m * 16) * FF + col0) = pack8(o0, o1); }
    }
};
struct EpiMoeDown {
    static constexpr bool PERM = true;
    bf16* YP; const LAS int* tok;
    __device__ __forceinline__ void operator()(const Acc& acc, const Unit& u, int ui, int wr, int wc, int fr, int fq) const {
        const int r0 = wr * 64 + fr, col0 = u.pn * BM + wc * 32 + 8 * fq;
#pragma unroll
        for (int ai = 0; ai < 2; ++ai)
#pragma unroll
            for (int m = 0; m < 4; ++m) { const int e = tok[ui * 256 + r0 + ai * HALF + m * 16];
                if (e >= 0) { bf16* rowp = YP + (size_t)e * D + col0;
#pragma unroll
                    for (int bj = 0; bj < 2; ++bj) *(v4u*)(rowp + bj * HALF) = pack8(acc[ai][bj][m][0], acc[ai][bj][m][1]); } }
    }
};
}

namespace att {
constexpr int PITCH = WH;
constexpr int SLOTB = 8192;
constexpr int L_K = 0, L_V = 2 * SLOTB, L_WS = 4 * SLOTB, L_OST = L_WS + NWAVES * 64 * 4, L_KPART = L_OST + NWAVES * 4096, L_KMEAN = L_KPART + 8 * 8 * 64 * 4, L_SEL = L_KMEAN + 8 * 64 * 4, L_LUT = L_SEL + 256, L_END = L_LUT + 512;
static_assert(L_END <= RING_BYTES, "attention LDS");
__device__ __forceinline__ int crow(int r, int hi) { return (r & 3) + 8 * (r >> 2) + 4 * hi; }
__device__ __forceinline__ void glds16(const void* gsrc, unsigned lds_dst) { unsigned keep;
    asm volatile("s_mov_b32 %0, m0\n\ts_mov_b32 m0, %2\n\ts_nop 0\n\tglobal_load_lds_dwordx4 %1, off\n\ts_mov_b32 m0, %0" : "=&s"(keep) : "v"(gsrc), "s"(lds_dst) : "memory"); }
#define ATT_WAIT_BAR() asm volatile("s_waitcnt vmcnt(0) lgkmcnt(0)\n\ts_barrier" ::: "memory")
__device__ const unsigned char REL_BUCKET_LUT[128] = {0, 1, 2, 3, 4, 5, 6, 7, 8, 9, 10, 11, 12, 13, 14, 15, 16, 16, 16, 17, 17, 18, 18, 18, 19, 19, 19, 20, 20, 20, 20, 21, 21, 21, 21, 22, 22, 22, 22, 22, 23, 23, 23, 23, 23, 23, 24, 24, 24, 24, 24, 24, 25, 25, 25, 25, 25, 25, 25, 26, 26, 26, 26, 26, 26, 26, 26, 27, 27, 27, 27, 27, 27, 27, 27, 27, 27, 28, 28, 28, 28, 28, 28, 28, 28, 28, 28, 29, 29, 29, 29, 29, 29, 29, 29, 29, 29, 29, 29, 30, 30, 30, 30, 30, 30, 30, 30, 30, 30, 30, 30, 30, 30, 31, 31, 31, 31, 31, 31, 31, 31, 31, 31, 31, 31, 31, 31, 31};

__device__ __forceinline__ void qkt(f32x16& p0, f32x16& p1, const LAS char* Kslot, const bf16x8* qr, const f32x16& cinit, int r32, int hi) {
    const LAS char* kb = Kslot + hi * 1024 + r32 * 16;
#pragma unroll
    for (int d0 = 0; d0 < 4; ++d0) {
        const bf16x8 b0 = *(const LAS bf16x8*)(kb + d0 * 2048);
        const bf16x8 b1 = *(const LAS bf16x8*)(kb + d0 * 2048 + 512);
        if (d0 == 0) { p0 = __builtin_amdgcn_mfma_f32_32x32x16_bf16(b0, qr[0], cinit, 0, 0, 0); p1 = __builtin_amdgcn_mfma_f32_32x32x16_bf16(b1, qr[0], cinit, 0, 0, 0); }
        else { p0 = __builtin_amdgcn_mfma_f32_32x32x16_bf16(b0, qr[d0], p0, 0, 0, 0); p1 = __builtin_amdgcn_mfma_f32_32x32x16_bf16(b1, qr[d0], p1, 0, 0, 0); }
    }
}
__device__ __forceinline__ void pv(f32x16* o, int vb, bf16x8 pa0, bf16x8 pa1, bf16x8 pa2, bf16x8 pa3) {
#pragma unroll
    for (int d0 = 0; d0 < 2; ++d0) { s16x4 lo[4], hi[4];
#pragma unroll
        for (int ks = 0; ks < 4; ++ks) {
            asm volatile("ds_read_b64_tr_b16 %0,%1 offset:%c2" : "=&v"(lo[ks]) : "v"(vb), "i"(d0 * 4096 + ks * 1024) : "memory");
            asm volatile("ds_read_b64_tr_b16 %0,%1 offset:%c2" : "=&v"(hi[ks]) : "v"(vb), "i"(d0 * 4096 + ks * 1024 + 512) : "memory"); }
        asm volatile("s_waitcnt lgkmcnt(0)" ::: "memory"); __builtin_amdgcn_sched_barrier(0);
#define ATT_PK(k) (bf16x8){lo[k][0], lo[k][1], lo[k][2], lo[k][3], hi[k][0], hi[k][1], hi[k][2], hi[k][3]}
        o[d0] = __builtin_amdgcn_mfma_f32_32x32x16_bf16(pa0, ATT_PK(0), o[d0], 0, 0, 0);
        o[d0] = __builtin_amdgcn_mfma_f32_32x32x16_bf16(pa1, ATT_PK(1), o[d0], 0, 0, 0);
        o[d0] = __builtin_amdgcn_mfma_f32_32x32x16_bf16(pa2, ATT_PK(2), o[d0], 0, 0, 0);
        o[d0] = __builtin_amdgcn_mfma_f32_32x32x16_bf16(pa3, ATT_PK(3), o[d0], 0, 0, 0);
#undef ATT_PK
    }
}
__device__ __forceinline__ bf16x8 pack8r(const f32x16& p, int b) { v4u w; w.x = cvt_pk_bf16(p[b], p[b + 1]); w.y = cvt_pk_bf16(p[b + 2], p[b + 3]); w.z = cvt_pk_bf16(p[b + 4], p[b + 5]); w.w = cvt_pk_bf16(p[b + 6], p[b + 7]); return __builtin_bit_cast(bf16x8, w); }
__device__ __forceinline__ f32x16 splat16(float v) { f32x16 r;
#pragma unroll
    for (int i = 0; i < 16; ++i) r[i] = v;
    return r; }

template <bool MOBA>
__device__ __forceinline__ void attn_unit(int b, int h, int qb, const bf16* Q, const bf16* __restrict__ Kp, const bf16* __restrict__ Vp, bf16* O, const float* rel_bias, LAS unsigned char* shm) {
    const int tid = otid(), lane = tid & 63, r32 = lane & 31, hi = lane >> 5; const int wid = __builtin_amdgcn_readfirstlane(tid >> 6);
    const long rowbase = (long)b * SEQ; const int q0 = qb * 256;
    const bf16* Qw = Q + (rowbase + q0 + wid * 32) * PITCH + h * HD;
    const bf16* Kh = Kp + rowbase * PITCH + h * HD; const bf16* Vh = Vp + rowbase * PITCH + h * HD;
    const unsigned lds0 = (unsigned)(uintptr_t)shm;
    LAS float* wsf = (LAS float*)(shm + L_WS) + wid * 64;
    const bf16* ksrc = Kh + (long)lane * PITCH + wid * 8;
    const bf16* vsrc = Vh + (long)(16 * (wid & 3) + (lane >> 2)) * PITCH + (wid >> 2) * 32 + (lane & 3) * 8;
    const unsigned kdst = lds0 + L_K + wid * 1024, vdst = lds0 + L_V + wid * 1024;
#define DMA_K(t, slot) glds16(ksrc + (long)(t) * 64 * PITCH, (unsigned)__builtin_amdgcn_readfirstlane(kdst + (slot)))
#define DMA_V(t, slot) glds16(vsrc + (long)(t) * 64 * PITCH, (unsigned)__builtin_amdgcn_readfirstlane(vdst + (slot)))
    const int vb0 = (int)(lds0 + L_V) + ((lane >> 4) & 1) * 32 + (lane & 3) * 8 + (4 * hi + ((lane & 15) >> 2)) * 64;
    const LAS char* Kbase = (const LAS char*)(shm + L_K);
    const int NT = 4 * (qb + 1);
    const int qrel = wid * 32 + r32;
    DMA_K(NT - 1, 0); DMA_V(NT - 1, 0);
    bf16x8 qr[4];
#pragma unroll
    for (int d0 = 0; d0 < 4; ++d0) qr[d0] = *(const bf16x8*)(&Qw[(long)r32 * PITCH + d0 * 16 + hi * 8]);
    float biasfar = 0.f; unsigned selmask = 0u;
    if constexpr (MOBA) {
        LAS float* KPART = (LAS float*)(shm + L_KPART); LAS float* KMEAN = (LAS float*)(shm + L_KMEAN); LAS unsigned char* SEL = (LAS unsigned char*)(shm + L_SEL); LAS float* LUT = (LAS float*)(shm + L_LUT);
        if (tid < 128) LUT[tid] = rel_bias[REL_BUCKET_LUT[tid] * NH + h] * LOG2E;
        const int dch = lane & 7, rs = lane >> 3;
        for (int mb = 0; mb < qb; ++mb) {
            float s[8];
#pragma unroll
            for (int c = 0; c < 8; ++c) s[c] = 0.f;
#pragma unroll
            for (int j = 0; j < 4; ++j) { const v4u w = *(const v4u*)(Kh + (long)(mb * 256 + wid * 32 + j * 8 + rs) * PITCH + dch * 8);
                s[0] += bf_lo(w.x); s[1] += bf_hi(w.x); s[2] += bf_lo(w.y); s[3] += bf_hi(w.y); s[4] += bf_lo(w.z); s[5] += bf_hi(w.z); s[6] += bf_lo(w.w); s[7] += bf_hi(w.w); }
#pragma unroll
            for (int c = 0; c < 8; ++c) { s[c] += shx(s[c], 8, lane); s[c] += shx(s[c], 16, lane); s[c] += shx(s[c], 32, lane); }
            if (rs == 0) {
#pragma unroll
                for (int c = 0; c < 8; ++c) KPART[(mb * 8 + wid) * 64 + dch * 8 + c] = s[c]; }
        }
        __syncthreads();
        { const int mb = tid >> 6, d = tid & 63; if (mb < qb) { float t = 0.f;
#pragma unroll
            for (int w = 0; w < 8; ++w) t += KPART[(mb * 8 + w) * 64 + d];
            KMEAN[mb * 64 + d] = t * (1.0f / 256.0f); } }
        __syncthreads();
        { const int q = tid >> 1, dh = tid & 1; const bf16* qp = Q + (rowbase + q0 + q) * PITCH + h * HD + dh * 32; float qv[32];
#pragma unroll
            for (int j = 0; j < 4; ++j) { const v4u w = *(const v4u*)(qp + j * 8); qv[j * 8 + 0] = bf_lo(w.x); qv[j * 8 + 1] = bf_hi(w.x); qv[j * 8 + 2] = bf_lo(w.y); qv[j * 8 + 3] = bf_hi(w.y); qv[j * 8 + 4] = bf_lo(w.z); qv[j * 8 + 5] = bf_hi(w.z); qv[j * 8 + 6] = bf_lo(w.w); qv[j * 8 + 7] = bf_hi(w.w); }
            float g[7];
#pragma unroll
            for (int mb = 0; mb < 7; ++mb) { float a = 0.f; if (mb < qb) {
#pragma unroll
                    for (int d = 0; d < 32; ++d) a += qv[d] * KMEAN[mb * 64 + dh * 32 + d]; }
                a += shx(a, 1, lane); g[mb] = a; }
            unsigned mask = 0u;
            if (qb <= 3) mask = (1u << qb) - 1u;
            else {
#pragma unroll
                for (int pass = 0; pass < 3; ++pass) { float best = -INFINITY; int bi = 0;
#pragma unroll
                    for (int mb = 0; mb < 7; ++mb) if (mb < qb && !((mask >> mb) & 1u) && g[mb] > best) { best = g[mb]; bi = mb; }
                    mask |= 1u << bi; } }
            if (dh == 0) SEL[q] = (unsigned char)mask; }
        __syncthreads();
        selmask = SEL[qrel]; biasfar = LUT[127];
    }
    f32x16 o[2]; o[0] = splat16(0.f); o[1] = splat16(0.f);
    float m_run = -INFINITY, l_run = 0.f, carry = 0.f;
    bf16x8 tri0, tri1, ones;
#pragma unroll
    for (int jj = 0; jj < 8; ++jj) { const int j0 = 8 * (jj >> 2) + 4 * hi + (jj & 3); tri0[jj] = (j0 >= r32) ? (short)0x3F80 : (short)0; tri1[jj] = (16 + j0 >= r32) ? (short)0x3F80 : (short)0; ones[jj] = (short)0x3F80; }
    const int jd = wid >> 1;
    for (int i = 0; i < NT; ++i) {
        const int kt = NT - 1 - i; const int slot = (i & 1) * SLOTB;
        ATT_WAIT_BAR();
        if (i + 1 < NT) { DMA_K(kt - 1, slot ^ SLOTB); DMA_V(kt - 1, slot ^ SLOTB); }
        const int jb = kt - (NT - 4);
        if (jb > jd) continue;
        const bool diag = (jb == jd);
        f32x16 p0, p1;
        if constexpr (MOBA) {
            const bool band = jb >= 0; const int mblk = kt >> 2;
            const bool sel = band || ((selmask >> mblk) & 1u);
            if (!__any(sel)) continue;
            const int dmin = (q0 + wid * 32) - (64 * kt + 63);
            const bool near = dmin < 113;
            const float ci = sel ? (near ? 0.f : biasfar) : -INFINITY;
            const f32x16 cinit = splat16(ci);
            qkt(p0, p1, Kbase + slot, qr, cinit, r32, hi);
            if (near) { const LAS float* LUT = (const LAS float*)(shm + L_LUT); const int dq = (q0 + qrel) - 64 * kt;
#pragma unroll
                for (int r = 0; r < 16; ++r) { const int d0_ = dq - crow(r, hi), d1_ = d0_ - 32;
                    const float b0 = LUT[d0_ < 0 ? 0 : (d0_ > 127 ? 127 : d0_)], b1 = LUT[d1_ < 0 ? 0 : (d1_ > 127 ? 127 : d1_)];
                    p0[r] = (d0_ < 0) ? -INFINITY : p0[r] + b0; p1[r] = (d1_ < 0) ? -INFINITY : p1[r] + b1; } }
            float rm = p0[0];
#pragma unroll
            for (int r = 1; r < 16; ++r) rm = fmaxf(rm, p0[r]);
#pragma unroll
            for (int r = 0; r < 16; ++r) rm = fmaxf(rm, p1[r]);
            rm = fmaxf(rm, shx(rm, 32, lane));
            const float m_new = fmaxf(m_run, rm);
            const float alpha = (m_new == -INFINITY) ? 1.f : fast_exp2(m_run - m_new);
            const float msub = (m_new == -INFINITY) ? 0.f : m_new;
            float ls = 0.f;
#pragma unroll
            for (int r = 0; r < 16; ++r) { p0[r] = fast_exp2(p0[r] - msub); p1[r] = fast_exp2(p1[r] - msub); ls += p0[r] + p1[r]; }
            l_run = l_run * alpha + ls; m_run = m_new;
            if (__any(alpha != 1.f)) { if (hi == 0) wsf[r32] = alpha; LDS_WAIT();
#pragma unroll
                for (int d_ = 0; d_ < 2; ++d_)
#pragma unroll
                    for (int r = 0; r < 16; ++r) o[d_][r] *= wsf[crow(r, hi)];
                LDS_WAIT(); }
        } else {
            const f32x16 zero = splat16(0.f);
            qkt(p0, p1, Kbase + slot, qr, zero, r32, hi);
            f32x16 s0, s1;
            const int kq = qrel - 64 * (jb < 0 ? 0 : jb);
#pragma unroll
            for (int r = 0; r < 16; ++r) { const float z0 = p0[r], z1 = p1[r];
                float a0 = fmaxf(z0, fast_log2(1.0f + fast_exp2(fminf(z0, 64.f)))), a1 = fmaxf(z1, fast_log2(1.0f + fast_exp2(fminf(z1, 64.f))));
                if (diag) { const int kv = crow(r, hi); if (kv >= kq) a0 = 0.f; if (kv + 32 >= kq) a1 = 0.f; }
                s0[r] = a0; s1[r] = a1; }
            const bf16x8 L0 = pack8r(s0, 0), L1 = pack8r(s0, 8), L2 = pack8r(s1, 0), L3 = pack8r(s1, 8);
            const f32x16 c16 = splat16(carry);
            f32x16 W0 = __builtin_amdgcn_mfma_f32_32x32x16_bf16(tri0, L0, c16, 0, 0, 0);
            W0 = __builtin_amdgcn_mfma_f32_32x32x16_bf16(tri1, L1, W0, 0, 0, 0);
            W0 = __builtin_amdgcn_mfma_f32_32x32x16_bf16(ones, L2, W0, 0, 0, 0);
            W0 = __builtin_amdgcn_mfma_f32_32x32x16_bf16(ones, L3, W0, 0, 0, 0);
            f32x16 W1 = __builtin_amdgcn_mfma_f32_32x32x16_bf16(tri0, L2, c16, 0, 0, 0);
            W1 = __builtin_amdgcn_mfma_f32_32x32x16_bf16(tri1, L3, W1, 0, 0, 0);
            carry = shl(W0[0], r32);
#pragma unroll
            for (int r = 0; r < 16; ++r) { float e0 = fast_exp2(p0[r] - W0[r]), e1 = fast_exp2(p1[r] - W1[r]);
                if (diag) { const int kv = crow(r, hi); if (kv >= kq) e0 = 0.f; if (kv + 32 >= kq) e1 = 0.f; }
                p0[r] = e0; p1[r] = e1; }
        }
        pv(o, vb0 + slot, pack8r(p0, 0), pack8r(p0, 8), pack8r(p1, 0), pack8r(p1, 8));
    }
    float rli[16];
    if constexpr (MOBA) {
        l_run += shx(l_run, 32, lane);
        if (hi == 0) wsf[32 + r32] = l_run; LDS_WAIT();
#pragma unroll
        for (int r = 0; r < 16; ++r) rli[r] = fast_rcp(wsf[32 + crow(r, hi)]);
    } else {
#pragma unroll
        for (int r = 0; r < 16; ++r) rli[r] = 1.f;
    }
    bf16* Ow = O + (rowbase + q0 + wid * 32) * PITCH + h * HD;
    { LAS bf16* stg = (LAS bf16*)(shm + L_OST) + wid * 2048;
#pragma unroll
        for (int r = 0; r < 16; ++r) { const int orow = crow(r, hi);
#pragma unroll
            for (int d0 = 0; d0 < 2; ++d0) stg[orow * 64 + d0 * 32 + r32] = (bf16)f2bf(o[d0][r] * rli[r]); }
        LDS_WAIT();
#pragma unroll
        for (int i = 0; i < 4; ++i) { const int row = i * 8 + (lane >> 3), ch = lane & 7; const v4u v = *(const LAS v4u*)(stg + row * 64 + ch * 8); *(v4u*)(Ow + (long)row * PITCH + ch * 8) = v; } }
    asm volatile("s_waitcnt lgkmcnt(0)\n\ts_barrier" ::: "memory");
#undef DMA_K
#undef DMA_V
}
}

struct Args { const float* in[20]; float* out; unsigned char* ws; int ph_lo, ph_hi; };
struct Frame {
    LAS unsigned char* lds; gu32* ctl; int tid, lane, wave, vcu, G;
};
#define FRESH(F) do { (F).tid = otid(); (F).lane = (F).tid & 63; (F).wave = __builtin_amdgcn_readfirstlane((F).tid >> 6); } while (0)
__device__ __forceinline__ float wave_sum(float v, int lane) {
#pragma unroll
    for (int o = 1; o < 64; o <<= 1) v += shx(v, o, lane);
    return v;
}
__device__ __forceinline__ void transpose_item(const float* W, int K, int N, bf16* WT, int mode, LAS float* scr, int item, int lane) {
    const int nblk = N / 32, kb = item / nblk, nb = item % nblk, k0 = 64 * kb, n0 = 32 * nb;
    const int rbase = (mode == 0) ? n0 : (256 * (n0 >> 7) + (n0 & 127) + (mode == 2 ? 128 : 0));
#pragma unroll 8
    for (int i = 0; i < 32; ++i) { const int kk = 2 * i + (lane >> 5); scr[kk * 33 + (lane & 31)] = W[(size_t)(k0 + kk) * N + n0 + (lane & 31)]; }
    LDS_WAIT(); asm volatile("" ::: "memory");
    const int c = lane & 7;
#pragma unroll
    for (int j = 0; j < 4; ++j) { const int n = (lane >> 3) + 8 * j; const LAS float* s = scr + (8 * c) * 33 + n;
        v4u o; o.x = pk2(s[0 * 33], s[1 * 33]); o.y = pk2(s[2 * 33], s[3 * 33]); o.z = pk2(s[4 * 33], s[5 * 33]); o.w = pk2(s[6 * 33], s[7 * 33]);
        *(GAS v4u*)(WT + (size_t)(rbase + n) * K + k0 + 8 * c) = o; }
    LDS_WAIT(); asm volatile("" ::: "memory");
}

struct RowArgs { const float* xin; float* xout; const bf16* Y; const float2* tokw_in; const float* gpost; const float* gate; const float* gpre; const float* shift; const float* scale; bf16* H;
                 const float* wrouter; int* lists; float2* tokw_out; unsigned* cnt; };
template <bool HAS_Y, bool PAIR, bool WRITE_H, bool ROUTER>
__device__ __forceinline__ void row_phase(Frame& F, const RowArgs& a) {
    FRESH(F);
    const int lane = F.lane; const int gw = F.vcu * NWAVES + F.wave; const int rows_per_wave = M / (F.G * NWAVES);
    const int m0 = gw * rows_per_wave; const int b = (F.vcu * NWAVES * rows_per_wave) / SEQ;
    LAS float* wr = (LAS float*)F.lds;
    LAS float* vec = (LAS float*)(F.lds + 32768);
    if constexpr (ROUTER) { for (int i = F.tid; i < D * NE / 4; i += NTHREADS) ((LAS f32x4*)wr)[i] = ((const f32x4*)a.wrouter)[i]; }
    for (int i = F.tid; i < D; i += NTHREADS) {
        if (HAS_Y) { vec[i] = a.gpost[i]; vec[D + i] = a.gate[(size_t)b * NMOD + i]; }
        if (WRITE_H) { vec[2 * D + i] = a.gpre[i]; vec[3 * D + i] = a.shift[(size_t)b * NMOD + i]; vec[4 * D + i] = a.scale[(size_t)b * NMOD + i] + 1.0f; } }
    __syncthreads();
    int my_e0 = -1, my_e1 = -1; float my_w0 = 0.f, my_w1 = 0.f;
    for (int i = 0; i < rows_per_wave; ++i) { const int m = m0 + i;
        f32x4 x[4];
#pragma unroll
        for (int j = 0; j < 4; ++j) x[j] = *(const f32x4*)(a.xin + (size_t)m * D + 256 * j + 4 * lane);
        if constexpr (HAS_Y) {
            f32x4 y[4];
            if constexpr (PAIR) { const float2 w = a.tokw_in[m];
#pragma unroll
                for (int j = 0; j < 4; ++j) { const v2u u0 = *(const v2u*)(a.Y + (size_t)(2 * m) * D + 256 * j + 4 * lane), u1 = *(const v2u*)(a.Y + (size_t)(2 * m + 1) * D + 256 * j + 4 * lane);
                    y[j] = (f32x4){w.x * bf_lo(u0.x) + w.y * bf_lo(u1.x), w.x * bf_hi(u0.x) + w.y * bf_hi(u1.x), w.x * bf_lo(u0.y) + w.y * bf_lo(u1.y), w.x * bf_hi(u0.y) + w.y * bf_hi(u1.y)}; }
            } else {
#pragma unroll
                for (int j = 0; j < 4; ++j) { const v2u u0 = *(const v2u*)(a.Y + (size_t)m * D + 256 * j + 4 * lane); y[j] = (f32x4){bf_lo(u0.x), bf_hi(u0.x), bf_lo(u0.y), bf_hi(u0.y)}; }
            }
            float s = 0.f;
#pragma unroll
            for (int j = 0; j < 4; ++j) s += (y[j].x * y[j].x + y[j].y * y[j].y) + (y[j].z * y[j].z + y[j].w * y[j].w);
            const float rstd = 1.0f / sqrtf(wave_sum(s, lane) * (1.0f / D) + EPS);
#pragma unroll
            for (int j = 0; j < 4; ++j) { const f32x4 gp = *(const LAS f32x4*)(vec + 256 * j + 4 * lane), gt = *(const LAS f32x4*)(vec + D + 256 * j + 4 * lane);
                x[j] = x[j] + gt * ((y[j] * rstd) * gp); *(f32x4*)(a.xout + (size_t)m * D + 256 * j + 4 * lane) = x[j]; }
        }
        if constexpr (WRITE_H) {
            float s = 0.f;
#pragma unroll
            for (int j = 0; j < 4; ++j) s += (x[j].x * x[j].x + x[j].y * x[j].y) + (x[j].z * x[j].z + x[j].w * x[j].w);
            const float rstd = 1.0f / sqrtf(wave_sum(s, lane) * (1.0f / D) + EPS);
#pragma unroll
            for (int j = 0; j < 4; ++j) { const f32x4 gp = *(const LAS f32x4*)(vec + 2 * D + 256 * j + 4 * lane), sh = *(const LAS f32x4*)(vec + 3 * D + 256 * j + 4 * lane), sc = *(const LAS f32x4*)(vec + 4 * D + 256 * j + 4 * lane);
                x[j] = ((x[j] * rstd) * gp) * sc + sh;
                v2u o; o.x = pk2(x[j].x, x[j].y); o.y = pk2(x[j].z, x[j].w); *(v2u*)(a.H + (size_t)m * D + 256 * j + 4 * lane) = o; }
            if constexpr (ROUTER) {
                float lg[NE];
#pragma unroll
                for (int e = 0; e < NE; ++e) lg[e] = 0.f;
#pragma unroll
                for (int j = 0; j < 4; ++j)
#pragma unroll
                    for (int c = 0; c < 4; ++c) { const LAS f32x4* wp = (const LAS f32x4*)(wr + (size_t)(256 * j + 4 * lane + c) * NE); const f32x4 w0 = wp[0], w1 = wp[1]; const float hvv = x[j][c];
                        lg[0] += hvv * w0.x; lg[1] += hvv * w0.y; lg[2] += hvv * w0.z; lg[3] += hvv * w0.w; lg[4] += hvv * w1.x; lg[5] += hvv * w1.y; lg[6] += hvv * w1.z; lg[7] += hvv * w1.w;
                        if (c == 3) asm volatile("" ::: "memory"); }
#pragma unroll
                for (int e = 0; e < NE; ++e) lg[e] = wave_sum(lg[e], lane);
                int e0 = 0; float v0 = lg[0];
#pragma unroll
                for (int e = 1; e < NE; ++e) if (lg[e] > v0) { v0 = lg[e]; e0 = e; }
                int e1 = -1; float v1 = -INFINITY;
#pragma unroll
                for (int e = 0; e < NE; ++e) if (e != e0 && lg[e] > v1) { v1 = lg[e]; e1 = e; }
                const float t = fast_exp2((v1 - v0) * LOG2E); const float w0 = 1.0f / (1.0f + t), w1 = t / (1.0f + t);
                if (lane == i) { my_e0 = e0; my_e1 = e1; my_w0 = w0; my_w1 = w1; }
            }
        }
    }
    if constexpr (ROUTER) {
        const bool act = lane < rows_per_wave; int pos0 = 0, pos1 = 0;
        const unsigned long long lt = (1ull << lane) - 1ull;
#pragma unroll
        for (int e = 0; e < NE; ++e) { const unsigned long long b0 = __ballot(act && my_e0 == e), b1 = __ballot(act && my_e1 == e);
            const int n0 = __popcll(b0), n1 = __popcll(b1); int base = 0;
            if (n0 + n1 > 0) { if (lane == 0) base = (int)__hip_atomic_fetch_add(a.cnt + 64 * e, (unsigned)(n0 + n1), RLX_AGENT); base = __builtin_amdgcn_readfirstlane(base); }
            if (act && my_e0 == e) pos0 = base + __popcll(b0 & lt);
            if (act && my_e1 == e) pos1 = base + n0 + __popcll(b1 & lt); }
        if (act) { const int m = m0 + lane; a.lists[my_e0 * M + pos0] = 2 * m; a.lists[my_e1 * M + pos1] = 2 * m + 1; a.tokw_out[m] = make_float2(my_w0, my_w1); }
    }
    __syncthreads();
}

template <class Sched>
__device__ __forceinline__ void moe_tables(Frame& F, const Sched& S, const int* lists, int panel0) {
    FRESH(F);
    LAS int* seg = (LAS int*)(F.lds + LDS_SEG); LAS int* tok = (LAS int*)(F.lds + LDS_TOK);
    if (F.tid == 0) { int acc = 0;
        for (int e = 0; e < NE; ++e) { const int c = (int)__hip_atomic_load((unsigned*)(F.ctl + CW_CNT + 64 * e), RLX_AGENT); seg[e] = acc; seg[16 + e] = c; acc += (c + 255) & ~255; }
        seg[8] = acc; }
    __syncthreads();
    pg8::Unit u;
    for (int ui = 0; ui < LDS_TOK_UNITS && S.next(ui, u); ++ui) {
        if (F.tid < 256) { const int row = (panel0 + u.pm) * 256 + F.tid; int e = 0;
#pragma unroll
            for (int j = 1; j < NE; ++j) e += (row >= seg[j]) ? 1 : 0;
            const int pos = row - seg[e]; tok[ui * 256 + F.tid] = (pos < seg[16 + e]) ? lists[e * M + pos] : -1; }
    }
    __syncthreads();
}

constexpr int PH_LAYER0 = 2, PH_STRIDE = 16, PH_END = PH_LAYER0 + 2 * PH_STRIDE;
__global__ void __launch_bounds__(NTHREADS, 2) mega_fwd(Args args) {
    extern __shared__ __attribute__((aligned(16))) unsigned char lds_raw[];
    Frame F; F.lds = (LAS unsigned char*)lds_raw; F.tid = threadIdx.x; F.lane = F.tid & 63; F.wave = __builtin_amdgcn_readfirstlane(F.tid >> 6);
    F.G = gridDim.x; { const int bx = blockIdx.x; F.vcu = (F.G % 8 == 0) ? (bx % 8) * (F.G / 8) + bx / 8 : bx; }
    unsigned char* ws = args.ws; F.ctl = (gu32*)(ws + WS_CTL);
    volatile LAS unsigned* MISC = (volatile LAS unsigned*)(F.lds + LDS_MISC);
    if (F.tid < 16) MISC[F.tid] = 0u;
    __syncthreads();
    XcdBarrier bar; bar.bar = (unsigned*)(F.ctl + CW_BAR); bar.x = 0; bar.st = nullptr;
    if (MK_ONE_LAUNCH) bar = xcd_barrier_post((unsigned*)(F.ctl + CW_BAR), MISC);
    const int lo = args.ph_lo, hi = args.ph_hi;
#define IN(k) (lo <= (k) && (k) < hi)
#define SEAM(k, knext) do { if (IN(k) && IN(knext)) xcd_barrier(bar); } while (0)
    const float* x_in = args.in[0]; const float* c_in = args.in[1]; const float* w_mod = args.in[2]; const float* b_mod = args.in[3];
    const float* g_mix_pre = args.in[4]; const float* g_mix_post = args.in[5]; const float* g_ffn_pre = args.in[6]; const float* g_ffn_post = args.in[7];
    const float* w_in = args.in[8]; const float* w_psb = args.in[9]; const float* w_pmb = args.in[10]; const float* w_out = args.in[11]; const float* rel_bias = args.in[12];
    const float* w1d = args.in[13]; const float* w3d = args.in[14]; const float* w2d = args.in[15]; const float* w_router = args.in[16];
    const float* w1m = args.in[17]; const float* w3m = args.in[18]; const float* w2m = args.in[19];
    float* xout = args.out;
    float* MOD = (float*)(ws + WS_MOD); int* LISTS = (int*)(ws + WS_LIST); float2* TOKW = (float2*)(ws + WS_TOKW);
    bf16* WIN = (bf16*)(ws + WS_WIN); bf16* WPSB = (bf16*)(ws + WS_WPSB); bf16* WPMB = (bf16*)(ws + WS_WPMB); bf16* WOUT = (bf16*)(ws + WS_WOUT);
    bf16* W13D = (bf16*)(ws + WS_W13D); bf16* W2D = (bf16*)(ws + WS_W2D); bf16* W13M = (bf16*)(ws + WS_W13M); bf16* W2M = (bf16*)(ws + WS_W2M);
    bf16* H = (bf16*)(ws + WS_H); bf16* BIG = (bf16*)(ws + WS_BIG);

    if (!SK(0) && IN(0)) {
        FRESH(F);
        if ((int)blockIdx.x < 192) {
            LAS float* cond = (LAS float*)F.lds;
            LAS float* part = (LAS float*)(F.lds + 65536);
            for (int i = F.tid; i < NB * D; i += NTHREADS) { const int bb = i / D, k = i % D; const float cv = c_in[i]; cond[k * 16 + bb] = cv * sigmoidf_(cv); }
            __syncthreads();
            const int l = (int)blockIdx.x / 96, n0 = ((int)blockIdx.x % 96) * 64;
            float acc[16];
#pragma unroll
            for (int bb = 0; bb < 16; ++bb) acc[bb] = 0.f;
            const float* wp = w_mod + (size_t)l * D * NMOD + n0 + F.lane;
#pragma unroll 4
            for (int kk = 0; kk < 128; ++kk) { const int k = F.wave * 128 + kk; const float wv = wp[(size_t)k * NMOD];
                const LAS f32x4* cp = (const LAS f32x4*)(cond + k * 16); const f32x4 c0 = cp[0], c1 = cp[1], c2 = cp[2], c3 = cp[3];
                acc[0] += c0.x * wv; acc[1] += c0.y * wv; acc[2] += c0.z * wv; acc[3] += c0.w * wv; acc[4] += c1.x * wv; acc[5] += c1.y * wv; acc[6] += c1.z * wv; acc[7] += c1.w * wv;
                acc[8] += c2.x * wv; acc[9] += c2.y * wv; acc[10] += c2.z * wv; acc[11] += c2.w * wv; acc[12] += c3.x * wv; acc[13] += c3.y * wv; acc[14] += c3.z * wv; acc[15] += c3.w * wv; }
#pragma unroll
            for (int bb = 0; bb < 16; ++bb) part[(F.wave * 16 + bb) * 64 + F.lane] = acc[bb];
            __syncthreads();
            for (int i = F.tid; i < 16 * 64; i += NTHREADS) { const int bb = i >> 6, n = i & 63; float s = b_mod[(size_t)l * NMOD + n0 + n];
#pragma unroll
                for (int w = 0; w < 8; ++w) s += part[(w * 16 + bb) * 64 + n];
                MOD[((size_t)l * NB + bb) * NMOD + n0 + n] = s; }
            __syncthreads();
        }
        LAS float* scr = (LAS float*)(F.lds + F.wave * 16384);
        const int gw = F.vcu * NWAVES + F.wave, NGW = F.G * NWAVES;
        constexpr int I_IN = (D / 64) * (INCOLS / 32), I_P = (WH / 64) * (D / 32), I_O = (D / 64) * (D / 32), I_13 = (D / 64) * (FF / 32), I_2 = (FF / 64) * (D / 32);
        constexpr int N_IN = 2 * I_IN, N_P = 4 * I_P, N_O = 2 * I_O, N_13 = 18 * I_13, N_2 = 9 * I_2, NITEMS = N_IN + N_P + N_O + N_13 + N_2;
        for (int it = gw; it < NITEMS; it += NGW) {
            int r = it;
            if (r < N_IN) { const int l = r / I_IN; transpose_item(w_in + (size_t)l * D * INCOLS, D, INCOLS, WIN + (size_t)l * INCOLS * D, 0, scr, r % I_IN, F.lane); continue; } r -= N_IN;
            if (r < N_P) { const int q = r / I_P, l = q & 1; const float* src = (q < 2 ? w_psb : w_pmb) + (size_t)l * WH * D; bf16* dst = (q < 2 ? WPSB : WPMB) + (size_t)l * D * WH; transpose_item(src, WH, D, dst, 0, scr, r % I_P, F.lane); continue; } r -= N_P;
            if (r < N_O) { const int l = r / I_O; transpose_item(w_out + (size_t)l * D * D, D, D, WOUT + (size_t)l * D * D, 0, scr, r % I_O, F.lane); continue; } r -= N_O;
            if (r < N_13) { const int q = r / I_13; const float* src; bf16* dst; int mode;
                if (q == 0) { src = w1d; dst = W13D; mode = 1; } else if (q == 1) { src = w3d; dst = W13D; mode = 2; }
                else if (q < 10) { src = w1m + (size_t)(q - 2) * D * FF; dst = W13M + (size_t)(q - 2) * 2 * FF * D; mode = 1; }
                else { src = w3m + (size_t)(q - 10) * D * FF; dst = W13M + (size_t)(q - 10) * 2 * FF * D; mode = 2; }
                transpose_item(src, D, FF, dst, mode, scr, r % I_13, F.lane); continue; } r -= N_13;
            { const int q = r / I_2; const float* src = (q == 0) ? w2d : w2m + (size_t)(q - 1) * FF * D; bf16* dst = (q == 0) ? W2D : W2M + (size_t)(q - 1) * D * FF; transpose_item(src, FF, D, dst, 0, scr, r % I_2, F.lane); }
        }
    }
    SEAM(0, 1);
    if (!SK(1) && IN(1)) {
        RowArgs a{}; a.xin = x_in; a.gpre = g_mix_pre; a.shift = MOD + 0 * D; a.scale = MOD + 1 * D; a.H = H;
        row_phase<false, false, true, false>(F, a);
    }
    SEAM(1, PH_LAYER0);

    for (int l = 0; l < 2; ++l) {
        const int pb = PH_LAYER0 + PH_STRIDE * l;
        const float* modl = MOD + (size_t)l * NB * NMOD;
        if (!SK(2) && IN(pb + 0)) {
            pg8::SchedPlain S; S.init(M / 256, INCOLS / 256, F.G, (int)blockIdx.x); S.A = (const char*)H; S.B = (const char*)(WIN + (size_t)l * INCOLS * D); S.tA = S.tB = (size_t)256 * D * 2;
            pg8::EpiInProj E{BIG};
            pg8::gemm_phase<pg8::EpiInProj, pg8::SchedPlain, true>(F.lds, D, S, E);
        }
        SEAM(pb + 0, pb + 1);
        if (!SK(3) && IN(pb + 1)) {
            bf16* QA = BIG + BIG_QA / 2; bf16* KA = BIG + BIG_KA / 2; bf16* VA = BIG + BIG_VA / 2; bf16* QB = BIG + BIG_QB / 2; bf16* KB = BIG + BIG_KB / 2; bf16* VB = BIG + BIG_VB / 2;
            for (int v = F.vcu; v < 256; v += F.G) { const int bh = v >> 1, set = v & 1;
                for (int i = 0; i < 8; ++i) { const int k = i & 3; const int qb = set == 0 ? (k == 0 ? 0 : k == 1 ? 7 : k == 2 ? 1 : 6) : (k == 0 ? 2 : k == 1 ? 5 : k == 2 ? 3 : 4);
                    if (i < 4) att::attn_unit<false>(bh >> 3, bh & 7, qb, QA, KA, VA, QA, rel_bias, F.lds);
                    else att::attn_unit<true>(bh >> 3, bh & 7, qb, QB, KB, VB, QB, rel_bias, F.lds); } }
        }
        SEAM(pb + 1, pb + 2);
        if (!SK(4) && IN(pb + 2)) {
            bf16* GA = BIG + BIG_GA / 2; bf16* GB = BIG + BIG_GB / 2;
            { pg8::SchedPlain S; S.init(M / 256, D / 256, F.G, (int)blockIdx.x); S.A = (const char*)(BIG + BIG_QA / 2); S.B = (const char*)(WPSB + (size_t)l * D * WH); S.tA = S.tB = (size_t)256 * WH * 2;
              pg8::EpiGate<false> E{GA, GA}; pg8::gemm_phase<pg8::EpiGate<false>, pg8::SchedPlain, true>(F.lds, WH, S, E); }
            VM_WAIT(); __syncthreads();
            { pg8::SchedPlain S; S.init(M / 256, D / 256, F.G, (int)blockIdx.x); S.A = (const char*)(BIG + BIG_QB / 2); S.B = (const char*)(WPMB + (size_t)l * D * WH); S.tA = S.tB = (size_t)256 * WH * 2;
              pg8::EpiGate<true> E{GB, GA}; pg8::gemm_phase<pg8::EpiGate<true>, pg8::SchedPlain, true>(F.lds, WH, S, E); }
        }
        SEAM(pb + 2, pb + 3);
        if (!SK(5) && IN(pb + 3)) {
            pg8::SchedPlain S; S.init(M / 256, D / 256, F.G, (int)blockIdx.x); S.A = (const char*)(BIG + BIG_GA / 2); S.B = (const char*)(WOUT + (size_t)l * D * D); S.tA = S.tB = (size_t)256 * D * 2;
            pg8::EpiBf16 E{BIG + BIG_Y / 2, D};
            pg8::gemm_phase<pg8::EpiBf16, pg8::SchedPlain, true>(F.lds, D, S, E);
        }
        SEAM(pb + 3, pb + 4);
        if (!SK(6) && IN(pb + 4)) {
            RowArgs a{}; a.xin = (l == 0) ? x_in : xout; a.xout = xout; a.Y = BIG + BIG_Y / 2; a.gpost = g_mix_post + (size_t)l * D; a.gate = modl + 2 * D;
            a.gpre = g_ffn_pre + (size_t)l * D; a.shift = modl + 3 * D; a.scale = modl + 4 * D; a.H = H;
            a.wrouter = w_router; a.lists = LISTS; a.tokw_out = TOKW; a.cnt = (unsigned*)(F.ctl + CW_CNT);
            if (l == 0) row_phase<true, false, true, false>(F, a); else row_phase<true, false, true, true>(F, a);
        }
        SEAM(pb + 4, pb + 5);
        if (l == 0) {
            if (!SK(7) && IN(pb + 5)) {
                pg8::SchedPlain S; S.init(M / 256, 2 * FF / 256, F.G, (int)blockIdx.x); S.A = (const char*)H; S.B = (const char*)W13D; S.tA = S.tB = (size_t)256 * D * 2;
                pg8::EpiSwiGLU E{BIG + BIG_ACT / 2};
                pg8::gemm_phase<pg8::EpiSwiGLU, pg8::SchedPlain, true>(F.lds, D, S, E);
            }
            SEAM(pb + 5, pb + 6);
            if (!SK(8) && IN(pb + 6)) {
                pg8::SchedPlain S; S.init(M / 256, D / 256, F.G, (int)blockIdx.x); S.A = (const char*)(BIG + BIG_ACT / 2); S.B = (const char*)W2D; S.tA = S.tB = (size_t)256 * FF * 2;
                pg8::EpiBf16 E{BIG + BIG_YF / 2, D};
                pg8::gemm_phase<pg8::EpiBf16, pg8::SchedPlain, true>(F.lds, FF, S, E);
            }
            SEAM(pb + 6, pb + 11);
        } else {
            for (int c = 0; c < MOE_NCHUNK; ++c) {
                const int panel0 = c * MOE_CHUNK_PANELS;
                int npan = 0;
                if (IN(pb + 5 + 2 * c) || IN(pb + 6 + 2 * c)) { int tot = 0;
                    for (int e = 0; e < NE; ++e) tot += ((int)__hip_atomic_load((unsigned*)(F.ctl + CW_CNT + 64 * e), RLX_AGENT) + 255) >> 8;
                    npan = tot - panel0; npan = npan < 0 ? 0 : (npan > MOE_CHUNK_PANELS ? MOE_CHUNK_PANELS : npan); }
                if (!SK(9) && IN(pb + 5 + 2 * c)) {
                    pg8::SchedMoeUp S; S.init(npan, 2 * FF / 256, F.G, (int)blockIdx.x); S.A = (const char*)H; S.B = (const char*)W13M; S.tA = 0; S.tB = (size_t)256 * D * 2; S.eB = (size_t)2 * FF * D * 2;
                    S.panel0 = panel0; S.seg = (const LAS int*)(F.lds + LDS_SEG); S.tok = (const LAS int*)(F.lds + LDS_TOK);
                    moe_tables(F, S, LISTS, panel0);
                    pg8::EpiSwiGLU E{BIG + BIG_HID / 2};
                    pg8::gemm_phase<pg8::EpiSwiGLU, pg8::SchedMoeUp, true>(F.lds, D, S, E);
                }
                SEAM(pb + 5 + 2 * c, pb + 6 + 2 * c);
                if (!SK(10) && IN(pb + 6 + 2 * c)) {
                    pg8::SchedMoeDown S; S.init(npan, D / 256, F.G, (int)blockIdx.x); S.A = (const char*)(BIG + BIG_HID / 2); S.B = (const char*)W2M; S.tA = S.tB = (size_t)256 * FF * 2; S.eB = (size_t)D * FF * 2;
                    S.panel0 = panel0; S.seg = (const LAS int*)(F.lds + LDS_SEG); S.tok = (const LAS int*)(F.lds + LDS_TOK);
                    moe_tables(F, S, LISTS, panel0);
                    pg8::EpiMoeDown E{BIG + BIG_YP / 2, (const LAS int*)(F.lds + LDS_TOK)};
                    pg8::gemm_phase<pg8::EpiMoeDown, pg8::SchedMoeDown, true>(F.lds, FF, S, E);
                }
                SEAM(pb + 6 + 2 * c, (c + 1 < MOE_NCHUNK) ? pb + 7 + 2 * c : pb + 11);
            }
        }
        if (!SK(11) && IN(pb + 11)) {
            RowArgs a{}; a.xin = xout; a.xout = xout; a.gpost = g_ffn_post + (size_t)l * D; a.gate = modl + 5 * D; a.H = H;
            if (l == 0) { a.Y = BIG + BIG_YF / 2; a.gpre = g_mix_pre + (size_t)(l + 1) * D; a.shift = MOD + (size_t)(l + 1) * NB * NMOD + 0 * D; a.scale = MOD + (size_t)(l + 1) * NB * NMOD + 1 * D;
                row_phase<true, false, true, false>(F, a); }
            else { a.Y = BIG + BIG_YP / 2; a.tokw_in = TOKW; row_phase<true, true, false, false>(F, a); }
        }
        if (l == 0) SEAM(pb + 11, pb + PH_STRIDE);
    }
#undef IN
#undef SEAM
}

extern "C" void kernel_launch(void* const* d_in, const int* in_sizes, int n_in, void* d_out, int out_size, void* d_ws, size_t ws_size, hipStream_t stream) {
    static int grid = 0;
    if (grid == 0) {
        if (n_in != 20 || in_sizes[0] != M * D || out_size != M * D || ws_size < WS_END) { fprintf(stderr, "kernel_launch: unexpected shapes (n_in %d, ws %zu)\n", n_in, ws_size); grid = -1; return; }
        int dev = 0, cus = 0;
        if (hipGetDevice(&dev) != hipSuccess || hipDeviceGetAttribute(&cus, hipDeviceAttributeMultiprocessorCount, dev) != hipSuccess) { grid = -1; return; }
        if (hipFuncSetAttribute((const void*)mega_fwd, hipFuncAttributeMaxDynamicSharedMemorySize, LDS_BYTES) != hipSuccess) { fprintf(stderr, "kernel_launch: hipFuncSetAttribute failed\n"); grid = -1; return; }
        int per_cu = 0;
        if (hipOccupancyMaxActiveBlocksPerMultiprocessor(&per_cu, (const void*)mega_fwd, NTHREADS, LDS_BYTES) != hipSuccess || per_cu < 1) fprintf(stderr, "kernel_launch: occupancy query reports %d\n", per_cu);
        (void)hipGetLastError();
        grid = cus;
        if (grid != 256) { fprintf(stderr, "kernel_launch: built for 256 CUs, found %d\n", cus); grid = -1; return; }
    }
    if (grid < 0) return;
    if (hipMemsetAsync((char*)d_ws + WS_CTL, 0, CTL_ZERO_BYTES, stream) != hipSuccess) return;
    Args a{};
    for (int i = 0; i < 20; ++i) a.in[i] = (const float*)d_in[i];
    a.out = (float*)d_out; a.ws = (unsigned char*)d_ws;
#if MK_ONE_LAUNCH
    a.ph_lo = 0; a.ph_hi = PH_END;
    hipLaunchKernelGGL(mega_fwd, dim3(grid), dim3(NTHREADS), LDS_BYTES, stream, a);
#else
    for (int p = 0; p < PH_END; ++p) {
        const int rel = p < PH_LAYER0 ? -1 : (p - PH_LAYER0) % PH_STRIDE, l = p < PH_LAYER0 ? 0 : (p - PH_LAYER0) / PH_STRIDE;
        if (rel >= 0) { if (l == 0 && rel > 6 && rel != 11) continue; if (rel > 11) continue; }
        a.ph_lo = p; a.ph_hi = p + 1;
        hipLaunchKernelGGL(mega_fwd, dim3(grid), dim3(NTHREADS), LDS_BYTES, stream, a);
    }
#endif
}
```

```cpp
#include <hip/hip_runtime.h>
#include <hip/hip_bf16.h>
#include <cstdio>
#include <cstdint>
#include <cmath>

#ifndef MK_ONE_LAUNCH
#define MK_ONE_LAUNCH 1
#endif
#ifndef MK_SKIP
#define MK_SKIP 0
#endif
#define SK(b) ((MK_SKIP >> (b)) & 1)

#define GAS __attribute__((address_space(1)))
#define LAS __attribute__((address_space(3)))
typedef unsigned short bf16;
typedef unsigned v4u __attribute__((ext_vector_type(4)));
typedef unsigned v2u __attribute__((ext_vector_type(2)));
typedef float f32x4 __attribute__((ext_vector_type(4)));
typedef float f32x2 __attribute__((ext_vector_type(2)));
typedef float f32x16 __attribute__((ext_vector_type(16)));
typedef short bf16x8 __attribute__((ext_vector_type(8)));
typedef short s16x4 __attribute__((ext_vector_type(4)));
typedef GAS unsigned gu32;
#define RLX_AGENT __ATOMIC_RELAXED, __HIP_MEMORY_SCOPE_AGENT
#define LDS_WAIT() asm volatile("s_waitcnt lgkmcnt(0)" ::: "memory")
#define VM_WAIT() asm volatile("s_waitcnt vmcnt(0)" ::: "memory")

constexpr int NB = 16, SEQ = 2048, D = 1024, M = NB * SEQ, NH = 8, HD = 64, WH = 512, INCOLS = 5120, FF = 3584, NE = 8, NMOD = 6 * D;
constexpr float EPS = 1e-6f;
constexpr float LOG2E = 1.4426950408889634f;
constexpr float C2 = 0.125f * LOG2E;
constexpr int NWAVES = 8, NTHREADS = 512;

constexpr size_t MiB = 1u << 20;
constexpr size_t WS_CTL = 0, CTL_ZERO_BYTES = 1 * MiB;
constexpr size_t WS_MOD = 1 * MiB;
constexpr size_t WS_LIST = 2 * MiB;
constexpr size_t WS_TOKW = 3 * MiB;
constexpr size_t WS_WIN = 4 * MiB;
constexpr size_t WS_WPSB = 24 * MiB;
constexpr size_t WS_WPMB = 26 * MiB;
constexpr size_t WS_WOUT = 28 * MiB;
constexpr size_t WS_W13D = 32 * MiB;
constexpr size_t WS_W2D = 46 * MiB;
constexpr size_t WS_W13M = 53 * MiB;
constexpr size_t WS_W2M = 165 * MiB;
constexpr size_t WS_H = 221 * MiB;
constexpr size_t WS_BIG = 285 * MiB;
constexpr size_t WS_END = 605 * MiB;
constexpr size_t PLANE = (size_t)M * WH * 2;
constexpr size_t BIG_QA = 0, BIG_KA = PLANE, BIG_VA = 2 * PLANE, BIG_QB = 3 * PLANE, BIG_KB = 4 * PLANE, BIG_VB = 5 * PLANE, BIG_GA = 6 * PLANE, BIG_GB = 8 * PLANE;
constexpr size_t BIG_Y = 0;
constexpr size_t BIG_ACT = 0, BIG_YF = 224 * MiB;
constexpr int MOE_CHUNK_PANELS = 88, MOE_NCHUNK = 3;
constexpr size_t BIG_HID = 0, BIG_YP = 160 * MiB;
static_assert(BIG_YP + (size_t)M * 2 * D * 2 <= 320 * MiB && (size_t)MOE_CHUNK_PANELS * 256 * FF * 2 <= BIG_YP && BIG_YF + (size_t)M * D * 2 <= 320 * MiB, "BIG map");
constexpr int CW_TMO = 0, CW_CODE = 1, CW_BAR = 4096, CW_CNT = 16384;

constexpr int RING_BYTES = 131072;
constexpr int LDS_TOK = RING_BYTES;
constexpr int LDS_TOK_UNITS = 12;
constexpr int LDS_SEG = LDS_TOK + LDS_TOK_UNITS * 1024;
constexpr int LDS_MISC = LDS_SEG + 128;
constexpr int LDS_BYTES = LDS_MISC + 64;
static_assert(LDS_BYTES <= 160 * 1024, "LDS");

__device__ __forceinline__ unsigned f2bf(float f) { unsigned u = __builtin_bit_cast(unsigned, f); return (u + 0x7fffu + ((u >> 16) & 1u)) >> 16; }
__device__ __forceinline__ unsigned pk2(float lo, float hi) { return f2bf(lo) | (f2bf(hi) << 16); }
__device__ __forceinline__ float bf_lo(unsigned w) { return __builtin_bit_cast(float, w << 16); }
__device__ __forceinline__ float bf_hi(unsigned w) { return __builtin_bit_cast(float, w & 0xffff0000u); }
__device__ __forceinline__ unsigned cvt_pk_bf16(float lo, float hi) { typedef __bf16 bf2 __attribute__((ext_vector_type(2))); f32x2 v = {lo, hi}; bf2 b = __builtin_convertvector(v, bf2); return __builtin_bit_cast(unsigned, b); }
__device__ __forceinline__ float fast_exp2(float x) { return __builtin_amdgcn_exp2f(x); }
__device__ __forceinline__ float fast_log2(float x) { return __builtin_amdgcn_logf(x); }
__device__ __forceinline__ float fast_rcp(float x) { return __builtin_amdgcn_rcpf(x); }
__device__ __forceinline__ int otid() { int t = threadIdx.x; asm volatile("" : "+v"(t)); return t; }
__device__ __forceinline__ float shx(float v, int o, int lane) { return __builtin_bit_cast(float, __builtin_amdgcn_ds_bpermute((lane ^ o) << 2, __builtin_bit_cast(int, v))); }
__device__ __forceinline__ float shl(float v, int src) { return __builtin_bit_cast(float, __builtin_amdgcn_ds_bpermute(src << 2, __builtin_bit_cast(int, v))); }
__device__ __forceinline__ float sigmoidf_(float x) { return fast_rcp(1.0f + fast_exp2(-x * LOG2E)); }

#define XB_TMO      128
#define XB_XCNT(j)  (256  + 64 * (j))
#define XB_XSUB(j)  (1280 + 64 * (j))
#define XB_XGEN(j)  (2304 + 64 * (j))
#define XB_TOP      3328
#define XB_TOPGEN   3392
#define XCD_BAR_WORDS 3456
#define XB_SPIN_CAP (1u << 18)
__device__ __forceinline__ unsigned xb_ld(unsigned* p)              { return __hip_atomic_load(p, __ATOMIC_RELAXED, __HIP_MEMORY_SCOPE_AGENT); }
__device__ __forceinline__ unsigned xb_add(unsigned* p, unsigned v) { return __hip_atomic_fetch_add(p, v, __ATOMIC_RELAXED, __HIP_MEMORY_SCOPE_AGENT); }
__device__ __forceinline__ unsigned xb_xcc_id() { return (unsigned)__builtin_amdgcn_s_getreg((3 << 11) | 20) & 0xFu; }
#define XB_SPIN(cond, bar) do { unsigned _sp = 0; while (cond) { __builtin_amdgcn_s_sleep(1); \
    if ((++_sp & 255u) == 0u) { if (xb_ld(&(bar)[XB_TMO])) break; if (_sp > XB_SPIN_CAP) { atomicAdd(&(bar)[XB_TMO], 1u); break; } } } } while (0)
struct XcdBarrier { unsigned* bar; unsigned x; volatile LAS unsigned* st; };
__device__ __forceinline__ XcdBarrier xcd_barrier_post(unsigned* bar, volatile LAS unsigned* st) {
    XcdBarrier b; b.bar = bar; b.x = xb_xcc_id(); b.st = st;
    if (threadIdx.x == 0) (void)xb_add(&bar[XB_XCNT(b.x)], 1u);
    return b;
}
__device__ __forceinline__ void xcd_barrier_complete(unsigned* bar, unsigned x, unsigned& nloc, unsigned& nx) {
    const unsigned G = gridDim.x * gridDim.y * gridDim.z;
    unsigned sum, cnt, mine, sp = 0u;
    for (;;) {
        sum = 0u; cnt = 0u; mine = 0u;
#pragma unroll
        for (unsigned j = 0; j < 16; ++j) { const unsigned c = xb_ld(&bar[XB_XCNT(j)]); sum += c; cnt += (c > 0u) ? 1u : 0u; mine = (j == x) ? c : mine; }
        if (sum == G) break;
        __builtin_amdgcn_s_sleep(1);
        if ((++sp & 255u) == 0u) { if (xb_ld(&bar[XB_TMO])) break; if (sp > XB_SPIN_CAP) { atomicAdd(&bar[XB_TMO], 1u); break; } }
    }
    nloc = mine > 0u ? mine : 1u; nx = cnt > 0u ? cnt : 1u;
}
__device__ __forceinline__ void xcd_barrier(const XcdBarrier& b) {
    asm volatile("s_waitcnt vmcnt(0)" ::: "memory");
    __syncthreads();
    if (threadIdx.x == 0) {
        unsigned* bar = b.bar;
        __builtin_amdgcn_s_waitcnt(0);
        unsigned nloc = b.st[0], nx = b.st[1];
        if (nloc == 0u) { xcd_barrier_complete(bar, b.x, nloc, nx); b.st[0] = nloc; b.st[1] = nx; }
        const unsigned old = xb_add(&bar[XB_XSUB(b.x)], 1u);
        const unsigned gen = old / nloc;
        if (old + 1u == (gen + 1u) * nloc) {
            __builtin_amdgcn_fence(__ATOMIC_RELEASE, "agent");
            asm volatile("s_waitcnt vmcnt(0)" ::: "memory");
            const unsigned og = xb_add(&bar[XB_TOP], 1u);
            const unsigned tg = og / nx;
            if (og + 1u == (tg + 1u) * nx) xb_add(&bar[XB_TOPGEN], 1u);
            else XB_SPIN(xb_ld(&bar[XB_TOPGEN]) == tg, bar);
            __builtin_amdgcn_fence(__ATOMIC_ACQUIRE, "agent");
            xb_add(&bar[XB_XGEN(b.x)], 1u);
            asm volatile("s_waitcnt vmcnt(0)" ::: "memory");
        } else {
            XB_SPIN(xb_ld(&bar[XB_XGEN(b.x)]) == gen, bar);
            __builtin_amdgcn_fence(__ATOMIC_ACQUIRE, "agent");
            asm volatile("s_waitcnt vmcnt(0)" ::: "memory");
        }
    }
    __syncthreads();
}

namespace pg8 {
constexpr int BM = 256, BK = 64, HALF = 128, HTB = HALF * BK * 2, STAGE_BYTES = 8 * HTB, NXCD = 8, WGM = 8;
__host__ __device__ __forceinline__ int lds_byte(int r, int c) { const int st = (r >> 4) * 2 + (c >> 5), rr = r & 15, cc = c & 31, ob = rr * 64 + cc * 2; return st * 1024 + (ob ^ (((ob >> 9) & 1) << 5)); }
__host__ __device__ __forceinline__ void stage_rc(int b, int& R, int& C) { const int st = b / 1024, sb = b % 1024, swz = sb ^ (((sb >> 9) & 1) << 5); R = (st >> 1) * 16 + swz / 64; C = (st & 1) * 32 + (swz % 64) / 2; }
__host__ __device__ __forceinline__ int perm32(int rho) { const int n = rho >> 4, i = rho & 15; return 8 * (i >> 2) + 4 * n + (i & 3); }
struct Unit { int pm, pn; };
struct StaticOrder {
    int nM, nN, nwg, G, c;
    __host__ __device__ void init(int nM_, int nN_, int G_, int c_) { nM = nM_; nN = nN_; nwg = nM * nN; G = G_; c = c_; }
    __host__ __device__ bool next(int i, Unit& u) const {
        const long L = (long)i * G + c; if (L >= nwg) return false;
        int wgid = (int)L; { const int q = nwg / NXCD, r = nwg % NXCD, xcd = wgid % NXCD, off = wgid / NXCD; wgid = (xcd < r ? xcd * (q + 1) : r * (q + 1) + (xcd - r) * q) + off; }
        const int nig = WGM * nN, gid = wgid / nig, fm = gid * WGM, gsz = (nM - fm) < WGM ? (nM - fm) : WGM;
        u.pm = fm + ((wgid % nig) % gsz); u.pn = (wgid % nig) / gsz; return true;
    }
};
template <class Epi, class Sched, bool ALIGN_EPI>
__device__ __forceinline__ void gemm_phase(LAS unsigned char* lds, const int K, const Sched& S, const Epi& E) {
    const int tid = otid(), wid = __builtin_amdgcn_readfirstlane(tid >> 6), lane = tid & 63, wr = wid >> 2, wc = wid & 3, fr = lane & 15, fq = lane >> 4;
    const int nt = K / BK;
    unsigned voffA[2], voffB[2];
#pragma unroll
    for (int i = 0; i < 2; ++i) { int R, C; stage_rc(tid * 16 + i * 8192, R, C); const int Rb = Epi::PERM ? ((R & ~31) + perm32(R & 31)) : R;
        voffA[i] = (unsigned)(R * K + C) * 2u; voffB[i] = (unsigned)(Rb * K + C) * 2u; }
#define PG8_GVOFF(uix) do { _Pragma("unroll") for (int _h = 0; _h < 2; ++_h) _Pragma("unroll") for (int _i = 0; _i < 2; ++_i) { int R_, C_; stage_rc(tid * 16 + _i * 8192, R_, C_); vg[_h][_i] = S.gvoff((uix), _h * HALF + R_, C_, K); } } while (0)
    const size_t kstep = (size_t)(BK * 2);
    const size_t hstep = (size_t)HALF * K * 2;
    const unsigned ldsw = (unsigned)wid * 1024u;
    const int aoff = lds_byte(wr * 64 + fr, fq * 8), boff = lds_byte(wc * 32 + fr, fq * 8);
#define PG8_SA(b, h) (((b) * 2 + (h)) * HTB)
#define PG8_SB(b, h) ((4 + (b) * 2 + (h)) * HTB)
#define PG8_STAGE(bufoff, gbase, voff) do { _Pragma("unroll") for (int _i = 0; _i < 2; ++_i) \
        __builtin_amdgcn_global_load_lds((const unsigned*)((const char*)(gbase) + (voff)[_i]), (LAS unsigned*)(lds + (bufoff) + ldsw + _i * 8192), 16, 0, 0); } while (0)
#define PG8_STAGE_A(bufoff, kp, h) do { if constexpr (Sched::GATHER) { PG8_STAGE(bufoff, kp, vg[h]); } else { PG8_STAGE(bufoff, (kp) + (h) * hstep, voffA); } } while (0)
#define PG8_LDA(dst, b, h) do { _Pragma("unroll") for (int m = 0; m < 4; ++m) _Pragma("unroll") for (int k = 0; k < 2; ++k) dst[m][k] = *(const LAS bf16x8*)(lds + PG8_SA(b, h) + aoff + m * 2048 + k * 1024); } while (0)
#define PG8_LDB(dst, b, h) do { _Pragma("unroll") for (int n = 0; n < 2; ++n) _Pragma("unroll") for (int k = 0; k < 2; ++k) dst[n][k] = *(const LAS bf16x8*)(lds + PG8_SB(b, h) + boff + n * 2048 + k * 1024); } while (0)
#define PG8_MMA(ai, bj, At, Bt) do { __builtin_amdgcn_s_setprio(1); _Pragma("unroll") for (int m = 0; m < 4; ++m) _Pragma("unroll") for (int n = 0; n < 2; ++n) _Pragma("unroll") for (int k = 0; k < 2; ++k) \
        acc[ai][bj][m][n] = __builtin_amdgcn_mfma_f32_16x16x32_bf16(Bt[n][k], At[m][k], acc[ai][bj][m][n], 0, 0, 0); __builtin_amdgcn_s_setprio(0); } while (0)
#define PG8_WAIT_V(n) asm volatile("s_waitcnt vmcnt(" #n ")" ::: "memory")
#define PG8_WAIT_L(n) asm volatile("s_waitcnt lgkmcnt(" #n ")" ::: "memory")
#define PG8_BAR __builtin_amdgcn_s_barrier()
#define PG8_SCHED __builtin_amdgcn_sched_barrier(0)
    Unit cur, nxt; int ui = 0;
    if (!S.next(0, cur)) return;
    f32x4 acc[2][2][4][2];
#pragma unroll
    for (int a = 0; a < 2; ++a)
#pragma unroll
        for (int b = 0; b < 2; ++b)
#pragma unroll
            for (int m = 0; m < 4; ++m)
#pragma unroll
                for (int n = 0; n < 2; ++n) acc[a][b][m][n] = (f32x4){0.f, 0.f, 0.f, 0.f};
    bf16x8 At[4][2], B0[2][2], B1[2][2];
    unsigned vg[2][2];
    if constexpr (Sched::GATHER) PG8_GVOFF(0);
    const char* cA = S.a_base(cur); const char* cB = S.b_base(cur);
    PG8_STAGE(PG8_SB(0, 0), cB, voffB); PG8_STAGE(PG8_SB(0, 1), cB + hstep, voffB); PG8_STAGE_A(PG8_SA(0, 0), cA, 0); PG8_STAGE_A(PG8_SA(0, 1), cA, 1);
    if (wr == 1) PG8_BAR;
    PG8_WAIT_V(2); PG8_BAR;
    PG8_STAGE(PG8_SB(1, 0), cB + kstep, voffB); PG8_STAGE_A(PG8_SA(1, 0), cA + kstep, 0); PG8_STAGE(PG8_SB(1, 1), cB + hstep + kstep, voffB);
    PG8_WAIT_V(6); PG8_BAR;
    for (;;) {
        const bool has_next = S.next(ui + 1, nxt);
        const char* nA = has_next ? S.a_base(nxt) : cA; const char* nB = has_next ? S.b_base(nxt) : cB;
        for (int t = 0; t < nt; t += 2) {
            const bool last = (t == nt - 2);
            const char* a1 = cA + (size_t)(t + 1) * kstep;
            const char* a2 = last ? nA : cA + (size_t)(t + 2) * kstep; const char* b2 = last ? nB : cB + (size_t)(t + 2) * kstep;
            const char* a3 = a2 + kstep; const char* b3 = b2 + kstep;
            PG8_LDB(B0, 0, 0); PG8_LDB(B1, 0, 1); PG8_SCHED; PG8_LDA(At, 0, 0); PG8_STAGE_A(PG8_SA(1, 1), a1, 1);
            if constexpr (Sched::GATHER) { if (last && has_next) PG8_GVOFF(ui + 1); }
            PG8_WAIT_V(8); PG8_WAIT_L(0); PG8_BAR; PG8_MMA(0, 0, At, B0); PG8_MMA(0, 1, At, B1); PG8_BAR; PG8_SCHED;
            PG8_LDA(At, 0, 1); PG8_STAGE(PG8_SB(0, 0), b2, voffB); PG8_STAGE(PG8_SB(0, 1), b2 + hstep, voffB); PG8_STAGE_A(PG8_SA(0, 0), a2, 0);
            PG8_WAIT_V(8); PG8_WAIT_L(0); PG8_BAR; PG8_MMA(1, 0, At, B0); PG8_MMA(1, 1, At, B1); PG8_BAR; PG8_SCHED;
            PG8_LDB(B0, 1, 0); PG8_LDB(B1, 1, 1); PG8_SCHED; PG8_LDA(At, 1, 0); PG8_STAGE_A(PG8_SA(0, 1), a2, 1);
            PG8_WAIT_V(8); PG8_WAIT_L(0); PG8_BAR; PG8_MMA(0, 0, At, B0); PG8_MMA(0, 1, At, B1); PG8_BAR; PG8_SCHED;
            PG8_LDA(At, 1, 1); PG8_STAGE(PG8_SB(1, 0), b3, voffB); PG8_STAGE(PG8_SB(1, 1), b3 + hstep, voffB); PG8_STAGE_A(PG8_SA(1, 0), a3, 0);
            PG8_WAIT_V(8); PG8_WAIT_L(0); PG8_BAR; PG8_MMA(1, 0, At, B0); PG8_MMA(1, 1, At, B1); PG8_BAR; PG8_SCHED;
        }
        if constexpr (ALIGN_EPI) { if (wr == 0) PG8_BAR; }
        E(acc, cur, ui, wr, wc, fr, fq);
        if (!has_next) break;
#pragma unroll
        for (int a = 0; a < 2; ++a)
#pragma unroll
            for (int b = 0; b < 2; ++b)
#pragma unroll
                for (int m = 0; m < 4; ++m)
#pragma unroll
                    for (int n = 0; n < 2; ++n) acc[a][b][m][n] = (f32x4){0.f, 0.f, 0.f, 0.f};
        cur = nxt; cA = nA; cB = nB; ++ui;
        if constexpr (ALIGN_EPI) { if (wr == 1) PG8_BAR; }
    }
    PG8_WAIT_V(0);
    if constexpr (!ALIGN_EPI) { if (wr == 0) PG8_BAR; }
    PG8_BAR;
#undef PG8_SA
#undef PG8_SB
#undef PG8_STAGE
#undef PG8_STAGE_A
#undef PG8_GVOFF
#undef PG8_LDA
#undef PG8_LDB
#undef PG8_MMA
#undef PG8_WAIT_V
#undef PG8_WAIT_L
#undef PG8_BAR
#undef PG8_SCHED
}

struct SchedPlain : StaticOrder {
    static constexpr bool GATHER = false;
    const char* A; const char* B; size_t tA, tB;
    __device__ __forceinline__ const char* a_base(const Unit& u) const { return A + (size_t)u.pm * tA; }
    __device__ __forceinline__ const char* b_base(const Unit& u) const { return B + (size_t)u.pn * tB; }
    __device__ __forceinline__ unsigned gvoff(int, int, int, int) const { return 0u; }
};
struct SchedMoe : StaticOrder {
    const char* A; const char* B; size_t tA, tB, eB; int panel0; const LAS int* seg; const LAS int* tok;
    __device__ __forceinline__ int expert(const Unit& u) const { const int row = (panel0 + u.pm) * 256; int e = 0;
#pragma unroll
        for (int j = 1; j < NE; ++j) e += (row >= seg[j]) ? 1 : 0;
        return e; }
    __device__ __forceinline__ const char* b_base(const Unit& u) const { return B + (size_t)expert(u) * eB + (size_t)u.pn * tB; }
};
struct SchedMoeUp : SchedMoe {
    static constexpr bool GATHER = true;
    __device__ __forceinline__ const char* a_base(const Unit&) const { return A; }
    __device__ __forceinline__ unsigned gvoff(int ui, int row, int col, int K) const { const int e = tok[ui * 256 + row]; const int t = e < 0 ? 0 : (e >> 1); return (unsigned)(t * K + col) * 2u; }
};
struct SchedMoeDown : SchedMoe {
    static constexpr bool GATHER = false;
    __device__ __forceinline__ const char* a_base(const Unit& u) const { return A + (size_t)u.pm * tA; }
    __device__ __forceinline__ unsigned gvoff(int, int, int, int) const { return 0u; }
};

typedef f32x4 Acc[2][2][4][2];
__device__ __forceinline__ v4u pack8(f32x4 v0, f32x4 v1) { v4u w; w.x = cvt_pk_bf16(v0[0], v0[1]); w.y = cvt_pk_bf16(v0[2], v0[3]); w.z = cvt_pk_bf16(v1[0], v1[1]); w.w = cvt_pk_bf16(v1[2], v1[3]); return w; }
__device__ __forceinline__ void unpack8(v4u w, f32x4& v0, f32x4& v1) { v0 = (f32x4){bf_lo(w.x), bf_hi(w.x), bf_lo(w.y), bf_hi(w.y)}; v1 = (f32x4){bf_lo(w.z), bf_hi(w.z), bf_lo(w.w), bf_hi(w.w)}; }

struct EpiInProj {
    static constexpr bool PERM = true;
    bf16* big;
    __device__ __forceinline__ void operator()(const Acc& acc, const Unit& u, int, int wr, int wc, int fr, int fq) const {
        const int t = u.pn; bf16* base; int ldc, colt; float sc = 1.f;
        if (t < 12) { const int pl = t >> 1; base = big + (size_t)pl * ((size_t)M * WH); ldc = WH; colt = (t & 1) * 256; if (pl == 0 || pl == 3) sc = C2; }
        else { const int g = (t - 12) >> 2; base = big + (size_t)6 * ((size_t)M * WH) + (size_t)g * ((size_t)M * D); ldc = D; colt = ((t - 12) & 3) * 256; }
        const int row0 = u.pm * BM + wr * 64 + fr, col0 = colt + wc * 32 + 8 * fq;
#pragma unroll
        for (int ai = 0; ai < 2; ++ai)
#pragma unroll
            for (int m = 0; m < 4; ++m) { bf16* rowp = base + (size_t)(row0 + ai * HALF + m * 16) * ldc + col0;
#pragma unroll
                for (int bj = 0; bj < 2; ++bj) *(v4u*)(rowp + bj * HALF) = pack8(acc[ai][bj][m][0] * sc, acc[ai][bj][m][1] * sc); }
    }
};
struct EpiBf16 {
    static constexpr bool PERM = true;
    bf16* O; int ldc;
    __device__ __forceinline__ void operator()(const Acc& acc, const Unit& u, int, int wr, int wc, int fr, int fq) const {
        const int row0 = u.pm * BM + wr * 64 + fr, col0 = u.pn * BM + wc * 32 + 8 * fq;
#pragma unroll
        for (int ai = 0; ai < 2; ++ai)
#pragma unroll
            for (int m = 0; m < 4; ++m) { bf16* rowp = O + (size_t)(row0 + ai * HALF + m * 16) * ldc + col0;
#pragma unroll
                for (int bj = 0; bj < 2; ++bj) *(v4u*)(rowp + bj * HALF) = pack8(acc[ai][bj][m][0], acc[ai][bj][m][1]); }
    }
};
template <bool ADD> struct EpiGate {
    static constexpr bool PERM = true;
    const bf16* G; bf16* T;
    __device__ __forceinline__ void operator()(const Acc& acc, const Unit& u, int, int wr, int wc, int fr, int fq) const {
        const int row0 = u.pm * BM + wr * 64 + fr, col0 = u.pn * BM + wc * 32 + 8 * fq;
#pragma unroll
        for (int ai = 0; ai < 2; ++ai)
#pragma unroll
            for (int m = 0; m < 4; ++m) { const size_t off = (size_t)(row0 + ai * HALF + m * 16) * D + col0;
#pragma unroll
                for (int bj = 0; bj < 2; ++bj) { const v4u gw = *(const v4u*)(G + off + bj * HALF); f32x4 g0, g1; unpack8(gw, g0, g1);
                    f32x4 t0 = {0.f, 0.f, 0.f, 0.f}, t1 = {0.f, 0.f, 0.f, 0.f};
                    if (ADD) { const v4u tw = *(const v4u*)(T + off + bj * HALF); unpack8(tw, t0, t1); }
                    f32x4 o0, o1;
#pragma unroll
                    for (int c = 0; c < 4; ++c) { o0[c] = t0[c] + sigmoidf_(g0[c]) * acc[ai][bj][m][0][c]; o1[c] = t1[c] + sigmoidf_(g1[c]) * acc[ai][bj][m][1][c]; }
                    *(v4u*)(T + off + bj * HALF) = pack8(o0, o1); } }
    }
};
struct EpiSwiGLU {
    static constexpr bool PERM = true;
    bf16* O;
    __device__ __forceinline__ void operator()(const Acc& acc, const Unit& u, int, int wr, int wc, int fr, int fq) const {
        const int row0 = u.pm * BM + wr * 64 + fr, col0 = u.pn * HALF + wc * 32 + 8 * fq;
#pragma unroll
        for (int ai = 0; ai < 2; ++ai)
#pragma unroll
            for (int m = 0; m < 4; ++m) { f32x4 o0, o1;
#pragma unroll
                for (int c = 0; c < 4; ++c) { const float a = acc[ai][0][m][0][c], b = acc[ai][0][m][1][c]; o0[c] = a * sigmoidf_(a) * acc[ai][1][m][0][c]; o1[c] = b * sigmoidf_(b) * acc[ai][1][m][1][c]; }
                *(v4u*)(O + (size_t)(row0 + ai * HALF + m * 16) * FF + col0) = pack8(o0, o1); }
    }
};
struct EpiMoeDown {
    static constexpr bool PERM = true;
    bf16* YP; const LAS int* tok;
    __device__ __forceinline__ void operator()(const Acc& acc, const Unit& u, int ui, int wr, int wc, int fr, int fq) const {
        const int r0 = wr * 64 + fr, col0 = u.pn * BM + wc * 32 + 8 * fq;
#pragma unroll
        for (int ai = 0; ai < 2; ++ai)
#pragma unroll
            for (int m = 0; m < 4; ++m) { const int e = tok[ui * 256 + r0 + ai * HALF + m * 16];
                if (e >= 0) { bf16* rowp = YP + (size_t)e * D + col0;
#pragma unroll
                    for (int bj = 0; bj < 2; ++bj) *(v4u*)(rowp + bj * HALF) = pack8(acc[ai][bj][m][0], acc[ai][bj][m][1]); } }
    }
};
}

namespace att {
constexpr int PITCH = WH;
constexpr int SLOTB = 8192;
constexpr int L_K = 0, L_V = 2 * SLOTB, L_WS = 4 * SLOTB, L_OST = L_WS + NWAVES * 64 * 4, L_KPART = L_OST + NWAVES * 4096, L_KMEAN = L_KPART + 8 * 8 * 64 * 4, L_SEL = L_KMEAN + 8 * 64 * 4, L_LUT = L_SEL + 256, L_END = L_LUT + 512;
static_assert(L_END <= RING_BYTES, "attention LDS");
__device__ __forceinline__ int crow(int r, int hi) { return (r & 3) + 8 * (r >> 2) + 4 * hi; }
__device__ __forceinline__ void glds16(const void* gsrc, unsigned lds_dst) { unsigned keep;
    asm volatile("s_mov_b32 %0, m0\n\ts_mov_b32 m0, %2\n\ts_nop 0\n\tglobal_load_lds_dwordx4 %1, off\n\ts_mov_b32 m0, %0" : "=&s"(keep) : "v"(gsrc), "s"(lds_dst) : "memory"); }
#define ATT_WAIT_BAR() asm volatile("s_waitcnt vmcnt(0) lgkmcnt(0)\n\ts_barrier" ::: "memory")
__device__ const unsigned char REL_BUCKET_LUT[128] = {0, 1, 2, 3, 4, 5, 6, 7, 8, 9, 10, 11, 12, 13, 14, 15, 16, 16, 16, 17, 17, 18, 18, 18, 19, 19, 19, 20, 20, 20, 20, 21, 21, 21, 21, 22, 22, 22, 22, 22, 23, 23, 23, 23, 23, 23, 24, 24, 24, 24, 24, 24, 25, 25, 25, 25, 25, 25, 25, 26, 26, 26, 26, 26, 26, 26, 26, 27, 27, 27, 27, 27, 27, 27, 27, 27, 27, 28, 28, 28, 28, 28, 28, 28, 28, 28, 28, 29, 29, 29, 29, 29, 29, 29, 29, 29, 29, 29, 29, 30, 30, 30, 30, 30, 30, 30, 30, 30, 30, 30, 30, 30, 30, 31, 31, 31, 31, 31, 31, 31, 31, 31, 31, 31, 31, 31, 31, 31};

__device__ __forceinline__ void qkt(f32x16& p0, f32x16& p1, const LAS char* Kslot, const bf16x8* qr, const f32x16& cinit, int r32, int hi) {
    const LAS char* kb = Kslot + hi * 1024 + r32 * 16;
#pragma unroll
    for (int d0 = 0; d0 < 4; ++d0) {
        const bf16x8 b0 = *(const LAS bf16x8*)(kb + d0 * 2048);
        const bf16x8 b1 = *(const LAS bf16x8*)(kb + d0 * 2048 + 512);
        if (d0 == 0) { p0 = __builtin_amdgcn_mfma_f32_32x32x16_bf16(b0, qr[0], cinit, 0, 0, 0); p1 = __builtin_amdgcn_mfma_f32_32x32x16_bf16(b1, qr[0], cinit, 0, 0, 0); }
        else { p0 = __builtin_amdgcn_mfma_f32_32x32x16_bf16(b0, qr[d0], p0, 0, 0, 0); p1 = __builtin_amdgcn_mfma_f32_32x32x16_bf16(b1, qr[d0], p1, 0, 0, 0); }
    }
}
__device__ __forceinline__ void pv(f32x16* o, int vb, bf16x8 pa0, bf16x8 pa1, bf16x8 pa2, bf16x8 pa3) {
#pragma unroll
    for (int d0 = 0; d0 < 2; ++d0) { s16x4 lo[4], hi[4];
#pragma unroll
        for (int ks = 0; ks < 4; ++ks) {
            asm volatile("ds_read_b64_tr_b16 %0,%1 offset:%c2" : "=&v"(lo[ks]) : "v"(vb), "i"(d0 * 4096 + ks * 1024) : "memory");
            asm volatile("ds_read_b64_tr_b16 %0,%1 offset:%c2" : "=&v"(hi[ks]) : "v"(vb), "i"(d0 * 4096 + ks * 1024 + 512) : "memory"); }
        asm volatile("s_waitcnt lgkmcnt(0)" ::: "memory"); __builtin_amdgcn_sched_barrier(0);
#define ATT_PK(k) (bf16x8){lo[k][0], lo[k][1], lo[k][2], lo[k][3], hi[k][0], hi[k][1], hi[k][2], hi[k][3]}
        o[d0] = __builtin_amdgcn_mfma_f32_32x32x16_bf16(pa0, ATT_PK(0), o[d0], 0, 0, 0);
        o[d0] = __builtin_amdgcn_mfma_f32_32x32x16_bf16(pa1, ATT_PK(1), o[d0], 0, 0, 0);
        o[d0] = __builtin_amdgcn_mfma_f32_32x32x16_bf16(pa2, ATT_PK(2), o[d0], 0, 0, 0);
        o[d0] = __builtin_amdgcn_mfma_f32_32x32x16_bf16(pa3, ATT_PK(3), o[d0], 0, 0, 0);
#undef ATT_PK
    }
}
__device__ __forceinline__ bf16x8 pack8r(const f32x16& p, int b) { v4u w; w.x = cvt_pk_bf16(p[b], p[b + 1]); w.y = cvt_pk_bf16(p[b + 2], p[b + 3]); w.z = cvt_pk_bf16(p[b + 4], p[b + 5]); w.w = cvt_pk_bf16(p[b + 6], p[b + 7]); return __builtin_bit_cast(bf16x8, w); }
__device__ __forceinline__ f32x16 splat16(float v) { f32x16 r;
#pragma unroll
    for (int i = 0; i < 16; ++i) r[i] = v;
    return r; }

template <bool MOBA>
__device__ __forceinline__ void attn_unit(int b, int h, int qb, const bf16* Q, const bf16* __restrict__ Kp, const bf16* __restrict__ Vp, bf16* O, const float* rel_bias, LAS unsigned char* shm) {
    const int tid = otid(), lane = tid & 63, r32 = lane & 31, hi = lane >> 5; const int wid = __builtin_amdgcn_readfirstlane(tid >> 6);
    const long rowbase = (long)b * SEQ; const int q0 = qb * 256;
    const bf16* Qw = Q + (rowbase + q0 + wid * 32) * PITCH + h * HD;
    const bf16* Kh = Kp + rowbase * PITCH + h * HD; const bf16* Vh = Vp + rowbase * PITCH + h * HD;
    const unsigned lds0 = (unsigned)(uintptr_t)shm;
    LAS float* wsf = (LAS float*)(shm + L_WS) + wid * 64;
    const bf16* ksrc = Kh + (long)lane * PITCH + wid * 8;
    const bf16* vsrc = Vh + (long)(16 * (wid & 3) + (lane >> 2)) * PITCH + (wid >> 2) * 32 + (lane & 3) * 8;
    const unsigned kdst = lds0 + L_K + wid * 1024, vdst = lds0 + L_V + wid * 1024;
#define DMA_K(t, slot) glds16(ksrc + (long)(t) * 64 * PITCH, (unsigned)__builtin_amdgcn_readfirstlane(kdst + (slot)))
#define DMA_V(t, slot) glds16(vsrc + (long)(t) * 64 * PITCH, (unsigned)__builtin_amdgcn_readfirstlane(vdst + (slot)))
    const int vb0 = (int)(lds0 + L_V) + ((lane >> 4) & 1) * 32 + (lane & 3) * 8 + (4 * hi + ((lane & 15) >> 2)) * 64;
    const LAS char* Kbase = (const LAS char*)(shm + L_K);
    const int NT = 4 * (qb + 1);
    const int qrel = wid * 32 + r32;
    DMA_K(NT - 1, 0); DMA_V(NT - 1, 0);
    bf16x8 qr[4];
#pragma unroll
    for (int d0 = 0; d0 < 4; ++d0) qr[d0] = *(const bf16x8*)(&Qw[(long)r32 * PITCH + d0 * 16 + hi * 8]);
    float biasfar = 0.f; unsigned selmask = 0u;
    if constexpr (MOBA) {
        LAS float* KPART = (LAS float*)(shm + L_KPART); LAS float* KMEAN = (LAS float*)(shm + L_KMEAN); LAS unsigned char* SEL = (LAS unsigned char*)(shm + L_SEL); LAS float* LUT = (LAS float*)(shm + L_LUT);
        if (tid < 128) LUT[tid] = rel_bias[REL_BUCKET_LUT[tid] * NH + h] * LOG2E;
        const int dch = lane & 7, rs = lane >> 3;
        for (int mb = 0; mb < qb; ++mb) {
            float s[8];
#pragma unroll
            for (int c = 0; c < 8; ++c) s[c] = 0.f;
#pragma unroll
            for (int j = 0; j < 4; ++j) { const v4u w = *(const v4u*)(Kh + (long)(mb * 256 + wid * 32 + j * 8 + rs) * PITCH + dch * 8);
                s[0] += bf_lo(w.x); s[1] += bf_hi(w.x); s[2] += bf_lo(w.y); s[3] += bf_hi(w.y); s[4] += bf_lo(w.z); s[5] += bf_hi(w.z); s[6] += bf_lo(w.w); s[7] += bf_hi(w.w); }
#pragma unroll
            for (int c = 0; c < 8; ++c) { s[c] += shx(s[c], 8, lane); s[c] += shx(s[c], 16, lane); s[c] += shx(s[c], 32, lane); }
            if (rs == 0) {
#pragma unroll
                for (int c = 0; c < 8; ++c) KPART[(mb * 8 + wid) * 64 + dch * 8 + c] = s[c]; }
        }
        __syncthreads();
        { const int mb = tid >> 6, d = tid & 63; if (mb < qb) { float t = 0.f;
#pragma unroll
            for (int w = 0; w < 8; ++w) t += KPART[(mb * 8 + w) * 64 + d];
            KMEAN[mb * 64 + d] = t * (1.0f / 256.0f); } }
        __syncthreads();
        { const int q = tid >> 1, dh = tid & 1; const bf16* qp = Q + (rowbase + q0 + q) * PITCH + h * HD + dh * 32; float qv[32];
#pragma unroll
            for (int j = 0; j < 4; ++j) { const v4u w = *(const v4u*)(qp + j * 8); qv[j * 8 + 0] = bf_lo(w.x); qv[j * 8 + 1] = bf_hi(w.x); qv[j * 8 + 2] = bf_lo(w.y); qv[j * 8 + 3] = bf_hi(w.y); qv[j * 8 + 4] = bf_lo(w.z); qv[j * 8 + 5] = bf_hi(w.z); qv[j * 8 + 6] = bf_lo(w.w); qv[j * 8 + 7] = bf_hi(w.w); }
            float g[7];
#pragma unroll
            for (int mb = 0; mb < 7; ++mb) { float a = 0.f; if (mb < qb) {
#pragma unroll
                    for (int d = 0; d < 32; ++d) a += qv[d] * KMEAN[mb * 64 + dh * 32 + d]; }
                a += shx(a, 1, lane); g[mb] = a; }
            unsigned mask = 0u;
            if (qb <= 3) mask = (1u << qb) - 1u;
            else {
#pragma unroll
                for (int pass = 0; pass < 3; ++pass) { float best = -INFINITY; int bi = 0;
#pragma unroll
                    for (int mb = 0; mb < 7; ++mb) if (mb < qb && !((mask >> mb) & 1u) && g[mb] > best) { best = g[mb]; bi = mb; }
                    mask |= 1u << bi; } }
            if (dh == 0) SEL[q] = (unsigned char)mask; }
        __syncthreads();
        selmask = SEL[qrel]; biasfar = LUT[127];
    }
    f32x16 o[2]; o[0] = splat16(0.f); o[1] = splat16(0.f);
    float m_run = -INFINITY, l_run = 0.f, carry = 0.f;
    bf16x8 tri0, tri1, ones;
#pragma unroll
    for (int jj = 0; jj < 8; ++jj) { const int j0 = 8 * (jj >> 2) + 4 * hi + (jj & 3); tri0[jj] = (j0 >= r32) ? (short)0x3F80 : (short)0; tri1[jj] = (16 + j0 >= r32) ? (short)0x3F80 : (short)0; ones[jj] = (short)0x3F80; }
    const int jd = wid >> 1;
    for (int i = 0; i < NT; ++i) {
        const int kt = NT - 1 - i; const int slot = (i & 1) * SLOTB;
        ATT_WAIT_BAR();
        if (i + 1 < NT) { DMA_K(kt - 1, slot ^ SLOTB); DMA_V(kt - 1, slot ^ SLOTB); }
        const int jb = kt - (NT - 4);
        if (jb > jd) continue;
        const bool diag = (jb == jd);
        f32x16 p0, p1;
        if constexpr (MOBA) {
            const bool band = jb >= 0; const int mblk = kt >> 2;
            const bool sel = band || ((selmask >> mblk) & 1u);
            if (!__any(sel)) continue;
            const int dmin = (q0 + wid * 32) - (64 * kt + 63);
            const bool near = dmin < 113;
            const float ci = sel ? (near ? 0.f : biasfar) : -INFINITY;
            const f32x16 cinit = splat16(ci);
            qkt(p0, p1, Kbase + slot, qr, cinit, r32, hi);
            if (near) { const LAS float* LUT = (const LAS float*)(shm + L_LUT); const int dq = (q0 + qrel) - 64 * kt;
#pragma unroll
                for (int r = 0; r < 16; ++r) { const int d0_ = dq - crow(r, hi), d1_ = d0_ - 32;
                    const float b0 = LUT[d0_ < 0 ? 0 : (d0_ > 127 ? 127 : d0_)], b1 = LUT[d1_ < 0 ? 0 : (d1_ > 127 ? 127 : d1_)];
                    p0[r] = (d0_ < 0) ? -INFINITY : p0[r] + b0; p1[r] = (d1_ < 0) ? -INFINITY : p1[r] + b1; } }
            float rm = p0[0];
#pragma unroll
            for (int r = 1; r < 16; ++r) rm = fmaxf(rm, p0[r]);
#pragma unroll
            for (int r = 0; r < 16; ++r) rm = fmaxf(rm, p1[r]);
            rm = fmaxf(rm, shx(rm, 32, lane));
            const float m_new = fmaxf(m_run, rm);
            const float alpha = (m_new == -INFINITY) ? 1.f : fast_exp2(m_run - m_new);
            const float msub = (m_new == -INFINITY) ? 0.f : m_new;
            float ls = 0.f;
#pragma unroll
            for (int r = 0; r < 16; ++r) { p0[r] = fast_exp2(p0[r] - msub); p1[r] = fast_exp2(p1[r] - msub); ls += p0[r] + p1[r]; }
            l_run = l_run * alpha + ls; m_run = m_new;
            if (__any(alpha != 1.f)) { if (hi == 0) wsf[r32] = alpha; LDS_WAIT();
#pragma unroll
                for (int d_ = 0; d_ < 2; ++d_)
#pragma unroll
                    for (int r = 0; r < 16; ++r) o[d_][r] *= wsf[crow(r, hi)];
                LDS_WAIT(); }
        } else {
            const f32x16 zero = splat16(0.f);
            qkt(p0, p1, Kbase + slot, qr, zero, r32, hi);
            f32x16 s0, s1;
            const int kq = qrel - 64 * (jb < 0 ? 0 : jb);
#pragma unroll
            for (int r = 0; r < 16; ++r) { const float z0 = p0[r], z1 = p1[r];
                float a0 = fmaxf(z0, fast_log2(1.0f + fast_exp2(fminf(z0, 64.f)))), a1 = fmaxf(z1, fast_log2(1.0f + fast_exp2(fminf(z1, 64.f))));
                if (diag) { const int kv = crow(r, hi); if (kv >= kq) a0 = 0.f; if (kv + 32 >= kq) a1 = 0.f; }
                s0[r] = a0; s1[r] = a1; }
            const bf16x8 L0 = pack8r(s0, 0), L1 = pack8r(s0, 8), L2 = pack8r(s1, 0), L3 = pack8r(s1, 8);
            const f32x16 c16 = splat16(carry);
            f32x16 W0 = __builtin_amdgcn_mfma_f32_32x32x16_bf16(tri0, L0, c16, 0, 0, 0);
            W0 = __builtin_amdgcn_mfma_f32_32x32x16_bf16(tri1, L1, W0, 0, 0, 0);
            W0 = __builtin_amdgcn_mfma_f32_32x32x16_bf16(ones, L2, W0, 0, 0, 0);
            W0 = __builtin_amdgcn_mfma_f32_32x32x16_bf16(ones, L3, W0, 0, 0, 0);
            f32x16 W1 = __builtin_amdgcn_mfma_f32_32x32x16_bf16(tri0, L2, c16, 0, 0, 0);
            W1 = __builtin_amdgcn_mfma_f32_32x32x16_bf16(tri1, L3, W1, 0, 0, 0);
            carry = shl(W0[0], r32);
#pragma unroll
            for (int r = 0; r < 16; ++r) { float e0 = fast_exp2(p0[r] - W0[r]), e1 = fast_exp2(p1[r] - W1[r]);
                if (diag) { const int kv = crow(r, hi); if (kv >= kq) e0 = 0.f; if (kv + 32 >= kq) e1 = 0.f; }
                p0[r] = e0; p1[r] = e1; }
        }
        pv(o, vb0 + slot, pack8r(p0, 0), pack8r(p0, 8), pack8r(p1, 0), pack8r(p1, 8));
    }
    float rli[16];
    if constexpr (MOBA) {
        l_run += shx(l_run, 32, lane);
        if (hi == 0) wsf[32 + r32] = l_run; LDS_WAIT();
#pragma unroll
        for (int r = 0; r < 16; ++r) rli[r] = fast_rcp(wsf[32 + crow(r, hi)]);
    } else {
#pragma unroll
        for (int r = 0; r < 16; ++r) rli[r] = 1.f;
    }
    bf16* Ow = O + (rowbase + q0 + wid * 32) * PITCH + h * HD;
    { LAS bf16* stg = (LAS bf16*)(shm + L_OST) + wid * 2048;
#pragma unroll
        for (int r = 0; r < 16; ++r) { const int orow = crow(r, hi);
#pragma unroll
            for (int d0 = 0; d0 < 2; ++d0) stg[orow * 64 + d0 * 32 + r32] = (bf16)f2bf(o[d0][r] * rli[r]); }
        LDS_WAIT();
#pragma unroll
        for (int i = 0; i < 4; ++i) { const int row = i * 8 + (lane >> 3), ch = lane & 7; const v4u v = *(const LAS v4u*)(stg + row * 64 + ch * 8); *(v4u*)(Ow + (long)row * PITCH + ch * 8) = v; } }
    asm volatile("s_waitcnt lgkmcnt(0)\n\ts_barrier" ::: "memory");
#undef DMA_K
#undef DMA_V
}
}

struct Args { const float* in[20]; float* out; unsigned char* ws; int ph_lo, ph_hi; };
struct Frame {
    LAS unsigned char* lds; gu32* ctl; int tid, lane, wave, vcu, G;
};
#define FRESH(F) do { (F).tid = otid(); (F).lane = (F).tid & 63; (F).wave = __builtin_amdgcn_readfirstlane((F).tid >> 6); } while (0)
__device__ __forceinline__ float wave_sum(float v, int lane) {
#pragma unroll
    for (int o = 1; o < 64; o <<= 1) v += shx(v, o, lane);
    return v;
}
__device__ __forceinline__ void transpose_item(const float* W, int K, int N, bf16* WT, int mode, LAS float* scr, int item, int lane) {
    const int nblk = N / 32, kb = item / nblk, nb = item % nblk, k0 = 64 * kb, n0 = 32 * nb;
    const int rbase = (mode == 0) ? n0 : (256 * (n0 >> 7) + (n0 & 127) + (mode == 2 ? 128 : 0));
#pragma unroll 8
    for (int i = 0; i < 32; ++i) { const int kk = 2 * i + (lane >> 5); scr[kk * 33 + (lane & 31)] = W[(size_t)(k0 + kk) * N + n0 + (lane & 31)]; }
    LDS_WAIT(); asm volatile("" ::: "memory");
    const int c = lane & 7;
#pragma unroll
    for (int j = 0; j < 4; ++j) { const int n = (lane >> 3) + 8 * j; const LAS float* s = scr + (8 * c) * 33 + n;
        v4u o; o.x = pk2(s[0 * 33], s[1 * 33]); o.y = pk2(s[2 * 33], s[3 * 33]); o.z = pk2(s[4 * 33], s[5 * 33]); o.w = pk2(s[6 * 33], s[7 * 33]);
        *(GAS v4u*)(WT + (size_t)(rbase + n) * K + k0 + 8 * c) = o; }
    LDS_WAIT(); asm volatile("" ::: "memory");
}

struct RowArgs { const float* xin; float* xout; const bf16* Y; const float2* tokw_in; const float* gpost; const float* gate; const float* gpre; const float* shift; const float* scale; bf16* H;
                 const float* wrouter; int* lists; float2* tokw_out; unsigned* cnt; };
template <bool HAS_Y, bool PAIR, bool WRITE_H, bool ROUTER>
__device__ __forceinline__ void row_phase(Frame& F, const RowArgs& a) {
    FRESH(F);
    const int lane = F.lane; const int gw = F.vcu * NWAVES + F.wave; const int rows_per_wave = M / (F.G * NWAVES);
    const int m0 = gw * rows_per_wave; const int b = (F.vcu * NWAVES * rows_per_wave) / SEQ;
    LAS float* wr = (LAS float*)F.lds;
    LAS float* vec = (LAS float*)(F.lds + 32768);
    if constexpr (ROUTER) { for (int i = F.tid; i < D * NE / 4; i += NTHREADS) ((LAS f32x4*)wr)[i] = ((const f32x4*)a.wrouter)[i]; }
    for (int i = F.tid; i < D; i += NTHREADS) {
        if (HAS_Y) { vec[i] = a.gpost[i]; vec[D + i] = a.gate[(size_t)b * NMOD + i]; }
        if (WRITE_H) { vec[2 * D + i] = a.gpre[i]; vec[3 * D + i] = a.shift[(size_t)b * NMOD + i]; vec[4 * D + i] = a.scale[(size_t)b * NMOD + i] + 1.0f; } }
    __syncthreads();
    int my_e0 = -1, my_e1 = -1; float my_w0 = 0.f, my_w1 = 0.f;
    for (int i = 0; i < rows_per_wave; ++i) { const int m = m0 + i;
        f32x4 x[4];
#pragma unroll
        for (int j = 0; j < 4; ++j) x[j] = *(const f32x4*)(a.xin + (size_t)m * D + 256 * j + 4 * lane);
        if constexpr (HAS_Y) {
            f32x4 y[4];
            if constexpr (PAIR) { const float2 w = a.tokw_in[m];
#pragma unroll
                for (int j = 0; j < 4; ++j) { const v2u u0 = *(const v2u*)(a.Y + (size_t)(2 * m) * D + 256 * j + 4 * lane), u1 = *(const v2u*)(a.Y + (size_t)(2 * m + 1) * D + 256 * j + 4 * lane);
                    y[j] = (f32x4){w.x * bf_lo(u0.x) + w.y * bf_lo(u1.x), w.x * bf_hi(u0.x) + w.y * bf_hi(u1.x), w.x * bf_lo(u0.y) + w.y * bf_lo(u1.y), w.x * bf_hi(u0.y) + w.y * bf_hi(u1.y)}; }
            } else {
#pragma unroll
                for (int j = 0; j < 4; ++j) { const v2u u0 = *(const v2u*)(a.Y + (size_t)m * D + 256 * j + 4 * lane); y[j] = (f32x4){bf_lo(u0.x), bf_hi(u0.x), bf_lo(u0.y), bf_hi(u0.y)}; }
            }
            float s = 0.f;
#pragma unroll
            for (int j = 0; j < 4; ++j) s += (y[j].x * y[j].x + y[j].y * y[j].y) + (y[j].z * y[j].z + y[j].w * y[j].w);
            const float rstd = 1.0f / sqrtf(wave_sum(s, lane) * (1.0f / D) + EPS);
#pragma unroll
            for (int j = 0; j < 4; ++j) { const f32x4 gp = *(const LAS f32x4*)(vec + 256 * j + 4 * lane), gt = *(const LAS f32x4*)(vec + D + 256 * j + 4 * lane);
                x[j] = x[j] + gt * ((y[j] * rstd) * gp); *(f32x4*)(a.xout + (size_t)m * D + 256 * j + 4 * lane) = x[j]; }
        }
        if constexpr (WRITE_H) {
            float s = 0.f;
#pragma unroll
            for (int j = 0; j < 4; ++j) s += (x[j].x * x[j].x + x[j].y * x[j].y) + (x[j].z * x[j].z + x[j].w * x[j].w);
            const float rstd = 1.0f / sqrtf(wave_sum(s, lane) * (1.0f / D) + EPS);
#pragma unroll
            for (int j = 0; j < 4; ++j) { const f32x4 gp = *(const LAS f32x4*)(vec + 2 * D + 256 * j + 4 * lane), sh = *(const LAS f32x4*)(vec + 3 * D + 256 * j + 4 * lane), sc = *(const LAS f32x4*)(vec + 4 * D + 256 * j + 4 * lane);
                x[j] = ((x[j] * rstd) * gp) * sc + sh;
                v2u o; o.x = pk2(x[j].x, x[j].y); o.y = pk2(x[j].z, x[j].w); *(v2u*)(a.H + (size_t)m * D + 256 * j + 4 * lane) = o; }
            if constexpr (ROUTER) {
                float lg[NE];
#pragma unroll
                for (int e = 0; e < NE; ++e) lg[e] = 0.f;
#pragma unroll
                for (int j = 0; j < 4; ++j)
#pragma unroll
                    for (int c = 0; c < 4; ++c) { const LAS f32x4* wp = (const LAS f32x4*)(wr + (size_t)(256 * j + 4 * lane + c) * NE); const f32x4 w0 = wp[0], w1 = wp[1]; const float hvv = x[j][c];
                        lg[0] += hvv * w0.x; lg[1] += hvv * w0.y; lg[2] += hvv * w0.z; lg[3] += hvv * w0.w; lg[4] += hvv * w1.x; lg[5] += hvv * w1.y; lg[6] += hvv * w1.z; lg[7] += hvv * w1.w;
                        if (c == 3) asm volatile("" ::: "memory"); }
#pragma unroll
                for (int e = 0; e < NE; ++e) lg[e] = wave_sum(lg[e], lane);
                int e0 = 0; float v0 = lg[0];
#pragma unroll
                for (int e = 1; e < NE; ++e) if (lg[e] > v0) { v0 = lg[e]; e0 = e; }
                int e1 = -1; float v1 = -INFINITY;
#pragma unroll
                for (int e = 0; e < NE; ++e) if (e != e0 && lg[e] > v1) { v1 = lg[e]; e1 = e; }
                const float t = fast_exp2((v1 - v0) * LOG2E); const float w0 = 1.0f / (1.0f + t), w1 = t / (1.0f + t);
                if (lane == i) { my_e0 = e0; my_e1 = e1; my_w0 = w0; my_w1 = w1; }
            }
        }
    }
    if constexpr (ROUTER) {
        const bool act = lane < rows_per_wave; int pos0 = 0, pos1 = 0;
        const unsigned long long lt = (1ull << lane) - 1ull;
#pragma unroll
        for (int e = 0; e < NE; ++e) { const unsigned long long b0 = __ballot(act && my_e0 == e), b1 = __ballot(act && my_e1 == e);
            const int n0 = __popcll(b0), n1 = __popcll(b1); int base = 0;
            if (n0 + n1 > 0) { if (lane == 0) base = (int)__hip_atomic_fetch_add(a.cnt + 64 * e, (unsigned)(n0 + n1), RLX_AGENT); base = __builtin_amdgcn_readfirstlane(base); }
            if (act && my_e0 == e) pos0 = base + __popcll(b0 & lt);
            if (act && my_e1 == e) pos1 = base + n0 + __popcll(b1 & lt); }
        if (act) { const int m = m0 + lane; a.lists[my_e0 * M + pos0] = 2 * m; a.lists[my_e1 * M + pos1] = 2 * m + 1; a.tokw_out[m] = make_float2(my_w0, my_w1); }
    }
    __syncthreads();
}

template <class Sched>
__device__ __forceinline__ void moe_tables(Frame& F, const Sched& S, const int* lists, int panel0) {
    FRESH(F);
    LAS int* seg = (LAS int*)(F.lds + LDS_SEG); LAS int* tok = (LAS int*)(F.lds + LDS_TOK);
    if (F.tid == 0) { int acc = 0;
        for (int e = 0; e < NE; ++e) { const int c = (int)__hip_atomic_load((unsigned*)(F.ctl + CW_CNT + 64 * e), RLX_AGENT); seg[e] = acc; seg[16 + e] = c; acc += (c + 255) & ~255; }
        seg[8] = acc; }
    __syncthreads();
    pg8::Unit u;
    for (int ui = 0; ui < LDS_TOK_UNITS && S.next(ui, u); ++ui) {
        if (F.tid < 256) { const int row = (panel0 + u.pm) * 256 + F.tid; int e = 0;
#pragma unroll
            for (int j = 1; j < NE; ++j) e += (row >= seg[j]) ? 1 : 0;
            const int pos = row - seg[e]; tok[ui * 256 + F.tid] = (pos < seg[16 + e]) ? lists[e * M + pos] : -1; }
    }
    __syncthreads();
}

constexpr int PH_LAYER0 = 2, PH_STRIDE = 16, PH_END = PH_LAYER0 + 2 * PH_STRIDE;
__global__ void __launch_bounds__(NTHREADS, 2) mega_fwd(Args args) {
    extern __shared__ __attribute__((aligned(16))) unsigned char lds_raw[];
    Frame F; F.lds = (LAS unsigned char*)lds_raw; F.tid = threadIdx.x; F.lane = F.tid & 63; F.wave = __builtin_amdgcn_readfirstlane(F.tid >> 6);
    F.G = gridDim.x; { const int bx = blockIdx.x; F.vcu = (F.G % 8 == 0) ? (bx % 8) * (F.G / 8) + bx / 8 : bx; }
    unsigned char* ws = args.ws; F.ctl = (gu32*)(ws + WS_CTL);
    volatile LAS unsigned* MISC = (volatile LAS unsigned*)(F.lds + LDS_MISC);
    if (F.tid < 16) MISC[F.tid] = 0u;
    __syncthreads();
    XcdBarrier bar; bar.bar = (unsigned*)(F.ctl + CW_BAR); bar.x = 0; bar.st = nullptr;
    if (MK_ONE_LAUNCH) bar = xcd_barrier_post((unsigned*)(F.ctl + CW_BAR), MISC);
    const int lo = args.ph_lo, hi = args.ph_hi;
#define IN(k) (lo <= (k) && (k) < hi)
#define SEAM(k, knext) do { if (IN(k) && IN(knext)) xcd_barrier(bar); } while (0)
    const float* x_in = args.in[0]; const float* c_in = args.in[1]; const float* w_mod = args.in[2]; const float* b_mod = args.in[3];
    const float* g_mix_pre = args.in[4]; const float* g_mix_post = args.in[5]; const float* g_ffn_pre = args.in[6]; const float* g_ffn_post = args.in[7];
    const float* w_in = args.in[8]; const float* w_psb = args.in[9]; const float* w_pmb = args.in[10]; const float* w_out = args.in[11]; const float* rel_bias = args.in[12];
    const float* w1d = args.in[13]; const float* w3d = args.in[14]; const float* w2d = args.in[15]; const float* w_router = args.in[16];
    const float* w1m = args.in[17]; const float* w3m = args.in[18]; const float* w2m = args.in[19];
    float* xout = args.out;
    float* MOD = (float*)(ws + WS_MOD); int* LISTS = (int*)(ws + WS_LIST); float2* TOKW = (float2*)(ws + WS_TOKW);
    bf16* WIN = (bf16*)(ws + WS_WIN); bf16* WPSB = (bf16*)(ws + WS_WPSB); bf16* WPMB = (bf16*)(ws + WS_WPMB); bf16* WOUT = (bf16*)(ws + WS_WOUT);
    bf16* W13D = (bf16*)(ws + WS_W13D); bf16* W2D = (bf16*)(ws + WS_W2D); bf16* W13M = (bf16*)(ws + WS_W13M); bf16* W2M = (bf16*)(ws + WS_W2M);
    bf16* H = (bf16*)(ws + WS_H); bf16* BIG = (bf16*)(ws + WS_BIG);

    if (!SK(0) && IN(0)) {
        FRESH(F);
        if ((int)blockIdx.x < 192) {
            LAS float* cond = (LAS float*)F.lds;
            LAS float* part = (LAS float*)(F.lds + 65536);
            for (int i = F.tid; i < NB * D; i += NTHREADS) { const int bb = i / D, k = i % D; const float cv = c_in[i]; cond[k * 16 + bb] = cv * sigmoidf_(cv); }
            __syncthreads();
            const int l = (int)blockIdx.x / 96, n0 = ((int)blockIdx.x % 96) * 64;
            float acc[16];
#pragma unroll
            for (int bb = 0; bb < 16; ++bb) acc[bb] = 0.f;
            const float* wp = w_mod + (size_t)l * D * NMOD + n0 + F.lane;
#pragma unroll 4
            for (int kk = 0; kk < 128; ++kk) { const int k = F.wave * 128 + kk; const float wv = wp[(size_t)k * NMOD];
                const LAS f32x4* cp = (const LAS f32x4*)(cond + k * 16); const f32x4 c0 = cp[0], c1 = cp[1], c2 = cp[2], c3 = cp[3];
                acc[0] += c0.x * wv; acc[1] += c0.y * wv; acc[2] += c0.z * wv; acc[3] += c0.w * wv; acc[4] += c1.x * wv; acc[5] += c1.y * wv; acc[6] += c1.z * wv; acc[7] += c1.w * wv;
                acc[8] += c2.x * wv; acc[9] += c2.y * wv; acc[10] += c2.z * wv; acc[11] += c2.w * wv; acc[12] += c3.x * wv; acc[13] += c3.y * wv; acc[14] += c3.z * wv; acc[15] += c3.w * wv; }
#pragma unroll
            for (int bb = 0; bb < 16; ++bb) part[(F.wave * 16 + bb) * 64 + F.lane] = acc[bb];
            __syncthreads();
            for (int i = F.tid; i < 16 * 64; i += NTHREADS) { const int bb = i >> 6, n = i & 63; float s = b_mod[(size_t)l * NMOD + n0 + n];
#pragma unroll
                for (int w = 0; w < 8; ++w) s += part[(w * 16 + bb) * 64 + n];
                MOD[((size_t)l * NB + bb) * NMOD + n0 + n] = s; }
            __syncthreads();
        }
        LAS float* scr = (LAS float*)(F.lds + F.wave * 16384);
        const int gw = F.vcu * NWAVES + F.wave, NGW = F.G * NWAVES;
        constexpr int I_IN = (D / 64) * (INCOLS / 32), I_P = (WH / 64) * (D / 32), I_O = (D / 64) * (D / 32), I_13 = (D / 64) * (FF / 32), I_2 = (FF / 64) * (D / 32);
        constexpr int N_IN = 2 * I_IN, N_P = 4 * I_P, N_O = 2 * I_O, N_13 = 18 * I_13, N_2 = 9 * I_2, NITEMS = N_IN + N_P + N_O + N_13 + N_2;
        for (int it = gw; it < NITEMS; it += NGW) {
            int r = it;
            if (r < N_IN) { const int l = r / I_IN; transpose_item(w_in + (size_t)l * D * INCOLS, D, INCOLS, WIN + (size_t)l * INCOLS * D, 0, scr, r % I_IN, F.lane); continue; } r -= N_IN;
            if (r < N_P) { const int q = r / I_P, l = q & 1; const float* src = (q < 2 ? w_psb : w_pmb) + (size_t)l * WH * D; bf16* dst = (q < 2 ? WPSB : WPMB) + (size_t)l * D * WH; transpose_item(src, WH, D, dst, 0, scr, r % I_P, F.lane); continue; } r -= N_P;
            if (r < N_O) { const int l = r / I_O; transpose_item(w_out + (size_t)l * D * D, D, D, WOUT + (size_t)l * D * D, 0, scr, r % I_O, F.lane); continue; } r -= N_O;
            if (r < N_13) { const int q = r / I_13; const float* src; bf16* dst; int mode;
                if (q == 0) { src = w1d; dst = W13D; mode = 1; } else if (q == 1) { src = w3d; dst = W13D; mode = 2; }
                else if (q < 10) { src = w1m + (size_t)(q - 2) * D * FF; dst = W13M + (size_t)(q - 2) * 2 * FF * D; mode = 1; }
                else { src = w3m + (size_t)(q - 10) * D * FF; dst = W13M + (size_t)(q - 10) * 2 * FF * D; mode = 2; }
                transpose_item(src, D, FF, dst, mode, scr, r % I_13, F.lane); continue; } r -= N_13;
            { const int q = r / I_2; const float* src = (q == 0) ? w2d : w2m + (size_t)(q - 1) * FF * D; bf16* dst = (q == 0) ? W2D : W2M + (size_t)(q - 1) * D * FF; transpose_item(src, FF, D, dst, 0, scr, r % I_2, F.lane); }
        }
    }
    SEAM(0, 1);
    if (!SK(1) && IN(1)) {
        RowArgs a{}; a.xin = x_in; a.gpre = g_mix_pre; a.shift = MOD + 0 * D; a.scale = MOD + 1 * D; a.H = H;
        row_phase<false, false, true, false>(F, a);
    }
    SEAM(1, PH_LAYER0);

    for (int l = 0; l < 2; ++l) {
        const int pb = PH_LAYER0 + PH_STRIDE * l;
        const float* modl = MOD + (size_t)l * NB * NMOD;
        if (!SK(2) && IN(pb + 0)) {
            pg8::SchedPlain S; S.init(M / 256, INCOLS / 256, F.G, (int)blockIdx.x); S.A = (const char*)H; S.B = (const char*)(WIN + (size_t)l * INCOLS * D); S.tA = S.tB = (size_t)256 * D * 2;
            pg8::EpiInProj E{BIG};
            pg8::gemm_phase<pg8::EpiInProj, pg8::SchedPlain, true>(F.lds, D, S, E);
        }
        SEAM(pb + 0, pb + 1);
        if (!SK(3) && IN(pb + 1)) {
            bf16* QA = BIG + BIG_QA / 2; bf16* KA = BIG + BIG_KA / 2; bf16* VA = BIG + BIG_VA / 2; bf16* QB = BIG + BIG_QB / 2; bf16* KB = BIG + BIG_KB / 2; bf16* VB = BIG + BIG_VB / 2;
            for (int v = F.vcu; v < 256; v += F.G) { const int bh = v >> 1, set = v & 1;
                for (int i = 0; i < 8; ++i) { const int k = i & 3; const int qb = set == 0 ? (k == 0 ? 0 : k == 1 ? 7 : k == 2 ? 1 : 6) : (k == 0 ? 2 : k == 1 ? 5 : k == 2 ? 3 : 4);
                    if (i < 4) att::attn_unit<false>(bh >> 3, bh & 7, qb, QA, KA, VA, QA, rel_bias, F.lds);
                    else att::attn_unit<true>(bh >> 3, bh & 7, qb, QB, KB, VB, QB, rel_bias, F.lds); } }
        }
        SEAM(pb + 1, pb + 2);
        if (!SK(4) && IN(pb + 2)) {
            bf16* GA = BIG + BIG_GA / 2; bf16* GB = BIG + BIG_GB / 2;
            { pg8::SchedPlain S; S.init(M / 256, D / 256, F.G, (int)blockIdx.x); S.A = (const char*)(BIG + BIG_QA / 2); S.B = (const char*)(WPSB + (size_t)l * D * WH); S.tA = S.tB = (size_t)256 * WH * 2;
              pg8::EpiGate<false> E{GA, GA}; pg8::gemm_phase<pg8::EpiGate<false>, pg8::SchedPlain, true>(F.lds, WH, S, E); }
            VM_WAIT(); __syncthreads();
            { pg8::SchedPlain S; S.init(M / 256, D / 256, F.G, (int)blockIdx.x); S.A = (const char*)(BIG + BIG_QB / 2); S.B = (const char*)(WPMB + (size_t)l * D * WH); S.tA = S.tB = (size_t)256 * WH * 2;
              pg8::EpiGate<true> E{GB, GA}; pg8::gemm_phase<pg8::EpiGate<true>, pg8::SchedPlain, true>(F.lds, WH, S, E); }
        }
        SEAM(pb + 2, pb + 3);
        if (!SK(5) && IN(pb + 3)) {
            pg8::SchedPlain S; S.init(M / 256, D / 256, F.G, (int)blockIdx.x); S.A = (const char*)(BIG + BIG_GA / 2); S.B = (const char*)(WOUT + (size_t)l * D * D); S.tA = S.tB = (size_t)256 * D * 2;
            pg8::EpiBf16 E{BIG + BIG_Y / 2, D};
            pg8::gemm_phase<pg8::EpiBf16, pg8::SchedPlain, true>(F.lds, D, S, E);
        }
        SEAM(pb + 3, pb + 4);
        if (!SK(6) && IN(pb + 4)) {
            RowArgs a{}; a.xin = (l == 0) ? x_in : xout; a.xout = xout; a.Y = BIG + BIG_Y / 2; a.gpost = g_mix_post + (size_t)l * D; a.gate = modl + 2 * D;
            a.gpre = g_ffn_pre + (size_t)l * D; a.shift = modl + 3 * D; a.scale = modl + 4 * D; a.H = H;
            a.wrouter = w_router; a.lists = LISTS; a.tokw_out = TOKW; a.cnt = (unsigned*)(F.ctl + CW_CNT);
            if (l == 0) row_phase<true, false, true, false>(F, a); else row_phase<true, false, true, true>(F, a);
        }
        SEAM(pb + 4, pb + 5);
        if (l == 0) {
            if (!SK(7) && IN(pb + 5)) {
                pg8::SchedPlain S; S.init(M / 256, 2 * FF / 256, F.G, (int)blockIdx.x); S.A = (const char*)H; S.B = (const char*)W13D; S.tA = S.tB = (size_t)256 * D * 2;
                pg8::EpiSwiGLU E{BIG + BIG_ACT / 2};
                pg8::gemm_phase<pg8::EpiSwiGLU, pg8::SchedPlain, true>(F.lds, D, S, E);
            }
            SEAM(pb + 5, pb + 6);
            if (!SK(8) && IN(pb + 6)) {
                pg8::SchedPlain S; S.init(M / 256, D / 256, F.G, (int)blockIdx.x); S.A = (const char*)(BIG + BIG_ACT / 2); S.B = (const char*)W2D; S.tA = S.tB = (size_t)256 * FF * 2;
                pg8::EpiBf16 E{BIG + BIG_YF / 2, D};
                pg8::gemm_phase<pg8::EpiBf16, pg8::SchedPlain, true>(F.lds, FF, S, E);
            }
            SEAM(pb + 6, pb + 11);
        } else {
            for (int c = 0; c < MOE_NCHUNK; ++c) {
                const int panel0 = c * MOE_CHUNK_PANELS;
                int npan = 0;
                if (IN(pb + 5 + 2 * c) || IN(pb + 6 + 2 * c)) { int tot = 0;
                    for (int e = 0; e < NE; ++e) tot += ((int)__hip_atomic_load((unsigned*)(F.ctl + CW_CNT + 64 * e), RLX_AGENT) + 255) >> 8;
                    npan = tot - panel0; npan = npan < 0 ? 0 : (npan > MOE_CHUNK_PANELS ? MOE_CHUNK_PANELS : npan); }
                if (!SK(9) && IN(pb + 5 + 2 * c)) {
                    pg8::SchedMoeUp S; S.init(npan, 2 * FF / 256, F.G, (int)blockIdx.x); S.A = (const char*)H; S.B = (const char*)W13M; S.tA = 0; S.tB = (size_t)256 * D * 2; S.eB = (size_t)2 * FF * D * 2;
                    S.panel0 = panel0; S.seg = (const LAS int*)(F.lds + LDS_SEG); S.tok = (const LAS int*)(F.lds + LDS_TOK);
                    moe_tables(F, S, LISTS, panel0);
                    pg8::EpiSwiGLU E{BIG + BIG_HID / 2};
                    pg8::gemm_phase<pg8::EpiSwiGLU, pg8::SchedMoeUp, true>(F.lds, D, S, E);
                }
                SEAM(pb + 5 + 2 * c, pb + 6 + 2 * c);
                if (!SK(10) && IN(pb + 6 + 2 * c)) {
                    pg8::SchedMoeDown S; S.init(npan, D / 256, F.G, (int)blockIdx.x); S.A = (const char*)(BIG + BIG_HID / 2); S.B = (const char*)W2M; S.tA = S.tB = (size_t)256 * FF * 2; S.eB = (size_t)D * FF * 2;
                    S.panel0 = panel0; S.seg = (const LAS int*)(F.lds + LDS_SEG); S.tok = (const LAS int*)(F.lds + LDS_TOK);
                    moe_tables(F, S, LISTS, panel0);
                    pg8::EpiMoeDown E{BIG + BIG_YP / 2, (const LAS int*)(F.lds + LDS_TOK)};
                    pg8::gemm_phase<pg8::EpiMoeDown, pg8::SchedMoeDown, true>(F.lds, FF, S, E);
                }
                SEAM(pb + 6 + 2 * c, (c + 1 < MOE_NCHUNK) ? pb + 7 + 2 * c : pb + 11);
            }
        }
        if (!SK(11) && IN(pb + 11)) {
            RowArgs a{}; a.xin = xout; a.xout = xout; a.gpost = g_ffn_post + (size_t)l * D; a.gate = modl + 5 * D; a.H = H;
            if (l == 0) { a.Y = BIG + BIG_YF / 2; a.gpre = g_mix_pre + (size_t)(l + 1) * D; a.shift = MOD + (size_t)(l + 1) * NB * NMOD + 0 * D; a.scale = MOD + (size_t)(l + 1) * NB * NMOD + 1 * D;
                row_phase<true, false, true, false>(F, a); }
            else { a.Y = BIG + BIG_YP / 2; a.tokw_in = TOKW; row_phase<true, true, false, false>(F, a); }
        }
        if (l == 0) SEAM(pb + 11, pb + PH_STRIDE);
    }
#undef IN
#undef SEAM
}

extern "C" void kernel_launch(void* const* d_in, const int* in_sizes, int n_in, void* d_out, int out_size, void* d_ws, size_t ws_size, hipStream_t stream) {
    static int grid = 0;
    if (grid == 0) {
        if (n_in != 20 || in_sizes[0] != M * D || out_size != M * D || ws_size < WS_END) { fprintf(stderr, "kernel_launch: unexpected shapes (n_in %d, ws %zu)\n", n_in, ws_size); grid = -1; return; }
        int dev = 0, cus = 0;
        if (hipGetDevice(&dev) != hipSuccess || hipDeviceGetAttribute(&cus, hipDeviceAttributeMultiprocessorCount, dev) != hipSuccess) { grid = -1; return; }
        if (hipFuncSetAttribute((const void*)mega_fwd, hipFuncAttributeMaxDynamicSharedMemorySize, LDS_BYTES) != hipSuccess) { fprintf(stderr, "kernel_launch: hipFuncSetAttribute failed\n"); grid = -1; return; }
        int per_cu = 0;
        if (hipOccupancyMaxActiveBlocksPerMultiprocessor(&per_cu, (const void*)mega_fwd, NTHREADS, LDS_BYTES) != hipSuccess || per_cu < 1) fprintf(stderr, "kernel_launch: occupancy query reports %d\n", per_cu);
        (void)hipGetLastError();
        grid = cus;
        if (grid != 256) { fprintf(stderr, "kernel_launch: built for 256 CUs, found %d\n", cus); grid = -1; return; }
    }
    if (grid < 0) return;
    if (hipMemsetAsync((char*)d_ws + WS_CTL, 0, CTL_ZERO_BYTES, stream) != hipSuccess) return;
    Args a{};
    for (int i = 0; i < 20; ++i) a.in[i] = (const float*)d_in[i];
    a.out = (float*)d_out; a.ws = (unsigned char*)d_ws;
#if MK_ONE_LAUNCH
    a.ph_lo = 0; a.ph_hi = PH_END;
    hipLaunchKernelGGL(mega_fwd, dim3(grid), dim3(NTHREADS), LDS_BYTES, stream, a);
#else
    for (int p = 0; p < PH_END; ++p) {
        const int rel = p < PH_LAYER0 ? -1 : (p - PH_LAYER0) % PH_STRIDE, l = p < PH_LAYER0 ? 0 : (p - PH_LAYER0) / PH_STRIDE;
        if (rel >= 0) { if (l == 0 && rel > 6 && rel != 11) continue; if (rel > 11) continue; }
        a.ph_lo = p; a.ph_hi = p + 1;
        hipLaunchKernelGGL(mega_fwd, dim3(grid), dim3(NTHREADS), LDS_BYTES, stream, a);
    }
#endif
}
```

```cpp
#include <hip/hip_runtime.h>
#include <hip/hip_bf16.h>
#include <cstdio>
#include <cstdint>
#include <cmath>

#ifndef MK_ONE_LAUNCH
#define MK_ONE_LAUNCH 1
#endif
#ifndef MK_SKIP
#define MK_SKIP 0
#endif
#define SK(b) ((MK_SKIP >> (b)) & 1)

#define GAS __attribute__((address_space(1)))
#define LAS __attribute__((address_space(3)))
typedef unsigned short bf16;
typedef unsigned v4u __attribute__((ext_vector_type(4)));
typedef unsigned v2u __attribute__((ext_vector_type(2)));
typedef float f32x4 __attribute__((ext_vector_type(4)));
typedef float f32x2 __attribute__((ext_vector_type(2)));
typedef float f32x16 __attribute__((ext_vector_type(16)));
typedef short bf16x8 __attribute__((ext_vector_type(8)));
typedef short s16x4 __attribute__((ext_vector_type(4)));
typedef GAS unsigned gu32;
#define RLX_AGENT __ATOMIC_RELAXED, __HIP_MEMORY_SCOPE_AGENT
#define LDS_WAIT() asm volatile("s_waitcnt lgkmcnt(0)" ::: "memory")
#define VM_WAIT() asm volatile("s_waitcnt vmcnt(0)" ::: "memory")

constexpr int NB = 16, SEQ = 2048, D = 1024, M = NB * SEQ, NH = 8, HD = 64, WH = 512, INCOLS = 5120, FF = 3584, NE = 8, NMOD = 6 * D;
constexpr float EPS = 1e-6f;
constexpr float LOG2E = 1.4426950408889634f;
constexpr float C2 = 0.125f * LOG2E;
constexpr int NWAVES = 8, NTHREADS = 512;

constexpr size_t MiB = 1u << 20;
constexpr size_t WS_CTL = 0, CTL_ZERO_BYTES = 1 * MiB;
constexpr size_t WS_MOD = 1 * MiB;
constexpr size_t WS_LIST = 2 * MiB;
constexpr size_t WS_TOKW = 3 * MiB;
constexpr size_t WS_WIN = 4 * MiB;
constexpr size_t WS_WPSB = 24 * MiB;
constexpr size_t WS_WPMB = 26 * MiB;
constexpr size_t WS_WOUT = 28 * MiB;
constexpr size_t WS_W13D = 32 * MiB;
constexpr size_t WS_W2D = 46 * MiB;
constexpr size_t WS_W13M = 53 * MiB;
constexpr size_t WS_W2M = 165 * MiB;
constexpr size_t WS_H = 221 * MiB;
constexpr size_t WS_BIG = 285 * MiB;
constexpr size_t WS_END = 605 * MiB;
constexpr size_t PLANE = (size_t)M * WH * 2;
constexpr size_t BIG_QA = 0, BIG_KA = PLANE, BIG_VA = 2 * PLANE, BIG_QB = 3 * PLANE, BIG_KB = 4 * PLANE, BIG_VB = 5 * PLANE, BIG_GA = 6 * PLANE, BIG_GB = 8 * PLANE;
constexpr size_t BIG_Y = 0;
constexpr size_t BIG_ACT = 0, BIG_YF = 224 * MiB;
constexpr int MOE_CHUNK_PANELS = 88, MOE_NCHUNK = 3;
constexpr size_t BIG_HID = 0, BIG_YP = 160 * MiB;
static_assert(BIG_YP + (size_t)M * 2 * D * 2 <= 320 * MiB && (size_t)MOE_CHUNK_PANELS * 256 * FF * 2 <= BIG_YP && BIG_YF + (size_t)M * D * 2 <= 320 * MiB, "BIG map");
constexpr int CW_TMO = 0, CW_CODE = 1, CW_BAR = 4096, CW_CNT = 16384;

constexpr int RING_BYTES = 131072;
constexpr int LDS_TOK = RING_BYTES;
constexpr int LDS_TOK_UNITS = 12;
constexpr int LDS_SEG = LDS_TOK + LDS_TOK_UNITS * 1024;
constexpr int LDS_MISC = LDS_SEG + 128;
constexpr int LDS_BYTES = LDS_MISC + 64;
static_assert(LDS_BYTES <= 160 * 1024, "LDS");

__device__ __forceinline__ unsigned f2bf(float f) { unsigned u = __builtin_bit_cast(unsigned, f); return (u + 0x7fffu + ((u >> 16) & 1u)) >> 16; }
__device__ __forceinline__ unsigned pk2(float lo, float hi) { return f2bf(lo) | (f2bf(hi) << 16); }
__device__ __forceinline__ float bf_lo(unsigned w) { return __builtin_bit_cast(float, w << 16); }
__device__ __forceinline__ float bf_hi(unsigned w) { return __builtin_bit_cast(float, w & 0xffff0000u); }
__device__ __forceinline__ unsigned cvt_pk_bf16(float lo, float hi) { typedef __bf16 bf2 __attribute__((ext_vector_type(2))); f32x2 v = {lo, hi}; bf2 b = __builtin_convertvector(v, bf2); return __builtin_bit_cast(unsigned, b); }
__device__ __forceinline__ float fast_exp2(float x) { return __builtin_amdgcn_exp2f(x); }
__device__ __forceinline__ float fast_log2(float x) { return __builtin_amdgcn_logf(x); }
__device__ __forceinline__ float fast_rcp(float x) { return __builtin_amdgcn_rcpf(x); }
__device__ __forceinline__ int otid() { int t = threadIdx.x; asm volatile("" : "+v"(t)); return t; }
__device__ __forceinline__ float shx(float v, int o, int lane) { return __builtin_bit_cast(float, __builtin_amdgcn_ds_bpermute((lane ^ o) << 2, __builtin_bit_cast(int, v))); }
__device__ __forceinline__ float shl(float v, int src) { return __builtin_bit_cast(float, __builtin_amdgcn_ds_bpermute(src << 2, __builtin_bit_cast(int, v))); }
__device__ __forceinline__ float sigmoidf_(float x) { return fast_rcp(1.0f + fast_exp2(-x * LOG2E)); }

#define XB_TMO      128
#define XB_XCNT(j)  (256  + 64 * (j))
#define XB_XSUB(j)  (1280 + 64 * (j))
#define XB_XGEN(j)  (2304 + 64 * (j))
#define XB_TOP      3328
#define XB_TOPGEN   3392
#define XCD_BAR_WORDS 3456
#define XB_SPIN_CAP (1u << 18)
__device__ __forceinline__ unsigned xb_ld(unsigned* p)              { return __hip_atomic_load(p, __ATOMIC_RELAXED, __HIP_MEMORY_SCOPE_AGENT); }
__device__ __forceinline__ unsigned xb_add(unsigned* p, unsigned v) { return __hip_atomic_fetch_add(p, v, __ATOMIC_RELAXED, __HIP_MEMORY_SCOPE_AGENT); }
__device__ __forceinline__ unsigned xb_xcc_id() { return (unsigned)__builtin_amdgcn_s_getreg((3 << 11) | 20) & 0xFu; }
#define XB_SPIN(cond, bar) do { unsigned _sp = 0; while (cond) { __builtin_amdgcn_s_sleep(1); \
    if ((++_sp & 255u) == 0u) { if (xb_ld(&(bar)[XB_TMO])) break; if (_sp > XB_SPIN_CAP) { atomicAdd(&(bar)[XB_TMO], 1u); break; } } } } while (0)
struct XcdBarrier { unsigned* bar; unsigned x; volatile LAS unsigned* st; };
__device__ __forceinline__ XcdBarrier xcd_barrier_post(unsigned* bar, volatile LAS unsigned* st) {
    XcdBarrier b; b.bar = bar; b.x = xb_xcc_id(); b.st = st;
    if (threadIdx.x == 0) (void)xb_add(&bar[XB_XCNT(b.x)], 1u);
    return b;
}
__device__ __forceinline__ void xcd_barrier_complete(unsigned* bar, unsigned x, unsigned& nloc, unsigned& nx) {
    const unsigned G = gridDim.x * gridDim.y * gridDim.z;
    unsigned sum, cnt, mine, sp = 0u;
    for (;;) {
        sum = 0u; cnt = 0u; mine = 0u;
#pragma unroll
        for (unsigned j = 0; j < 16; ++j) { const unsigned c = xb_ld(&bar[XB_XCNT(j)]); sum += c; cnt += (c > 0u) ? 1u : 0u; mine = (j == x) ? c : mine; }
        if (sum == G) break;
        __builtin_amdgcn_s_sleep(1);
        if ((++sp & 255u) == 0u) { if (xb_ld(&bar[XB_TMO])) break; if (sp > XB_SPIN_CAP) { atomicAdd(&bar[XB_TMO], 1u); break; } }
    }
    nloc = mine > 0u ? mine : 1u; nx = cnt > 0u ? cnt : 1u;
}
__device__ __forceinline__ void xcd_barrier(const XcdBarrier& b) {
    asm volatile("s_waitcnt vmcnt(0)" ::: "memory");
    __syncthreads();
    if (threadIdx.x == 0) {
        unsigned* bar = b.bar;
        __builtin_amdgcn_s_waitcnt(0);
        unsigned nloc = b.st[0], nx = b.st[1];
        if (nloc == 0u) { xcd_barrier_complete(bar, b.x, nloc, nx); b.st[0] = nloc; b.st[1] = nx; }
        const unsigned old = xb_add(&bar[XB_XSUB(b.x)], 1u);
        const unsigned gen = old / nloc;
        if (old + 1u == (gen + 1u) * nloc) {
            __builtin_amdgcn_fence(__ATOMIC_RELEASE, "agent");
            asm volatile("s_waitcnt vmcnt(0)" ::: "memory");
            const unsigned og = xb_add(&bar[XB_TOP], 1u);
            const unsigned tg = og / nx;
            if (og + 1u == (tg + 1u) * nx) xb_add(&bar[XB_TOPGEN], 1u);
            else XB_SPIN(xb_ld(&bar[XB_TOPGEN]) == tg, bar);
            __builtin_amdgcn_fence(__ATOMIC_ACQUIRE, "agent");
            xb_add(&bar[XB_XGEN(b.x)], 1u);
            asm volatile("s_waitcnt vmcnt(0)" ::: "memory");
        } else {
            XB_SPIN(xb_ld(&bar[XB_XGEN(b.x)]) == gen, bar);
            __builtin_amdgcn_fence(__ATOMIC_ACQUIRE, "agent");
            asm volatile("s_waitcnt vmcnt(0)" ::: "memory");
        }
    }
    __syncthreads();
}

namespace pg8 {
constexpr int BM = 256, BK = 64, HALF = 128, HTB = HALF * BK * 2, STAGE_BYTES = 8 * HTB, NXCD = 8, WGM = 8;
__host__ __device__ __forceinline__ int lds_byte(int r, int c) { const int st = (r >> 4) * 2 + (c >> 5), rr = r & 15, cc = c & 31, ob = rr * 64 + cc * 2; return st * 1024 + (ob ^ (((ob >> 9) & 1) << 5)); }
__host__ __device__ __forceinline__ void stage_rc(int b, int& R, int& C) { const int st = b / 1024, sb = b % 1024, swz = sb ^ (((sb >> 9) & 1) << 5); R = (st >> 1) * 16 + swz / 64; C = (st & 1) * 32 + (swz % 64) / 2; }
__host__ __device__ __forceinline__ int perm32(int rho) { const int n = rho >> 4, i = rho & 15; return 8 * (i >> 2) + 4 * n + (i & 3); }
struct Unit { int pm, pn; };
struct StaticOrder {
    int nM, nN, nwg, G, c;
    __host__ __device__ void init(int nM_, int nN_, int G_, int c_) { nM = nM_; nN = nN_; nwg = nM * nN; G = G_; c = c_; }
    __host__ __device__ bool next(int i, Unit& u) const {
        const long L = (long)i * G + c; if (L >= nwg) return false;
        int wgid = (int)L; { const int q = nwg / NXCD, r = nwg % NXCD, xcd = wgid % NXCD, off = wgid / NXCD; wgid = (xcd < r ? xcd * (q + 1) : r * (q + 1) + (xcd - r) * q) + off; }
        const int nig = WGM * nN, gid = wgid / nig, fm = gid * WGM, gsz = (nM - fm) < WGM ? (nM - fm) : WGM;
        u.pm = fm + ((wgid % nig) % gsz); u.pn = (wgid % nig) / gsz; return true;
    }
};
template <class Epi, class Sched, bool ALIGN_EPI>
__device__ __forceinline__ void gemm_phase(LAS unsigned char* lds, const int K, const Sched& S, const Epi& E) {
    const int tid = otid(), wid = __builtin_amdgcn_readfirstlane(tid >> 6), lane = tid & 63, wr = wid >> 2, wc = wid & 3, fr = lane & 15, fq = lane >> 4;
    const int nt = K / BK;
    unsigned voffA[2], voffB[2];
#pragma unroll
    for (int i = 0; i < 2; ++i) { int R, C; stage_rc(tid * 16 + i * 8192, R, C); const int Rb = Epi::PERM ? ((R & ~31) + perm32(R & 31)) : R;
        voffA[i] = (unsigned)(R * K + C) * 2u; voffB[i] = (unsigned)(Rb * K + C) * 2u; }
#define PG8_GVOFF(uix) do { _Pragma("unroll") for (int _h = 0; _h < 2; ++_h) _Pragma("unroll") for (int _i = 0; _i < 2; ++_i) { int R_, C_; stage_rc(tid * 16 + _i * 8192, R_, C_); vg[_h][_i] = S.gvoff((uix), _h * HALF + R_, C_, K); } } while (0)
    const size_t kstep = (size_t)(BK * 2);
    const size_t hstep = (size_t)HALF * K * 2;
    const unsigned ldsw = (unsigned)wid * 1024u;
    const int aoff = lds_byte(wr * 64 + fr, fq * 8), boff = lds_byte(wc * 32 + fr, fq * 8);
#define PG8_SA(b, h) (((b) * 2 + (h)) * HTB)
#define PG8_SB(b, h) ((4 + (b) * 2 + (h)) * HTB)
#define PG8_STAGE(bufoff, gbase, voff) do { _Pragma("unroll") for (int _i = 0; _i < 2; ++_i) \
        __builtin_amdgcn_global_load_lds((const unsigned*)((const char*)(gbase) + (voff)[_i]), (LAS unsigned*)(lds + (bufoff) + ldsw + _i * 8192), 16, 0, 0); } while (0)
#define PG8_STAGE_A(bufoff, kp, h) do { if constexpr (Sched::GATHER) { PG8_STAGE(bufoff, kp, vg[h]); } else { PG8_STAGE(bufoff, (kp) + (h) * hstep, voffA); } } while (0)
#define PG8_LDA(dst, b, h) do { _Pragma("unroll") for (int m = 0; m < 4; ++m) _Pragma("unroll") for (int k = 0; k < 2; ++k) dst[m][k] = *(const LAS bf16x8*)(lds + PG8_SA(b, h) + aoff + m * 2048 + k * 1024); } while (0)
#define PG8_LDB(dst, b, h) do { _Pragma("unroll") for (int n = 0; n < 2; ++n) _Pragma("unroll") for (int k = 0; k < 2; ++k) dst[n][k] = *(const LAS bf16x8*)(lds + PG8_SB(b, h) + boff + n * 2048 + k * 1024); } while (0)
#define PG8_MMA(ai, bj, At, Bt) do { __builtin_amdgcn_s_setprio(1); _Pragma("unroll") for (int m = 0; m < 4; ++m) _Pragma("unroll") for (int n = 0; n < 2; ++n) _Pragma("unroll") for (int k = 0; k < 2; ++k) \
        acc[ai][bj][m][n] = __builtin_amdgcn_mfma_f32_16x16x32_bf16(Bt[n][k], At[m][k], acc[ai][bj][m][n], 0, 0, 0); __builtin_amdgcn_s_setprio(0); } while (0)
#define PG8_WAIT_V(n) asm volatile("s_waitcnt vmcnt(" #n ")" ::: "memory")
#define PG8_WAIT_L(n) asm volatile("s_waitcnt lgkmcnt(" #n ")" ::: "memory")
#define PG8_BAR __builtin_amdgcn_s_barrier()
#define PG8_SCHED __builtin_amdgcn_sched_barrier(0)
    Unit cur, nxt; int ui = 0;
    if (!S.next(0, cur)) return;
    f32x4 acc[2][2][4][2];
#pragma unroll
    for (int a = 0; a < 2; ++a)
#pragma unroll
        for (int b = 0; b < 2; ++b)
#pragma unroll
            for (int m = 0; m < 4; ++m)
#pragma unroll
                for (int n = 0; n < 2; ++n) acc[a][b][m][n] = (f32x4){0.f, 0.f, 0.f, 0.f};
    bf16x8 At[4][2], B0[2][2], B1[2][2];
    unsigned vg[2][2];
    if constexpr (Sched::GATHER) PG8_GVOFF(0);
    const char* cA = S.a_base(cur); const char* cB = S.b_base(cur);
    PG8_STAGE(PG8_SB(0, 0), cB, voffB); PG8_STAGE(PG8_SB(0, 1), cB + hstep, voffB); PG8_STAGE_A(PG8_SA(0, 0), cA, 0); PG8_STAGE_A(PG8_SA(0, 1), cA, 1);
    if (wr == 1) PG8_BAR;
    PG8_WAIT_V(2); PG8_BAR;
    PG8_STAGE(PG8_SB(1, 0), cB + kstep, voffB); PG8_STAGE_A(PG8_SA(1, 0), cA + kstep, 0); PG8_STAGE(PG8_SB(1, 1), cB + hstep + kstep, voffB);
    PG8_WAIT_V(6); PG8_BAR;
    for (;;) {
        const bool has_next = S.next(ui + 1, nxt);
        const char* nA = has_next ? S.a_base(nxt) : cA; const char* nB = has_next ? S.b_base(nxt) : cB;
        for (int t = 0; t < nt; t += 2) {
            const bool last = (t == nt - 2);
            const char* a1 = cA + (size_t)(t + 1) * kstep;
            const char* a2 = last ? nA : cA + (size_t)(t + 2) * kstep; const char* b2 = last ? nB : cB + (size_t)(t + 2) * kstep;
            const char* a3 = a2 + kstep; const char* b3 = b2 + kstep;
            PG8_LDB(B0, 0, 0); PG8_LDB(B1, 0, 1); PG8_SCHED; PG8_LDA(At, 0, 0); PG8_STAGE_A(PG8_SA(1, 1), a1, 1);
            if constexpr (Sched::GATHER) { if (last && has_next) PG8_GVOFF(ui + 1); }
            PG8_WAIT_V(8); PG8_WAIT_L(0); PG8_BAR; PG8_MMA(0, 0, At, B0); PG8_MMA(0, 1, At, B1); PG8_BAR; PG8_SCHED;
            PG8_LDA(At, 0, 1); PG8_STAGE(PG8_SB(0, 0), b2, voffB); PG8_STAGE(PG8_SB(0, 1), b2 + hstep, voffB); PG8_STAGE_A(PG8_SA(0, 0), a2, 0);
            PG8_WAIT_V(8); PG8_WAIT_L(0); PG8_BAR; PG8_MMA(1, 0, At, B0); PG8_MMA(1, 1, At, B1); PG8_BAR; PG8_SCHED;
            PG8_LDB(B0, 1, 0); PG8_LDB(B1, 1, 1); PG8_SCHED; PG8_LDA(At, 1, 0); PG8_STAGE_A(PG8_SA(0, 1), a2, 1);
            PG8_WAIT_V(8); PG8_WAIT_L(0); PG8_BAR; PG8_MMA(0, 0, At, B0); PG8_MMA(0, 1, At, B1); PG8_BAR; PG8_SCHED;
            PG8_LDA(At, 1, 1); PG8_STAGE(PG8_SB(1, 0), b3, voffB); PG8_STAGE(PG8_SB(1, 1), b3 + hstep, voffB); PG8_STAGE_A(PG8_SA(1, 0), a3, 0);
            PG8_WAIT_V(8); PG8_WAIT_L(0); PG8_BAR; PG8_MMA(1, 0, At, B0); PG8_MMA(1, 1, At, B1); PG8_BAR; PG8_SCHED;
        }
        if constexpr (ALIGN_EPI) { if (wr == 0) PG8_BAR; }
        E(acc, cur, ui, wr, wc, fr, fq);
        if (!has_next) break;
#pragma unroll
        for (int a = 0; a < 2; ++a)
#pragma unroll
            for (int b = 0; b < 2; ++b)
#pragma unroll
                for (int m = 0; m < 4; ++m)
#pragma unroll
                    for (int n = 0; n < 2; ++n) acc[a][b][m][n] = (f32x4){0.f, 0.f, 0.f, 0.f};
        cur = nxt; cA = nA; cB = nB; ++ui;
        if constexpr (ALIGN_EPI) { if (wr == 1) PG8_BAR; }
    }
    PG8_WAIT_V(0);
    if constexpr (!ALIGN_EPI) { if (wr == 0) PG8_BAR; }
    PG8_BAR;
#undef PG8_SA
#undef PG8_SB
#undef PG8_STAGE
#undef PG8_STAGE_A
#undef PG8_GVOFF
#undef PG8_LDA
#undef PG8_LDB
#undef PG8_MMA
#undef PG8_WAIT_V
#undef PG8_WAIT_L
#undef PG8_BAR
#undef PG8_SCHED
}

struct SchedPlain : StaticOrder {
    static constexpr bool GATHER = false;
    const char* A; const char* B; size_t tA, tB;
    __device__ __forceinline__ const char* a_base(const Unit& u) const { return A + (size_t)u.pm * tA; }
    __device__ __forceinline__ const char* b_base(const Unit& u) const { return B + (size_t)u.pn * tB; }
    __device__ __forceinline__ unsigned gvoff(int, int, int, int) const { return 0u; }
};
struct SchedMoe : StaticOrder {
    const char* A; const char* B; size_t tA, tB, eB; int panel0; const LAS int* seg; const LAS int* tok;
    __device__ __forceinline__ int expert(const Unit& u) const { const int row = (panel0 + u.pm) * 256; int e = 0;
#pragma unroll
        for (int j = 1; j < NE; ++j) e += (row >= seg[j]) ? 1 : 0;
        return e; }
    __device__ __forceinline__ const char* b_base(const Unit& u) const { return B + (size_t)expert(u) * eB + (size_t)u.pn * tB; }
};
struct SchedMoeUp : SchedMoe {
    static constexpr bool GATHER = true;
    __device__ __forceinline__ const char* a_base(const Unit&) const { return A; }
    __device__ __forceinline__ unsigned gvoff(int ui, int row, int col, int K) const { const int e = tok[ui * 256 + row]; const int t = e < 0 ? 0 : (e >> 1); return (unsigned)(t * K + col) * 2u; }
};
struct SchedMoeDown : SchedMoe {
    static constexpr bool GATHER = false;
    __device__ __forceinline__ const char* a_base(const Unit& u) const { return A + (size_t)u.pm * tA; }
    __device__ __forceinline__ unsigned gvoff(int, int, int, int) const { return 0u; }
};

typedef f32x4 Acc[2][2][4][2];
__device__ __forceinline__ v4u pack8(f32x4 v0, f32x4 v1) { v4u w; w.x = cvt_pk_bf16(v0[0], v0[1]); w.y = cvt_pk_bf16(v0[2], v0[3]); w.z = cvt_pk_bf16(v1[0], v1[1]); w.w = cvt_pk_bf16(v1[2], v1[3]); return w; }
__device__ __forceinline__ void unpack8(v4u w, f32x4& v0, f32x4& v1) { v0 = (f32x4){bf_lo(w.x), bf_hi(w.x), bf_lo(w.y), bf_hi(w.y)}; v1 = (f32x4){bf_lo(w.z), bf_hi(w.z), bf_lo(w.w), bf_hi(w.w)}; }

struct EpiInProj {
    static constexpr bool PERM = true;
    bf16* big;
    __device__ __forceinline__ void operator()(const Acc& acc, const Unit& u, int, int wr, int wc, int fr, int fq) const {
        const int t = u.pn; bf16* base; int ldc, colt; float sc = 1.f;
        if (t < 12) { const int pl = t >> 1; base = big + (size_t)pl * ((size_t)M * WH); ldc = WH; colt = (t & 1) * 256; if (pl == 0 || pl == 3) sc = C2; }
        else { const int g = (t - 12) >> 2; base = big + (size_t)6 * ((size_t)M * WH) + (size_t)g * ((size_t)M * D); ldc = D; colt = ((t - 12) & 3) * 256; }
        const int row0 = u.pm * BM + wr * 64 + fr, col0 = colt + wc * 32 + 8 * fq;
#pragma unroll
        for (int ai = 0; ai < 2; ++ai)
#pragma unroll
            for (int m = 0; m < 4; ++m) { bf16* rowp = base + (size_t)(row0 + ai * HALF + m * 16) * ldc + col0;
#pragma unroll
                for (int bj = 0; bj < 2; ++bj) *(v4u*)(rowp + bj * HALF) = pack8(acc[ai][bj][m][0] * sc, acc[ai][bj][m][1] * sc); }
    }
};
struct EpiBf16 {
    static constexpr bool PERM = true;
    bf16* O; int ldc;
    __device__ __forceinline__ void operator()(const Acc& acc, const Unit& u, int, int wr, int wc, int fr, int fq) const {
        const int row0 = u.pm * BM + wr * 64 + fr, col0 = u.pn * BM + wc * 32 + 8 * fq;
#pragma unroll
        for (int ai = 0; ai < 2; ++ai)
#pragma unroll
            for (int m = 0; m < 4; ++m) { bf16* rowp = O + (size_t)(row0 + ai * HALF + m * 16) * ldc + col0;
#pragma unroll
                for (int bj = 0; bj < 2; ++bj) *(v4u*)(rowp + bj * HALF) = pack8(acc[ai][bj][m][0], acc[ai][bj][m][1]); }
    }
};
template <bool ADD> struct EpiGate {
    static constexpr bool PERM = true;
    const bf16* G; bf16* T;
    __device__ __forceinline__ void operator()(const Acc& acc, const Unit& u, int, int wr, int wc, int fr, int fq) const {
        const int row0 = u.pm * BM + wr * 64 + fr, col0 = u.pn * BM + wc * 32 + 8 * fq;
#pragma unroll
        for (int ai = 0; ai < 2; ++ai)
#pragma unroll
            for (int m = 0; m < 4; ++m) { const size_t off = (size_t)(row0 + ai * HALF + m * 16) * D + col0;
#pragma unroll
                for (int bj = 0; bj < 2; ++bj) { const v4u gw = *(const v4u*)(G + off + bj * HALF); f32x4 g0, g1; unpack8(gw, g0, g1);
                    f32x4 t0 = {0.f, 0.f, 0.f, 0.f}, t1 = {0.f, 0.f, 0.f, 0.f};
                    if (ADD) { const v4u tw = *(const v4u*)(T + off + bj * HALF); unpack8(tw, t0, t1); }
                    f32x4 o0, o1;
#pragma unroll
                    for (int c = 0; c < 4; ++c) { o0[c] = t0[c] + sigmoidf_(g0[c]) * acc[ai][bj][m][0][c]; o1[c] = t1[c] + sigmoidf_(g1[c]) * acc[ai][bj][m][1][c]; }
                    *(v4u*)(T + off + bj * HALF) = pack8(o0, o1); } }
    }
};
struct EpiSwiGLU {
    static constexpr bool PERM = true;
    bf16* O;
    __device__ __forceinline__ void operator()(const Acc& acc, const Unit& u, int, int wr, int wc, int fr, int fq) const {
        const int row0 = u.pm * BM + wr * 64 + fr, col0 = u.pn * HALF + wc * 32 + 8 * fq;
#pragma unroll
        for (int ai = 0; ai < 2; ++ai)
#pragma unroll
            for (int m = 0; m < 4; ++m) { f32x4 o0, o1;
#pragma unroll
                for (int c = 0; c < 4; ++c) { const float a = acc[ai][0][m][0][c], b = acc[ai][0][m][1][c]; o0[c] = a * sigmoidf_(a) * acc[ai][1][m][0][c]; o1[c] = b * sigmoidf_(b) * acc[ai][1][m][1][c]; }
                *(v4u*)(O + (size_t)(row0 + ai * HALF + m * 16) * FF + col0) = pack8(o0, o1); }
    }
};
struct EpiMoeDown {
    static constexpr bool PERM = true;
    bf16* YP; const LAS int* tok;
    __device__ __forceinline__ void operator()(const Acc& acc, const Unit& u, int ui, int wr, int wc, int fr, int fq) const {
        const int r0 = wr * 64 + fr, col0 = u.pn * BM + wc * 32 + 8 * fq;
#pragma unroll
        for (int ai = 0; ai < 2; ++ai)
#pragma unroll
            for (int m = 0; m < 4; ++m) { const int e = tok[ui * 256 + r0 + ai * HALF + m * 16];
                if (e >= 0) { bf16* rowp = YP + (size_t)e * D + col0;
#pragma unroll
                    for (int bj = 0; bj < 2; ++bj) *(v4u*)(rowp + bj * HALF) = pack8(acc[ai][bj][m][0], acc[ai][bj][m][1]); } }
    }
};
}

namespace att {
constexpr int PITCH = WH;
constexpr int SLOTB = 8192;
constexpr int NSLOT = 4;
constexpr int L_K = 0, L_V = NSLOT * SLOTB, L_WS = 2 * NSLOT * SLOTB, L_OST = L_WS + NWAVES * 64 * 4, L_KPART = L_OST + NWAVES * 4096, L_KMEAN = L_KPART + 8 * 8 * 64 * 4, L_SEL = L_KMEAN + 8 * 64 * 4, L_LUT = L_SEL + 256, L_DONE = L_LUT + 512, L_END = L_DONE + 64;
static_assert(L_END <= RING_BYTES, "attention LDS");
__device__ __forceinline__ int crow(int r, int hi) { return (r & 3) + 8 * (r >> 2) + 4 * hi; }
__device__ __forceinline__ void glds16(const void* gsrc, unsigned lds_dst) { unsigned keep;
    asm volatile("s_mov_b32 %0, m0\n\ts_mov_b32 m0, %2\n\ts_nop 0\n\tglobal_load_lds_dwordx4 %1, off\n\ts_mov_b32 m0, %0" : "=&s"(keep) : "v"(gsrc), "s"(lds_dst) : "memory"); }
#define ATT_WAIT_BAR(N) asm volatile("s_waitcnt vmcnt(" #N ") lgkmcnt(0)\n\ts_barrier" ::: "memory")
constexpr float SB_DONE_THR = 192.f;
__device__ const unsigned char REL_BUCKET_LUT[128] = {0, 1, 2, 3, 4, 5, 6, 7, 8, 9, 10, 11, 12, 13, 14, 15, 16, 16, 16, 17, 17, 18, 18, 18, 19, 19, 19, 20, 20, 20, 20, 21, 21, 21, 21, 22, 22, 22, 22, 22, 23, 23, 23, 23, 23, 23, 24, 24, 24, 24, 24, 24, 25, 25, 25, 25, 25, 25, 25, 26, 26, 26, 26, 26, 26, 26, 26, 27, 27, 27, 27, 27, 27, 27, 27, 27, 27, 28, 28, 28, 28, 28, 28, 28, 28, 28, 28, 29, 29, 29, 29, 29, 29, 29, 29, 29, 29, 29, 29, 30, 30, 30, 30, 30, 30, 30, 30, 30, 30, 30, 30, 30, 30, 31, 31, 31, 31, 31, 31, 31, 31, 31, 31, 31, 31, 31, 31, 31};

__device__ __forceinline__ void qkt(f32x16& p0, f32x16& p1, const LAS char* Kslot, const bf16x8* qr, const f32x16& cinit, int r32, int hi) {
    const LAS char* kb = Kslot + hi * 1024 + r32 * 16;
#pragma unroll
    for (int d0 = 0; d0 < 4; ++d0) {
        const bf16x8 b0 = *(const LAS bf16x8*)(kb + d0 * 2048);
        const bf16x8 b1 = *(const LAS bf16x8*)(kb + d0 * 2048 + 512);
        if (d0 == 0) { p0 = __builtin_amdgcn_mfma_f32_32x32x16_bf16(b0, qr[0], cinit, 0, 0, 0); p1 = __builtin_amdgcn_mfma_f32_32x32x16_bf16(b1, qr[0], cinit, 0, 0, 0); }
        else { p0 = __builtin_amdgcn_mfma_f32_32x32x16_bf16(b0, qr[d0], p0, 0, 0, 0); p1 = __builtin_amdgcn_mfma_f32_32x32x16_bf16(b1, qr[d0], p1, 0, 0, 0); }
    }
}
__device__ __forceinline__ void pv(f32x16* o, int vb, bf16x8 pa0, bf16x8 pa1, bf16x8 pa2, bf16x8 pa3) {
#pragma unroll
    for (int d0 = 0; d0 < 2; ++d0) { s16x4 lo[4], hi[4];
#pragma unroll
        for (int ks = 0; ks < 4; ++ks) {
            asm volatile("ds_read_b64_tr_b16 %0,%1 offset:%c2" : "=&v"(lo[ks]) : "v"(vb), "i"(d0 * 4096 + ks * 1024) : "memory");
            asm volatile("ds_read_b64_tr_b16 %0,%1 offset:%c2" : "=&v"(hi[ks]) : "v"(vb), "i"(d0 * 4096 + ks * 1024 + 512) : "memory"); }
        asm volatile("s_waitcnt lgkmcnt(0)" ::: "memory"); __builtin_amdgcn_sched_barrier(0);
#define ATT_PK(k) (bf16x8){lo[k][0], lo[k][1], lo[k][2], lo[k][3], hi[k][0], hi[k][1], hi[k][2], hi[k][3]}
        o[d0] = __builtin_amdgcn_mfma_f32_32x32x16_bf16(pa0, ATT_PK(0), o[d0], 0, 0, 0);
        o[d0] = __builtin_amdgcn_mfma_f32_32x32x16_bf16(pa1, ATT_PK(1), o[d0], 0, 0, 0);
        o[d0] = __builtin_amdgcn_mfma_f32_32x32x16_bf16(pa2, ATT_PK(2), o[d0], 0, 0, 0);
        o[d0] = __builtin_amdgcn_mfma_f32_32x32x16_bf16(pa3, ATT_PK(3), o[d0], 0, 0, 0);
#undef ATT_PK
    }
}
__device__ __forceinline__ bf16x8 pack8r(const f32x16& p, int b) { v4u w; w.x = cvt_pk_bf16(p[b], p[b + 1]); w.y = cvt_pk_bf16(p[b + 2], p[b + 3]); w.z = cvt_pk_bf16(p[b + 4], p[b + 5]); w.w = cvt_pk_bf16(p[b + 6], p[b + 7]); return __builtin_bit_cast(bf16x8, w); }
__device__ __forceinline__ f32x16 splat16(float v) { f32x16 r;
#pragma unroll
    for (int i = 0; i < 16; ++i) r[i] = v;
    return r; }

template <bool MOBA>
__device__ __forceinline__ void attn_unit(int b, int h, int qb, const bf16* Q, const bf16* __restrict__ Kp, const bf16* __restrict__ Vp, bf16* O, const float* rel_bias, LAS unsigned char* shm) {
    const int tid = otid(), lane = tid & 63, r32 = lane & 31, hi = lane >> 5; const int wid = __builtin_amdgcn_readfirstlane(tid >> 6);
    const long rowbase = (long)b * SEQ; const int q0 = qb * 256;
    const bf16* Qw = Q + (rowbase + q0 + wid * 32) * PITCH + h * HD;
    const bf16* Kh = Kp + rowbase * PITCH + h * HD; const bf16* Vh = Vp + rowbase * PITCH + h * HD;
    const unsigned lds0 = (unsigned)(uintptr_t)shm;
    LAS float* wsf = (LAS float*)(shm + L_WS) + wid * 64;
    const bf16* ksrc = Kh + (long)lane * PITCH + wid * 8;
    const bf16* vsrc = Vh + (long)(16 * (wid & 3) + (lane >> 2)) * PITCH + (wid >> 2) * 32 + (lane & 3) * 8;
    const unsigned kdst = lds0 + L_K + wid * 1024, vdst = lds0 + L_V + wid * 1024;
#define DMA_K(t, slot) glds16(ksrc + (long)(t) * 64 * PITCH, (unsigned)__builtin_amdgcn_readfirstlane(kdst + (slot)))
#define DMA_V(t, slot) glds16(vsrc + (long)(t) * 64 * PITCH, (unsigned)__builtin_amdgcn_readfirstlane(vdst + (slot)))
    const int vb0 = (int)(lds0 + L_V) + ((lane >> 4) & 1) * 32 + (lane & 3) * 8 + (4 * hi + ((lane & 15) >> 2)) * 64;
    const LAS char* Kbase = (const LAS char*)(shm + L_K);
    const int NT = 4 * (qb + 1);
    const int qrel = wid * 32 + r32;
    DMA_K(NT - 1, 0); DMA_V(NT - 1, 0); DMA_K(NT - 2, SLOTB); DMA_V(NT - 2, SLOTB); DMA_K(NT - 3, 2 * SLOTB); DMA_V(NT - 3, 2 * SLOTB);
    LAS int* doneAt = (LAS int*)(shm + L_DONE);
    if (!MOBA) { if (tid < 8) doneAt[tid] = 0x7fffffff; }
    bf16x8 qr[4];
#pragma unroll
    for (int d0 = 0; d0 < 4; ++d0) qr[d0] = *(const bf16x8*)(&Qw[(long)r32 * PITCH + d0 * 16 + hi * 8]);
    float biasfar = 0.f; unsigned selmask = 0u;
    if constexpr (MOBA) {
        LAS float* KPART = (LAS float*)(shm + L_KPART); LAS float* KMEAN = (LAS float*)(shm + L_KMEAN); LAS unsigned char* SEL = (LAS unsigned char*)(shm + L_SEL); LAS float* LUT = (LAS float*)(shm + L_LUT);
        if (tid < 128) LUT[tid] = rel_bias[REL_BUCKET_LUT[tid] * NH + h] * LOG2E;
        const int dch = lane & 7, rs = lane >> 3;
        for (int mb = 0; mb < qb; ++mb) {
            float s[8];
#pragma unroll
            for (int c = 0; c < 8; ++c) s[c] = 0.f;
#pragma unroll
            for (int j = 0; j < 4; ++j) { const v4u w = *(const v4u*)(Kh + (long)(mb * 256 + wid * 32 + j * 8 + rs) * PITCH + dch * 8);
                s[0] += bf_lo(w.x); s[1] += bf_hi(w.x); s[2] += bf_lo(w.y); s[3] += bf_hi(w.y); s[4] += bf_lo(w.z); s[5] += bf_hi(w.z); s[6] += bf_lo(w.w); s[7] += bf_hi(w.w); }
#pragma unroll
            for (int c = 0; c < 8; ++c) { s[c] += shx(s[c], 8, lane); s[c] += shx(s[c], 16, lane); s[c] += shx(s[c], 32, lane); }
            if (rs == 0) {
#pragma unroll
                for (int c = 0; c < 8; ++c) KPART[(mb * 8 + wid) * 64 + dch * 8 + c] = s[c]; }
        }
        __syncthreads();
        { const int mb = tid >> 6, d = tid & 63; if (mb < qb) { float t = 0.f;
#pragma unroll
            for (int w = 0; w < 8; ++w) t += KPART[(mb * 8 + w) * 64 + d];
            KMEAN[mb * 64 + d] = t * (1.0f / 256.0f); } }
        __syncthreads();
        { const int q = tid >> 1, dh = tid & 1; const bf16* qp = Q + (rowbase + q0 + q) * PITCH + h * HD + dh * 32; float qv[32];
#pragma unroll
            for (int j = 0; j < 4; ++j) { const v4u w = *(const v4u*)(qp + j * 8); qv[j * 8 + 0] = bf_lo(w.x); qv[j * 8 + 1] = bf_hi(w.x); qv[j * 8 + 2] = bf_lo(w.y); qv[j * 8 + 3] = bf_hi(w.y); qv[j * 8 + 4] = bf_lo(w.z); qv[j * 8 + 5] = bf_hi(w.z); qv[j * 8 + 6] = bf_lo(w.w); qv[j * 8 + 7] = bf_hi(w.w); }
            float g[7];
#pragma unroll
            for (int mb = 0; mb < 7; ++mb) { float a = 0.f; if (mb < qb) {
#pragma unroll
                    for (int d = 0; d < 32; ++d) a += qv[d] * KMEAN[mb * 64 + dh * 32 + d]; }
                a += shx(a, 1, lane); g[mb] = a; }
            unsigned mask = 0u;
            if (qb <= 3) mask = (1u << qb) - 1u;
            else {
#pragma unroll
                for (int pass = 0; pass < 3; ++pass) { float best = -INFINITY; int bi = 0;
#pragma unroll
                    for (int mb = 0; mb < 7; ++mb) if (mb < qb && !((mask >> mb) & 1u) && g[mb] > best) { best = g[mb]; bi = mb; }
                    mask |= 1u << bi; } }
            if (dh == 0) SEL[q] = (unsigned char)mask; }
        __syncthreads();
        selmask = SEL[qrel]; biasfar = LUT[127];
    }
    f32x16 o[2]; o[0] = splat16(0.f); o[1] = splat16(0.f);
    float m_run = -INFINITY, l_run = 0.f, carry = 0.f;
    bf16x8 tri0, tri1, ones;
#pragma unroll
    for (int jj = 0; jj < 8; ++jj) { const int j0 = 8 * (jj >> 2) + 4 * hi + (jj & 3); tri0[jj] = (j0 >= r32) ? (short)0x3F80 : (short)0; tri1[jj] = (16 + j0 >= r32) ? (short)0x3F80 : (short)0; ones[jj] = (short)0x3F80; }
    const int jd = wid >> 1;
    bool mydone = false;
    for (int i = 0; i < NT; ++i) {
        const int kt = NT - 1 - i; const int slot = (i & 3) * SLOTB;
        { const int n = (NT - 1 - i) < 2 ? (NT - 1 - i) : 2;
          if (n == 2) ATT_WAIT_BAR(4); else if (n == 1) ATT_WAIT_BAR(2); else ATT_WAIT_BAR(0); }
        if constexpr (!MOBA) { if (i >= 1) { const v4u d0 = *(const LAS v4u*)doneAt, d1 = *(const LAS v4u*)(doneAt + 4); const int lim = i - 1;
                bool all = ((int)d0.x <= lim) && ((int)d0.y <= lim) && ((int)d0.z <= lim) && ((int)d0.w <= lim) && ((int)d1.x <= lim) && ((int)d1.y <= lim) && ((int)d1.z <= lim) && ((int)d1.w <= lim);
                if (__builtin_amdgcn_readfirstlane(all ? 1 : 0)) break; } }
        if (i + 3 < NT) { DMA_K(kt - 3, ((i + 3) & 3) * SLOTB); DMA_V(kt - 3, ((i + 3) & 3) * SLOTB); }
        if constexpr (!MOBA) { if (mydone) continue; }
        const int jb = kt - (NT - 4);
        if (jb > jd) continue;
        const bool diag = (jb == jd);
        f32x16 p0, p1;
        if constexpr (MOBA) {
            const bool band = jb >= 0; const int mblk = kt >> 2;
            const bool sel = band || ((selmask >> mblk) & 1u);
            if (!__any(sel)) continue;
            const int dmin = (q0 + wid * 32) - (64 * kt + 63);
            const bool near = dmin < 113;
            const float ci = sel ? (near ? 0.f : biasfar) : -INFINITY;
            const f32x16 cinit = splat16(ci);
            qkt(p0, p1, Kbase + slot, qr, cinit, r32, hi);
            if (near) { const LAS float* LUT = (const LAS float*)(shm + L_LUT); const int dq = (q0 + qrel) - 64 * kt;
#pragma unroll
                for (int r = 0; r < 16; ++r) { const int d0_ = dq - crow(r, hi), d1_ = d0_ - 32;
                    const float b0 = LUT[d0_ < 0 ? 0 : (d0_ > 127 ? 127 : d0_)], b1 = LUT[d1_ < 0 ? 0 : (d1_ > 127 ? 127 : d1_)];
                    p0[r] = (d0_ < 0) ? -INFINITY : p0[r] + b0; p1[r] = (d1_ < 0) ? -INFINITY : p1[r] + b1; } }
            float rm = p0[0];
#pragma unroll
            for (int r = 1; r < 16; ++r) rm = fmaxf(rm, p0[r]);
#pragma unroll
            for (int r = 0; r < 16; ++r) rm = fmaxf(rm, p1[r]);
            rm = fmaxf(rm, shx(rm, 32, lane));
            const float m_new = fmaxf(m_run, rm);
            const float alpha = (m_new == -INFINITY) ? 1.f : fast_exp2(m_run - m_new);
            const float msub = (m_new == -INFINITY) ? 0.f : m_new;
            float ls = 0.f;
#pragma unroll
            for (int r = 0; r < 16; ++r) { p0[r] = fast_exp2(p0[r] - msub); p1[r] = fast_exp2(p1[r] - msub); ls += p0[r] + p1[r]; }
            l_run = l_run * alpha + ls; m_run = m_new;
            if (__any(alpha != 1.f)) { if (hi == 0) wsf[r32] = alpha; LDS_WAIT();
#pragma unroll
                for (int d_ = 0; d_ < 2; ++d_)
#pragma unroll
                    for (int r = 0; r < 16; ++r) o[d_][r] *= wsf[crow(r, hi)];
                LDS_WAIT(); }
        } else {
            const f32x16 zero = splat16(0.f);
            qkt(p0, p1, Kbase + slot, qr, zero, r32, hi);
            f32x16 s0, s1;
            const int kq = qrel - 64 * (jb < 0 ? 0 : jb);
#pragma unroll
            for (int r = 0; r < 16; ++r) { const float z0 = p0[r], z1 = p1[r];
                float a0 = fmaxf(z0, fast_log2(1.0f + fast_exp2(fminf(z0, 64.f)))), a1 = fmaxf(z1, fast_log2(1.0f + fast_exp2(fminf(z1, 64.f))));
                if (diag) { const int kv = crow(r, hi); if (kv >= kq) a0 = 0.f; if (kv + 32 >= kq) a1 = 0.f; }
                s0[r] = a0; s1[r] = a1; }
            const bf16x8 L0 = pack8r(s0, 0), L1 = pack8r(s0, 8), L2 = pack8r(s1, 0), L3 = pack8r(s1, 8);
            const f32x16 c16 = splat16(carry);
            f32x16 W0 = __builtin_amdgcn_mfma_f32_32x32x16_bf16(tri0, L0, c16, 0, 0, 0);
            W0 = __builtin_amdgcn_mfma_f32_32x32x16_bf16(tri1, L1, W0, 0, 0, 0);
            W0 = __builtin_amdgcn_mfma_f32_32x32x16_bf16(ones, L2, W0, 0, 0, 0);
            W0 = __builtin_amdgcn_mfma_f32_32x32x16_bf16(ones, L3, W0, 0, 0, 0);
            f32x16 W1 = __builtin_amdgcn_mfma_f32_32x32x16_bf16(tri0, L2, c16, 0, 0, 0);
            W1 = __builtin_amdgcn_mfma_f32_32x32x16_bf16(tri1, L3, W1, 0, 0, 0);
            carry = shl(W0[0], r32);
#pragma unroll
            for (int r = 0; r < 16; ++r) { float e0 = fast_exp2(p0[r] - W0[r]), e1 = fast_exp2(p1[r] - W1[r]);
                if (diag) { const int kv = crow(r, hi); if (kv >= kq) e0 = 0.f; if (kv + 32 >= kq) e1 = 0.f; }
                p0[r] = e0; p1[r] = e1; }
            if (__all(carry > SB_DONE_THR)) { mydone = true; if (lane == 0) doneAt[wid] = i; }
        }
        pv(o, vb0 + slot, pack8r(p0, 0), pack8r(p0, 8), pack8r(p1, 0), pack8r(p1, 8));
    }
    asm volatile("s_waitcnt vmcnt(0)" ::: "memory");
    float rli[16];
    if constexpr (MOBA) {
        l_run += shx(l_run, 32, lane);
        if (hi == 0) wsf[32 + r32] = l_run; LDS_WAIT();
#pragma unroll
        for (int r = 0; r < 16; ++r) rli[r] = fast_rcp(wsf[32 + crow(r, hi)]);
    } else {
#pragma unroll
        for (int r = 0; r < 16; ++r) rli[r] = 1.f;
    }
    bf16* Ow = O + (rowbase + q0 + wid * 32) * PITCH + h * HD;
    { LAS bf16* stg = (LAS bf16*)(shm + L_OST) + wid * 2048;
#pragma unroll
        for (int r = 0; r < 16; ++r) { const int orow = crow(r, hi);
#pragma unroll
            for (int d0 = 0; d0 < 2; ++d0) stg[orow * 64 + d0 * 32 + r32] = (bf16)f2bf(o[d0][r] * rli[r]); }
        LDS_WAIT();
#pragma unroll
        for (int i = 0; i < 4; ++i) { const int row = i * 8 + (lane >> 3), ch = lane & 7; const v4u v = *(const LAS v4u*)(stg + row * 64 + ch * 8); *(v4u*)(Ow + (long)row * PITCH + ch * 8) = v; } }
    asm volatile("s_waitcnt lgkmcnt(0)\n\ts_barrier" ::: "memory");
#undef DMA_K
#undef DMA_V
}
}

struct Args { const float* in[20]; float* out; unsigned char* ws; int ph_lo, ph_hi; };
struct Frame {
    LAS unsigned char* lds; gu32* ctl; int tid, lane, wave, vcu, G;
};
#define FRESH(F) do { (F).tid = otid(); (F).lane = (F).tid & 63; (F).wave = __builtin_amdgcn_readfirstlane((F).tid >> 6); } while (0)
__device__ __forceinline__ float wave_sum(float v, int lane) {
#pragma unroll
    for (int o = 1; o < 64; o <<= 1) v += shx(v, o, lane);
    return v;
}
__device__ __forceinline__ void transpose_item(const float* W, int K, int N, bf16* WT, int mode, LAS float* scr, int item, int lane) {
    const int nblk = N / 32, kb = item / nblk, nb = item % nblk, k0 = 64 * kb, n0 = 32 * nb;
    const int rbase = (mode == 0) ? n0 : (256 * (n0 >> 7) + (n0 & 127) + (mode == 2 ? 128 : 0));
#pragma unroll 8
    for (int i = 0; i < 32; ++i) { const int kk = 2 * i + (lane >> 5); scr[kk * 33 + (lane & 31)] = W[(size_t)(k0 + kk) * N + n0 + (lane & 31)]; }
    LDS_WAIT(); asm volatile("" ::: "memory");
    const int c = lane & 7;
#pragma unroll
    for (int j = 0; j < 4; ++j) { const int n = (lane >> 3) + 8 * j; const LAS float* s = scr + (8 * c) * 33 + n;
        v4u o; o.x = pk2(s[0 * 33], s[1 * 33]); o.y = pk2(s[2 * 33], s[3 * 33]); o.z = pk2(s[4 * 33], s[5 * 33]); o.w = pk2(s[6 * 33], s[7 * 33]);
        *(GAS v4u*)(WT + (size_t)(rbase + n) * K + k0 + 8 * c) = o; }
    LDS_WAIT(); asm volatile("" ::: "memory");
}

struct RowArgs { const float* xin; float* xout; const bf16* Y; const float2* tokw_in; const float* gpost; const float* gate; const float* gpre; const float* shift; const float* scale; bf16* H;
                 const float* wrouter; int* lists; float2* tokw_out; unsigned* cnt; };
template <bool HAS_Y, bool PAIR, bool WRITE_H, bool ROUTER>
__device__ __forceinline__ void row_phase(Frame& F, const RowArgs& a) {
    FRESH(F);
    const int lane = F.lane; const int gw = F.vcu * NWAVES + F.wave; const int rows_per_wave = M / (F.G * NWAVES);
    const int m0 = gw * rows_per_wave; const int b = (F.vcu * NWAVES * rows_per_wave) / SEQ;
    LAS float* wr = (LAS float*)F.lds;
    LAS float* vec = (LAS float*)(F.lds + 32768);
    if constexpr (ROUTER) { for (int i = F.tid; i < D * NE / 4; i += NTHREADS) ((LAS f32x4*)wr)[i] = ((const f32x4*)a.wrouter)[i]; }
    for (int i = F.tid; i < D; i += NTHREADS) {
        if (HAS_Y) { vec[i] = a.gpost[i]; vec[D + i] = a.gate[(size_t)b * NMOD + i]; }
        if (WRITE_H) { vec[2 * D + i] = a.gpre[i]; vec[3 * D + i] = a.shift[(size_t)b * NMOD + i]; vec[4 * D + i] = a.scale[(size_t)b * NMOD + i] + 1.0f; } }
    __syncthreads();
    int my_e0 = -1, my_e1 = -1; float my_w0 = 0.f, my_w1 = 0.f;
    for (int i = 0; i < rows_per_wave; ++i) { const int m = m0 + i;
        f32x4 x[4];
#pragma unroll
        for (int j = 0; j < 4; ++j) x[j] = *(const f32x4*)(a.xin + (size_t)m * D + 256 * j + 4 * lane);
        if constexpr (HAS_Y) {
            f32x4 y[4];
            if constexpr (PAIR) { const float2 w = a.tokw_in[m];
#pragma unroll
                for (int j = 0; j < 4; ++j) { const v2u u0 = *(const v2u*)(a.Y + (size_t)(2 * m) * D + 256 * j + 4 * lane), u1 = *(const v2u*)(a.Y + (size_t)(2 * m + 1) * D + 256 * j + 4 * lane);
                    y[j] = (f32x4){w.x * bf_lo(u0.x) + w.y * bf_lo(u1.x), w.x * bf_hi(u0.x) + w.y * bf_hi(u1.x), w.x * bf_lo(u0.y) + w.y * bf_lo(u1.y), w.x * bf_hi(u0.y) + w.y * bf_hi(u1.y)}; }
            } else {
#pragma unroll
                for (int j = 0; j < 4; ++j) { const v2u u0 = *(const v2u*)(a.Y + (size_t)m * D + 256 * j + 4 * lane); y[j] = (f32x4){bf_lo(u0.x), bf_hi(u0.x), bf_lo(u0.y), bf_hi(u0.y)}; }
            }
            float s = 0.f;
#pragma unroll
            for (int j = 0; j < 4; ++j) s += (y[j].x * y[j].x + y[j].y * y[j].y) + (y[j].z * y[j].z + y[j].w * y[j].w);
            const float rstd = 1.0f / sqrtf(wave_sum(s, lane) * (1.0f / D) + EPS);
#pragma unroll
            for (int j = 0; j < 4; ++j) { const f32x4 gp = *(const LAS f32x4*)(vec + 256 * j + 4 * lane), gt = *(const LAS f32x4*)(vec + D + 256 * j + 4 * lane);
                x[j] = x[j] + gt * ((y[j] * rstd) * gp); *(f32x4*)(a.xout + (size_t)m * D + 256 * j + 4 * lane) = x[j]; }
        }
        if constexpr (WRITE_H) {
            float s = 0.f;
#pragma unroll
            for (int j = 0; j < 4; ++j) s += (x[j].x * x[j].x + x[j].y * x[j].y) + (x[j].z * x[j].z + x[j].w * x[j].w);
            const float rstd = 1.0f / sqrtf(wave_sum(s, lane) * (1.0f / D) + EPS);
#pragma unroll
            for (int j = 0; j < 4; ++j) { const f32x4 gp = *(const LAS f32x4*)(vec + 2 * D + 256 * j + 4 * lane), sh = *(const LAS f32x4*)(vec + 3 * D + 256 * j + 4 * lane), sc = *(const LAS f32x4*)(vec + 4 * D + 256 * j + 4 * lane);
                x[j] = ((x[j] * rstd) * gp) * sc + sh;
                v2u o; o.x = pk2(x[j].x, x[j].y); o.y = pk2(x[j].z, x[j].w); *(v2u*)(a.H + (size_t)m * D + 256 * j + 4 * lane) = o; }
            if constexpr (ROUTER) {
                float lg[NE];
#pragma unroll
                for (int e = 0; e < NE; ++e) lg[e] = 0.f;
#pragma unroll
                for (int j = 0; j < 4; ++j)
#pragma unroll
                    for (int c = 0; c < 4; ++c) { const LAS f32x4* wp = (const LAS f32x4*)(wr + (size_t)(256 * j + 4 * lane + c) * NE); const f32x4 w0 = wp[0], w1 = wp[1]; const float hvv = x[j][c];
                        lg[0] += hvv * w0.x; lg[1] += hvv * w0.y; lg[2] += hvv * w0.z; lg[3] += hvv * w0.w; lg[4] += hvv * w1.x; lg[5] += hvv * w1.y; lg[6] += hvv * w1.z; lg[7] += hvv * w1.w;
                        if (c == 3) asm volatile("" ::: "memory"); }
#pragma unroll
                for (int e = 0; e < NE; ++e) lg[e] = wave_sum(lg[e], lane);
                int e0 = 0; float v0 = lg[0];
#pragma unroll
                for (int e = 1; e < NE; ++e) if (lg[e] > v0) { v0 = lg[e]; e0 = e; }
                int e1 = -1; float v1 = -INFINITY;
#pragma unroll
                for (int e = 0; e < NE; ++e) if (e != e0 && lg[e] > v1) { v1 = lg[e]; e1 = e; }
                const float t = fast_exp2((v1 - v0) * LOG2E); const float w0 = 1.0f / (1.0f + t), w1 = t / (1.0f + t);
                if (lane == i) { my_e0 = e0; my_e1 = e1; my_w0 = w0; my_w1 = w1; }
            }
        }
    }
    if constexpr (ROUTER) {
        const bool act = lane < rows_per_wave; int pos0 = 0, pos1 = 0;
        const unsigned long long lt = (1ull << lane) - 1ull;
#pragma unroll
        for (int e = 0; e < NE; ++e) { const unsigned long long b0 = __ballot(act && my_e0 == e), b1 = __ballot(act && my_e1 == e);
            const int n0 = __popcll(b0), n1 = __popcll(b1); int base = 0;
            if (n0 + n1 > 0) { if (lane == 0) base = (int)__hip_atomic_fetch_add(a.cnt + 64 * e, (unsigned)(n0 + n1), RLX_AGENT); base = __builtin_amdgcn_readfirstlane(base); }
            if (act && my_e0 == e) pos0 = base + __popcll(b0 & lt);
            if (act && my_e1 == e) pos1 = base + n0 + __popcll(b1 & lt); }
        if (act) { const int m = m0 + lane; a.lists[my_e0 * M + pos0] = 2 * m; a.lists[my_e1 * M + pos1] = 2 * m + 1; a.tokw_out[m] = make_float2(my_w0, my_w1); }
    }
    __syncthreads();
}

template <class Sched>
__device__ __forceinline__ void moe_tables(Frame& F, const Sched& S, const int* lists, int panel0) {
    FRESH(F);
    LAS int* seg = (LAS int*)(F.lds + LDS_SEG); LAS int* tok = (LAS int*)(F.lds + LDS_TOK);
    if (F.tid == 0) { int acc = 0;
        for (int e = 0; e < NE; ++e) { const int c = (int)__hip_atomic_load((unsigned*)(F.ctl + CW_CNT + 64 * e), RLX_AGENT); seg[e] = acc; seg[16 + e] = c; acc += (c + 255) & ~255; }
        seg[8] = acc; }
    __syncthreads();
    pg8::Unit u;
    for (int ui = 0; ui < LDS_TOK_UNITS && S.next(ui, u); ++ui) {
        if (F.tid < 256) { const int row = (panel0 + u.pm) * 256 + F.tid; int e = 0;
#pragma unroll
            for (int j = 1; j < NE; ++j) e += (row >= seg[j]) ? 1 : 0;
            const int pos = row - seg[e]; tok[ui * 256 + F.tid] = (pos < seg[16 + e]) ? lists[e * M + pos] : -1; }
    }
    __syncthreads();
}

constexpr int PH_LAYER0 = 2, PH_STRIDE = 16, PH_END = PH_LAYER0 + 2 * PH_STRIDE;
__global__ void __launch_bounds__(NTHREADS, 2) mega_fwd(Args args) {
    extern __shared__ __attribute__((aligned(16))) unsigned char lds_raw[];
    Frame F; F.lds = (LAS unsigned char*)lds_raw; F.tid = threadIdx.x; F.lane = F.tid & 63; F.wave = __builtin_amdgcn_readfirstlane(F.tid >> 6);
    F.G = gridDim.x; { const int bx = blockIdx.x; F.vcu = (F.G % 8 == 0) ? (bx % 8) * (F.G / 8) + bx / 8 : bx; }
    unsigned char* ws = args.ws; F.ctl = (gu32*)(ws + WS_CTL);
    volatile LAS unsigned* MISC = (volatile LAS unsigned*)(F.lds + LDS_MISC);
    if (F.tid < 16) MISC[F.tid] = 0u;
    __syncthreads();
    XcdBarrier bar; bar.bar = (unsigned*)(F.ctl + CW_BAR); bar.x = 0; bar.st = nullptr;
    if (MK_ONE_LAUNCH) bar = xcd_barrier_post((unsigned*)(F.ctl + CW_BAR), MISC);
    const int lo = args.ph_lo, hi = args.ph_hi;
#define IN(k) (lo <= (k) && (k) < hi)
#define SEAM(k, knext) do { if (IN(k) && IN(knext)) xcd_barrier(bar); } while (0)
    const float* x_in = args.in[0]; const float* c_in = args.in[1]; const float* w_mod = args.in[2]; const float* b_mod = args.in[3];
    const float* g_mix_pre = args.in[4]; const float* g_mix_post = args.in[5]; const float* g_ffn_pre = args.in[6]; const float* g_ffn_post = args.in[7];
    const float* w_in = args.in[8]; const float* w_psb = args.in[9]; const float* w_pmb = args.in[10]; const float* w_out = args.in[11]; const float* rel_bias = args.in[12];
    const float* w1d = args.in[13]; const float* w3d = args.in[14]; const float* w2d = args.in[15]; const float* w_router = args.in[16];
    const float* w1m = args.in[17]; const float* w3m = args.in[18]; const float* w2m = args.in[19];
    float* xout = args.out;
    float* MOD = (float*)(ws + WS_MOD); int* LISTS = (int*)(ws + WS_LIST); float2* TOKW = (float2*)(ws + WS_TOKW);
    bf16* WIN = (bf16*)(ws + WS_WIN); bf16* WPSB = (bf16*)(ws + WS_WPSB); bf16* WPMB = (bf16*)(ws + WS_WPMB); bf16* WOUT = (bf16*)(ws + WS_WOUT);
    bf16* W13D = (bf16*)(ws + WS_W13D); bf16* W2D = (bf16*)(ws + WS_W2D); bf16* W13M = (bf16*)(ws + WS_W13M); bf16* W2M = (bf16*)(ws + WS_W2M);
    bf16* H = (bf16*)(ws + WS_H); bf16* BIG = (bf16*)(ws + WS_BIG);

    if (!SK(0) && IN(0)) {
        FRESH(F);
        if ((int)blockIdx.x < 192) {
            LAS float* cond = (LAS float*)F.lds;
            LAS float* part = (LAS float*)(F.lds + 65536);
            for (int i = F.tid; i < NB * D; i += NTHREADS) { const int bb = i / D, k = i % D; const float cv = c_in[i]; cond[k * 16 + bb] = cv * sigmoidf_(cv); }
            __syncthreads();
            const int l = (int)blockIdx.x / 96, n0 = ((int)blockIdx.x % 96) * 64;
            float acc[16];
#pragma unroll
            for (int bb = 0; bb < 16; ++bb) acc[bb] = 0.f;
            const float* wp = w_mod + (size_t)l * D * NMOD + n0 + F.lane;
#pragma unroll 4
            for (int kk = 0; kk < 128; ++kk) { const int k = F.wave * 128 + kk; const float wv = wp[(size_t)k * NMOD];
                const LAS f32x4* cp = (const LAS f32x4*)(cond + k * 16); const f32x4 c0 = cp[0], c1 = cp[1], c2 = cp[2], c3 = cp[3];
                acc[0] += c0.x * wv; acc[1] += c0.y * wv; acc[2] += c0.z * wv; acc[3] += c0.w * wv; acc[4] += c1.x * wv; acc[5] += c1.y * wv; acc[6] += c1.z * wv; acc[7] += c1.w * wv;
                acc[8] += c2.x * wv; acc[9] += c2.y * wv; acc[10] += c2.z * wv; acc[11] += c2.w * wv; acc[12] += c3.x * wv; acc[13] += c3.y * wv; acc[14] += c3.z * wv; acc[15] += c3.w * wv; }
#pragma unroll
            for (int bb = 0; bb < 16; ++bb) part[(F.wave * 16 + bb) * 64 + F.lane] = acc[bb];
            __syncthreads();
            for (int i = F.tid; i < 16 * 64; i += NTHREADS) { const int bb = i >> 6, n = i & 63; float s = b_mod[(size_t)l * NMOD + n0 + n];
#pragma unroll
                for (int w = 0; w < 8; ++w) s += part[(w * 16 + bb) * 64 + n];
                MOD[((size_t)l * NB + bb) * NMOD + n0 + n] = s; }
            __syncthreads();
        }
        LAS float* scr = (LAS float*)(F.lds + F.wave * 16384);
        const int gw = F.vcu * NWAVES + F.wave, NGW = F.G * NWAVES;
        constexpr int I_IN = (D / 64) * (INCOLS / 32), I_P = (WH / 64) * (D / 32), I_O = (D / 64) * (D / 32), I_13 = (D / 64) * (FF / 32), I_2 = (FF / 64) * (D / 32);
        constexpr int N_IN = 2 * I_IN, N_P = 4 * I_P, N_O = 2 * I_O, N_13 = 18 * I_13, N_2 = 9 * I_2, NITEMS = N_IN + N_P + N_O + N_13 + N_2;
        for (int it = gw; it < NITEMS; it += NGW) {
            int r = it;
            if (r < N_IN) { const int l = r / I_IN; transpose_item(w_in + (size_t)l * D * INCOLS, D, INCOLS, WIN + (size_t)l * INCOLS * D, 0, scr, r % I_IN, F.lane); continue; } r -= N_IN;
            if (r < N_P) { const int q = r / I_P, l = q & 1; const float* src = (q < 2 ? w_psb : w_pmb) + (size_t)l * WH * D; bf16* dst = (q < 2 ? WPSB : WPMB) + (size_t)l * D * WH; transpose_item(src, WH, D, dst, 0, scr, r % I_P, F.lane); continue; } r -= N_P;
            if (r < N_O) { const int l = r / I_O; transpose_item(w_out + (size_t)l * D * D, D, D, WOUT + (size_t)l * D * D, 0, scr, r % I_O, F.lane); continue; } r -= N_O;
            if (r < N_13) { const int q = r / I_13; const float* src; bf16* dst; int mode;
                if (q == 0) { src = w1d; dst = W13D; mode = 1; } else if (q == 1) { src = w3d; dst = W13D; mode = 2; }
                else if (q < 10) { src = w1m + (size_t)(q - 2) * D * FF; dst = W13M + (size_t)(q - 2) * 2 * FF * D; mode = 1; }
                else { src = w3m + (size_t)(q - 10) * D * FF; dst = W13M + (size_t)(q - 10) * 2 * FF * D; mode = 2; }
                transpose_item(src, D, FF, dst, mode, scr, r % I_13, F.lane); continue; } r -= N_13;
            { const int q = r / I_2; const float* src = (q == 0) ? w2d : w2m + (size_t)(q - 1) * FF * D; bf16* dst = (q == 0) ? W2D : W2M + (size_t)(q - 1) * D * FF; transpose_item(src, FF, D, dst, 0, scr, r % I_2, F.lane); }
        }
    }
    SEAM(0, 1);
    if (!SK(1) && IN(1)) {
        RowArgs a{}; a.xin = x_in; a.gpre = g_mix_pre; a.shift = MOD + 0 * D; a.scale = MOD + 1 * D; a.H = H;
        row_phase<false, false, true, false>(F, a);
    }
    SEAM(1, PH_LAYER0);

    for (int l = 0; l < 2; ++l) {
        const int pb = PH_LAYER0 + PH_STRIDE * l;
        const float* modl = MOD + (size_t)l * NB * NMOD;
        if (!SK(2) && IN(pb + 0)) {
            pg8::SchedPlain S; S.init(M / 256, INCOLS / 256, F.G, (int)blockIdx.x); S.A = (const char*)H; S.B = (const char*)(WIN + (size_t)l * INCOLS * D); S.tA = S.tB = (size_t)256 * D * 2;
            pg8::EpiInProj E{BIG};
            pg8::gemm_phase<pg8::EpiInProj, pg8::SchedPlain, true>(F.lds, D, S, E);
        }
        SEAM(pb + 0, pb + 1);
        if (!SK(3) && IN(pb + 1)) {
            bf16* QA = BIG + BIG_QA / 2; bf16* KA = BIG + BIG_KA / 2; bf16* VA = BIG + BIG_VA / 2; bf16* QB = BIG + BIG_QB / 2; bf16* KB = BIG + BIG_KB / 2; bf16* VB = BIG + BIG_VB / 2;
            for (int v = F.vcu; v < 256; v += F.G) { const int bh = v >> 1, set = v & 1;
                for (int i = 0; i < 8; ++i) { const int k = i & 3; const int qb = set == 0 ? (k == 0 ? 0 : k == 1 ? 7 : k == 2 ? 1 : 6) : (k == 0 ? 2 : k == 1 ? 5 : k == 2 ? 3 : 4);
#if defined(MK_PROBE_ATTN2)
                    if (i < 4) att::attn_unit<false>(bh >> 3, bh & 7, qb, QA, KA, VA, H, rel_bias, F.lds);
                    else att::attn_unit<true>(bh >> 3, bh & 7, qb, QB, KB, VB, H, rel_bias, F.lds);
#endif
                    if (i < 4) att::attn_unit<false>(bh >> 3, bh & 7, qb, QA, KA, VA, QA, rel_bias, F.lds);
                    else att::attn_unit<true>(bh >> 3, bh & 7, qb, QB, KB, VB, QB, rel_bias, F.lds); } }
        }
        SEAM(pb + 1, pb + 2);
        if (!SK(4) && IN(pb + 2)) {
            bf16* GA = BIG + BIG_GA / 2; bf16* GB = BIG + BIG_GB / 2;
            { pg8::SchedPlain S; S.init(M / 256, D / 256, F.G, (int)blockIdx.x); S.A = (const char*)(BIG + BIG_QA / 2); S.B = (const char*)(WPSB + (size_t)l * D * WH); S.tA = S.tB = (size_t)256 * WH * 2;
              pg8::EpiGate<false> E{GA, GA}; pg8::gemm_phase<pg8::EpiGate<false>, pg8::SchedPlain, true>(F.lds, WH, S, E); }
            VM_WAIT(); __syncthreads();
            { pg8::SchedPlain S; S.init(M / 256, D / 256, F.G, (int)blockIdx.x); S.A = (const char*)(BIG + BIG_QB / 2); S.B = (const char*)(WPMB + (size_t)l * D * WH); S.tA = S.tB = (size_t)256 * WH * 2;
              pg8::EpiGate<true> E{GB, GA}; pg8::gemm_phase<pg8::EpiGate<true>, pg8::SchedPlain, true>(F.lds, WH, S, E); }
        }
        SEAM(pb + 2, pb + 3);
        if (!SK(5) && IN(pb + 3)) {
            pg8::SchedPlain S; S.init(M / 256, D / 256, F.G, (int)blockIdx.x); S.A = (const char*)(BIG + BIG_GA / 2); S.B = (const char*)(WOUT + (size_t)l * D * D); S.tA = S.tB = (size_t)256 * D * 2;
            pg8::EpiBf16 E{BIG + BIG_Y / 2, D};
            pg8::gemm_phase<pg8::EpiBf16, pg8::SchedPlain, true>(F.lds, D, S, E);
        }
        SEAM(pb + 3, pb + 4);
        if (!SK(6) && IN(pb + 4)) {
            RowArgs a{}; a.xin = (l == 0) ? x_in : xout; a.xout = xout; a.Y = BIG + BIG_Y / 2; a.gpost = g_mix_post + (size_t)l * D; a.gate = modl + 2 * D;
            a.gpre = g_ffn_pre + (size_t)l * D; a.shift = modl + 3 * D; a.scale = modl + 4 * D; a.H = H;
            a.wrouter = w_router; a.lists = LISTS; a.tokw_out = TOKW; a.cnt = (unsigned*)(F.ctl + CW_CNT);
            if (l == 0) row_phase<true, false, true, false>(F, a); else row_phase<true, false, true, true>(F, a);
        }
        SEAM(pb + 4, pb + 5);
        if (l == 0) {
            if (!SK(7) && IN(pb + 5)) {
                pg8::SchedPlain S; S.init(M / 256, 2 * FF / 256, F.G, (int)blockIdx.x); S.A = (const char*)H; S.B = (const char*)W13D; S.tA = S.tB = (size_t)256 * D * 2;
                pg8::EpiSwiGLU E{BIG + BIG_ACT / 2};
                pg8::gemm_phase<pg8::EpiSwiGLU, pg8::SchedPlain, true>(F.lds, D, S, E);
            }
            SEAM(pb + 5, pb + 6);
            if (!SK(8) && IN(pb + 6)) {
                pg8::SchedPlain S; S.init(M / 256, D / 256, F.G, (int)blockIdx.x); S.A = (const char*)(BIG + BIG_ACT / 2); S.B = (const char*)W2D; S.tA = S.tB = (size_t)256 * FF * 2;
                pg8::EpiBf16 E{BIG + BIG_YF / 2, D};
                pg8::gemm_phase<pg8::EpiBf16, pg8::SchedPlain, true>(F.lds, FF, S, E);
            }
            SEAM(pb + 6, pb + 11);
        } else {
            for (int c = 0; c < MOE_NCHUNK; ++c) {
                const int panel0 = c * MOE_CHUNK_PANELS;
                int npan = 0;
                if (IN(pb + 5 + 2 * c) || IN(pb + 6 + 2 * c)) { int tot = 0;
                    for (int e = 0; e < NE; ++e) tot += ((int)__hip_atomic_load((unsigned*)(F.ctl + CW_CNT + 64 * e), RLX_AGENT) + 255) >> 8;
                    npan = tot - panel0; npan = npan < 0 ? 0 : (npan > MOE_CHUNK_PANELS ? MOE_CHUNK_PANELS : npan); }
                if (!SK(9) && IN(pb + 5 + 2 * c)) {
                    pg8::SchedMoeUp S; S.init(npan, 2 * FF / 256, F.G, (int)blockIdx.x); S.A = (const char*)H; S.B = (const char*)W13M; S.tA = 0; S.tB = (size_t)256 * D * 2; S.eB = (size_t)2 * FF * D * 2;
                    S.panel0 = panel0; S.seg = (const LAS int*)(F.lds + LDS_SEG); S.tok = (const LAS int*)(F.lds + LDS_TOK);
                    moe_tables(F, S, LISTS, panel0);
                    pg8::EpiSwiGLU E{BIG + BIG_HID / 2};
                    pg8::gemm_phase<pg8::EpiSwiGLU, pg8::SchedMoeUp, true>(F.lds, D, S, E);
                }
                SEAM(pb + 5 + 2 * c, pb + 6 + 2 * c);
                if (!SK(10) && IN(pb + 6 + 2 * c)) {
                    pg8::SchedMoeDown S; S.init(npan, D / 256, F.G, (int)blockIdx.x); S.A = (const char*)(BIG + BIG_HID / 2); S.B = (const char*)W2M; S.tA = S.tB = (size_t)256 * FF * 2; S.eB = (size_t)D * FF * 2;
                    S.panel0 = panel0; S.seg = (const LAS int*)(F.lds + LDS_SEG); S.tok = (const LAS int*)(F.lds + LDS_TOK);
                    moe_tables(F, S, LISTS, panel0);
                    pg8::EpiMoeDown E{BIG + BIG_YP / 2, (const LAS int*)(F.lds + LDS_TOK)};
                    pg8::gemm_phase<pg8::EpiMoeDown, pg8::SchedMoeDown, true>(F.lds, FF, S, E);
                }
                SEAM(pb + 6 + 2 * c, (c + 1 < MOE_NCHUNK) ? pb + 7 + 2 * c : pb + 11);
            }
        }
        if (!SK(11) && IN(pb + 11)) {
            RowArgs a{}; a.xin = xout; a.xout = xout; a.gpost = g_ffn_post + (size_t)l * D; a.gate = modl + 5 * D; a.H = H;
            if (l == 0) { a.Y = BIG + BIG_YF / 2; a.gpre = g_mix_pre + (size_t)(l + 1) * D; a.shift = MOD + (size_t)(l + 1) * NB * NMOD + 0 * D; a.scale = MOD + (size_t)(l + 1) * NB * NMOD + 1 * D;
                row_phase<true, false, true, false>(F, a); }
            else { a.Y = BIG + BIG_YP / 2; a.tokw_in = TOKW; row_phase<true, true, false, false>(F, a); }
        }
        if (l == 0) SEAM(pb + 11, pb + PH_STRIDE);
    }
#undef IN
#undef SEAM
}

extern "C" void kernel_launch(void* const* d_in, const int* in_sizes, int n_in, void* d_out, int out_size, void* d_ws, size_t ws_size, hipStream_t stream) {
    static int grid = 0;
    if (grid == 0) {
        if (n_in != 20 || in_sizes[0] != M * D || out_size != M * D || ws_size < WS_END) { fprintf(stderr, "kernel_launch: unexpected shapes (n_in %d, ws %zu)\n", n_in, ws_size); grid = -1; return; }
        int dev = 0, cus = 0;
        if (hipGetDevice(&dev) != hipSuccess || hipDeviceGetAttribute(&cus, hipDeviceAttributeMultiprocessorCount, dev) != hipSuccess) { grid = -1; return; }
        if (hipFuncSetAttribute((const void*)mega_fwd, hipFuncAttributeMaxDynamicSharedMemorySize, LDS_BYTES) != hipSuccess) { fprintf(stderr, "kernel_launch: hipFuncSetAttribute failed\n"); grid = -1; return; }
        int per_cu = 0;
        if (hipOccupancyMaxActiveBlocksPerMultiprocessor(&per_cu, (const void*)mega_fwd, NTHREADS, LDS_BYTES) != hipSuccess || per_cu < 1) fprintf(stderr, "kernel_launch: occupancy query reports %d\n", per_cu);
        (void)hipGetLastError();
        grid = cus;
        if (grid != 256) { fprintf(stderr, "kernel_launch: built for 256 CUs, found %d\n", cus); grid = -1; return; }
    }
    if (grid < 0) return;
    if (hipMemsetAsync((char*)d_ws + WS_CTL, 0, CTL_ZERO_BYTES, stream) != hipSuccess) return;
    Args a{};
    for (int i = 0; i < 20; ++i) a.in[i] = (const float*)d_in[i];
    a.out = (float*)d_out; a.ws = (unsigned char*)d_ws;
#if MK_ONE_LAUNCH
    a.ph_lo = 0; a.ph_hi = PH_END;
    hipLaunchKernelGGL(mega_fwd, dim3(grid), dim3(NTHREADS), LDS_BYTES, stream, a);
#else
    for (int p = 0; p < PH_END; ++p) {
        const int rel = p < PH_LAYER0 ? -1 : (p - PH_LAYER0) % PH_STRIDE, l = p < PH_LAYER0 ? 0 : (p - PH_LAYER0) / PH_STRIDE;
        if (rel >= 0) { if (l == 0 && rel > 6 && rel != 11) continue; if (rel > 11) continue; }
        a.ph_lo = p; a.ph_hi = p + 1;
        hipLaunchKernelGGL(mega_fwd, dim3(grid), dim3(NTHREADS), LDS_BYTES, stream, a);
    }
#endif
}
```

```cpp
#include <hip/hip_runtime.h>
#include <hip/hip_bf16.h>
#include <cstdio>
#include <cstdint>
#include <cmath>

#ifndef MK_ONE_LAUNCH
#define MK_ONE_LAUNCH 1
#endif
#ifndef MK_SKIP
#define MK_SKIP 0
#endif
#define SK(b) ((MK_SKIP >> (b)) & 1)

#define GAS __attribute__((address_space(1)))
#define LAS __attribute__((address_space(3)))
typedef unsigned short bf16;
typedef unsigned v4u __attribute__((ext_vector_type(4)));
typedef unsigned v2u __attribute__((ext_vector_type(2)));
typedef float f32x4 __attribute__((ext_vector_type(4)));
typedef float f32x2 __attribute__((ext_vector_type(2)));
typedef float f32x16 __attribute__((ext_vector_type(16)));
typedef short bf16x8 __attribute__((ext_vector_type(8)));
typedef short s16x4 __attribute__((ext_vector_type(4)));
typedef GAS unsigned gu32;
#define RLX_AGENT __ATOMIC_RELAXED, __HIP_MEMORY_SCOPE_AGENT
#define LDS_WAIT() asm volatile("s_waitcnt lgkmcnt(0)" ::: "memory")
#define VM_WAIT() asm volatile("s_waitcnt vmcnt(0)" ::: "memory")

constexpr int NB = 16, SEQ = 2048, D = 1024, M = NB * SEQ, NH = 8, HD = 64, WH = 512, INCOLS = 5120, FF = 3584, NE = 8, NMOD = 6 * D;
constexpr float EPS = 1e-6f;
constexpr float LOG2E = 1.4426950408889634f;
constexpr float C2 = 0.125f * LOG2E;
constexpr int NWAVES = 8, NTHREADS = 512;

constexpr size_t MiB = 1u << 20;
constexpr size_t WS_CTL = 0, CTL_ZERO_BYTES = 1 * MiB;
constexpr size_t WS_MOD = 1 * MiB;
constexpr size_t WS_LIST = 2 * MiB;
constexpr size_t WS_TOKW = 3 * MiB;
constexpr size_t WS_WIN = 4 * MiB;
constexpr size_t WS_WPSB = 24 * MiB;
constexpr size_t WS_WPMB = 26 * MiB;
constexpr size_t WS_WOUT = 28 * MiB;
constexpr size_t WS_W13D = 32 * MiB;
constexpr size_t WS_W2D = 39 * MiB;
constexpr size_t WS_W13M = 43 * MiB;
constexpr size_t WS_W2M = 99 * MiB;
constexpr size_t WS_H = 127 * MiB;
constexpr size_t WS_BIG = 191 * MiB;
constexpr size_t WS_END = 605 * MiB;
constexpr float W13_SCALE = 32.f, W2_SCALE = 64.f;
constexpr size_t PLANE = (size_t)M * WH * 2;
constexpr size_t BIG_QA = 0, BIG_KA = PLANE, BIG_VA = 2 * PLANE, BIG_QB = 3 * PLANE, BIG_KB = 4 * PLANE, BIG_VB = 5 * PLANE, BIG_GA = 6 * PLANE, BIG_GB = 8 * PLANE;
constexpr size_t BIG_Y = 0;
constexpr size_t BIG_ACT = 0, BIG_YF = 112 * MiB;
constexpr int MOE_CHUNK_PANELS = 264, MOE_NCHUNK = 1;
constexpr size_t BIG_HID = 0, BIG_YP = 232 * MiB;
static_assert(BIG_YP + (size_t)M * 2 * D * 2 <= 414 * MiB && (size_t)MOE_CHUNK_PANELS * 256 * FF <= BIG_YP && BIG_YF + (size_t)M * D * 2 <= 414 * MiB, "BIG map");
constexpr int CW_TMO = 0, CW_CODE = 1, CW_BAR = 4096, CW_CNT = 16384;

constexpr int RING_BYTES = 131072;
constexpr int LDS_TOK = RING_BYTES;
constexpr int LDS_TOK_UNITS = 30;
constexpr int LDS_SEG = LDS_TOK + LDS_TOK_UNITS * 512;
constexpr int LDS_MISC = LDS_SEG + 128;
constexpr int LDS_BYTES = LDS_MISC + 64;
static_assert(LDS_BYTES <= 160 * 1024, "LDS");

__device__ __forceinline__ unsigned f2bf(float f) { unsigned u = __builtin_bit_cast(unsigned, f); return (u + 0x7fffu + ((u >> 16) & 1u)) >> 16; }
__device__ __forceinline__ unsigned pk2(float lo, float hi) { return f2bf(lo) | (f2bf(hi) << 16); }
__device__ __forceinline__ float bf_lo(unsigned w) { return __builtin_bit_cast(float, w << 16); }
__device__ __forceinline__ float bf_hi(unsigned w) { return __builtin_bit_cast(float, w & 0xffff0000u); }
__device__ __forceinline__ unsigned cvt_pk_bf16(float lo, float hi) { typedef __bf16 bf2 __attribute__((ext_vector_type(2))); f32x2 v = {lo, hi}; bf2 b = __builtin_convertvector(v, bf2); return __builtin_bit_cast(unsigned, b); }
__device__ __forceinline__ unsigned pk4_fp8(float a, float b, float c, float d) {
    a = __builtin_amdgcn_fmed3f(a, -448.f, 448.f); b = __builtin_amdgcn_fmed3f(b, -448.f, 448.f); c = __builtin_amdgcn_fmed3f(c, -448.f, 448.f); d = __builtin_amdgcn_fmed3f(d, -448.f, 448.f);
    int r = __builtin_amdgcn_cvt_pk_fp8_f32(a, b, 0, false); r = __builtin_amdgcn_cvt_pk_fp8_f32(c, d, r, true); return (unsigned)r; }
__device__ __forceinline__ float fast_exp2(float x) { return __builtin_amdgcn_exp2f(x); }
__device__ __forceinline__ float fast_log2(float x) { return __builtin_amdgcn_logf(x); }
__device__ __forceinline__ float fast_rcp(float x) { return __builtin_amdgcn_rcpf(x); }
__device__ __forceinline__ int otid() { int t = threadIdx.x; asm volatile("" : "+v"(t)); return t; }
__device__ __forceinline__ float shx(float v, int o, int lane) { return __builtin_bit_cast(float, __builtin_amdgcn_ds_bpermute((lane ^ o) << 2, __builtin_bit_cast(int, v))); }
__device__ __forceinline__ float shl(float v, int src) { return __builtin_bit_cast(float, __builtin_amdgcn_ds_bpermute(src << 2, __builtin_bit_cast(int, v))); }
__device__ __forceinline__ float sigmoidf_(float x) { return fast_rcp(1.0f + fast_exp2(-x * LOG2E)); }

#define XB_TMO      128
#define XB_XCNT(j)  (256  + 64 * (j))
#define XB_XSUB(j)  (1280 + 64 * (j))
#define XB_XGEN(j)  (2304 + 64 * (j))
#define XB_TOP      3328
#define XB_TOPGEN   3392
#define XCD_BAR_WORDS 3456
#define XB_SPIN_CAP (1u << 18)
__device__ __forceinline__ unsigned xb_ld(unsigned* p)              { return __hip_atomic_load(p, __ATOMIC_RELAXED, __HIP_MEMORY_SCOPE_AGENT); }
__device__ __forceinline__ unsigned xb_add(unsigned* p, unsigned v) { return __hip_atomic_fetch_add(p, v, __ATOMIC_RELAXED, __HIP_MEMORY_SCOPE_AGENT); }
__device__ __forceinline__ unsigned xb_xcc_id() { return (unsigned)__builtin_amdgcn_s_getreg((3 << 11) | 20) & 0xFu; }
#define XB_SPIN(cond, bar) do { unsigned _sp = 0; while (cond) { __builtin_amdgcn_s_sleep(1); \
    if ((++_sp & 255u) == 0u) { if (xb_ld(&(bar)[XB_TMO])) break; if (_sp > XB_SPIN_CAP) { atomicAdd(&(bar)[XB_TMO], 1u); break; } } } } while (0)
struct XcdBarrier { unsigned* bar; unsigned x; volatile LAS unsigned* st; };
__device__ __forceinline__ XcdBarrier xcd_barrier_post(unsigned* bar, volatile LAS unsigned* st) {
    XcdBarrier b; b.bar = bar; b.x = xb_xcc_id(); b.st = st;
    if (threadIdx.x == 0) (void)xb_add(&bar[XB_XCNT(b.x)], 1u);
    return b;
}
__device__ __forceinline__ void xcd_barrier_complete(unsigned* bar, unsigned x, unsigned& nloc, unsigned& nx) {
    const unsigned G = gridDim.x * gridDim.y * gridDim.z;
    unsigned sum, cnt, mine, sp = 0u;
    for (;;) {
        sum = 0u; cnt = 0u; mine = 0u;
#pragma unroll
        for (unsigned j = 0; j < 16; ++j) { const unsigned c = xb_ld(&bar[XB_XCNT(j)]); sum += c; cnt += (c > 0u) ? 1u : 0u; mine = (j == x) ? c : mine; }
        if (sum == G) break;
        __builtin_amdgcn_s_sleep(1);
        if ((++sp & 255u) == 0u) { if (xb_ld(&bar[XB_TMO])) break; if (sp > XB_SPIN_CAP) { atomicAdd(&bar[XB_TMO], 1u); break; } }
    }
    nloc = mine > 0u ? mine : 1u; nx = cnt > 0u ? cnt : 1u;
}
__device__ __forceinline__ void xcd_barrier(const XcdBarrier& b) {
    asm volatile("s_waitcnt vmcnt(0)" ::: "memory");
    __syncthreads();
    if (threadIdx.x == 0) {
        unsigned* bar = b.bar;
        __builtin_amdgcn_s_waitcnt(0);
        unsigned nloc = b.st[0], nx = b.st[1];
        if (nloc == 0u) { xcd_barrier_complete(bar, b.x, nloc, nx); b.st[0] = nloc; b.st[1] = nx; }
        const unsigned old = xb_add(&bar[XB_XSUB(b.x)], 1u);
        const unsigned gen = old / nloc;
        if (old + 1u == (gen + 1u) * nloc) {
            __builtin_amdgcn_fence(__ATOMIC_RELEASE, "agent");
            asm volatile("s_waitcnt vmcnt(0)" ::: "memory");
            const unsigned og = xb_add(&bar[XB_TOP], 1u);
            const unsigned tg = og / nx;
            if (og + 1u == (tg + 1u) * nx) xb_add(&bar[XB_TOPGEN], 1u);
            else XB_SPIN(xb_ld(&bar[XB_TOPGEN]) == tg, bar);
            __builtin_amdgcn_fence(__ATOMIC_ACQUIRE, "agent");
            xb_add(&bar[XB_XGEN(b.x)], 1u);
            asm volatile("s_waitcnt vmcnt(0)" ::: "memory");
        } else {
            XB_SPIN(xb_ld(&bar[XB_XGEN(b.x)]) == gen, bar);
            __builtin_amdgcn_fence(__ATOMIC_ACQUIRE, "agent");
            asm volatile("s_waitcnt vmcnt(0)" ::: "memory");
        }
    }
    __syncthreads();
}

namespace pg8 {
typedef int v4i_t __attribute__((ext_vector_type(4)));
constexpr int BM = 256, BK = 64, HALF = 128, HTB = HALF * BK * 2, STAGE_BYTES = 8 * HTB, NXCD = 8, WGM = 8;
__host__ __device__ __forceinline__ int lds_byte(int r, int c) { const int st = (r >> 4) * 2 + (c >> 5), rr = r & 15, cc = c & 31, ob = rr * 64 + cc * 2; return st * 1024 + (ob ^ (((ob >> 9) & 1) << 5)); }
__host__ __device__ __forceinline__ void stage_rc(int b, int& R, int& C) { const int st = b / 1024, sb = b % 1024, swz = sb ^ (((sb >> 9) & 1) << 5); R = (st >> 1) * 16 + swz / 64; C = (st & 1) * 32 + (swz % 64) / 2; }
__host__ __device__ __forceinline__ int perm32(int rho) { const int n = rho >> 4, i = rho & 15; return 8 * (i >> 2) + 4 * n + (i & 3); }
struct Unit { int pm, pn; };
struct StaticOrder {
    int nM, nN, nwg, G, c;
    __host__ __device__ void init(int nM_, int nN_, int G_, int c_) { nM = nM_; nN = nN_; nwg = nM * nN; G = G_; c = c_; }
    __host__ __device__ bool next(int i, Unit& u) const {
        const long L = (long)i * G + c; if (L >= nwg) return false;
        int wgid = (int)L; { const int q = nwg / NXCD, r = nwg % NXCD, xcd = wgid % NXCD, off = wgid / NXCD; wgid = (xcd < r ? xcd * (q + 1) : r * (q + 1) + (xcd - r) * q) + off; }
        const int nig = WGM * nN, gid = wgid / nig, fm = gid * WGM, gsz = (nM - fm) < WGM ? (nM - fm) : WGM;
        u.pm = fm + ((wgid % nig) % gsz); u.pn = (wgid % nig) / gsz; return true;
    }
};
template <class Epi, class Sched, bool ALIGN_EPI, int MODE>
__device__ __forceinline__ void gemm_phase(LAS unsigned char* lds, const int K, const Sched& S, const Epi& E) {
    const int tid = otid(), wid = __builtin_amdgcn_readfirstlane(tid >> 6), lane = tid & 63, wr = wid >> 2, wc = wid & 3, fr = lane & 15, fq = lane >> 4;
    const int nt = K / BK;
    unsigned voffA[2], voffB[2];
#pragma unroll
    for (int i = 0; i < 2; ++i) { int R, C; stage_rc(tid * 16 + i * 8192, R, C); const int Rb = Epi::PERM ? ((R & ~31) + perm32(R & 31)) : R;
        voffA[i] = (unsigned)(R * K + C) * 2u; voffB[i] = (unsigned)(Rb * K + C) * 2u; }
#define PG8_GVOFF(uix) do { _Pragma("unroll") for (int _h = 0; _h < 2; ++_h) _Pragma("unroll") for (int _i = 0; _i < 2; ++_i) { int R_, C_; stage_rc(tid * 16 + _i * 8192, R_, C_); vg[_h][_i] = S.gvoff((uix), _h * HALF + R_, C_, K); } } while (0)
    const size_t kstep = (size_t)(BK * 2);
    const size_t hstep = (size_t)HALF * K * 2;
    const unsigned ldsw = (unsigned)wid * 1024u;
    const int aoff = lds_byte(wr * 64 + fr, fq * 8), boff = lds_byte(wc * 32 + fr, fq * 8);
#define PG8_SA(b, h) (((b) * 2 + (h)) * HTB)
#define PG8_SB(b, h) ((4 + (b) * 2 + (h)) * HTB)
#define PG8_STAGE(bufoff, gbase, voff) do { _Pragma("unroll") for (int _i = 0; _i < 2; ++_i) \
        __builtin_amdgcn_global_load_lds((const unsigned*)((const char*)(gbase) + (voff)[_i]), (LAS unsigned*)(lds + (bufoff) + ldsw + _i * 8192), 16, 0, 0); } while (0)
#define PG8_STAGE_A(bufoff, kp, h) do { if constexpr (Sched::GATHER) { PG8_STAGE(bufoff, kp, vg[h]); } else { PG8_STAGE(bufoff, (kp) + (h) * hstep, voffA); } } while (0)
#define PG8_LDA(dst, b, h) do { _Pragma("unroll") for (int m = 0; m < 4; ++m) _Pragma("unroll") for (int k = 0; k < 2; ++k) dst[m][k] = *(const LAS bf16x8*)(lds + PG8_SA(b, h) + aoff + m * 2048 + k * 1024); } while (0)
#define PG8_LDB(dst, b, h) do { _Pragma("unroll") for (int n = 0; n < 2; ++n) _Pragma("unroll") for (int k = 0; k < 2; ++k) dst[n][k] = *(const LAS bf16x8*)(lds + PG8_SB(b, h) + boff + n * 2048 + k * 1024); } while (0)
#define PG8_CAT8(x) __builtin_shufflevector(__builtin_bit_cast(v4i_t, (x)[0]), __builtin_bit_cast(v4i_t, (x)[1]), 0, 1, 2, 3, 4, 5, 6, 7)
#define PG8_MMA(ai, bj, At, Bt) do { __builtin_amdgcn_s_setprio(1); if constexpr (MODE == 1) { _Pragma("unroll") for (int m = 0; m < 4; ++m) _Pragma("unroll") for (int n = 0; n < 2; ++n) \
        asm volatile("v_mfma_f32_16x16x128_f8f6f4 %0, %1, %2, %0" : "+v"(acc[ai][bj][m][n]) : "v"(PG8_CAT8(Bt[n])), "v"(PG8_CAT8(At[m]))); } else { \
        _Pragma("unroll") for (int m = 0; m < 4; ++m) _Pragma("unroll") for (int n = 0; n < 2; ++n) _Pragma("unroll") for (int k = 0; k < 2; ++k) \
        acc[ai][bj][m][n] = __builtin_amdgcn_mfma_f32_16x16x32_bf16(Bt[n][k], At[m][k], acc[ai][bj][m][n], 0, 0, 0); } __builtin_amdgcn_s_setprio(0); } while (0)
#define PG8_WAIT_V(n) asm volatile("s_waitcnt vmcnt(" #n ")" ::: "memory")
#define PG8_WAIT_L(n) asm volatile("s_waitcnt lgkmcnt(" #n ")" ::: "memory")
#define PG8_BAR __builtin_amdgcn_s_barrier()
#define PG8_SCHED __builtin_amdgcn_sched_barrier(0)
    Unit cur, nxt; int ui = 0;
    if (!S.next(0, cur)) return;
    f32x4 acc[2][2][4][2];
#pragma unroll
    for (int a = 0; a < 2; ++a)
#pragma unroll
        for (int b = 0; b < 2; ++b)
#pragma unroll
            for (int m = 0; m < 4; ++m)
#pragma unroll
                for (int n = 0; n < 2; ++n) acc[a][b][m][n] = (f32x4){0.f, 0.f, 0.f, 0.f};
    bf16x8 At[4][2], B0[2][2], B1[2][2];
    unsigned vg[2][2];
    if constexpr (Sched::GATHER) PG8_GVOFF(0);
    const char* cA = S.a_base(cur); const char* cB = S.b_base(cur);
    PG8_STAGE(PG8_SB(0, 0), cB, voffB); PG8_STAGE(PG8_SB(0, 1), cB + hstep, voffB); PG8_STAGE_A(PG8_SA(0, 0), cA, 0); PG8_STAGE_A(PG8_SA(0, 1), cA, 1);
    if (wr == 1) PG8_BAR;
    PG8_WAIT_V(2); PG8_BAR;
    PG8_STAGE(PG8_SB(1, 0), cB + kstep, voffB); PG8_STAGE_A(PG8_SA(1, 0), cA + kstep, 0); PG8_STAGE(PG8_SB(1, 1), cB + hstep + kstep, voffB);
    PG8_WAIT_V(6); PG8_BAR;
    for (;;) {
        const bool has_next = S.next(ui + 1, nxt);
        const char* nA = has_next ? S.a_base(nxt) : cA; const char* nB = has_next ? S.b_base(nxt) : cB;
        for (int t = 0; t < nt; t += 2) {
            const bool last = (t == nt - 2);
            const char* a1 = cA + (size_t)(t + 1) * kstep;
            const char* a2 = last ? nA : cA + (size_t)(t + 2) * kstep; const char* b2 = last ? nB : cB + (size_t)(t + 2) * kstep;
            const char* a3 = a2 + kstep; const char* b3 = b2 + kstep;
            PG8_LDB(B0, 0, 0); PG8_LDB(B1, 0, 1); PG8_SCHED; PG8_LDA(At, 0, 0); PG8_STAGE_A(PG8_SA(1, 1), a1, 1);
            if constexpr (Sched::GATHER) { if (last && has_next) PG8_GVOFF(ui + 1); }
            PG8_WAIT_V(8); PG8_WAIT_L(0); PG8_BAR; PG8_MMA(0, 0, At, B0); PG8_MMA(0, 1, At, B1); PG8_BAR; PG8_SCHED;
            PG8_LDA(At, 0, 1); PG8_STAGE(PG8_SB(0, 0), b2, voffB); PG8_STAGE(PG8_SB(0, 1), b2 + hstep, voffB); PG8_STAGE_A(PG8_SA(0, 0), a2, 0);
            PG8_WAIT_V(8); PG8_WAIT_L(0); PG8_BAR; PG8_MMA(1, 0, At, B0); PG8_MMA(1, 1, At, B1); PG8_BAR; PG8_SCHED;
            PG8_LDB(B0, 1, 0); PG8_LDB(B1, 1, 1); PG8_SCHED; PG8_LDA(At, 1, 0); PG8_STAGE_A(PG8_SA(0, 1), a2, 1);
            PG8_WAIT_V(8); PG8_WAIT_L(0); PG8_BAR; PG8_MMA(0, 0, At, B0); PG8_MMA(0, 1, At, B1); PG8_BAR; PG8_SCHED;
            PG8_LDA(At, 1, 1); PG8_STAGE(PG8_SB(1, 0), b3, voffB); PG8_STAGE(PG8_SB(1, 1), b3 + hstep, voffB); PG8_STAGE_A(PG8_SA(1, 0), a3, 0);
            PG8_WAIT_V(8); PG8_WAIT_L(0); PG8_BAR; PG8_MMA(1, 0, At, B0); PG8_MMA(1, 1, At, B1); PG8_BAR; PG8_SCHED;
        }
        if constexpr (ALIGN_EPI) { if (wr == 0) PG8_BAR; }
        if constexpr (MODE == 1) asm volatile("s_nop 15\n\ts_nop 15" ::: "memory");
        E(acc, cur, ui, wr, wc, fr, fq);
        if (!has_next) break;
#pragma unroll
        for (int a = 0; a < 2; ++a)
#pragma unroll
            for (int b = 0; b < 2; ++b)
#pragma unroll
                for (int m = 0; m < 4; ++m)
#pragma unroll
                    for (int n = 0; n < 2; ++n) acc[a][b][m][n] = (f32x4){0.f, 0.f, 0.f, 0.f};
        cur = nxt; cA = nA; cB = nB; ++ui;
        if constexpr (ALIGN_EPI) { if (wr == 1) PG8_BAR; }
    }
    PG8_WAIT_V(0);
    if constexpr (!ALIGN_EPI) { if (wr == 0) PG8_BAR; }
    PG8_BAR;
#undef PG8_SA
#undef PG8_SB
#undef PG8_STAGE
#undef PG8_STAGE_A
#undef PG8_GVOFF
#undef PG8_LDA
#undef PG8_LDB
#undef PG8_MMA
#undef PG8_CAT8
#undef PG8_WAIT_V
#undef PG8_WAIT_L
#undef PG8_BAR
#undef PG8_SCHED
}

struct SchedPlain : StaticOrder {
    static constexpr bool GATHER = false;
    const char* A; const char* B; size_t tA, tB;
    __device__ __forceinline__ const char* a_base(const Unit& u) const { return A + (size_t)u.pm * tA; }
    __device__ __forceinline__ const char* b_base(const Unit& u) const { return B + (size_t)u.pn * tB; }
    __device__ __forceinline__ unsigned gvoff(int, int, int, int) const { return 0u; }
};
struct SchedMoe : StaticOrder {
    const char* A; const char* B; size_t tA, tB, eB; int panel0; const LAS int* seg; const LAS unsigned short* tok;
    __device__ __forceinline__ int expert(const Unit& u) const { const int row = (panel0 + u.pm) * 256; int e = 0;
#pragma unroll
        for (int j = 1; j < NE; ++j) e += (row >= seg[j]) ? 1 : 0;
        return e; }
    __device__ __forceinline__ const char* b_base(const Unit& u) const { return B + (size_t)expert(u) * eB + (size_t)u.pn * tB; }
};
struct SchedMoeUp : SchedMoe {
    static constexpr bool GATHER = true;
    __device__ __forceinline__ const char* a_base(const Unit&) const { return A; }
    __device__ __forceinline__ unsigned gvoff(int ui, int row, int col, int K) const { const int t = (int)tok[ui * 256 + row] >> 1; return (unsigned)(t * K + col) * 2u; }
};
struct SchedMoeDown : SchedMoe {
    static constexpr bool GATHER = false;
    __device__ __forceinline__ const char* a_base(const Unit& u) const { return A + (size_t)u.pm * tA; }
    __device__ __forceinline__ unsigned gvoff(int, int, int, int) const { return 0u; }
};

typedef f32x4 Acc[2][2][4][2];
__device__ __forceinline__ v4u pack8(f32x4 v0, f32x4 v1) { v4u w; w.x = cvt_pk_bf16(v0[0], v0[1]); w.y = cvt_pk_bf16(v0[2], v0[3]); w.z = cvt_pk_bf16(v1[0], v1[1]); w.w = cvt_pk_bf16(v1[2], v1[3]); return w; }
__device__ __forceinline__ void unpack8(v4u w, f32x4& v0, f32x4& v1) { v0 = (f32x4){bf_lo(w.x), bf_hi(w.x), bf_lo(w.y), bf_hi(w.y)}; v1 = (f32x4){bf_lo(w.z), bf_hi(w.z), bf_lo(w.w), bf_hi(w.w)}; }

struct EpiInProj {
    static constexpr bool PERM = true;
    bf16* big;
    __device__ __forceinline__ void operator()(const Acc& acc, const Unit& u, int, int wr, int wc, int fr, int fq) const {
        const int t = u.pn; bf16* base; int ldc, colt; float sc = 1.f;
        if (t < 12) { const int pl = t >> 1; base = big + (size_t)pl * ((size_t)M * WH); ldc = WH; colt = (t & 1) * 256; if (pl == 0 || pl == 3) sc = C2; }
        else { const int g = (t - 12) >> 2; base = big + (size_t)6 * ((size_t)M * WH) + (size_t)g * ((size_t)M * D); ldc = D; colt = ((t - 12) & 3) * 256; }
        const int row0 = u.pm * BM + wr * 64 + fr, col0 = colt + wc * 32 + 8 * fq;
#pragma unroll
        for (int ai = 0; ai < 2; ++ai)
#pragma unroll
            for (int m = 0; m < 4; ++m) { bf16* rowp = base + (size_t)(row0 + ai * HALF + m * 16) * ldc + col0;
#pragma unroll
                for (int bj = 0; bj < 2; ++bj) *(v4u*)(rowp + bj * HALF) = pack8(acc[ai][bj][m][0] * sc, acc[ai][bj][m][1] * sc); }
    }
};
struct EpiBf16 {
    static constexpr bool PERM = true;
    bf16* O; int ldc; float sc;
    __device__ __forceinline__ void operator()(const Acc& acc, const Unit& u, int, int wr, int wc, int fr, int fq) const {
        const int row0 = u.pm * BM + wr * 64 + fr, col0 = u.pn * BM + wc * 32 + 8 * fq;
#pragma unroll
        for (int ai = 0; ai < 2; ++ai)
#pragma unroll
            for (int m = 0; m < 4; ++m) { bf16* rowp = O + (size_t)(row0 + ai * HALF + m * 16) * ldc + col0;
#pragma unroll
                for (int bj = 0; bj < 2; ++bj) *(v4u*)(rowp + bj * HALF) = pack8(acc[ai][bj][m][0] * sc, acc[ai][bj][m][1] * sc); }
    }
};
template <bool ADD> struct EpiGate {
    static constexpr bool PERM = true;
    const bf16* G; bf16* T;
    __device__ __forceinline__ void operator()(const Acc& acc, const Unit& u, int, int wr, int wc, int fr, int fq) const {
        const int row0 = u.pm * BM + wr * 64 + fr, col0 = u.pn * BM + wc * 32 + 8 * fq;
#pragma unroll
        for (int ai = 0; ai < 2; ++ai)
#pragma unroll
            for (int m = 0; m < 4; ++m) { const size_t off = (size_t)(row0 + ai * HALF + m * 16) * D + col0;
#pragma unroll
                for (int bj = 0; bj < 2; ++bj) { const v4u gw = *(const v4u*)(G + off + bj * HALF); f32x4 g0, g1; unpack8(gw, g0, g1);
                    f32x4 t0 = {0.f, 0.f, 0.f, 0.f}, t1 = {0.f, 0.f, 0.f, 0.f};
                    if (ADD) { const v4u tw = *(const v4u*)(T + off + bj * HALF); unpack8(tw, t0, t1); }
                    f32x4 o0, o1;
#pragma unroll
                    for (int c = 0; c < 4; ++c) { o0[c] = t0[c] + sigmoidf_(g0[c]) * acc[ai][bj][m][0][c]; o1[c] = t1[c] + sigmoidf_(g1[c]) * acc[ai][bj][m][1][c]; }
                    *(v4u*)(T + off + bj * HALF) = pack8(o0, o1); } }
    }
};
struct EpiSwiGLU {
    static constexpr bool PERM = true;
    unsigned char* O; float sc;
    __device__ __forceinline__ void operator()(const Acc& acc, const Unit& u, int, int wr, int wc, int fr, int fq) const {
        const int row0 = u.pm * BM + wr * 64 + fr, col0 = u.pn * HALF + wc * 32 + 8 * fq;
#pragma unroll
        for (int ai = 0; ai < 2; ++ai)
#pragma unroll
            for (int m = 0; m < 4; ++m) { f32x4 o0, o1;
#pragma unroll
                for (int c = 0; c < 4; ++c) { const float a = acc[ai][0][m][0][c] * sc, b = acc[ai][0][m][1][c] * sc; o0[c] = a * sigmoidf_(a) * (acc[ai][1][m][0][c] * sc); o1[c] = b * sigmoidf_(b) * (acc[ai][1][m][1][c] * sc); }
                v2u w; w.x = pk4_fp8(o0[0], o0[1], o0[2], o0[3]); w.y = pk4_fp8(o1[0], o1[1], o1[2], o1[3]);
                *(v2u*)(O + (size_t)(row0 + ai * HALF + m * 16) * FF + col0) = w; }
    }
};
struct EpiMoeDown {
    static constexpr bool PERM = true;
    bf16* YP; const LAS unsigned short* tok; const LAS int* seg; float sc;
    __device__ __forceinline__ void operator()(const Acc& acc, const Unit& u, int ui, int wr, int wc, int fr, int fq) const {
        const int r0 = wr * 64 + fr, col0 = u.pn * BM + wc * 32 + 8 * fq;
        const int prow = u.pm * 256; int e = 0;
#pragma unroll
        for (int j = 1; j < NE; ++j) e += (prow >= seg[j]) ? 1 : 0;
        const int nvalid = seg[16 + e] - (prow - seg[e]);
#pragma unroll
        for (int ai = 0; ai < 2; ++ai)
#pragma unroll
            for (int m = 0; m < 4; ++m) { const int r = r0 + ai * HALF + m * 16;
                if (r < nvalid) { bf16* rowp = YP + (size_t)tok[ui * 256 + r] * D + col0;
#pragma unroll
                    for (int bj = 0; bj < 2; ++bj) *(v4u*)(rowp + bj * HALF) = pack8(acc[ai][bj][m][0] * sc, acc[ai][bj][m][1] * sc); } }
    }
};
}

namespace att {
constexpr int PITCH = WH;
constexpr int SLOTB = 8192;
constexpr int NSLOT = 4;
constexpr int L_K = 0, L_V = NSLOT * SLOTB, L_WS = 2 * NSLOT * SLOTB, L_OST = L_WS + NWAVES * 64 * 4, L_KPART = L_OST + NWAVES * 4096, L_KMEAN = L_KPART + 8 * 8 * 64 * 4, L_SEL = L_KMEAN + 8 * 64 * 4, L_LUT = L_SEL + 256, L_DONE = L_LUT + 512, L_END = L_DONE + 64;
static_assert(L_END <= RING_BYTES, "attention LDS");
__device__ __forceinline__ int crow(int r, int hi) { return (r & 3) + 8 * (r >> 2) + 4 * hi; }
__device__ __forceinline__ void glds16(const void* gsrc, unsigned lds_dst) { unsigned keep;
    asm volatile("s_mov_b32 %0, m0\n\ts_mov_b32 m0, %2\n\ts_nop 0\n\tglobal_load_lds_dwordx4 %1, off\n\ts_mov_b32 m0, %0" : "=&s"(keep) : "v"(gsrc), "s"(lds_dst) : "memory"); }
#define ATT_WAIT_BAR(N) asm volatile("s_waitcnt vmcnt(" #N ") lgkmcnt(0)\n\ts_barrier" ::: "memory")
constexpr float SB_DONE_THR = 192.f;
__device__ const unsigned char REL_BUCKET_LUT[128] = {0, 1, 2, 3, 4, 5, 6, 7, 8, 9, 10, 11, 12, 13, 14, 15, 16, 16, 16, 17, 17, 18, 18, 18, 19, 19, 19, 20, 20, 20, 20, 21, 21, 21, 21, 22, 22, 22, 22, 22, 23, 23, 23, 23, 23, 23, 24, 24, 24, 24, 24, 24, 25, 25, 25, 25, 25, 25, 25, 26, 26, 26, 26, 26, 26, 26, 26, 27, 27, 27, 27, 27, 27, 27, 27, 27, 27, 28, 28, 28, 28, 28, 28, 28, 28, 28, 28, 29, 29, 29, 29, 29, 29, 29, 29, 29, 29, 29, 29, 30, 30, 30, 30, 30, 30, 30, 30, 30, 30, 30, 30, 30, 30, 31, 31, 31, 31, 31, 31, 31, 31, 31, 31, 31, 31, 31, 31, 31};

__device__ __forceinline__ void qkt(f32x16& p0, f32x16& p1, const LAS char* Kslot, const bf16x8* qr, const f32x16& cinit, int r32, int hi) {
    const LAS char* kb = Kslot + hi * 1024 + r32 * 16;
#pragma unroll
    for (int d0 = 0; d0 < 4; ++d0) {
        const bf16x8 b0 = *(const LAS bf16x8*)(kb + d0 * 2048);
        const bf16x8 b1 = *(const LAS bf16x8*)(kb + d0 * 2048 + 512);
        if (d0 == 0) { p0 = __builtin_amdgcn_mfma_f32_32x32x16_bf16(b0, qr[0], cinit, 0, 0, 0); p1 = __builtin_amdgcn_mfma_f32_32x32x16_bf16(b1, qr[0], cinit, 0, 0, 0); }
        else { p0 = __builtin_amdgcn_mfma_f32_32x32x16_bf16(b0, qr[d0], p0, 0, 0, 0); p1 = __builtin_amdgcn_mfma_f32_32x32x16_bf16(b1, qr[d0], p1, 0, 0, 0); }
    }
}
__device__ __forceinline__ void pv(f32x16* o, int vb, bf16x8 pa0, bf16x8 pa1, bf16x8 pa2, bf16x8 pa3) {
#pragma unroll
    for (int d0 = 0; d0 < 2; ++d0) { s16x4 lo[4], hi[4];
#pragma unroll
        for (int ks = 0; ks < 4; ++ks) {
            asm volatile("ds_read_b64_tr_b16 %0,%1 offset:%c2" : "=&v"(lo[ks]) : "v"(vb), "i"(d0 * 4096 + ks * 1024) : "memory");
            asm volatile("ds_read_b64_tr_b16 %0,%1 offset:%c2" : "=&v"(hi[ks]) : "v"(vb), "i"(d0 * 4096 + ks * 1024 + 512) : "memory"); }
        asm volatile("s_waitcnt lgkmcnt(0)" ::: "memory"); __builtin_amdgcn_sched_barrier(0);
#define ATT_PK(k) (bf16x8){lo[k][0], lo[k][1], lo[k][2], lo[k][3], hi[k][0], hi[k][1], hi[k][2], hi[k][3]}
        o[d0] = __builtin_amdgcn_mfma_f32_32x32x16_bf16(pa0, ATT_PK(0), o[d0], 0, 0, 0);
        o[d0] = __builtin_amdgcn_mfma_f32_32x32x16_bf16(pa1, ATT_PK(1), o[d0], 0, 0, 0);
        o[d0] = __builtin_amdgcn_mfma_f32_32x32x16_bf16(pa2, ATT_PK(2), o[d0], 0, 0, 0);
        o[d0] = __builtin_amdgcn_mfma_f32_32x32x16_bf16(pa3, ATT_PK(3), o[d0], 0, 0, 0);
#undef ATT_PK
    }
}
__device__ __forceinline__ bf16x8 pack8r(const f32x16& p, int b) { v4u w; w.x = cvt_pk_bf16(p[b], p[b + 1]); w.y = cvt_pk_bf16(p[b + 2], p[b + 3]); w.z = cvt_pk_bf16(p[b + 4], p[b + 5]); w.w = cvt_pk_bf16(p[b + 6], p[b + 7]); return __builtin_bit_cast(bf16x8, w); }
__device__ __forceinline__ f32x16 splat16(float v) { f32x16 r;
#pragma unroll
    for (int i = 0; i < 16; ++i) r[i] = v;
    return r; }

template <bool MOBA>
__device__ __forceinline__ void attn_unit(int b, int h, int qb, const bf16* Q, const bf16* __restrict__ Kp, const bf16* __restrict__ Vp, bf16* O, const float* rel_bias, LAS unsigned char* shm) {
    const int tid = otid(), lane = tid & 63, r32 = lane & 31, hi = lane >> 5; const int wid = __builtin_amdgcn_readfirstlane(tid >> 6);
    const long rowbase = (long)b * SEQ; const int q0 = qb * 256;
    const bf16* Qw = Q + (rowbase + q0 + wid * 32) * PITCH + h * HD;
    const bf16* Kh = Kp + rowbase * PITCH + h * HD; const bf16* Vh = Vp + rowbase * PITCH + h * HD;
    const unsigned lds0 = (unsigned)(uintptr_t)shm;
    LAS float* wsf = (LAS float*)(shm + L_WS) + wid * 64;
    const bf16* ksrc = Kh + (long)lane * PITCH + wid * 8;
    const bf16* vsrc = Vh + (long)(16 * (wid & 3) + (lane >> 2)) * PITCH + (wid >> 2) * 32 + (lane & 3) * 8;
    const unsigned kdst = lds0 + L_K + wid * 1024, vdst = lds0 + L_V + wid * 1024;
#define DMA_K(t, slot) glds16(ksrc + (long)(t) * 64 * PITCH, (unsigned)__builtin_amdgcn_readfirstlane(kdst + (slot)))
#define DMA_V(t, slot) glds16(vsrc + (long)(t) * 64 * PITCH, (unsigned)__builtin_amdgcn_readfirstlane(vdst + (slot)))
    const int vb0 = (int)(lds0 + L_V) + ((lane >> 4) & 1) * 32 + (lane & 3) * 8 + (4 * hi + ((lane & 15) >> 2)) * 64;
    const LAS char* Kbase = (const LAS char*)(shm + L_K);
    const int NT = 4 * (qb + 1);
    const int qrel = wid * 32 + r32;
    DMA_K(NT - 1, 0); DMA_V(NT - 1, 0); DMA_K(NT - 2, SLOTB); DMA_V(NT - 2, SLOTB); DMA_K(NT - 3, 2 * SLOTB); DMA_V(NT - 3, 2 * SLOTB);
    LAS int* doneAt = (LAS int*)(shm + L_DONE);
    if (!MOBA) { if (tid < 8) doneAt[tid] = 0x7fffffff; }
    bf16x8 qr[4];
#pragma unroll
    for (int d0 = 0; d0 < 4; ++d0) qr[d0] = *(const bf16x8*)(&Qw[(long)r32 * PITCH + d0 * 16 + hi * 8]);
    float biasfar = 0.f; unsigned selmask = 0u;
    if constexpr (MOBA) {
        LAS float* KPART = (LAS float*)(shm + L_KPART); LAS float* KMEAN = (LAS float*)(shm + L_KMEAN); LAS unsigned char* SEL = (LAS unsigned char*)(shm + L_SEL); LAS float* LUT = (LAS float*)(shm + L_LUT);
        if (tid < 128) LUT[tid] = rel_bias[REL_BUCKET_LUT[tid] * NH + h] * LOG2E;
        const int dch = lane & 7, rs = lane >> 3;
        for (int mb = 0; mb < qb; ++mb) {
            float s[8];
#pragma unroll
            for (int c = 0; c < 8; ++c) s[c] = 0.f;
#pragma unroll
            for (int j = 0; j < 4; ++j) { const v4u w = *(const v4u*)(Kh + (long)(mb * 256 + wid * 32 + j * 8 + rs) * PITCH + dch * 8);
                s[0] += bf_lo(w.x); s[1] += bf_hi(w.x); s[2] += bf_lo(w.y); s[3] += bf_hi(w.y); s[4] += bf_lo(w.z); s[5] += bf_hi(w.z); s[6] += bf_lo(w.w); s[7] += bf_hi(w.w); }
#pragma unroll
            for (int c = 0; c < 8; ++c) { s[c] += shx(s[c], 8, lane); s[c] += shx(s[c], 16, lane); s[c] += shx(s[c], 32, lane); }
            if (rs == 0) {
#pragma unroll
                for (int c = 0; c < 8; ++c) KPART[(mb * 8 + wid) * 64 + dch * 8 + c] = s[c]; }
        }
        __syncthreads();
        { const int mb = tid >> 6, d = tid & 63; if (mb < qb) { float t = 0.f;
#pragma unroll
            for (int w = 0; w < 8; ++w) t += KPART[(mb * 8 + w) * 64 + d];
            KMEAN[mb * 64 + d] = t * (1.0f / 256.0f); } }
        __syncthreads();
        { const int q = tid >> 1, dh = tid & 1; const bf16* qp = Q + (rowbase + q0 + q) * PITCH + h * HD + dh * 32; float qv[32];
#pragma unroll
            for (int j = 0; j < 4; ++j) { const v4u w = *(const v4u*)(qp + j * 8); qv[j * 8 + 0] = bf_lo(w.x); qv[j * 8 + 1] = bf_hi(w.x); qv[j * 8 + 2] = bf_lo(w.y); qv[j * 8 + 3] = bf_hi(w.y); qv[j * 8 + 4] = bf_lo(w.z); qv[j * 8 + 5] = bf_hi(w.z); qv[j * 8 + 6] = bf_lo(w.w); qv[j * 8 + 7] = bf_hi(w.w); }
            float g[7];
#pragma unroll
            for (int mb = 0; mb < 7; ++mb) { float a = 0.f; if (mb < qb) {
#pragma unroll
                    for (int d = 0; d < 32; ++d) a += qv[d] * KMEAN[mb * 64 + dh * 32 + d]; }
                a += shx(a, 1, lane); g[mb] = a; }
            unsigned mask = 0u;
            if (qb <= 3) mask = (1u << qb) - 1u;
            else {
#pragma unroll
                for (int pass = 0; pass < 3; ++pass) { float best = -INFINITY; int bi = 0;
#pragma unroll
                    for (int mb = 0; mb < 7; ++mb) if (mb < qb && !((mask >> mb) & 1u) && g[mb] > best) { best = g[mb]; bi = mb; }
                    mask |= 1u << bi; } }
            if (dh == 0) SEL[q] = (unsigned char)mask; }
        __syncthreads();
        selmask = SEL[qrel]; biasfar = LUT[127];
    }
    f32x16 o[2]; o[0] = splat16(0.f); o[1] = splat16(0.f);
    float m_run = -INFINITY, l_run = 0.f, carry = 0.f;
    bf16x8 tri0, tri1, ones;
#pragma unroll
    for (int jj = 0; jj < 8; ++jj) { const int j0 = 8 * (jj >> 2) + 4 * hi + (jj & 3); tri0[jj] = (j0 >= r32) ? (short)0x3F80 : (short)0; tri1[jj] = (16 + j0 >= r32) ? (short)0x3F80 : (short)0; ones[jj] = (short)0x3F80; }
    const int jd = wid >> 1;
    bool mydone = false;
    for (int i = 0; i < NT; ++i) {
        const int kt = NT - 1 - i; const int slot = (i & 3) * SLOTB;
        { const int n = (NT - 1 - i) < 2 ? (NT - 1 - i) : 2;
          if (n == 2) ATT_WAIT_BAR(4); else if (n == 1) ATT_WAIT_BAR(2); else ATT_WAIT_BAR(0); }
        if constexpr (!MOBA) { if (i >= 1) { const v4u d0 = *(const LAS v4u*)doneAt, d1 = *(const LAS v4u*)(doneAt + 4); const int lim = i - 1;
                bool all = ((int)d0.x <= lim) && ((int)d0.y <= lim) && ((int)d0.z <= lim) && ((int)d0.w <= lim) && ((int)d1.x <= lim) && ((int)d1.y <= lim) && ((int)d1.z <= lim) && ((int)d1.w <= lim);
                if (__builtin_amdgcn_readfirstlane(all ? 1 : 0)) break; } }
        if (i + 3 < NT) { DMA_K(kt - 3, ((i + 3) & 3) * SLOTB); DMA_V(kt - 3, ((i + 3) & 3) * SLOTB); }
        if constexpr (!MOBA) { if (mydone) continue; }
        const int jb = kt - (NT - 4);
        if (jb > jd) continue;
        const bool diag = (jb == jd);
        f32x16 p0, p1;
        if constexpr (MOBA) {
            const bool band = jb >= 0; const int mblk = kt >> 2;
            const bool sel = band || ((selmask >> mblk) & 1u);
            if (!__any(sel)) continue;
            const int dmin = (q0 + wid * 32) - (64 * kt + 63);
            const bool near = dmin < 113;
            const float ci = sel ? (near ? 0.f : biasfar) : -INFINITY;
            const f32x16 cinit = splat16(ci);
            qkt(p0, p1, Kbase + slot, qr, cinit, r32, hi);
            if (near) { const LAS float* LUT = (const LAS float*)(shm + L_LUT); const int dq = (q0 + qrel) - 64 * kt;
#pragma unroll
                for (int r = 0; r < 16; ++r) { const int d0_ = dq - crow(r, hi), d1_ = d0_ - 32;
                    const float b0 = LUT[d0_ < 0 ? 0 : (d0_ > 127 ? 127 : d0_)], b1 = LUT[d1_ < 0 ? 0 : (d1_ > 127 ? 127 : d1_)];
                    p0[r] = (d0_ < 0) ? -INFINITY : p0[r] + b0; p1[r] = (d1_ < 0) ? -INFINITY : p1[r] + b1; } }
            float rm = p0[0];
#pragma unroll
            for (int r = 1; r < 16; ++r) rm = fmaxf(rm, p0[r]);
#pragma unroll
            for (int r = 0; r < 16; ++r) rm = fmaxf(rm, p1[r]);
            rm = fmaxf(rm, shx(rm, 32, lane));
            const float m_new = fmaxf(m_run, rm);
            const float alpha = (m_new == -INFINITY) ? 1.f : fast_exp2(m_run - m_new);
            const float msub = (m_new == -INFINITY) ? 0.f : m_new;
            float ls = 0.f;
#pragma unroll
            for (int r = 0; r < 16; ++r) { p0[r] = fast_exp2(p0[r] - msub); p1[r] = fast_exp2(p1[r] - msub); ls += p0[r] + p1[r]; }
            l_run = l_run * alpha + ls; m_run = m_new;
            if (__any(alpha != 1.f)) { if (hi == 0) wsf[r32] = alpha; LDS_WAIT();
#pragma unroll
                for (int d_ = 0; d_ < 2; ++d_)
#pragma unroll
                    for (int r = 0; r < 16; ++r) o[d_][r] *= wsf[crow(r, hi)];
                LDS_WAIT(); }
        } else {
            const f32x16 zero = splat16(0.f);
            qkt(p0, p1, Kbase + slot, qr, zero, r32, hi);
            f32x16 s0, s1;
            const int kq = qrel - 64 * (jb < 0 ? 0 : jb);
#pragma unroll
            for (int r = 0; r < 16; ++r) { const float z0 = p0[r], z1 = p1[r];
                float a0 = fmaxf(z0, fast_log2(1.0f + fast_exp2(fminf(z0, 64.f)))), a1 = fmaxf(z1, fast_log2(1.0f + fast_exp2(fminf(z1, 64.f))));
                if (diag) { const int kv = crow(r, hi); if (kv >= kq) a0 = 0.f; if (kv + 32 >= kq) a1 = 0.f; }
                s0[r] = a0; s1[r] = a1; }
            const bf16x8 L0 = pack8r(s0, 0), L1 = pack8r(s0, 8), L2 = pack8r(s1, 0), L3 = pack8r(s1, 8);
            const f32x16 c16 = splat16(carry);
            f32x16 W0 = __builtin_amdgcn_mfma_f32_32x32x16_bf16(tri0, L0, c16, 0, 0, 0);
            W0 = __builtin_amdgcn_mfma_f32_32x32x16_bf16(tri1, L1, W0, 0, 0, 0);
            W0 = __builtin_amdgcn_mfma_f32_32x32x16_bf16(ones, L2, W0, 0, 0, 0);
            W0 = __builtin_amdgcn_mfma_f32_32x32x16_bf16(ones, L3, W0, 0, 0, 0);
            f32x16 W1 = __builtin_amdgcn_mfma_f32_32x32x16_bf16(tri0, L2, c16, 0, 0, 0);
            W1 = __builtin_amdgcn_mfma_f32_32x32x16_bf16(tri1, L3, W1, 0, 0, 0);
            carry = shl(W0[0], r32);
#pragma unroll
            for (int r = 0; r < 16; ++r) { float e0 = fast_exp2(p0[r] - W0[r]), e1 = fast_exp2(p1[r] - W1[r]);
                if (diag) { const int kv = crow(r, hi); if (kv >= kq) e0 = 0.f; if (kv + 32 >= kq) e1 = 0.f; }
                p0[r] = e0; p1[r] = e1; }
            if (__all(carry > SB_DONE_THR)) { mydone = true; if (lane == 0) doneAt[wid] = i; }
        }
        pv(o, vb0 + slot, pack8r(p0, 0), pack8r(p0, 8), pack8r(p1, 0), pack8r(p1, 8));
    }
    asm volatile("s_waitcnt vmcnt(0)" ::: "memory");
    float rli[16];
    if constexpr (MOBA) {
        l_run += shx(l_run, 32, lane);
        if (hi == 0) wsf[32 + r32] = l_run; LDS_WAIT();
#pragma unroll
        for (int r = 0; r < 16; ++r) rli[r] = fast_rcp(wsf[32 + crow(r, hi)]);
    } else {
#pragma unroll
        for (int r = 0; r < 16; ++r) rli[r] = 1.f;
    }
    bf16* Ow = O + (rowbase + q0 + wid * 32) * PITCH + h * HD;
    { LAS bf16* stg = (LAS bf16*)(shm + L_OST) + wid * 2048;
#pragma unroll
        for (int r = 0; r < 16; ++r) { const int orow = crow(r, hi);
#pragma unroll
            for (int d0 = 0; d0 < 2; ++d0) stg[orow * 64 + d0 * 32 + r32] = (bf16)f2bf(o[d0][r] * rli[r]); }
        LDS_WAIT();
#pragma unroll
        for (int i = 0; i < 4; ++i) { const int row = i * 8 + (lane >> 3), ch = lane & 7; const v4u v = *(const LAS v4u*)(stg + row * 64 + ch * 8); *(v4u*)(Ow + (long)row * PITCH + ch * 8) = v; } }
    asm volatile("s_waitcnt lgkmcnt(0)\n\ts_barrier" ::: "memory");
#undef DMA_K
#undef DMA_V
}
}

struct Args { const float* in[20]; float* out; unsigned char* ws; int ph_lo, ph_hi; };
struct Frame {
    LAS unsigned char* lds; gu32* ctl; int tid, lane, wave, vcu, G;
};
#define FRESH(F) do { (F).tid = otid(); (F).lane = (F).tid & 63; (F).wave = __builtin_amdgcn_readfirstlane((F).tid >> 6); } while (0)
__device__ __forceinline__ float wave_sum(float v, int lane) {
#pragma unroll
    for (int o = 1; o < 64; o <<= 1) v += shx(v, o, lane);
    return v;
}
__device__ __forceinline__ void transpose_item(const float* W, int K, int N, bf16* WT, int mode, LAS float* scr, int item, int lane) {
    const int nblk = N / 32, kb = item / nblk, nb = item % nblk, k0 = 64 * kb, n0 = 32 * nb;
    const int rbase = (mode == 0) ? n0 : (256 * (n0 >> 7) + (n0 & 127) + (mode == 2 ? 128 : 0));
#pragma unroll 8
    for (int i = 0; i < 32; ++i) { const int kk = 2 * i + (lane >> 5); scr[kk * 33 + (lane & 31)] = W[(size_t)(k0 + kk) * N + n0 + (lane & 31)]; }
    LDS_WAIT(); asm volatile("" ::: "memory");
    const int c = lane & 7;
#pragma unroll
    for (int j = 0; j < 4; ++j) { const int n = (lane >> 3) + 8 * j; const LAS float* s = scr + (8 * c) * 33 + n;
        v4u o; o.x = pk2(s[0 * 33], s[1 * 33]); o.y = pk2(s[2 * 33], s[3 * 33]); o.z = pk2(s[4 * 33], s[5 * 33]); o.w = pk2(s[6 * 33], s[7 * 33]);
        *(GAS v4u*)(WT + (size_t)(rbase + n) * K + k0 + 8 * c) = o; }
    LDS_WAIT(); asm volatile("" ::: "memory");
}

__device__ __forceinline__ void transpose_item8(const float* W, int K, int N, unsigned char* WT, int mode, float scale, LAS float* scr, int item, int lane) {
    const int nblk = N / 32, kb = item / nblk, nb = item % nblk, k0 = 64 * kb, n0 = 32 * nb;
    const int rbase = (mode == 0) ? n0 : (256 * (n0 >> 7) + (n0 & 127) + (mode == 2 ? 128 : 0));
#pragma unroll 8
    for (int i = 0; i < 32; ++i) { const int kk = 2 * i + (lane >> 5); scr[kk * 33 + (lane & 31)] = W[(size_t)(k0 + kk) * N + n0 + (lane & 31)]; }
    LDS_WAIT(); asm volatile("" ::: "memory");
    const int c = lane & 3;
#pragma unroll
    for (int j = 0; j < 2; ++j) { const int n = (lane >> 2) + 16 * j; const LAS float* sp = scr + (16 * c) * 33 + n;
        v4u o; o.x = pk4_fp8(sp[0 * 33] * scale, sp[1 * 33] * scale, sp[2 * 33] * scale, sp[3 * 33] * scale); o.y = pk4_fp8(sp[4 * 33] * scale, sp[5 * 33] * scale, sp[6 * 33] * scale, sp[7 * 33] * scale);
        o.z = pk4_fp8(sp[8 * 33] * scale, sp[9 * 33] * scale, sp[10 * 33] * scale, sp[11 * 33] * scale); o.w = pk4_fp8(sp[12 * 33] * scale, sp[13 * 33] * scale, sp[14 * 33] * scale, sp[15 * 33] * scale);
        *(GAS v4u*)(WT + (size_t)(rbase + n) * K + k0 + 16 * c) = o; }
    LDS_WAIT(); asm volatile("" ::: "memory");
}

struct RowArgs { const float* xin; float* xout; const bf16* Y; const float2* tokw_in; const float* gpost; const float* gate; const float* gpre; const float* shift; const float* scale; bf16* H;
                 const float* wrouter; int* lists; float2* tokw_out; unsigned* cnt; };
template <bool HAS_Y, bool PAIR, bool WRITE_H, bool ROUTER, bool H8 = false>
__device__ __forceinline__ void row_phase(Frame& F, const RowArgs& a) {
    FRESH(F);
    const int lane = F.lane; const int gw = F.vcu * NWAVES + F.wave; const int rows_per_wave = M / (F.G * NWAVES);
    const int m0 = gw * rows_per_wave; const int b = (F.vcu * NWAVES * rows_per_wave) / SEQ;
    LAS float* wr = (LAS float*)F.lds;
    LAS float* vec = (LAS float*)(F.lds + 32768);
    if constexpr (ROUTER) { for (int i = F.tid; i < D * NE / 4; i += NTHREADS) ((LAS f32x4*)wr)[i] = ((const f32x4*)a.wrouter)[i]; }
    for (int i = F.tid; i < D; i += NTHREADS) {
        if (HAS_Y) { vec[i] = a.gpost[i]; vec[D + i] = a.gate[(size_t)b * NMOD + i]; }
        if (WRITE_H) { vec[2 * D + i] = a.gpre[i]; vec[3 * D + i] = a.shift[(size_t)b * NMOD + i]; vec[4 * D + i] = a.scale[(size_t)b * NMOD + i] + 1.0f; } }
    __syncthreads();
    int my_e0 = -1, my_e1 = -1; float my_w0 = 0.f, my_w1 = 0.f;
    for (int i = 0; i < rows_per_wave; ++i) { const int m = m0 + i;
        f32x4 x[4];
#pragma unroll
        for (int j = 0; j < 4; ++j) x[j] = *(const f32x4*)(a.xin + (size_t)m * D + 256 * j + 4 * lane);
        if constexpr (HAS_Y) {
            f32x4 y[4];
            if constexpr (PAIR) { const float2 w = a.tokw_in[m];
#pragma unroll
                for (int j = 0; j < 4; ++j) { const v2u u0 = *(const v2u*)(a.Y + (size_t)(2 * m) * D + 256 * j + 4 * lane), u1 = *(const v2u*)(a.Y + (size_t)(2 * m + 1) * D + 256 * j + 4 * lane);
                    y[j] = (f32x4){w.x * bf_lo(u0.x) + w.y * bf_lo(u1.x), w.x * bf_hi(u0.x) + w.y * bf_hi(u1.x), w.x * bf_lo(u0.y) + w.y * bf_lo(u1.y), w.x * bf_hi(u0.y) + w.y * bf_hi(u1.y)}; }
            } else {
#pragma unroll
                for (int j = 0; j < 4; ++j) { const v2u u0 = *(const v2u*)(a.Y + (size_t)m * D + 256 * j + 4 * lane); y[j] = (f32x4){bf_lo(u0.x), bf_hi(u0.x), bf_lo(u0.y), bf_hi(u0.y)}; }
            }
            float s = 0.f;
#pragma unroll
            for (int j = 0; j < 4; ++j) s += (y[j].x * y[j].x + y[j].y * y[j].y) + (y[j].z * y[j].z + y[j].w * y[j].w);
            const float rstd = 1.0f / sqrtf(wave_sum(s, lane) * (1.0f / D) + EPS);
#pragma unroll
            for (int j = 0; j < 4; ++j) { const f32x4 gp = *(const LAS f32x4*)(vec + 256 * j + 4 * lane), gt = *(const LAS f32x4*)(vec + D + 256 * j + 4 * lane);
                x[j] = x[j] + gt * ((y[j] * rstd) * gp); *(f32x4*)(a.xout + (size_t)m * D + 256 * j + 4 * lane) = x[j]; }
        }
        if constexpr (WRITE_H) {
            float s = 0.f;
#pragma unroll
            for (int j = 0; j < 4; ++j) s += (x[j].x * x[j].x + x[j].y * x[j].y) + (x[j].z * x[j].z + x[j].w * x[j].w);
            const float rstd = 1.0f / sqrtf(wave_sum(s, lane) * (1.0f / D) + EPS);
#pragma unroll
            for (int j = 0; j < 4; ++j) { const f32x4 gp = *(const LAS f32x4*)(vec + 2 * D + 256 * j + 4 * lane), sh = *(const LAS f32x4*)(vec + 3 * D + 256 * j + 4 * lane), sc = *(const LAS f32x4*)(vec + 4 * D + 256 * j + 4 * lane);
                x[j] = ((x[j] * rstd) * gp) * sc + sh;
                if constexpr (H8) { *(unsigned*)((unsigned char*)a.H + (size_t)m * D + 256 * j + 4 * lane) = pk4_fp8(x[j].x, x[j].y, x[j].z, x[j].w); }
                else { v2u o; o.x = pk2(x[j].x, x[j].y); o.y = pk2(x[j].z, x[j].w); *(v2u*)(a.H + (size_t)m * D + 256 * j + 4 * lane) = o; } }
            if constexpr (ROUTER) {
                float lg[NE];
#pragma unroll
                for (int e = 0; e < NE; ++e) lg[e] = 0.f;
#pragma unroll
                for (int j = 0; j < 4; ++j)
#pragma unroll
                    for (int c = 0; c < 4; ++c) { const LAS f32x4* wp = (const LAS f32x4*)(wr + (size_t)(256 * j + 4 * lane + c) * NE); const f32x4 w0 = wp[0], w1 = wp[1]; const float hvv = x[j][c];
                        lg[0] += hvv * w0.x; lg[1] += hvv * w0.y; lg[2] += hvv * w0.z; lg[3] += hvv * w0.w; lg[4] += hvv * w1.x; lg[5] += hvv * w1.y; lg[6] += hvv * w1.z; lg[7] += hvv * w1.w;
                        if (c == 3) asm volatile("" ::: "memory"); }
#pragma unroll
                for (int e = 0; e < NE; ++e) lg[e] = wave_sum(lg[e], lane);
                int e0 = 0; float v0 = lg[0];
#pragma unroll
                for (int e = 1; e < NE; ++e) if (lg[e] > v0) { v0 = lg[e]; e0 = e; }
                int e1 = -1; float v1 = -INFINITY;
#pragma unroll
                for (int e = 0; e < NE; ++e) if (e != e0 && lg[e] > v1) { v1 = lg[e]; e1 = e; }
                const float t = fast_exp2((v1 - v0) * LOG2E); const float w0 = 1.0f / (1.0f + t), w1 = t / (1.0f + t);
                if (lane == i) { my_e0 = e0; my_e1 = e1; my_w0 = w0; my_w1 = w1; }
            }
        }
    }
    if constexpr (ROUTER) {
        const bool act = lane < rows_per_wave; int pos0 = 0, pos1 = 0;
        const unsigned long long lt = (1ull << lane) - 1ull;
#pragma unroll
        for (int e = 0; e < NE; ++e) { const unsigned long long b0 = __ballot(act && my_e0 == e), b1 = __ballot(act && my_e1 == e);
            const int n0 = __popcll(b0), n1 = __popcll(b1); int base = 0;
            if (n0 + n1 > 0) { if (lane == 0) base = (int)__hip_atomic_fetch_add(a.cnt + 64 * e, (unsigned)(n0 + n1), RLX_AGENT); base = __builtin_amdgcn_readfirstlane(base); }
            if (act && my_e0 == e) pos0 = base + __popcll(b0 & lt);
            if (act && my_e1 == e) pos1 = base + n0 + __popcll(b1 & lt); }
        if (act) { const int m = m0 + lane; a.lists[my_e0 * M + pos0] = 2 * m; a.lists[my_e1 * M + pos1] = 2 * m + 1; a.tokw_out[m] = make_float2(my_w0, my_w1); }
    }
    __syncthreads();
}

template <class Sched>
__device__ __forceinline__ void moe_tables(Frame& F, const Sched& S, const int* lists, int panel0) {
    FRESH(F);
    LAS int* seg = (LAS int*)(F.lds + LDS_SEG); LAS unsigned short* tok = (LAS unsigned short*)(F.lds + LDS_TOK);
    if (F.tid == 0) { int acc = 0;
        for (int e = 0; e < NE; ++e) { const int c = (int)__hip_atomic_load((unsigned*)(F.ctl + CW_CNT + 64 * e), RLX_AGENT); seg[e] = acc; seg[16 + e] = c; acc += (c + 255) & ~255; }
        seg[8] = acc; }
    __syncthreads();
    pg8::Unit u;
    for (int ui = 0; ui < LDS_TOK_UNITS && S.next(ui, u); ++ui) {
        if (F.tid < 256) { const int row = (panel0 + u.pm) * 256 + F.tid; int e = 0;
#pragma unroll
            for (int j = 1; j < NE; ++j) e += (row >= seg[j]) ? 1 : 0;
            const int pos = row - seg[e]; tok[ui * 256 + F.tid] = (unsigned short)((pos < seg[16 + e]) ? lists[e * M + pos] : 0); }
    }
    __syncthreads();
}

constexpr int PH_LAYER0 = 2, PH_STRIDE = 16, PH_END = PH_LAYER0 + 2 * PH_STRIDE;
__global__ void __launch_bounds__(NTHREADS, 2) mega_fwd(Args args) {
    extern __shared__ __attribute__((aligned(16))) unsigned char lds_raw[];
    Frame F; F.lds = (LAS unsigned char*)lds_raw; F.tid = threadIdx.x; F.lane = F.tid & 63; F.wave = __builtin_amdgcn_readfirstlane(F.tid >> 6);
    F.G = gridDim.x; { const int bx = blockIdx.x; F.vcu = (F.G % 8 == 0) ? (bx % 8) * (F.G / 8) + bx / 8 : bx; }
    unsigned char* ws = args.ws; F.ctl = (gu32*)(ws + WS_CTL);
    volatile LAS unsigned* MISC = (volatile LAS unsigned*)(F.lds + LDS_MISC);
    if (F.tid < 16) MISC[F.tid] = 0u;
    __syncthreads();
    XcdBarrier bar; bar.bar = (unsigned*)(F.ctl + CW_BAR); bar.x = 0; bar.st = nullptr;
    if (MK_ONE_LAUNCH) bar = xcd_barrier_post((unsigned*)(F.ctl + CW_BAR), MISC);
    const int lo = args.ph_lo, hi = args.ph_hi;
#define IN(k) (lo <= (k) && (k) < hi)
#define SEAM(k, knext) do { if (IN(k) && IN(knext)) xcd_barrier(bar); } while (0)
    const float* x_in = args.in[0]; const float* c_in = args.in[1]; const float* w_mod = args.in[2]; const float* b_mod = args.in[3];
    const float* g_mix_pre = args.in[4]; const float* g_mix_post = args.in[5]; const float* g_ffn_pre = args.in[6]; const float* g_ffn_post = args.in[7];
    const float* w_in = args.in[8]; const float* w_psb = args.in[9]; const float* w_pmb = args.in[10]; const float* w_out = args.in[11]; const float* rel_bias = args.in[12];
    const float* w1d = args.in[13]; const float* w3d = args.in[14]; const float* w2d = args.in[15]; const float* w_router = args.in[16];
    const float* w1m = args.in[17]; const float* w3m = args.in[18]; const float* w2m = args.in[19];
    float* xout = args.out;
    float* MOD = (float*)(ws + WS_MOD); int* LISTS = (int*)(ws + WS_LIST); float2* TOKW = (float2*)(ws + WS_TOKW);
    bf16* WIN = (bf16*)(ws + WS_WIN); bf16* WPSB = (bf16*)(ws + WS_WPSB); bf16* WPMB = (bf16*)(ws + WS_WPMB); bf16* WOUT = (bf16*)(ws + WS_WOUT);
    unsigned char* W13D = ws + WS_W13D; unsigned char* W2D = ws + WS_W2D; unsigned char* W13M = ws + WS_W13M; unsigned char* W2M = ws + WS_W2M;
    bf16* H = (bf16*)(ws + WS_H); bf16* BIG = (bf16*)(ws + WS_BIG);

    if (!SK(0) && IN(0)) {
        FRESH(F);
        if ((int)blockIdx.x < 192) {
            LAS float* cond = (LAS float*)F.lds;
            LAS float* part = (LAS float*)(F.lds + 65536);
            for (int i = F.tid; i < NB * D; i += NTHREADS) { const int bb = i / D, k = i % D; const float cv = c_in[i]; cond[k * 16 + bb] = cv * sigmoidf_(cv); }
            __syncthreads();
            const int l = (int)blockIdx.x / 96, n0 = ((int)blockIdx.x % 96) * 64;
            float acc[16];
#pragma unroll
            for (int bb = 0; bb < 16; ++bb) acc[bb] = 0.f;
            const float* wp = w_mod + (size_t)l * D * NMOD + n0 + F.lane;
#pragma unroll 4
            for (int kk = 0; kk < 128; ++kk) { const int k = F.wave * 128 + kk; const float wv = wp[(size_t)k * NMOD];
                const LAS f32x4* cp = (const LAS f32x4*)(cond + k * 16); const f32x4 c0 = cp[0], c1 = cp[1], c2 = cp[2], c3 = cp[3];
                acc[0] += c0.x * wv; acc[1] += c0.y * wv; acc[2] += c0.z * wv; acc[3] += c0.w * wv; acc[4] += c1.x * wv; acc[5] += c1.y * wv; acc[6] += c1.z * wv; acc[7] += c1.w * wv;
                acc[8] += c2.x * wv; acc[9] += c2.y * wv; acc[10] += c2.z * wv; acc[11] += c2.w * wv; acc[12] += c3.x * wv; acc[13] += c3.y * wv; acc[14] += c3.z * wv; acc[15] += c3.w * wv; }
#pragma unroll
            for (int bb = 0; bb < 16; ++bb) part[(F.wave * 16 + bb) * 64 + F.lane] = acc[bb];
            __syncthreads();
            for (int i = F.tid; i < 16 * 64; i += NTHREADS) { const int bb = i >> 6, n = i & 63; float s = b_mod[(size_t)l * NMOD + n0 + n];
#pragma unroll
                for (int w = 0; w < 8; ++w) s += part[(w * 16 + bb) * 64 + n];
                MOD[((size_t)l * NB + bb) * NMOD + n0 + n] = s; }
            __syncthreads();
        }
        LAS float* scr = (LAS float*)(F.lds + F.wave * 16384);
        const int gw = F.vcu * NWAVES + F.wave, NGW = F.G * NWAVES;
        constexpr int I_IN = (D / 64) * (INCOLS / 32), I_P = (WH / 64) * (D / 32), I_O = (D / 64) * (D / 32), I_13 = (D / 64) * (FF / 32), I_2 = (FF / 64) * (D / 32);
        constexpr int N_IN = 2 * I_IN, N_P = 4 * I_P, N_O = 2 * I_O, N_13 = 18 * I_13, N_2 = 9 * I_2, NITEMS = N_IN + N_P + N_O + N_13 + N_2;
        for (int it = gw; it < NITEMS; it += NGW) {
            int r = it;
            if (r < N_IN) { const int l = r / I_IN; transpose_item(w_in + (size_t)l * D * INCOLS, D, INCOLS, WIN + (size_t)l * INCOLS * D, 0, scr, r % I_IN, F.lane); continue; } r -= N_IN;
            if (r < N_P) { const int q = r / I_P, l = q & 1; const float* src = (q < 2 ? w_psb : w_pmb) + (size_t)l * WH * D; bf16* dst = (q < 2 ? WPSB : WPMB) + (size_t)l * D * WH; transpose_item(src, WH, D, dst, 0, scr, r % I_P, F.lane); continue; } r -= N_P;
            if (r < N_O) { const int l = r / I_O; transpose_item(w_out + (size_t)l * D * D, D, D, WOUT + (size_t)l * D * D, 0, scr, r % I_O, F.lane); continue; } r -= N_O;
            if (r < N_13) { const int q = r / I_13; const float* src; unsigned char* dst; int mode;
                if (q == 0) { src = w1d; dst = W13D; mode = 1; } else if (q == 1) { src = w3d; dst = W13D; mode = 2; }
                else if (q < 10) { src = w1m + (size_t)(q - 2) * D * FF; dst = W13M + (size_t)(q - 2) * 2 * FF * D; mode = 1; }
                else { src = w3m + (size_t)(q - 10) * D * FF; dst = W13M + (size_t)(q - 10) * 2 * FF * D; mode = 2; }
                transpose_item8(src, D, FF, dst, mode, W13_SCALE, scr, r % I_13, F.lane); continue; } r -= N_13;
            { const int q = r / I_2; const float* src = (q == 0) ? w2d : w2m + (size_t)(q - 1) * FF * D; unsigned char* dst = (q == 0) ? W2D : W2M + (size_t)(q - 1) * D * FF; transpose_item8(src, FF, D, dst, 0, W2_SCALE, scr, r % I_2, F.lane); }
        }
    }
    SEAM(0, 1);
    if (!SK(1) && IN(1)) {
        RowArgs a{}; a.xin = x_in; a.gpre = g_mix_pre; a.shift = MOD + 0 * D; a.scale = MOD + 1 * D; a.H = H;
        row_phase<false, false, true, false>(F, a);
    }
    SEAM(1, PH_LAYER0);

    for (int l = 0; l < 2; ++l) {
        const int pb = PH_LAYER0 + PH_STRIDE * l;
        const float* modl = MOD + (size_t)l * NB * NMOD;
        if (!SK(2) && IN(pb + 0)) {
            pg8::SchedPlain S; S.init(M / 256, INCOLS / 256, F.G, (int)blockIdx.x); S.A = (const char*)H; S.B = (const char*)(WIN + (size_t)l * INCOLS * D); S.tA = S.tB = (size_t)256 * D * 2;
            pg8::EpiInProj E{BIG};
            pg8::gemm_phase<pg8::EpiInProj, pg8::SchedPlain, true, 0>(F.lds, D, S, E);
        }
        SEAM(pb + 0, pb + 1);
        if (!SK(3) && IN(pb + 1)) {
            bf16* QA = BIG + BIG_QA / 2; bf16* KA = BIG + BIG_KA / 2; bf16* VA = BIG + BIG_VA / 2; bf16* QB = BIG + BIG_QB / 2; bf16* KB = BIG + BIG_KB / 2; bf16* VB = BIG + BIG_VB / 2;
            for (int v = F.vcu; v < 256; v += F.G) { const int bh = v >> 1, set = v & 1;
                for (int i = 0; i < 8; ++i) { const int k = i & 3; const int qb = set == 0 ? (k == 0 ? 0 : k == 1 ? 7 : k == 2 ? 1 : 6) : (k == 0 ? 2 : k == 1 ? 5 : k == 2 ? 3 : 4);
#if defined(MK_PROBE_ATTN2)
                    if (i < 4) att::attn_unit<false>(bh >> 3, bh & 7, qb, QA, KA, VA, H, rel_bias, F.lds);
                    else att::attn_unit<true>(bh >> 3, bh & 7, qb, QB, KB, VB, H, rel_bias, F.lds);
#endif
                    if (i < 4) att::attn_unit<false>(bh >> 3, bh & 7, qb, QA, KA, VA, QA, rel_bias, F.lds);
                    else att::attn_unit<true>(bh >> 3, bh & 7, qb, QB, KB, VB, QB, rel_bias, F.lds); } }
        }
        SEAM(pb + 1, pb + 2);
        if (!SK(4) && IN(pb + 2)) {
            bf16* GA = BIG + BIG_GA / 2; bf16* GB = BIG + BIG_GB / 2;
            { pg8::SchedPlain S; S.init(M / 256, D / 256, F.G, (int)blockIdx.x); S.A = (const char*)(BIG + BIG_QA / 2); S.B = (const char*)(WPSB + (size_t)l * D * WH); S.tA = S.tB = (size_t)256 * WH * 2;
              pg8::EpiGate<false> E{GA, GA}; pg8::gemm_phase<pg8::EpiGate<false>, pg8::SchedPlain, true, 0>(F.lds, WH, S, E); }
            VM_WAIT(); __syncthreads();
            { pg8::SchedPlain S; S.init(M / 256, D / 256, F.G, (int)blockIdx.x); S.A = (const char*)(BIG + BIG_QB / 2); S.B = (const char*)(WPMB + (size_t)l * D * WH); S.tA = S.tB = (size_t)256 * WH * 2;
              pg8::EpiGate<true> E{GB, GA}; pg8::gemm_phase<pg8::EpiGate<true>, pg8::SchedPlain, true, 0>(F.lds, WH, S, E); }
        }
        SEAM(pb + 2, pb + 3);
        if (!SK(5) && IN(pb + 3)) {
            pg8::SchedPlain S; S.init(M / 256, D / 256, F.G, (int)blockIdx.x); S.A = (const char*)(BIG + BIG_GA / 2); S.B = (const char*)(WOUT + (size_t)l * D * D); S.tA = S.tB = (size_t)256 * D * 2;
            pg8::EpiBf16 E{BIG + BIG_Y / 2, D, 1.0f};
            pg8::gemm_phase<pg8::EpiBf16, pg8::SchedPlain, true, 0>(F.lds, D, S, E);
        }
        SEAM(pb + 3, pb + 4);
        if (!SK(6) && IN(pb + 4)) {
            RowArgs a{}; a.xin = (l == 0) ? x_in : xout; a.xout = xout; a.Y = BIG + BIG_Y / 2; a.gpost = g_mix_post + (size_t)l * D; a.gate = modl + 2 * D;
            a.gpre = g_ffn_pre + (size_t)l * D; a.shift = modl + 3 * D; a.scale = modl + 4 * D; a.H = H;
            a.wrouter = w_router; a.lists = LISTS; a.tokw_out = TOKW; a.cnt = (unsigned*)(F.ctl + CW_CNT);
            if (l == 0) row_phase<true, false, true, false, true>(F, a); else row_phase<true, false, true, true, true>(F, a);
        }
        SEAM(pb + 4, pb + 5);
        if (l == 0) {
            if (!SK(7) && IN(pb + 5)) {
                pg8::SchedPlain S; S.init(M / 256, 2 * FF / 256, F.G, (int)blockIdx.x); S.A = (const char*)H; S.B = (const char*)W13D; S.tA = S.tB = (size_t)256 * D;
                pg8::EpiSwiGLU E{(unsigned char*)BIG + BIG_ACT, 1.0f / W13_SCALE};
                pg8::gemm_phase<pg8::EpiSwiGLU, pg8::SchedPlain, true, 1>(F.lds, D / 2, S, E);
            }
            SEAM(pb + 5, pb + 6);
            if (!SK(8) && IN(pb + 6)) {
                pg8::SchedPlain S; S.init(M / 256, D / 256, F.G, (int)blockIdx.x); S.A = (const char*)BIG + BIG_ACT; S.B = (const char*)W2D; S.tA = S.tB = (size_t)256 * FF;
                pg8::EpiBf16 E{BIG + BIG_YF / 2, D, 1.0f / W2_SCALE};
                pg8::gemm_phase<pg8::EpiBf16, pg8::SchedPlain, true, 1>(F.lds, FF / 2, S, E);
            }
            SEAM(pb + 6, pb + 11);
        } else {
            for (int c = 0; c < MOE_NCHUNK; ++c) {
                const int panel0 = c * MOE_CHUNK_PANELS;
                int npan = 0;
                if (IN(pb + 5 + 2 * c) || IN(pb + 6 + 2 * c)) { int tot = 0;
                    for (int e = 0; e < NE; ++e) tot += ((int)__hip_atomic_load((unsigned*)(F.ctl + CW_CNT + 64 * e), RLX_AGENT) + 255) >> 8;
                    npan = tot - panel0; npan = npan < 0 ? 0 : (npan > MOE_CHUNK_PANELS ? MOE_CHUNK_PANELS : npan); }
                if (!SK(9) && IN(pb + 5 + 2 * c)) {
                    pg8::SchedMoeUp S; S.init(npan, 2 * FF / 256, F.G, (int)blockIdx.x); S.A = (const char*)H; S.B = (const char*)W13M; S.tA = 0; S.tB = (size_t)256 * D; S.eB = (size_t)2 * FF * D;
                    S.panel0 = panel0; S.seg = (const LAS int*)(F.lds + LDS_SEG); S.tok = (const LAS unsigned short*)(F.lds + LDS_TOK);
                    moe_tables(F, S, LISTS, panel0);
                    pg8::EpiSwiGLU E{(unsigned char*)BIG + BIG_HID, 1.0f / W13_SCALE};
                    pg8::gemm_phase<pg8::EpiSwiGLU, pg8::SchedMoeUp, true, 1>(F.lds, D / 2, S, E);
                }
                SEAM(pb + 5 + 2 * c, pb + 6 + 2 * c);
                if (!SK(10) && IN(pb + 6 + 2 * c)) {
                    pg8::SchedMoeDown S; S.init(npan, D / 256, F.G, (int)blockIdx.x); S.A = (const char*)BIG + BIG_HID; S.B = (const char*)W2M; S.tA = S.tB = (size_t)256 * FF; S.eB = (size_t)D * FF;
                    S.panel0 = panel0; S.seg = (const LAS int*)(F.lds + LDS_SEG); S.tok = (const LAS unsigned short*)(F.lds + LDS_TOK);
                    moe_tables(F, S, LISTS, panel0);
                    pg8::EpiMoeDown E{BIG + BIG_YP / 2, (const LAS unsigned short*)(F.lds + LDS_TOK), (const LAS int*)(F.lds + LDS_SEG), 1.0f / W2_SCALE};
                    pg8::gemm_phase<pg8::EpiMoeDown, pg8::SchedMoeDown, true, 1>(F.lds, FF / 2, S, E);
                }
                SEAM(pb + 6 + 2 * c, (c + 1 < MOE_NCHUNK) ? pb + 7 + 2 * c : pb + 11);
            }
        }
        if (!SK(11) && IN(pb + 11)) {
            RowArgs a{}; a.xin = xout; a.xout = xout; a.gpost = g_ffn_post + (size_t)l * D; a.gate = modl + 5 * D; a.H = H;
            if (l == 0) { a.Y = BIG + BIG_YF / 2; a.gpre = g_mix_pre + (size_t)(l + 1) * D; a.shift = MOD + (size_t)(l + 1) * NB * NMOD + 0 * D; a.scale = MOD + (size_t)(l + 1) * NB * NMOD + 1 * D;
                row_phase<true, false, true, false>(F, a); }
            else { a.Y = BIG + BIG_YP / 2; a.tokw_in = TOKW; row_phase<true, true, false, false>(F, a); }
        }
        if (l == 0) SEAM(pb + 11, pb + PH_STRIDE);
    }
#undef IN
#undef SEAM
}

extern "C" void kernel_launch(void* const* d_in, const int* in_sizes, int n_in, void* d_out, int out_size, void* d_ws, size_t ws_size, hipStream_t stream) {
    static int grid = 0;
    if (grid == 0) {
        if (n_in != 20 || in_sizes[0] != M * D || out_size != M * D || ws_size < WS_END) { fprintf(stderr, "kernel_launch: unexpected shapes (n_in %d, ws %zu)\n", n_in, ws_size); grid = -1; return; }
        int dev = 0, cus = 0;
        if (hipGetDevice(&dev) != hipSuccess || hipDeviceGetAttribute(&cus, hipDeviceAttributeMultiprocessorCount, dev) != hipSuccess) { grid = -1; return; }
        if (hipFuncSetAttribute((const void*)mega_fwd, hipFuncAttributeMaxDynamicSharedMemorySize, LDS_BYTES) != hipSuccess) { fprintf(stderr, "kernel_launch: hipFuncSetAttribute failed\n"); grid = -1; return; }
        int per_cu = 0;
        if (hipOccupancyMaxActiveBlocksPerMultiprocessor(&per_cu, (const void*)mega_fwd, NTHREADS, LDS_BYTES) != hipSuccess || per_cu < 1) fprintf(stderr, "kernel_launch: occupancy query reports %d\n", per_cu);
        (void)hipGetLastError();
        grid = cus;
        if (grid != 256) { fprintf(stderr, "kernel_launch: built for 256 CUs, found %d\n", cus); grid = -1; return; }
    }
    if (grid < 0) return;
    if (hipMemsetAsync((char*)d_ws + WS_CTL, 0, CTL_ZERO_BYTES, stream) != hipSuccess) return;
    Args a{};
    for (int i = 0; i < 20; ++i) a.in[i] = (const float*)d_in[i];
    a.out = (float*)d_out; a.ws = (unsigned char*)d_ws;
#if MK_ONE_LAUNCH
    a.ph_lo = 0; a.ph_hi = PH_END;
    hipLaunchKernelGGL(mega_fwd, dim3(grid), dim3(NTHREADS), LDS_BYTES, stream, a);
#else
    for (int p = 0; p < PH_END; ++p) {
        const int rel = p < PH_LAYER0 ? -1 : (p - PH_LAYER0) % PH_STRIDE, l = p < PH_LAYER0 ? 0 : (p - PH_LAYER0) / PH_STRIDE;
        if (rel >= 0) { if (l == 0 && rel > 6 && rel != 11) continue; if (rel > 11) continue; }
        a.ph_lo = p; a.ph_hi = p + 1;
        hipLaunchKernelGGL(mega_fwd, dim3(grid), dim3(NTHREADS), LDS_BYTES, stream, a);
    }
#endif
}
```

```cpp
#include <hip/hip_runtime.h>
#include <hip/hip_bf16.h>
#include <cstdio>
#include <cstdint>
#include <cmath>

#ifndef MK_ONE_LAUNCH
#define MK_ONE_LAUNCH 1
#endif
#ifndef MK_WSH_MOEUP
#define MK_WSH_MOEUP 3
#endif
#ifndef MK_WSH_MOEDN
#define MK_WSH_MOEDN 3
#endif
#ifndef MK_OUT8
#define MK_OUT8 1
#endif
#ifndef MK_Y8
#define MK_Y8 1
#endif
#ifndef MK_SKIP
#define MK_SKIP 0
#endif
#define SK(b) ((MK_SKIP >> (b)) & 1)

#define GAS __attribute__((address_space(1)))
#define LAS __attribute__((address_space(3)))
typedef unsigned short bf16;
typedef unsigned v4u __attribute__((ext_vector_type(4)));
typedef unsigned v2u __attribute__((ext_vector_type(2)));
typedef float f32x4 __attribute__((ext_vector_type(4)));
typedef float f32x2 __attribute__((ext_vector_type(2)));
typedef float f32x16 __attribute__((ext_vector_type(16)));
typedef short bf16x8 __attribute__((ext_vector_type(8)));
typedef short s16x4 __attribute__((ext_vector_type(4)));
typedef GAS unsigned gu32;
#define RLX_AGENT __ATOMIC_RELAXED, __HIP_MEMORY_SCOPE_AGENT
#define LDS_WAIT() asm volatile("s_waitcnt lgkmcnt(0)" ::: "memory")
#define VM_WAIT() asm volatile("s_waitcnt vmcnt(0)" ::: "memory")

constexpr int NB = 16, SEQ = 2048, D = 1024, M = NB * SEQ, NH = 8, HD = 64, WH = 512, INCOLS = 5120, FF = 3584, NE = 8, NMOD = 6 * D;
constexpr float EPS = 1e-6f;
constexpr float LOG2E = 1.4426950408889634f;
constexpr float C2 = 0.125f * LOG2E;
constexpr int NWAVES = 8, NTHREADS = 512;

constexpr size_t MiB = 1u << 20;
constexpr size_t WS_CTL = 0, CTL_ZERO_BYTES = 1 * MiB;
constexpr size_t WS_MOD = 1 * MiB;
constexpr size_t WS_LIST = 2 * MiB;
constexpr size_t WS_TOKW = 3 * MiB;
constexpr size_t WS_HSCALE = 3 * MiB + 512 * 1024;
constexpr size_t WS_WCS = 3 * MiB + 768 * 1024;
constexpr size_t WS_WIN = 4 * MiB;
constexpr size_t WS_WPSB = 24 * MiB;
constexpr size_t WS_WPMB = 26 * MiB;
constexpr size_t WS_WOUT = 28 * MiB;
constexpr size_t WS_W13D = 32 * MiB;
constexpr size_t WS_W2D = 39 * MiB;
constexpr size_t WS_W13M = 43 * MiB;
constexpr size_t WS_W2M = 99 * MiB;
constexpr size_t WS_H = 127 * MiB;
constexpr size_t WS_BIG = 191 * MiB;
constexpr size_t WS_END = 605 * MiB;
constexpr float W13_SCALE = 32.f, W2_SCALE = 64.f, WO_SCALE = 32.f, MG_SCALE = 16.f;
constexpr size_t PLANE = (size_t)M * WH * 2;
constexpr size_t BIG_QA = 0, BIG_KA = PLANE, BIG_VA = 2 * PLANE, BIG_QB = 3 * PLANE, BIG_KB = 4 * PLANE, BIG_VB = 5 * PLANE, BIG_GA = 6 * PLANE, BIG_GB = 8 * PLANE;
constexpr size_t BIG_Y = 2 * PLANE;
constexpr size_t BIG_ACT = 0, BIG_YF = 112 * MiB;
constexpr int MOE_CHUNK_PANELS = 264, MOE_NCHUNK = 1;
constexpr size_t BIG_HID = 32 * MiB, BIG_YP = 264 * MiB;
static_assert(BIG_YP + (size_t)M * 2 * D * 2 <= 414 * MiB && BIG_HID + (size_t)MOE_CHUNK_PANELS * 256 * FF <= BIG_YP && BIG_YF + (size_t)M * D * 2 <= 414 * MiB, "BIG map");
constexpr int CW_TMO = 0, CW_CODE = 1, CW_BAR = 4096, CW_CNT = 16384, CW_WMAX = 20480, CW_MODF = 24576, CW_XF = 32768;

constexpr int RING_BYTES = 131072;
constexpr int LDS_TOK = RING_BYTES;
constexpr int LDS_TOK_UNITS = 30;
constexpr int LDS_SEG = LDS_TOK + LDS_TOK_UNITS * 512;
constexpr int LDS_MISC = LDS_SEG + 128;
constexpr int LDS_COLF = LDS_MISC + 64;
constexpr int LDS_BYTES = LDS_COLF + 15 * 1024;
static_assert(LDS_BYTES <= 160 * 1024, "LDS");

__device__ __forceinline__ unsigned f2bf(float f) { unsigned u = __builtin_bit_cast(unsigned, f); return (u + 0x7fffu + ((u >> 16) & 1u)) >> 16; }
__device__ __forceinline__ unsigned pk2(float lo, float hi) { return f2bf(lo) | (f2bf(hi) << 16); }
__device__ __forceinline__ float bf_lo(unsigned w) { return __builtin_bit_cast(float, w << 16); }
__device__ __forceinline__ float bf_hi(unsigned w) { return __builtin_bit_cast(float, w & 0xffff0000u); }
__device__ __forceinline__ unsigned cvt_pk_bf16(float lo, float hi) { typedef __bf16 bf2 __attribute__((ext_vector_type(2))); f32x2 v = {lo, hi}; bf2 b = __builtin_convertvector(v, bf2); return __builtin_bit_cast(unsigned, b); }
__device__ __forceinline__ unsigned pk4_fp8(float a, float b, float c, float d) {
    a = __builtin_amdgcn_fmed3f(a, -448.f, 448.f); b = __builtin_amdgcn_fmed3f(b, -448.f, 448.f); c = __builtin_amdgcn_fmed3f(c, -448.f, 448.f); d = __builtin_amdgcn_fmed3f(d, -448.f, 448.f);
    int r = __builtin_amdgcn_cvt_pk_fp8_f32(a, b, 0, false); r = __builtin_amdgcn_cvt_pk_fp8_f32(c, d, r, true); return (unsigned)r; }
__device__ __forceinline__ void unpack8_fp8(v2u w, f32x4& v0, f32x4& v1) {
    const f32x2 a = __builtin_amdgcn_cvt_pk_f32_fp8((int)w.x, false), b = __builtin_amdgcn_cvt_pk_f32_fp8((int)w.x, true), c = __builtin_amdgcn_cvt_pk_f32_fp8((int)w.y, false), d = __builtin_amdgcn_cvt_pk_f32_fp8((int)w.y, true);
    v0 = (f32x4){a.x, a.y, b.x, b.y}; v1 = (f32x4){c.x, c.y, d.x, d.y}; }
__device__ __forceinline__ float fast_exp2(float x) { return __builtin_amdgcn_exp2f(x); }
__device__ __forceinline__ float fast_log2(float x) { return __builtin_amdgcn_logf(x); }
__device__ __forceinline__ float fast_rcp(float x) { return __builtin_amdgcn_rcpf(x); }
__device__ __forceinline__ int obid() { int b = blockIdx.x; asm volatile("" : "+s"(b)); return b; }
__device__ __forceinline__ int otid() { int t = threadIdx.x; asm volatile("" : "+v"(t)); return t; }
__device__ __forceinline__ float shx(float v, int o, int lane) { return __builtin_bit_cast(float, __builtin_amdgcn_ds_bpermute((lane ^ o) << 2, __builtin_bit_cast(int, v))); }
__device__ __forceinline__ float shl(float v, int src) { return __builtin_bit_cast(float, __builtin_amdgcn_ds_bpermute(src << 2, __builtin_bit_cast(int, v))); }
__device__ __forceinline__ float sigmoidf_(float x) { return fast_rcp(1.0f + fast_exp2(-x * LOG2E)); }

#define XB_TMO      128
#define XB_XCNT(j)  (256  + 64 * (j))
#define XB_XSUB(j)  (1280 + 64 * (j))
#define XB_XGEN(j)  (2304 + 64 * (j))
#define XB_TOP      3328
#define XB_TOPGEN   3392
#define XCD_BAR_WORDS 3456
#define XB_SPIN_CAP (1u << 18)
__device__ __forceinline__ unsigned xb_ld(unsigned* p)              { return __hip_atomic_load(p, __ATOMIC_RELAXED, __HIP_MEMORY_SCOPE_AGENT); }
__device__ __forceinline__ unsigned xb_add(unsigned* p, unsigned v) { return __hip_atomic_fetch_add(p, v, __ATOMIC_RELAXED, __HIP_MEMORY_SCOPE_AGENT); }
__device__ __forceinline__ unsigned xb_xcc_id() { return (unsigned)__builtin_amdgcn_s_getreg((3 << 11) | 20) & 0xFu; }
#define XB_SPIN(cond, bar) do { unsigned _sp = 0; while (cond) { __builtin_amdgcn_s_sleep(1); \
    if ((++_sp & 255u) == 0u) { if (xb_ld(&(bar)[XB_TMO])) break; if (_sp > XB_SPIN_CAP) { atomicAdd(&(bar)[XB_TMO], 1u); break; } } } } while (0)
struct XcdBarrier { unsigned* bar; unsigned x; volatile LAS unsigned* st; };
__device__ __forceinline__ XcdBarrier xcd_barrier_post(unsigned* bar, volatile LAS unsigned* st) {
    XcdBarrier b; b.bar = bar; b.x = xb_xcc_id(); b.st = st;
    if (threadIdx.x == 0) (void)xb_add(&bar[XB_XCNT(b.x)], 1u);
    return b;
}
__device__ __forceinline__ void xcd_barrier_complete(unsigned* bar, unsigned x, unsigned& nloc, unsigned& nx) {
    const unsigned G = gridDim.x * gridDim.y * gridDim.z;
    unsigned sum, cnt, mine, sp = 0u;
    for (;;) {
        sum = 0u; cnt = 0u; mine = 0u;
#pragma unroll
        for (unsigned j = 0; j < 16; ++j) { const unsigned c = xb_ld(&bar[XB_XCNT(j)]); sum += c; cnt += (c > 0u) ? 1u : 0u; mine = (j == x) ? c : mine; }
        if (sum == G) break;
        __builtin_amdgcn_s_sleep(1);
        if ((++sp & 255u) == 0u) { if (xb_ld(&bar[XB_TMO])) break; if (sp > XB_SPIN_CAP) { atomicAdd(&bar[XB_TMO], 1u); break; } }
    }
    nloc = mine > 0u ? mine : 1u; nx = cnt > 0u ? cnt : 1u;
}
__device__ __forceinline__ void xcd_barrier(const XcdBarrier& b) {
    asm volatile("s_waitcnt vmcnt(0)" ::: "memory");
    __syncthreads();
    if (threadIdx.x == 0) {
        unsigned* bar = b.bar;
        __builtin_amdgcn_s_waitcnt(0);
        unsigned nloc = b.st[0], nx = b.st[1];
        if (nloc == 0u) { xcd_barrier_complete(bar, b.x, nloc, nx); b.st[0] = nloc; b.st[1] = nx; }
        const unsigned old = xb_add(&bar[XB_XSUB(b.x)], 1u);
        const unsigned gen = old / nloc;
        if (old + 1u == (gen + 1u) * nloc) {
            __builtin_amdgcn_fence(__ATOMIC_RELEASE, "agent");
            asm volatile("s_waitcnt vmcnt(0)" ::: "memory");
            const unsigned og = xb_add(&bar[XB_TOP], 1u);
            const unsigned tg = og / nx;
            if (og + 1u == (tg + 1u) * nx) xb_add(&bar[XB_TOPGEN], 1u);
            else XB_SPIN(xb_ld(&bar[XB_TOPGEN]) == tg, bar);
            __builtin_amdgcn_fence(__ATOMIC_ACQUIRE, "agent");
            xb_add(&bar[XB_XGEN(b.x)], 1u);
            asm volatile("s_waitcnt vmcnt(0)" ::: "memory");
        } else {
            XB_SPIN(xb_ld(&bar[XB_XGEN(b.x)]) == gen, bar);
            __builtin_amdgcn_fence(__ATOMIC_ACQUIRE, "agent");
            asm volatile("s_waitcnt vmcnt(0)" ::: "memory");
        }
    }
    __syncthreads();
}

namespace pg8 {
typedef int v4i_t __attribute__((ext_vector_type(4)));
constexpr int BM = 256, BK = 64, HALF = 128, HTB = HALF * BK * 2, STAGE_BYTES = 8 * HTB, NXCD = 8, WGM = 4;
__host__ __device__ __forceinline__ int lds_byte(int r, int c) { const int st = (r >> 4) * 2 + (c >> 5), rr = r & 15, cc = c & 31, ob = rr * 64 + cc * 2; return st * 1024 + (ob ^ (((ob >> 9) & 1) << 5)); }
__host__ __device__ __forceinline__ void stage_rc(int b, int& R, int& C) { const int st = b / 1024, sb = b % 1024, swz = sb ^ (((sb >> 9) & 1) << 5); R = (st >> 1) * 16 + swz / 64; C = (st & 1) * 32 + (swz % 64) / 2; }
__host__ __device__ __forceinline__ int perm32(int rho) { const int n = rho >> 4, i = rho & 15; return 8 * (i >> 2) + 4 * n + (i & 3); }
struct Unit { int pm, pn; };
struct StaticOrder {
    int nM, nN, nwg, G, c, wsh;
    __host__ __device__ __forceinline__ void init(int nM_, int nN_, int G_, int c_) { nM = nM_; nN = nN_; nwg = nM * nN; G = G_; c = c_; wsh = 2; }
    __host__ __device__ __forceinline__ bool next(int i, Unit& u) const {
        const long L = (long)i * G + c; if (L >= nwg) return false;
        int wgid = (int)L; { const int q = nwg / NXCD, r = nwg % NXCD, xcd = wgid % NXCD, off = wgid / NXCD; wgid = (xcd < r ? xcd * (q + 1) : r * (q + 1) + (xcd - r) * q) + off; }
        const int wg_ = 1 << wsh, nig = nN << wsh, gid = wgid / nig, fm = gid << wsh, gsz = (nM - fm) < wg_ ? (nM - fm) : wg_;
        const int w_ = wgid % nig;
        if (gsz == wg_) { u.pm = fm + (w_ & (wg_ - 1)); u.pn = w_ >> wsh; }
        else { u.pm = fm + (w_ % gsz); u.pn = w_ / gsz; }
        return true;
    }
};
template <class Epi, class Sched, bool ALIGN_EPI, int MODE>
__device__ __forceinline__ void gemm_phase(LAS unsigned char* lds, const int K, const Sched& S, const Epi& E, const int nt_ov = 0) {
    const int tid = otid(), wid = __builtin_amdgcn_readfirstlane(tid >> 6), lane = tid & 63, wr = wid >> 2, wc = wid & 3, fr = lane & 15, fq = lane >> 4;
    const int nt = nt_ov ? nt_ov : K / BK;
    unsigned voffA[2], voffB[2];
#pragma unroll
    for (int i = 0; i < 2; ++i) { int R, C; stage_rc(tid * 16 + i * 8192, R, C); const int Rb = Epi::PERM ? ((R & ~31) + perm32(R & 31)) : R;
        voffA[i] = (unsigned)(R * K + C) * 2u; voffB[i] = (unsigned)(Rb * K + C) * 2u; }
#define PG8_GVOFF(uix) do { _Pragma("unroll") for (int _h = 0; _h < 2; ++_h) _Pragma("unroll") for (int _i = 0; _i < 2; ++_i) { int R_, C_; stage_rc(tid * 16 + _i * 8192, R_, C_); vg[_h][_i] = S.gvoff((uix), _h * HALF + R_, C_, K); } } while (0)
    const size_t kstep = (size_t)(BK * 2);
    const size_t hstep = (size_t)HALF * K * 2;
    const unsigned ldsw = (unsigned)wid * 1024u;
    const int aoff = lds_byte(wr * 64 + fr, fq * 8), boff = lds_byte(wc * 32 + fr, fq * 8);
#define PG8_SA(b, h) (((b) * 2 + (h)) * HTB)
#define PG8_SB(b, h) ((4 + (b) * 2 + (h)) * HTB)
#define PG8_STAGE(bufoff, gbase, voff) do { _Pragma("unroll") for (int _i = 0; _i < 2; ++_i) \
        __builtin_amdgcn_global_load_lds((const unsigned*)((const char*)(gbase) + (voff)[_i]), (LAS unsigned*)(lds + (bufoff) + ldsw + _i * 8192), 16, 0, 0); } while (0)
#define PG8_STAGE_A(bufoff, kp, h) do { if constexpr (Sched::GATHER) { PG8_STAGE(bufoff, kp, vg[h]); } else { PG8_STAGE(bufoff, (kp) + (h) * hstep, voffA); } } while (0)
#define PG8_LDA(dst, b, h) do { _Pragma("unroll") for (int m = 0; m < 4; ++m) _Pragma("unroll") for (int k = 0; k < 2; ++k) dst[m][k] = *(const LAS bf16x8*)(lds + PG8_SA(b, h) + aoff + m * 2048 + k * 1024); } while (0)
#define PG8_LDB(dst, b, h) do { _Pragma("unroll") for (int n = 0; n < 2; ++n) _Pragma("unroll") for (int k = 0; k < 2; ++k) dst[n][k] = *(const LAS bf16x8*)(lds + PG8_SB(b, h) + boff + n * 2048 + k * 1024); } while (0)
#define PG8_CAT8(x) __builtin_shufflevector(__builtin_bit_cast(v4i_t, (x)[0]), __builtin_bit_cast(v4i_t, (x)[1]), 0, 1, 2, 3, 4, 5, 6, 7)
#define PG8_MMA(ai, bj, At, Bt) do { __builtin_amdgcn_s_setprio(1); if constexpr (MODE == 1) { _Pragma("unroll") for (int m = 0; m < 4; ++m) _Pragma("unroll") for (int n = 0; n < 2; ++n) \
        asm volatile("v_mfma_f32_16x16x128_f8f6f4 %0, %1, %2, %0" : "+v"(acc[ai][bj][m][n]) : "v"(PG8_CAT8(Bt[n])), "v"(PG8_CAT8(At[m]))); } else if constexpr (MODE == 2) { \
        _Pragma("unroll") for (int m = 0; m < 4; ++m) _Pragma("unroll") for (int n = 0; n < 2; ++n) _Pragma("unroll") for (int k = 0; k < 2; ++k) \
        asm volatile("v_mfma_i32_16x16x64_i8 %0, %1, %2, %0" : "+v"(acc[ai][bj][m][n]) : "v"(Bt[n][k]), "v"(At[m][k])); } else { \
        _Pragma("unroll") for (int m = 0; m < 4; ++m) _Pragma("unroll") for (int n = 0; n < 2; ++n) _Pragma("unroll") for (int k = 0; k < 2; ++k) \
        acc[ai][bj][m][n] = __builtin_amdgcn_mfma_f32_16x16x32_bf16(Bt[n][k], At[m][k], acc[ai][bj][m][n], 0, 0, 0); } __builtin_amdgcn_s_setprio(0); } while (0)
#define PG8_WAIT_V(n) asm volatile("s_waitcnt vmcnt(" #n ")" ::: "memory")
#define PG8_WAIT_L(n) asm volatile("s_waitcnt lgkmcnt(" #n ")" ::: "memory")
#define PG8_BAR __builtin_amdgcn_s_barrier()
#define PG8_SCHED __builtin_amdgcn_sched_barrier(0)
    Unit cur, nxt; int ui = 0;
    if (!S.next(0, cur)) return;
    f32x4 acc[2][2][4][2];
#pragma unroll
    for (int a = 0; a < 2; ++a)
#pragma unroll
        for (int b = 0; b < 2; ++b)
#pragma unroll
            for (int m = 0; m < 4; ++m)
#pragma unroll
                for (int n = 0; n < 2; ++n) acc[a][b][m][n] = (f32x4){0.f, 0.f, 0.f, 0.f};
    bf16x8 At[4][2], B0[2][2], B1[2][2];
    unsigned vg[2][2];
    if constexpr (Sched::GATHER) PG8_GVOFF(0);
    const char* cA = S.a_base(cur); const char* cB = S.b_base(cur);
    PG8_STAGE(PG8_SB(0, 0), cB, voffB); PG8_STAGE(PG8_SB(0, 1), cB + hstep, voffB); PG8_STAGE_A(PG8_SA(0, 0), cA, 0); PG8_STAGE_A(PG8_SA(0, 1), cA, 1);
    if (wr == 1) PG8_BAR;
    PG8_WAIT_V(2); PG8_BAR;
    PG8_STAGE(PG8_SB(1, 0), cB + kstep, voffB); PG8_STAGE_A(PG8_SA(1, 0), cA + kstep, 0); PG8_STAGE(PG8_SB(1, 1), cB + hstep + kstep, voffB);
    PG8_WAIT_V(6); PG8_BAR;
    for (;;) {
        const bool has_next = S.next(ui + 1, nxt);
        const char* nA = has_next ? S.a_base(nxt) : cA; const char* nB = has_next ? S.b_base(nxt) : cB;
        for (int t = 0; t < nt; t += 2) {
            const bool last = (t == nt - 2);
            const char* a1 = cA + (size_t)(t + 1) * kstep;
            const char* a2 = last ? nA : cA + (size_t)(t + 2) * kstep; const char* b2 = last ? nB : cB + (size_t)(t + 2) * kstep;
            const char* a3 = a2 + kstep; const char* b3 = b2 + kstep;
            PG8_LDB(B0, 0, 0); PG8_LDB(B1, 0, 1); PG8_SCHED; PG8_LDA(At, 0, 0); PG8_STAGE_A(PG8_SA(1, 1), a1, 1);
            if constexpr (Sched::GATHER) { if (last && has_next) PG8_GVOFF(ui + 1); }
            const bool seam = (t == 0) && (ui > 0);
#define PG8_WAIT_SEAM() do { if constexpr (MODE != 0 && Epi::NSTORE > 0) { if (seam) { if constexpr (Epi::NSTORE == 16) PG8_WAIT_V(24); else PG8_WAIT_V(16); } else PG8_WAIT_V(8); } else PG8_WAIT_V(8); } while (0)
            PG8_WAIT_SEAM(); PG8_WAIT_L(0); PG8_BAR; PG8_MMA(0, 0, At, B0); PG8_MMA(0, 1, At, B1); PG8_BAR; PG8_SCHED;
            PG8_LDA(At, 0, 1); PG8_STAGE(PG8_SB(0, 0), b2, voffB); PG8_STAGE(PG8_SB(0, 1), b2 + hstep, voffB); PG8_STAGE_A(PG8_SA(0, 0), a2, 0);
            PG8_WAIT_SEAM(); PG8_WAIT_L(0); PG8_BAR; PG8_MMA(1, 0, At, B0); PG8_MMA(1, 1, At, B1); PG8_BAR; PG8_SCHED;
            PG8_LDB(B0, 1, 0); PG8_LDB(B1, 1, 1); PG8_SCHED; PG8_LDA(At, 1, 0); PG8_STAGE_A(PG8_SA(0, 1), a2, 1);
            PG8_WAIT_V(8); PG8_WAIT_L(0); PG8_BAR; PG8_MMA(0, 0, At, B0); PG8_MMA(0, 1, At, B1); PG8_BAR; PG8_SCHED;
            PG8_LDA(At, 1, 1); PG8_STAGE(PG8_SB(1, 0), b3, voffB); PG8_STAGE(PG8_SB(1, 1), b3 + hstep, voffB); PG8_STAGE_A(PG8_SA(1, 0), a3, 0);
            PG8_WAIT_V(8); PG8_WAIT_L(0); PG8_BAR; PG8_MMA(1, 0, At, B0); PG8_MMA(1, 1, At, B1); PG8_BAR; PG8_SCHED;
        }
        if constexpr (ALIGN_EPI) { if (wr == 0) PG8_BAR; }
        if constexpr (MODE != 0) asm volatile("s_nop 15\n\ts_nop 15" : "+v"(acc[1][1][0][0]), "+v"(acc[1][1][0][1]), "+v"(acc[1][1][1][0]), "+v"(acc[1][1][1][1]), "+v"(acc[1][1][2][0]), "+v"(acc[1][1][2][1]), "+v"(acc[1][1][3][0]), "+v"(acc[1][1][3][1]) :: "memory");
        E(acc, cur, ui, wr, wc, fr, fq);
        if (!has_next) break;
#pragma unroll
        for (int a = 0; a < 2; ++a)
#pragma unroll
            for (int b = 0; b < 2; ++b)
#pragma unroll
                for (int m = 0; m < 4; ++m)
#pragma unroll
                    for (int n = 0; n < 2; ++n) acc[a][b][m][n] = (f32x4){0.f, 0.f, 0.f, 0.f};
        cur = nxt; cA = nA; cB = nB; ++ui;
        if constexpr (ALIGN_EPI) { if (wr == 1) PG8_BAR; }
    }
    PG8_WAIT_V(0);
    if constexpr (!ALIGN_EPI) { if (wr == 0) PG8_BAR; }
    PG8_BAR;
#undef PG8_SA
#undef PG8_SB
#undef PG8_STAGE
#undef PG8_STAGE_A
#undef PG8_WAIT_SEAM
#undef PG8_GVOFF
#undef PG8_LDA
#undef PG8_LDB
#undef PG8_MMA
#undef PG8_CAT8
#undef PG8_WAIT_V
#undef PG8_WAIT_L
#undef PG8_BAR
#undef PG8_SCHED
}

struct SchedPlain : StaticOrder {
    static constexpr bool GATHER = false;
    const char* A; const char* B; size_t tA, tB;
    __device__ __forceinline__ const char* a_base(const Unit& u) const { return A + (size_t)u.pm * tA; }
    __device__ __forceinline__ const char* b_base(const Unit& u) const { return B + (size_t)u.pn * tB; }
    __device__ __forceinline__ unsigned gvoff(int, int, int, int) const { return 0u; }
};
struct SchedMoe : StaticOrder {
    const char* A; const char* B; size_t tA, tB, eB; int panel0; const LAS int* seg; const LAS unsigned short* tok;
    __device__ __forceinline__ int expert(const Unit& u) const { const int row = (panel0 + u.pm) * 256; int e = 0;
#pragma unroll
        for (int j = 1; j < NE; ++j) e += (row >= seg[j]) ? 1 : 0;
        return e; }
    __device__ __forceinline__ const char* b_base(const Unit& u) const { return B + (size_t)expert(u) * eB + (size_t)u.pn * tB; }
};
struct SchedMoeUp : SchedMoe {
    static constexpr bool GATHER = true;
    __device__ __forceinline__ const char* a_base(const Unit&) const { return A; }
    __device__ __forceinline__ unsigned gvoff(int ui, int row, int col, int K) const { const int t = (int)tok[ui * 256 + row] >> 1; return (unsigned)(t * K + col) * 2u; }
};
struct SchedMoeDown : SchedMoe {
    static constexpr bool GATHER = false;
    __device__ __forceinline__ const char* a_base(const Unit& u) const { return A + (size_t)u.pm * tA; }
    __device__ __forceinline__ unsigned gvoff(int, int, int, int) const { return 0u; }
};
struct SchedMoeDownTail : SchedMoe {
    static constexpr bool GATHER = false;
    int nfull, pidx; size_t koff;
    __device__ __forceinline__ bool next(int i, Unit& u) const {
        if (i != 0 || pidx < 0) return false;
        const int wg_ = 1 << wsh, wgid = nfull + pidx, nig = nN << wsh, gid = wgid / nig, fm = gid << wsh, gsz = (nM - fm) < wg_ ? (nM - fm) : wg_, w_ = wgid % nig;
        u.pm = fm + (w_ % gsz); u.pn = w_ / gsz; return true; }
    __device__ __forceinline__ const char* a_base(const Unit& u) const { return A + (size_t)u.pm * tA + koff; }
    __device__ __forceinline__ const char* b_base(const Unit& u) const { return SchedMoe::b_base(u) + koff; }
    __device__ __forceinline__ unsigned gvoff(int, int, int, int) const { return 0u; }
};

typedef f32x4 Acc[2][2][4][2];
__device__ __forceinline__ v4u pack8(f32x4 v0, f32x4 v1) { v4u w; w.x = cvt_pk_bf16(v0[0], v0[1]); w.y = cvt_pk_bf16(v0[2], v0[3]); w.z = cvt_pk_bf16(v1[0], v1[1]); w.w = cvt_pk_bf16(v1[2], v1[3]); return w; }
__device__ __forceinline__ void unpack8(v4u w, f32x4& v0, f32x4& v1) { v0 = (f32x4){bf_lo(w.x), bf_hi(w.x), bf_lo(w.y), bf_hi(w.y)}; v1 = (f32x4){bf_lo(w.z), bf_hi(w.z), bf_lo(w.w), bf_hi(w.w)}; }

#ifndef MK_EPI_NT
#define MK_EPI_NT 0
#endif
#ifndef MK_HEAD
#define MK_HEAD 5120
#endif
#ifndef MK_SPLIT_TAIL
#define MK_SPLIT_TAIL 1
#endif
#if MK_EPI_NT
#define EPI_ST(T, p, v) __builtin_nontemporal_store((v), (T*)(p))
#else
#define EPI_ST(T, p, v) (*(T*)(p) = (v))
#endif
struct EpiInProj {
    static constexpr bool PERM = true; static constexpr int NSTORE = 16;
    bf16* big; const LAS float* rowf; int nostore; const LAS float* colf;
    __device__ __forceinline__ void operator()(const Acc& acc, const Unit& u, int ui, int wr, int wc, int fr, int fq) const {
        const int t = u.pn; bf16* base; int ldc, colt; float sc = 1.f;
        if (t < 12) { const int pl = t >> 1; base = big + (size_t)pl * ((size_t)M * WH); ldc = WH; colt = (t & 1) * 256; if (pl == 0 || pl == 3) sc = C2; }
        else { const int g = (t - 12) >> 2; base = big + (size_t)6 * ((size_t)M * WH) + (size_t)g * ((size_t)M * D / 2); ldc = D; colt = ((t - 12) & 3) * 256; }
        const int row0 = u.pm * BM + wr * 64 + fr, col0 = colt + wc * 32 + 8 * fq;
        const LAS float* cf_ = colf + ui * 256 + wc * 32 + 8 * fq; f32x4 cs[2][2];
#pragma unroll
        for (int bj = 0; bj < 2; ++bj) { cs[bj][0] = *(const LAS f32x4*)(cf_ + bj * HALF); cs[bj][1] = *(const LAS f32x4*)(cf_ + bj * HALF + 4); }
#pragma unroll
        for (int ai = 0; ai < 2; ++ai)
#pragma unroll
            for (int m = 0; m < 4; ++m) { bf16* rowp = base + (size_t)(row0 + ai * HALF + m * 16) * ldc + col0; const float rf = rowf[ui * 256 + wr * 64 + fr + ai * HALF + m * 16] * sc;
#pragma unroll
                for (int bj = 0; bj < 2; ++bj) { const v4i_t i0 = __builtin_bit_cast(v4i_t, acc[ai][bj][m][0]), i1 = __builtin_bit_cast(v4i_t, acc[ai][bj][m][1]);
                    const f32x4 v0 = (f32x4){(float)i0[0] * rf, (float)i0[1] * rf, (float)i0[2] * rf, (float)i0[3] * rf} * cs[bj][0], v1 = (f32x4){(float)i1[0] * rf, (float)i1[1] * rf, (float)i1[2] * rf, (float)i1[3] * rf} * cs[bj][1];
                    if (t >= 12) { v2u w8; w8.x = pk4_fp8(v0[0], v0[1], v0[2], v0[3]); w8.y = pk4_fp8(v1[0], v1[1], v1[2], v1[3]);
                        if (!nostore) EPI_ST(v2u, (unsigned char*)base + (size_t)(row0 + ai * HALF + m * 16) * D + col0 + bj * HALF, w8); else asm volatile("" :: "v"(w8)); }
                    else { const v4u pk_ = pack8(v0, v1); if (!nostore) EPI_ST(v4u, rowp + bj * HALF, pk_); else asm volatile("" :: "v"(pk_)); } } }
    }
};
struct EpiBf16 {
    static constexpr bool PERM = true; static constexpr int NSTORE = 16;
    bf16* O; int ldc; float sc;
    __device__ __forceinline__ void operator()(const Acc& acc, const Unit& u, int, int wr, int wc, int fr, int fq) const {
        const int row0 = u.pm * BM + wr * 64 + fr, col0 = u.pn * BM + wc * 32 + 8 * fq;
#pragma unroll
        for (int ai = 0; ai < 2; ++ai)
#pragma unroll
            for (int m = 0; m < 4; ++m) { bf16* rowp = O + (size_t)(row0 + ai * HALF + m * 16) * ldc + col0;
#pragma unroll
                for (int bj = 0; bj < 2; ++bj) { const f32x4 v0 = acc[ai][bj][m][0] * sc, v1 = acc[ai][bj][m][1] * sc;
                    EPI_ST(v4u, rowp + bj * HALF, pack8(v0, v1)); } }
    }
};
template <bool ADD> struct EpiGate {
    static constexpr bool PERM = true; static constexpr int NSTORE = 16;
    const unsigned char* G; bf16* T; unsigned char* T8;
    __device__ __forceinline__ void operator()(const Acc& acc, const Unit& u, int, int wr, int wc, int fr, int fq) const {
        const int row0 = u.pm * BM + wr * 64 + fr, col0 = u.pn * BM + wc * 32 + 8 * fq;
        constexpr int NB = ADD ? 1 : 2;
#pragma unroll
        for (int a0 = 0; a0 < 2; a0 += NB) {
            v2u gw[NB][4][2]; v4u tw[4][2];
#pragma unroll
            for (int ab = 0; ab < NB; ++ab)
#pragma unroll
                for (int m = 0; m < 4; ++m)
#pragma unroll
                    for (int bj = 0; bj < 2; ++bj) { const size_t off = (size_t)(row0 + (a0 + ab) * HALF + m * 16) * D + col0 + bj * HALF; gw[ab][m][bj] = *(const v2u*)(G + off); if (ADD) tw[m][bj] = *(const v4u*)(T + off); }
#pragma unroll
            for (int ab = 0; ab < NB; ++ab) { const int ai = a0 + ab;
#pragma unroll
            for (int m = 0; m < 4; ++m) { const size_t off = (size_t)(row0 + ai * HALF + m * 16) * D + col0;
#pragma unroll
                for (int bj = 0; bj < 2; ++bj) { f32x4 g0, g1; unpack8_fp8(gw[ab][m][bj], g0, g1);
                    f32x4 t0 = {0.f, 0.f, 0.f, 0.f}, t1 = {0.f, 0.f, 0.f, 0.f};
                    if (ADD) unpack8(tw[m][bj], t0, t1);
                    f32x4 e0 = g0 * (-LOG2E), e1 = g1 * (-LOG2E);
#pragma unroll
                    for (int c = 0; c < 4; ++c) { e0[c] = fast_exp2(e0[c]); e1[c] = fast_exp2(e1[c]); }
                    e0 = e0 + 1.0f; e1 = e1 + 1.0f;
#pragma unroll
                    for (int c = 0; c < 4; ++c) { e0[c] = fast_rcp(e0[c]); e1[c] = fast_rcp(e1[c]); }
                    const f32x4 o0 = t0 + e0 * acc[ai][bj][m][0], o1 = t1 + e1 * acc[ai][bj][m][1];
                    if (ADD && MK_OUT8) { const f32x4 q0 = o0 * MG_SCALE, q1 = o1 * MG_SCALE; v2u w8; w8.x = pk4_fp8(q0[0], q0[1], q0[2], q0[3]); w8.y = pk4_fp8(q1[0], q1[1], q1[2], q1[3]);
                        EPI_ST(v2u, (unsigned char*)T8 + off + bj * HALF, w8); }
                    else EPI_ST(v4u, T + off + bj * HALF, pack8(o0, o1)); } } } }
    }
};
__device__ __forceinline__ v2u swiglu8_fp8(f32x4 a0, f32x4 a1, f32x4 b0, f32x4 b1) {
    f32x4 t0 = a0 * (-LOG2E), t1 = a1 * (-LOG2E);
#pragma unroll
    for (int c = 0; c < 4; ++c) { t0[c] = fast_exp2(t0[c]); t1[c] = fast_exp2(t1[c]); }
    t0 = t0 + 1.0f; t1 = t1 + 1.0f;
#pragma unroll
    for (int c = 0; c < 4; ++c) { t0[c] = fast_rcp(t0[c]); t1[c] = fast_rcp(t1[c]); }
    f32x4 u0 = (a0 * b0) * t0, u1 = (a1 * b1) * t1;
    v2u w; w.x = pk4_fp8(u0[0], u0[1], u0[2], u0[3]); w.y = pk4_fp8(u1[0], u1[1], u1[2], u1[3]); return w;
}
struct EpiSwiGLU {
    static constexpr bool PERM = true; static constexpr int NSTORE = 8;
    unsigned char* O; float sc;
    __device__ __forceinline__ void operator()(const Acc& acc, const Unit& u, int, int wr, int wc, int fr, int fq) const {
        const int row0 = u.pm * BM + wr * 64 + fr, col0 = u.pn * HALF + wc * 32 + 8 * fq;
#pragma unroll
        for (int ai = 0; ai < 2; ++ai)
#pragma unroll
            for (int m = 0; m < 4; ++m) { const v2u w = swiglu8_fp8(acc[ai][0][m][0] * sc, acc[ai][0][m][1] * sc, acc[ai][1][m][0] * sc, acc[ai][1][m][1] * sc);
                EPI_ST(v2u, O + (size_t)(row0 + ai * HALF + m * 16) * FF + col0, w); }
    }
};
struct EpiSwiGLUi8 {
    static constexpr bool PERM = true; static constexpr int NSTORE = 8;
    unsigned char* O; const LAS float* rowf; const LAS float* colf;
    __device__ __forceinline__ void operator()(const Acc& acc, const Unit& u, int ui, int wr, int wc, int fr, int fq) const {
        const int row0 = u.pm * BM + wr * 64 + fr, col0 = u.pn * HALF + wc * 32 + 8 * fq;
        const LAS float* cf_ = colf + ui * 256 + wc * 32 + 8 * fq;
        const f32x4 ca0 = *(const LAS f32x4*)cf_, ca1 = *(const LAS f32x4*)(cf_ + 4), cb0 = *(const LAS f32x4*)(cf_ + HALF), cb1 = *(const LAS f32x4*)(cf_ + HALF + 4);
#pragma unroll
        for (int ai = 0; ai < 2; ++ai)
#pragma unroll
            for (int m = 0; m < 4; ++m) { const float rf = rowf[ui * 256 + wr * 64 + fr + ai * HALF + m * 16];
                const v4i_t a0 = __builtin_bit_cast(v4i_t, acc[ai][0][m][0]), a1 = __builtin_bit_cast(v4i_t, acc[ai][0][m][1]), b0 = __builtin_bit_cast(v4i_t, acc[ai][1][m][0]), b1 = __builtin_bit_cast(v4i_t, acc[ai][1][m][1]);
                const v2u w = swiglu8_fp8(__builtin_convertvector(a0, f32x4) * rf * ca0, __builtin_convertvector(a1, f32x4) * rf * ca1, __builtin_convertvector(b0, f32x4) * rf * cb0, __builtin_convertvector(b1, f32x4) * rf * cb1);
                EPI_ST(v2u, O + (size_t)(row0 + ai * HALF + m * 16) * FF + col0, w); }
    }
};
struct EpiMoeDown {
    static constexpr bool PERM = true; static constexpr int NSTORE = 0;
    bf16* YP; const LAS unsigned short* tok; const LAS int* seg; float sc;
    __device__ __forceinline__ void operator()(const Acc& acc, const Unit& u, int ui, int wr, int wc, int fr, int fq) const {
        const int r0 = wr * 64 + fr, col0 = u.pn * BM + wc * 32 + 8 * fq;
        const int prow = u.pm * 256; int e = 0;
#pragma unroll
        for (int j = 1; j < NE; ++j) e += (prow >= seg[j]) ? 1 : 0;
        const int nvalid = seg[16 + e] - (prow - seg[e]);
        const LAS unsigned short* tp = tok + ui * 256 + r0; asm volatile("" : "+v"(tp));
#pragma unroll
        for (int ai = 0; ai < 2; ++ai)
#pragma unroll
            for (int m = 0; m < 4; ++m) { const int r = r0 + ai * HALF + m * 16;
                if (r < nvalid) { bf16* rowp = YP + (size_t)tp[ai * HALF + m * 16] * D + col0;
#pragma unroll
                    for (int bj = 0; bj < 2; ++bj) { const f32x4 v0 = acc[ai][bj][m][0] * sc, v1 = acc[ai][bj][m][1] * sc;
                        if (MK_Y8) { v2u w8; w8.x = pk4_fp8(v0[0], v0[1], v0[2], v0[3]); w8.y = pk4_fp8(v1[0], v1[1], v1[2], v1[3]); EPI_ST(v2u, (unsigned char*)YP + (size_t)tp[ai * HALF + m * 16] * D + col0 + bj * HALF, w8); }
                        else EPI_ST(v4u, rowp + bj * HALF, pack8(v0, v1)); } } }
    }
};
struct EpiMoeDownTail {
    static constexpr bool PERM = true; static constexpr int NSTORE = 0;
    bf16* YP; const LAS unsigned short* tok; const LAS int* seg; float sc; f32x4* xbuf; unsigned* flg; int pidx, slice;
    template <int S_> __device__ __forceinline__ void fin(const Acc& acc, const Unit& u, int wr, int wc, int fr, int fq, int tid) const {
        constexpr int ai = S_ >> 1, bj = S_ & 1;
        f32x4 v[4][2];
#pragma unroll
        for (int m = 0; m < 4; ++m) { v[m][0] = acc[ai][bj][m][0]; v[m][1] = acc[ai][bj][m][1]; }
#pragma unroll
        for (int k = 1; k < 4; ++k) { const f32x4* src = xbuf + ((size_t)((pidx * 4 + S_) * 3 + (k - 1)) * 8) * 512 + tid;
#pragma unroll
            for (int m = 0; m < 4; ++m) { v[m][0] += src[(m * 2 + 0) * 512]; v[m][1] += src[(m * 2 + 1) * 512]; } }
        const int r0 = wr * 64 + fr, col0 = u.pn * BM + wc * 32 + 8 * fq + bj * HALF;
        const int prow = u.pm * 256; int e = 0;
#pragma unroll
        for (int j = 1; j < NE; ++j) e += (prow >= seg[j]) ? 1 : 0;
        const int nvalid = seg[16 + e] - (prow - seg[e]);
#pragma unroll
        for (int m = 0; m < 4; ++m) { const int r = r0 + ai * HALF + m * 16;
            if (r < nvalid) { const size_t t = tok[r]; const f32x4 v0 = v[m][0] * sc, v1 = v[m][1] * sc;
                if (MK_Y8) { v2u w8; w8.x = pk4_fp8(v0[0], v0[1], v0[2], v0[3]); w8.y = pk4_fp8(v1[0], v1[1], v1[2], v1[3]); EPI_ST(v2u, (unsigned char*)YP + t * D + col0, w8); }
                else EPI_ST(v4u, YP + t * D + col0, pack8(v0, v1)); } }
    }
    __device__ __forceinline__ void operator()(const Acc& acc, const Unit& u, int, int wr, int wc, int fr, int fq) const {
        const int tid = otid(), lane = tid & 63, wid = __builtin_amdgcn_readfirstlane(tid >> 6);
#pragma unroll
        for (int d = 0; d < 4; ++d) if (d != slice) { const int k = (slice - d) & 3;
            f32x4* dst = xbuf + ((size_t)((pidx * 4 + d) * 3 + (k - 1)) * 8) * 512 + tid;
#pragma unroll
            for (int m = 0; m < 4; ++m) { dst[(m * 2 + 0) * 512] = acc[d >> 1][d & 1][m][0]; dst[(m * 2 + 1) * 512] = acc[d >> 1][d & 1][m][1]; } }
        asm volatile("s_waitcnt vmcnt(0)" ::: "memory");
        __builtin_amdgcn_fence(__ATOMIC_RELEASE, "agent");
        asm volatile("s_waitcnt vmcnt(0)" ::: "memory");
        if (lane == 0) __hip_atomic_store(flg + ((pidx * 4 + slice) * 8 + wid) * 16, 1u, RLX_AGENT);
#pragma unroll 1
        for (int k = 1; k < 4; ++k) { unsigned* w = flg + ((pidx * 4 + ((slice + k) & 3)) * 8 + wid) * 16; unsigned sp = 0;
            while (__builtin_amdgcn_readfirstlane(__hip_atomic_load(w, RLX_AGENT)) == 0u) { __builtin_amdgcn_s_sleep(1); if (++sp > (1u << 16)) break; } }
        __builtin_amdgcn_fence(__ATOMIC_ACQUIRE, "agent");
        asm volatile("s_waitcnt vmcnt(0)" ::: "memory");
        if (slice == 0) fin<0>(acc, u, wr, wc, fr, fq, tid); else if (slice == 1) fin<1>(acc, u, wr, wc, fr, fq, tid); else if (slice == 2) fin<2>(acc, u, wr, wc, fr, fq, tid); else fin<3>(acc, u, wr, wc, fr, fq, tid);
    }
};
}

namespace att {
constexpr int PITCH = WH;
constexpr int SLOTB = 8192;
#ifndef MK_ATT_NSLOT
#define MK_ATT_NSLOT 4
#endif
constexpr int NSLOT = MK_ATT_NSLOT;
constexpr int L_K = 0, L_V = NSLOT * SLOTB, L_WS = 2 * NSLOT * SLOTB, L_OST = L_WS + NWAVES * 64 * 4, L_KPART = L_OST  , L_KMEAN = L_OST + NWAVES * 4096, L_SEL = L_KMEAN + 8 * 64 * 4, L_LUT = L_SEL + 256, L_DONE = L_LUT + 1536, L_END = L_DONE + 64;
static_assert(L_END <= LDS_SEG && 8 * 8 * 64 * 4 <= NWAVES * 4096, "attention LDS (it may use the MoE table region, not the segment / barrier words)");
__device__ __forceinline__ int crow(int r, int hi) { return (r & 3) + 8 * (r >> 2) + 4 * hi; }
__device__ __forceinline__ void glds16(const void* gsrc, unsigned lds_dst) { unsigned keep;
    asm volatile("s_mov_b32 %0, m0\n\ts_mov_b32 m0, %2\n\ts_nop 0\n\tglobal_load_lds_dwordx4 %1, off\n\ts_mov_b32 m0, %0" : "=&s"(keep) : "v"(gsrc), "s"(lds_dst) : "memory"); }
#define ATT_WAIT_BAR(N) asm volatile("s_waitcnt vmcnt(" #N ") lgkmcnt(0)\n\ts_barrier" ::: "memory")
constexpr float SB_DONE_THR = 64.f;
__device__ const unsigned char REL_BUCKET_LUT[128] = {0, 1, 2, 3, 4, 5, 6, 7, 8, 9, 10, 11, 12, 13, 14, 15, 16, 16, 16, 17, 17, 18, 18, 18, 19, 19, 19, 20, 20, 20, 20, 21, 21, 21, 21, 22, 22, 22, 22, 22, 23, 23, 23, 23, 23, 23, 24, 24, 24, 24, 24, 24, 25, 25, 25, 25, 25, 25, 25, 26, 26, 26, 26, 26, 26, 26, 26, 27, 27, 27, 27, 27, 27, 27, 27, 27, 27, 28, 28, 28, 28, 28, 28, 28, 28, 28, 28, 29, 29, 29, 29, 29, 29, 29, 29, 29, 29, 29, 29, 30, 30, 30, 30, 30, 30, 30, 30, 30, 30, 30, 30, 30, 30, 31, 31, 31, 31, 31, 31, 31, 31, 31, 31, 31, 31, 31, 31, 31};

__device__ __forceinline__ void qkt(f32x16& p0, f32x16& p1, const LAS char* Kslot, const bf16x8* qr, const f32x16& cinit, int r32, int hi) {
    const LAS char* kb = Kslot + hi * 1024 + r32 * 16;
    bf16x8 kf[8];
#pragma unroll
    for (int d0 = 0; d0 < 4; ++d0) { kf[2 * d0] = *(const LAS bf16x8*)(kb + d0 * 2048); kf[2 * d0 + 1] = *(const LAS bf16x8*)(kb + d0 * 2048 + 512); }
    __builtin_amdgcn_sched_barrier(0);
    p0 = __builtin_amdgcn_mfma_f32_32x32x16_bf16(kf[0], qr[0], cinit, 0, 0, 0); p1 = __builtin_amdgcn_mfma_f32_32x32x16_bf16(kf[1], qr[0], cinit, 0, 0, 0);
#pragma unroll
    for (int d0 = 1; d0 < 4; ++d0) { p0 = __builtin_amdgcn_mfma_f32_32x32x16_bf16(kf[2 * d0], qr[d0], p0, 0, 0, 0); p1 = __builtin_amdgcn_mfma_f32_32x32x16_bf16(kf[2 * d0 + 1], qr[d0], p1, 0, 0, 0); }
    asm volatile("s_nop 15\n\ts_nop 7" : "+v"(p0), "+v"(p1));
}
__device__ __forceinline__ float max3f(float a, float b, float c) { float r; asm("v_max3_f32 %0, %1, %2, %3" : "=v"(r) : "v"(a), "v"(b), "v"(c)); return r; }
__device__ __forceinline__ float max2f(float a, float b) { float r; asm("v_max_f32_e32 %0, %1, %2" : "=v"(r) : "v"(a), "v"(b)); return r; }
__device__ __forceinline__ float min2f(float a, float b) { float r; asm("v_min_f32_e32 %0, %1, %2" : "=v"(r) : "v"(a), "v"(b)); return r; }
__device__ __forceinline__ void pv(f32x16* o, int vb, bf16x8 pa0, bf16x8 pa1, bf16x8 pa2, bf16x8 pa3) {
#pragma unroll
    for (int d0 = 0; d0 < 2; ++d0) { s16x4 lo[4], hi[4];
#pragma unroll
        for (int ks = 0; ks < 4; ++ks) {
            asm volatile("ds_read_b64_tr_b16 %0,%1 offset:%c2" : "=&v"(lo[ks]) : "v"(vb), "i"(d0 * 4096 + ks * 1024) : "memory");
            asm volatile("ds_read_b64_tr_b16 %0,%1 offset:%c2" : "=&v"(hi[ks]) : "v"(vb), "i"(d0 * 4096 + ks * 1024 + 512) : "memory"); }
        asm volatile("s_waitcnt lgkmcnt(0)" ::: "memory"); __builtin_amdgcn_sched_barrier(0);
#define ATT_PK(k) (bf16x8){lo[k][0], lo[k][1], lo[k][2], lo[k][3], hi[k][0], hi[k][1], hi[k][2], hi[k][3]}
        o[d0] = __builtin_amdgcn_mfma_f32_32x32x16_bf16(pa0, ATT_PK(0), o[d0], 0, 0, 0);
        o[d0] = __builtin_amdgcn_mfma_f32_32x32x16_bf16(pa1, ATT_PK(1), o[d0], 0, 0, 0);
        o[d0] = __builtin_amdgcn_mfma_f32_32x32x16_bf16(pa2, ATT_PK(2), o[d0], 0, 0, 0);
        o[d0] = __builtin_amdgcn_mfma_f32_32x32x16_bf16(pa3, ATT_PK(3), o[d0], 0, 0, 0);
#undef ATT_PK
    }
}
__device__ __forceinline__ bf16x8 pack8r(const f32x16& p, int b);
template <bool SUB> __device__ __forceinline__ float exp_pv(f32x16* o, int vb, f32x16& p0, f32x16& p1, const f32x16& w0, const f32x16& w1) {
    s16x4 lo[8], hi[8];
#pragma unroll
    for (int d0 = 0; d0 < 2; ++d0)
#pragma unroll
        for (int ks = 0; ks < 4; ++ks) {
            asm volatile("ds_read_b64_tr_b16 %0,%1 offset:%c2" : "=&v"(lo[d0 * 4 + ks]) : "v"(vb), "i"(d0 * 4096 + ks * 1024) : "memory");
            asm volatile("ds_read_b64_tr_b16 %0,%1 offset:%c2" : "=&v"(hi[d0 * 4 + ks]) : "v"(vb), "i"(d0 * 4096 + ks * 1024 + 512) : "memory"); }
    float ls = 0.f;
#define EPV_PK(k) (bf16x8){lo[k][0], lo[k][1], lo[k][2], lo[k][3], hi[k][0], hi[k][1], hi[k][2], hi[k][3]}
#define EPV_GROUP(P, WW, B, K) do { _Pragma("unroll") for (int r = 0; r < 8; ++r) P[(B) + r] = fast_exp2(SUB ? P[(B) + r] - WW[(B) + r] : P[(B) + r]); \
        ls += ((P[(B)] + P[(B) + 1]) + (P[(B) + 2] + P[(B) + 3])) + ((P[(B) + 4] + P[(B) + 5]) + (P[(B) + 6] + P[(B) + 7])); \
        const bf16x8 pa_ = pack8r(P, (B)); \
        if ((K) == 0) asm volatile("s_waitcnt lgkmcnt(0)" : "+v"(lo[0]), "+v"(hi[0]), "+v"(lo[1]), "+v"(hi[1]), "+v"(lo[2]), "+v"(hi[2]), "+v"(lo[3]), "+v"(hi[3]), "+v"(lo[4]), "+v"(hi[4]), "+v"(lo[5]), "+v"(hi[5]), "+v"(lo[6]), "+v"(hi[6]), "+v"(lo[7]), "+v"(hi[7]) :: "memory"); \
        o[0] = __builtin_amdgcn_mfma_f32_32x32x16_bf16(pa_, EPV_PK(K), o[0], 0, 0, 0); o[1] = __builtin_amdgcn_mfma_f32_32x32x16_bf16(pa_, EPV_PK((K) + 4), o[1], 0, 0, 0); \
        __builtin_amdgcn_sched_barrier(0); } while (0)
    EPV_GROUP(p0, w0, 0, 0); EPV_GROUP(p0, w0, 8, 1); EPV_GROUP(p1, w1, 0, 2); EPV_GROUP(p1, w1, 8, 3);
#undef EPV_GROUP
#undef EPV_PK
    return ls;
}
__device__ __forceinline__ bf16x8 pack8r(const f32x16& p, int b) { v4u w; w.x = cvt_pk_bf16(p[b], p[b + 1]); w.y = cvt_pk_bf16(p[b + 2], p[b + 3]); w.z = cvt_pk_bf16(p[b + 4], p[b + 5]); w.w = cvt_pk_bf16(p[b + 6], p[b + 7]); return __builtin_bit_cast(bf16x8, w); }
__device__ __forceinline__ f32x16 splat16(float v) { f32x16 r;
#pragma unroll
    for (int i = 0; i < 16; ++i) r[i] = v;
    return r; }

template <bool MOBA>
__device__ __forceinline__ void attn_unit(int b, int h, int qb, const bf16* Q, const bf16* __restrict__ Kp, const bf16* __restrict__ Vp, bf16* O, const float* rel_bias, LAS unsigned char* shm, bool prep) {
    const int tid = otid(), lane = tid & 63, r32 = lane & 31, hi = lane >> 5; const int wid = __builtin_amdgcn_readfirstlane(tid >> 6);
    const long rowbase = (long)b * SEQ; const int q0 = qb * 256;
    const bf16* Qw = Q + (rowbase + q0 + wid * 32) * PITCH + h * HD;
    const bf16* Kh = Kp + rowbase * PITCH + h * HD; const bf16* Vh = Vp + rowbase * PITCH + h * HD;
    const unsigned lds0 = (unsigned)(uintptr_t)shm;
    LAS float* wsf = (LAS float*)(shm + L_WS) + wid * 64;
    const bf16* ksrc = Kh + (long)lane * PITCH + wid * 8;
    const bf16* vsrc = Vh + (long)(16 * (wid & 3) + (lane >> 2)) * PITCH + (wid >> 2) * 32 + (lane & 3) * 8;
    const unsigned kdst = lds0 + L_K + wid * 1024, vdst = lds0 + L_V + wid * 1024;
#define DMA_K(t, slot) glds16(ksrc + (long)(t) * 64 * PITCH, (unsigned)__builtin_amdgcn_readfirstlane(kdst + (slot)))
#define DMA_V(t, slot) glds16(vsrc + (long)(t) * 64 * PITCH, (unsigned)__builtin_amdgcn_readfirstlane(vdst + (slot)))
    const int vb0 = (int)(lds0 + L_V) + ((lane >> 4) & 1) * 32 + (lane & 3) * 8 + (4 * hi + ((lane & 15) >> 2)) * 64;
    const LAS char* Kbase = (const LAS char*)(shm + L_K);
    const int NT = 4 * (qb + 1);
    const int qrel = wid * 32 + r32;
#pragma unroll
    for (int w = 0; w < NSLOT - 1; ++w) if (w < NT) { DMA_K(NT - 1 - w, w * SLOTB); DMA_V(NT - 1 - w, w * SLOTB); }
    LAS int* doneAt = (LAS int*)(shm + L_DONE);
    if (!MOBA) { if (tid < 8) doneAt[tid] = 0x7fffffff; }
    bf16x8 qr[4];
#pragma unroll
    for (int d0 = 0; d0 < 4; ++d0) qr[d0] = *(const bf16x8*)(&Qw[(long)r32 * PITCH + d0 * 16 + hi * 8]);
    float biasfar = 0.f; unsigned selmask = 0u;
    if constexpr (MOBA) {
        LAS float* KPART = (LAS float*)(shm + L_KPART); LAS float* KMEAN = (LAS float*)(shm + L_KMEAN); LAS unsigned char* SEL = (LAS unsigned char*)(shm + L_SEL); LAS float* LUT = (LAS float*)(shm + L_LUT);
        if (prep) {
        if (tid < 384) { const int d = 319 - tid; LUT[tid] = d < 0 ? -INFINITY : rel_bias[REL_BUCKET_LUT[d > 127 ? 127 : d] * NH + h] * LOG2E; }
        const int dch = lane & 7, rs = lane >> 3;
        for (int mb = 0; mb < 7; ++mb) {
            float s[8];
#pragma unroll
            for (int c = 0; c < 8; ++c) s[c] = 0.f;
#pragma unroll
            for (int j = 0; j < 4; ++j) { const v4u w = *(const v4u*)(Kh + (long)(mb * 256 + wid * 32 + j * 8 + rs) * PITCH + dch * 8);
                s[0] += bf_lo(w.x); s[1] += bf_hi(w.x); s[2] += bf_lo(w.y); s[3] += bf_hi(w.y); s[4] += bf_lo(w.z); s[5] += bf_hi(w.z); s[6] += bf_lo(w.w); s[7] += bf_hi(w.w); }
#pragma unroll
            for (int c = 0; c < 8; ++c) { s[c] += shx(s[c], 8, lane); s[c] += shx(s[c], 16, lane); s[c] += shx(s[c], 32, lane); }
            if (rs == 0) {
#pragma unroll
                for (int c = 0; c < 8; ++c) KPART[(mb * 8 + wid) * 64 + dch * 8 + c] = s[c]; }
        }
        __syncthreads();
        { const int mb = tid >> 6, d = tid & 63; if (mb < 7) { float t = 0.f;
#pragma unroll
            for (int w = 0; w < 8; ++w) t += KPART[(mb * 8 + w) * 64 + d];
            KMEAN[mb * 64 + d] = t * (1.0f / 256.0f); } }
        __syncthreads();
        }
        { const int q = tid >> 1, dh = tid & 1; const bf16* qp = Q + (rowbase + q0 + q) * PITCH + h * HD + dh * 32; float qv[32];
#pragma unroll
            for (int j = 0; j < 4; ++j) { const v4u w = *(const v4u*)(qp + j * 8); qv[j * 8 + 0] = bf_lo(w.x); qv[j * 8 + 1] = bf_hi(w.x); qv[j * 8 + 2] = bf_lo(w.y); qv[j * 8 + 3] = bf_hi(w.y); qv[j * 8 + 4] = bf_lo(w.z); qv[j * 8 + 5] = bf_hi(w.z); qv[j * 8 + 6] = bf_lo(w.w); qv[j * 8 + 7] = bf_hi(w.w); }
            float g[7];
#pragma unroll
            for (int mb = 0; mb < 7; ++mb) { float a = 0.f; if (mb < qb) {
#pragma unroll
                    for (int d = 0; d < 32; ++d) a += qv[d] * KMEAN[mb * 64 + dh * 32 + d]; }
                a += shx(a, 1, lane); g[mb] = a; }
            unsigned mask = 0u;
            if (qb <= 3) mask = (1u << qb) - 1u;
            else {
#pragma unroll
                for (int pass = 0; pass < 3; ++pass) { float best = -INFINITY; int bi = 0;
#pragma unroll
                    for (int mb = 0; mb < 7; ++mb) if (mb < qb && !((mask >> mb) & 1u) && g[mb] > best) { best = g[mb]; bi = mb; }
                    mask |= 1u << bi; } }
            if (dh == 0) SEL[q] = (unsigned char)mask; }
        __syncthreads();
        selmask = SEL[qrel]; biasfar = LUT[319 - 127];
    }
    f32x16 o[2]; o[0] = splat16(0.f); o[1] = splat16(0.f);
    float m_run = 0.f, l_run = 0.f, carry = 0.f; bool first = true;
    bf16x8 tri0, tri1, ones;
#pragma unroll
    for (int jj = 0; jj < 8; ++jj) { const int j0 = 8 * (jj >> 2) + 4 * hi + (jj & 3); tri0[jj] = (j0 >= r32) ? (short)0x3F80 : (short)0; tri1[jj] = (16 + j0 >= r32) ? (short)0x3F80 : (short)0; ones[jj] = (short)0x3F80; }
    const int jd = wid >> 1;
    bool mydone = false;
    for (int i = 0; i < NT; ++i) {
        const int kt = NT - 1 - i; const int slot = (i % NSLOT) * SLOTB;
        { const int n = (NT - 1 - i) < (NSLOT - 2) ? (NT - 1 - i) : (NSLOT - 2);
          if (n >= 6) ATT_WAIT_BAR(12); else if (n == 5) ATT_WAIT_BAR(10); else if (n == 4) ATT_WAIT_BAR(8); else if (n == 3) ATT_WAIT_BAR(6); else if (n == 2) ATT_WAIT_BAR(4); else if (n == 1) ATT_WAIT_BAR(2); else ATT_WAIT_BAR(0); }
        if constexpr (!MOBA) { if (i >= 1) { const v4u d0 = *(const LAS v4u*)doneAt, d1 = *(const LAS v4u*)(doneAt + 4); const int lim = i - 1;
                bool all = ((int)d0.x <= lim) && ((int)d0.y <= lim) && ((int)d0.z <= lim) && ((int)d0.w <= lim) && ((int)d1.x <= lim) && ((int)d1.y <= lim) && ((int)d1.z <= lim) && ((int)d1.w <= lim);
                if (__builtin_amdgcn_readfirstlane(all ? 1 : 0)) break; } }
        if (i + NSLOT - 1 < NT) { DMA_K(kt - (NSLOT - 1), ((i + NSLOT - 1) % NSLOT) * SLOTB); DMA_V(kt - (NSLOT - 1), ((i + NSLOT - 1) % NSLOT) * SLOTB); }
        if constexpr (!MOBA) { if (mydone) continue; }
        const int jb = kt - (NT - 4);
        if (jb > jd) continue;
        const bool diag = (jb == jd);
        f32x16 p0, p1;
        if constexpr (MOBA) {
            const bool band = jb >= 0; const int mblk = kt >> 2;
            const bool sel = band || ((selmask >> mblk) & 1u);
            if (!__any(sel)) continue;
            const int dmin = (q0 + wid * 32) - (64 * kt + 63);
            const bool near = dmin < 113;
            const float ci = sel ? ((near ? 0.f : biasfar) - m_run) : -INFINITY;
            const f32x16 cinit = splat16(ci);
            qkt(p0, p1, Kbase + slot, qr, cinit, r32, hi);
            if (near) { const LAS float* rl = (const LAS float*)(shm + L_LUT) + (319 - ((q0 + qrel) - 64 * kt) + 4 * hi);
                asm volatile("" : "+v"(rl));
#pragma unroll
                for (int r = 0; r < 16; ++r) { p0[r] += rl[(r & 3) + 8 * (r >> 2)]; p1[r] += rl[(r & 3) + 8 * (r >> 2) + 32]; } }
            float rma = max3f(p0[0], p0[1], p1[0]), rmb = max3f(p0[2], p0[3], p1[1]); rma = max3f(rma, p1[2], p1[3]);
#pragma unroll
            for (int r = 4; r < 16; r += 4) { rma = max3f(rma, p0[r], p0[r + 1]); rmb = max3f(rmb, p0[r + 2], p0[r + 3]); rma = max3f(rma, p1[r], p1[r + 1]); rmb = max3f(rmb, p1[r + 2], p1[r + 3]); }
            float rm = max2f(rma, rmb);
            { const unsigned rb_ = __builtin_bit_cast(unsigned, rm);
              const auto sw_ = __builtin_amdgcn_permlane32_swap(rb_, rb_, false, false);
              rm = __builtin_fmaxf(__builtin_bit_cast(float, (unsigned)sw_[0]), __builtin_bit_cast(float, (unsigned)sw_[1])); }
            const bool grow = first || (rm > 8.0f);
            if (__any(grow)) { const float dl = grow ? rm : 0.f; m_run += dl; const float alpha = fast_exp2(-dl); l_run = first ? 0.f : l_run * alpha;
#pragma unroll
                for (int r = 0; r < 16; ++r) { p0[r] -= dl; p1[r] -= dl; }
                if (!first) { if (hi == 0) wsf[r32] = alpha; LDS_WAIT();
#pragma unroll
                    for (int d_ = 0; d_ < 2; ++d_)
#pragma unroll
                        for (int r = 0; r < 16; ++r) o[d_][r] *= wsf[crow(r, hi)];
                    LDS_WAIT(); } }
            first = false;
            l_run += exp_pv<false>(o, vb0 + slot, p0, p1, p0, p1);
            continue;
        } else {
            const f32x16 zero = splat16(0.f);
            qkt(p0, p1, Kbase + slot, qr, zero, r32, hi);
            f32x16 s0, s1;
            const int kq = qrel - 64 * (jb < 0 ? 0 : jb);
            if (diag) {
#pragma unroll
                for (int r = 0; r < 16; ++r) { const int kv = crow(r, hi); if (kv >= kq) p0[r] = -1e30f; if (kv + 32 >= kq) p1[r] = -1e30f; } }
#pragma unroll
            for (int r = 0; r < 16; ++r) { const float z0 = p0[r], z1 = p1[r];
                const float c0 = min2f(z0, 64.f), c1 = min2f(z1, 64.f);
                s0[r] = fast_log2(1.0f + fast_exp2(c0)) + (z0 - c0); s1[r] = fast_log2(1.0f + fast_exp2(c1)) + (z1 - c1); }
            const bf16x8 L0 = pack8r(s0, 0), L1 = pack8r(s0, 8), L2 = pack8r(s1, 0), L3 = pack8r(s1, 8);
            const f32x16 c16 = splat16(carry);
            f32x16 W0 = __builtin_amdgcn_mfma_f32_32x32x16_bf16(tri0, L0, c16, 0, 0, 0);
            W0 = __builtin_amdgcn_mfma_f32_32x32x16_bf16(tri1, L1, W0, 0, 0, 0);
            W0 = __builtin_amdgcn_mfma_f32_32x32x16_bf16(ones, L2, W0, 0, 0, 0);
            W0 = __builtin_amdgcn_mfma_f32_32x32x16_bf16(ones, L3, W0, 0, 0, 0);
            f32x16 W1 = __builtin_amdgcn_mfma_f32_32x32x16_bf16(tri0, L2, c16, 0, 0, 0);
            W1 = __builtin_amdgcn_mfma_f32_32x32x16_bf16(tri1, L3, W1, 0, 0, 0);
            carry = shl(W0[0], r32);
            if (__all(carry > SB_DONE_THR)) { mydone = true; if (lane == 0) doneAt[wid] = i; }
            (void)exp_pv<true>(o, vb0 + slot, p0, p1, W0, W1);
        }
    }
    asm volatile("s_waitcnt vmcnt(0)" ::: "memory");
    float rli[16];
    if constexpr (MOBA) {
        l_run += shx(l_run, 32, lane);
        if (hi == 0) wsf[32 + r32] = l_run; LDS_WAIT();
#pragma unroll
        for (int r = 0; r < 16; ++r) rli[r] = fast_rcp(wsf[32 + crow(r, hi)]);
    } else {
#pragma unroll
        for (int r = 0; r < 16; ++r) rli[r] = 1.f;
    }
    bf16* Ow = O + (rowbase + q0 + wid * 32) * PITCH + h * HD;
    { LAS bf16* stg = (LAS bf16*)(shm + L_OST) + wid * 2048;
#pragma unroll
        for (int r = 0; r < 16; ++r) { const int orow = crow(r, hi);
#pragma unroll
            for (int d0 = 0; d0 < 2; ++d0) stg[orow * 64 + d0 * 32 + r32] = (bf16)f2bf(o[d0][r] * rli[r]); }
        LDS_WAIT();
#pragma unroll
        for (int i = 0; i < 4; ++i) { const int row = i * 8 + (lane >> 3), ch = lane & 7; const v4u v = *(const LAS v4u*)(stg + row * 64 + ch * 8); *(v4u*)(Ow + (long)row * PITCH + ch * 8) = v; } }
    asm volatile("s_waitcnt lgkmcnt(0)\n\ts_barrier" ::: "memory");
#undef DMA_K
#undef DMA_V
}

typedef float f32x2_t __attribute__((ext_vector_type(2))); typedef __bf16 bf16x2_t __attribute__((ext_vector_type(2)));
__device__ __forceinline__ unsigned cvtpk_s(float lo, float hi) { f32x2_t v = {lo, hi}; bf16x2_t bb = __builtin_convertvector(v, bf16x2_t); return __builtin_bit_cast(unsigned, bb); }
typedef short v4i16_t __attribute__((ext_vector_type(4)));
__device__ __forceinline__ s16x4 vtr(const LAS char* p) { return __builtin_bit_cast(s16x4, __builtin_amdgcn_ds_read_tr16_b64_v4i16((LAS v4i16_t*)p)); }
__device__ __forceinline__ void kload8f(bf16x8* kf, const LAS char* kp) {
    kf[0] = *(const LAS bf16x8*)(kp);        kf[1] = *(const LAS bf16x8*)(kp + 512);  kf[2] = *(const LAS bf16x8*)(kp + 2048); kf[3] = *(const LAS bf16x8*)(kp + 2560);
    kf[4] = *(const LAS bf16x8*)(kp + 4096); kf[5] = *(const LAS bf16x8*)(kp + 4608); kf[6] = *(const LAS bf16x8*)(kp + 6144); kf[7] = *(const LAS bf16x8*)(kp + 6656); }
__device__ __forceinline__ void kload2f(bf16x8* kf, const LAS char* kp, int j) { kf[2 * j] = *(const LAS bf16x8*)(kp + j * 2048); kf[2 * j + 1] = *(const LAS bf16x8*)(kp + j * 2048 + 512); }
__device__ __forceinline__ void moba_unit2(int b, int h, int qb, const bf16* Q, const bf16* __restrict__ Kp, const bf16* __restrict__ Vp, bf16* O, const float* rel_bias, LAS unsigned char* shm, bool prep) {
    constexpr bool MOBA = true; constexpr int NS3 = 3;
    const int tid = otid(), lane = tid & 63, r32 = lane & 31, hi = lane >> 5; const int wid = __builtin_amdgcn_readfirstlane(tid >> 6);
    const long rowbase = (long)b * SEQ; const int q0 = qb * 256;
    const bf16* Qw = Q + (rowbase + q0 + wid * 32) * PITCH + h * HD;
    const bf16* Kh = Kp + rowbase * PITCH + h * HD; const bf16* Vh = Vp + rowbase * PITCH + h * HD;
    const unsigned lds0 = (unsigned)(uintptr_t)shm;
    LAS float* wsf = (LAS float*)(shm + L_WS) + wid * 64;
    const bf16* ksrc = Kh + (long)lane * PITCH + wid * 8;
    const bf16* vsrc = Vh + (long)(16 * (wid & 3) + (lane >> 2)) * PITCH + (wid >> 2) * 32 + (lane & 3) * 8;
    const unsigned kdst = lds0 + L_K + wid * 1024, vdst = lds0 + L_V + wid * 1024;
#define DMA_K(t, slot) glds16(ksrc + (long)(t) * 64 * PITCH, (unsigned)__builtin_amdgcn_readfirstlane(kdst + (slot)))
#define DMA_V(t, slot) glds16(vsrc + (long)(t) * 64 * PITCH, (unsigned)__builtin_amdgcn_readfirstlane(vdst + (slot)))
    const int vb0 = (int)(lds0 + L_V) + ((lane >> 4) & 1) * 32 + (lane & 3) * 8 + (4 * hi + ((lane & 15) >> 2)) * 64;
    const LAS char* Kbase = (const LAS char*)(shm + L_K);
    const LAS char* kp0 = (const LAS char*)(shm + L_K) + hi * 1024 + r32 * 16; const LAS char* vp0 = (const LAS char*)(shm + L_V) + ((lane >> 4) & 1) * 32 + (lane & 3) * 8 + (4 * hi + ((lane & 15) >> 2)) * 64;
    const int NT = 4 * (qb + 1);
    const int qrel = wid * 32 + r32;
    DMA_K(0, 0); DMA_V(0, 0); DMA_K(1, SLOTB);
    bf16x8 qr[4];
#pragma unroll
    for (int d0 = 0; d0 < 4; ++d0) qr[d0] = *(const bf16x8*)(&Qw[(long)r32 * PITCH + d0 * 16 + hi * 8]);
    float biasfar = 0.f; unsigned selmask = 0u;
    {
        LAS float* KPART = (LAS float*)(shm + L_KPART); LAS float* KMEAN = (LAS float*)(shm + L_KMEAN); LAS unsigned char* SEL = (LAS unsigned char*)(shm + L_SEL); LAS float* LUT = (LAS float*)(shm + L_LUT);
        if (prep) {
        if (tid < 384) { const int d = 319 - tid; LUT[tid] = d < 0 ? -INFINITY : rel_bias[REL_BUCKET_LUT[d > 127 ? 127 : d] * NH + h] * LOG2E; }
        const int dch = lane & 7, rs = lane >> 3;
        for (int mb = 0; mb < 7; ++mb) {
            float s[8];
#pragma unroll
            for (int c = 0; c < 8; ++c) s[c] = 0.f;
#pragma unroll
            for (int j = 0; j < 4; ++j) { const v4u w = *(const v4u*)(Kh + (long)(mb * 256 + wid * 32 + j * 8 + rs) * PITCH + dch * 8);
                s[0] += bf_lo(w.x); s[1] += bf_hi(w.x); s[2] += bf_lo(w.y); s[3] += bf_hi(w.y); s[4] += bf_lo(w.z); s[5] += bf_hi(w.z); s[6] += bf_lo(w.w); s[7] += bf_hi(w.w); }
#pragma unroll
            for (int c = 0; c < 8; ++c) { s[c] += shx(s[c], 8, lane); s[c] += shx(s[c], 16, lane); s[c] += shx(s[c], 32, lane); }
            if (rs == 0) {
#pragma unroll
                for (int c = 0; c < 8; ++c) KPART[(mb * 8 + wid) * 64 + dch * 8 + c] = s[c]; }
        }
        __syncthreads();
        { const int mb = tid >> 6, d = tid & 63; if (mb < 7) { float t = 0.f;
#pragma unroll
            for (int w = 0; w < 8; ++w) t += KPART[(mb * 8 + w) * 64 + d];
            KMEAN[mb * 64 + d] = t * (1.0f / 256.0f); } }
        __syncthreads();
        }
        { const int q = tid >> 1, dh = tid & 1; const bf16* qp = Q + (rowbase + q0 + q) * PITCH + h * HD + dh * 32; float qv[32];
#pragma unroll
            for (int j = 0; j < 4; ++j) { const v4u w = *(const v4u*)(qp + j * 8); qv[j * 8 + 0] = bf_lo(w.x); qv[j * 8 + 1] = bf_hi(w.x); qv[j * 8 + 2] = bf_lo(w.y); qv[j * 8 + 3] = bf_hi(w.y); qv[j * 8 + 4] = bf_lo(w.z); qv[j * 8 + 5] = bf_hi(w.z); qv[j * 8 + 6] = bf_lo(w.w); qv[j * 8 + 7] = bf_hi(w.w); }
            float g[7];
#pragma unroll
            for (int mb = 0; mb < 7; ++mb) { float a = 0.f; if (mb < qb) {
#pragma unroll
                    for (int d = 0; d < 32; ++d) a += qv[d] * KMEAN[mb * 64 + dh * 32 + d]; }
                a += shx(a, 1, lane); g[mb] = a; }
            unsigned mask = 0u;
            if (qb <= 3) mask = (1u << qb) - 1u;
            else {
#pragma unroll
                for (int pass = 0; pass < 3; ++pass) { float best = -INFINITY; int bi = 0;
#pragma unroll
                    for (int mb = 0; mb < 7; ++mb) if (mb < qb && !((mask >> mb) & 1u) && g[mb] > best) { best = g[mb]; bi = mb; }
                    mask |= 1u << bi; } }
            if (dh == 0) SEL[q] = (unsigned char)mask; }
        __syncthreads();
        selmask = SEL[qrel]; biasfar = LUT[319 - 127];
    }
    (void)Kbase; (void)vb0;
    float mhat = 0.f, l_reg = 0.f; f32x16 o[2]; o[0] = splat16(0.f); o[1] = splat16(0.f); bf16x8 kf[8];
#define FUT(t) ((((t) - (NT - 4)) > (wid >> 1)))
#define CIN(t) splat16(FUT(t) ? -INFINITY : (((t) >= NT - 4) || ((selmask >> ((t) >> 2)) & 1u)) ? (((((q0 + wid * 32) - (64 * (t) + 63)) < 113) ? 0.f : biasfar) - mhat) : -INFINITY)
#define NEARB(P0, P1, t) do { if ((((q0 + wid * 32) - (64 * (t) + 63)) < 113) && !FUT(t)) { const LAS float* rl = (const LAS float*)(shm + L_LUT) + (319 - ((q0 + qrel) - 64 * (t)) + 4 * hi); asm volatile("" : "+v"(rl)); \
        _Pragma("unroll") for (int r = 0; r < 16; ++r) { P0[r] += rl[(r & 3) + 8 * (r >> 2)]; P1[r] += rl[(r & 3) + 8 * (r >> 2) + 32]; } } } while (0)
    bool resc = false;
#define RESC() do { if (resc) { asm volatile("s_waitcnt lgkmcnt(0)" ::: "memory"); \
        _Pragma("unroll") for (int d_ = 0; d_ < 2; ++d_) _Pragma("unroll") for (int r = 0; r < 16; ++r) o[d_][r] *= wsf[crow(r, hi)]; } } while (0)
    f32x16 pA0, pA1, pB0, pB1;
    int sl_prev = 0, sl_cur = 0, sl_next = SLOTB;
#define ROT() do { sl_prev = sl_cur; sl_cur = sl_next; sl_next = (sl_next == (NS3 - 1) * SLOTB) ? 0 : sl_next + SLOTB; } while (0)
    DMA_K(2, 2 * SLOTB);
    ATT_WAIT_BAR(3);
    { const f32x16 c0_ = CIN(0); qkt(pA0, pA1, (const LAS char*)(shm + L_K), qr, c0_, r32, hi); }
    NEARB(pA0, pA1, 0);
    { float rm = max3f(pA0[0], pA0[1], pA1[0]), rb = max3f(pA0[2], pA0[3], pA1[1]); rm = max3f(rm, pA1[2], pA1[3]);
#pragma unroll
      for (int r = 4; r < 16; r += 4) { rm = max3f(rm, pA0[r], pA0[r + 1]); rb = max3f(rb, pA0[r + 2], pA0[r + 3]); rm = max3f(rm, pA1[r], pA1[r + 1]); rb = max3f(rb, pA1[r + 2], pA1[r + 3]); }
      float m_ = __builtin_fmaxf(rm, rb);
      { const unsigned u_ = __builtin_bit_cast(unsigned, m_); const auto rr = __builtin_amdgcn_permlane32_swap(u_, u_, false, false); m_ = __builtin_fmaxf(__builtin_bit_cast(float, (unsigned)rr[0]), __builtin_bit_cast(float, (unsigned)rr[1])); }
      const float dl = __builtin_fmaxf(m_, -64.f); mhat += dl;
#pragma unroll
      for (int r = 0; r < 16; ++r) { pA0[r] = fast_exp2(pA0[r] - dl); pA1[r] = fast_exp2(pA1[r] - dl); } }
    ATT_WAIT_BAR(0);
    if (3 < NT) DMA_K(3, 0); if (1 < NT) DMA_V(1, SLOTB);
    ROT();
    kload8f(kf, kp0 + sl_cur);
    ATT_WAIT_BAR(2);
    s16x4 vlo[8], vhi[8]; v4u pw0, pw1, pw2, pw3;
#define SBAR() __builtin_amdgcn_sched_barrier(0)
#define PKW(P, B) cvtpk_s(P[B], P[B + 1])
#define PAF(k) __builtin_bit_cast(bf16x8, pw##k)
#define VFR(i) (bf16x8){vlo[i][0], vlo[i][1], vlo[i][2], vlo[i][3], vhi[i][0], vhi[i][1], vhi[i][2], vhi[i][3]}
#define PIN(x) asm volatile("" : "+v"(x))
#define MX3(a, b, c) __builtin_fmaxf(__builtin_fmaxf((a), (b)), (c))
#define GAPA(MF, A0, A1, A2, A3, W0, W1, PW) do { MF; sacc += A0; sacc += A1; sacc += A2; sacc += A3; PIN(sacc); W0; W1; PIN(PW); SBAR(); } while (0)
#define EX(v) __builtin_amdgcn_exp2f(v)
#define GAPB(MF, X, B) do { MF; X[B] = EX(X[B]); X[B + 1] = EX(X[B + 1]); X[B + 2] = EX(X[B + 2]); X[B + 3] = EX(X[B + 3]); PIN(X); SBAR(); } while (0)
#define VRD(i) do { vlo[i] = vtr(vp_ + (((i) >> 2) * 4096 + ((i) & 3) * 1024)); vhi[i] = vtr(vp_ + (((i) >> 2) * 4096 + ((i) & 3) * 1024 + 512)); } while (0)
#define KRD(G, j) do { if (G) { kload2f(kf, kp0 + sl_next, j); SBAR(); } } while (0)
#define STEP(C0, C1, P0, P1, t, GK, GV, GL, NEARH) do { SBAR(); \
    const LAS char* vp_ = vp0 + sl_prev; const f32x16 cin_ = CIN(t); \
    VRD(0); SBAR(); float sacc = (P0[0] + P0[1]); \
    GAPA(C0 = __builtin_amdgcn_mfma_f32_32x32x16_bf16(kf[0], qr[0], cin_, 0, 0, 0), P0[2], P0[3], P0[4], P0[5],     pw0[0] = PKW(P0, 0), pw0[1] = PKW(P0, 2), pw0); \
    VRD(4); SBAR(); GAPA(C1 = __builtin_amdgcn_mfma_f32_32x32x16_bf16(kf[1], qr[0], cin_, 0, 0, 0), P0[6], P0[7], P0[8], P0[9],     pw0[2] = PKW(P0, 4), pw0[3] = PKW(P0, 6), pw0); \
    VRD(1); SBAR(); GAPA(C0 = __builtin_amdgcn_mfma_f32_32x32x16_bf16(kf[2], qr[1], C0, 0, 0, 0),   P0[10], P0[11], P0[12], P0[13], pw1[0] = PKW(P0, 8), pw1[1] = PKW(P0, 10), pw1); \
    VRD(5); SBAR(); GAPA(C1 = __builtin_amdgcn_mfma_f32_32x32x16_bf16(kf[3], qr[1], C1, 0, 0, 0),   P0[14], P0[15], P1[0], P1[1],   pw1[2] = PKW(P0, 12), pw1[3] = PKW(P0, 14), pw1); \
    VRD(2); SBAR(); GAPA(C0 = __builtin_amdgcn_mfma_f32_32x32x16_bf16(kf[4], qr[2], C0, 0, 0, 0),   P1[2], P1[3], P1[4], P1[5],     pw2[0] = PKW(P1, 0), pw2[1] = PKW(P1, 2), pw2); \
    VRD(6); SBAR(); GAPA(C1 = __builtin_amdgcn_mfma_f32_32x32x16_bf16(kf[5], qr[2], C1, 0, 0, 0),   P1[6], P1[7], P1[8], P1[9],     pw2[2] = PKW(P1, 4), pw2[3] = PKW(P1, 6), pw2); \
    VRD(3); SBAR(); GAPA(C0 = __builtin_amdgcn_mfma_f32_32x32x16_bf16(kf[6], qr[3], C0, 0, 0, 0),   P1[10], P1[11], P1[12], P1[13], pw3[0] = PKW(P1, 8), pw3[1] = PKW(P1, 10), pw3); \
    VRD(7); SBAR(); GAPA(C1 = __builtin_amdgcn_mfma_f32_32x32x16_bf16(kf[7], qr[3], C1, 0, 0, 0),   P1[14], P1[15], 0.f, 0.f,       pw3[2] = PKW(P1, 12), pw3[3] = PKW(P1, 14), pw3); \
    l_reg += sacc; \
    if (GK) { DMA_K((t) + 3, sl_cur); } if (GV) { DMA_V((t) + 1, sl_next); } \
    if (NEARH) NEARB(C0, C1, t); \
    { float a = MX3(C0[0], C0[1], C1[0]), bq = MX3(C0[2], C0[3], C1[1]); a = MX3(a, C1[2], C1[3]); \
      _Pragma("unroll") for (int r = 4; r < 16; r += 4) { a = MX3(a, C0[r], C0[r + 1]); bq = MX3(bq, C0[r + 2], C0[r + 3]); a = MX3(a, C1[r], C1[r + 1]); bq = MX3(bq, C1[r + 2], C1[r + 3]); } \
      float rm = __builtin_fmaxf(a, bq); { const unsigned u_ = __builtin_bit_cast(unsigned, rm); const auto rr = __builtin_amdgcn_permlane32_swap(u_, u_, false, false); rm = __builtin_fmaxf(__builtin_bit_cast(float, (unsigned)rr[0]), __builtin_bit_cast(float, (unsigned)rr[1])); } \
      resc = false; \
      if (__builtin_expect(__any(rm > 8.0f), 0)) { const float dl = __builtin_fmaxf(rm, 0.f); mhat += dl; \
        _Pragma("unroll") for (int r = 0; r < 16; ++r) { C0[r] -= dl; C1[r] -= dl; } \
        const float f = __builtin_amdgcn_exp2f(-dl); l_reg *= f; if (hi == 0) wsf[r32] = f; resc = true; } } \
    SBAR(); \
    GAPB(o[0] = __builtin_amdgcn_mfma_f32_32x32x16_bf16(PAF(0), VFR(0), o[0], 0, 0, 0), C0, 0); \
    GAPB(o[1] = __builtin_amdgcn_mfma_f32_32x32x16_bf16(PAF(0), VFR(4), o[1], 0, 0, 0), C0, 4); \
    KRD(GL, 0); GAPB(o[0] = __builtin_amdgcn_mfma_f32_32x32x16_bf16(PAF(1), VFR(1), o[0], 0, 0, 0), C0, 8); \
    KRD(GL, 1); GAPB(o[1] = __builtin_amdgcn_mfma_f32_32x32x16_bf16(PAF(1), VFR(5), o[1], 0, 0, 0), C0, 12); \
    KRD(GL, 2); GAPB(o[0] = __builtin_amdgcn_mfma_f32_32x32x16_bf16(PAF(2), VFR(2), o[0], 0, 0, 0), C1, 0); \
    KRD(GL, 3); GAPB(o[1] = __builtin_amdgcn_mfma_f32_32x32x16_bf16(PAF(2), VFR(6), o[1], 0, 0, 0), C1, 4); \
    GAPB(o[0] = __builtin_amdgcn_mfma_f32_32x32x16_bf16(PAF(3), VFR(3), o[0], 0, 0, 0), C1, 8); \
    GAPB(o[1] = __builtin_amdgcn_mfma_f32_32x32x16_bf16(PAF(3), VFR(7), o[1], 0, 0, 0), C1, 12); \
    } while (0)
    int t = 1;
    for (; t + 7 < NT; t += 2) {
        STEP(pB0, pB1, pA0, pA1, t, true, true, true, false);     ATT_WAIT_BAR(2); RESC(); ROT();
        STEP(pA0, pA1, pB0, pB1, t + 1, true, true, true, false); ATT_WAIT_BAR(2); RESC(); ROT();
    }
#define ENDW(tt) do { if ((tt) + 3 < NT) { ATT_WAIT_BAR(2); } else if ((tt) + 2 < NT) { ATT_WAIT_BAR(1); } else { ATT_WAIT_BAR(0); } } while (0)
    for (; t + 1 < NT; t += 2) {
        STEP(pB0, pB1, pA0, pA1, t, (t + 3 < NT), (t + 1 < NT), (t + 1 < NT), true);           ENDW(t);     RESC(); ROT();
        STEP(pA0, pA1, pB0, pB1, t + 1, (t + 4 < NT), (t + 2 < NT), (t + 2 < NT), true);       ENDW(t + 1); RESC(); ROT();
    }
    STEP(pB0, pB1, pA0, pA1, NT - 1, false, false, false, true); RESC();
    { float sacc = pB0[0] + pB0[1];
#pragma unroll
      for (int r = 2; r < 16; ++r) sacc += pB0[r];
#pragma unroll
      for (int r = 0; r < 16; ++r) sacc += pB1[r];
      l_reg += sacc;
      pw0 = (v4u){PKW(pB0, 0), PKW(pB0, 2), PKW(pB0, 4), PKW(pB0, 6)}; pw1 = (v4u){PKW(pB0, 8), PKW(pB0, 10), PKW(pB0, 12), PKW(pB0, 14)}; pw2 = (v4u){PKW(pB1, 0), PKW(pB1, 2), PKW(pB1, 4), PKW(pB1, 6)}; pw3 = (v4u){PKW(pB1, 8), PKW(pB1, 10), PKW(pB1, 12), PKW(pB1, 14)};
      SBAR(); pv(o, (int)(lds0 + L_V) + ((lane >> 4) & 1) * 32 + (lane & 3) * 8 + (4 * hi + ((lane & 15) >> 2)) * 64 + sl_cur, PAF(0), PAF(1), PAF(2), PAF(3)); }
    { const unsigned u_ = __builtin_bit_cast(unsigned, l_reg); const auto rr = __builtin_amdgcn_permlane32_swap(u_, u_, false, false); l_reg = __builtin_bit_cast(float, (unsigned)rr[0]) + __builtin_bit_cast(float, (unsigned)rr[1]); }
    if (hi == 0) wsf[32 + r32] = l_reg; LDS_WAIT();
    float rli[16];
#pragma unroll
    for (int r = 0; r < 16; ++r) rli[r] = fast_rcp(wsf[32 + crow(r, hi)]);
    bf16* Ow = O + (rowbase + q0 + wid * 32) * PITCH + h * HD;
    { LAS bf16* stg = (LAS bf16*)(shm + L_OST) + wid * 2048;
#pragma unroll
        for (int r = 0; r < 16; ++r) { const int orow = crow(r, hi);
#pragma unroll
            for (int d0 = 0; d0 < 2; ++d0) stg[orow * 64 + d0 * 32 + r32] = (bf16)f2bf(o[d0][r] * rli[r]); }
        LDS_WAIT();
#pragma unroll
        for (int i = 0; i < 4; ++i) { const int row = i * 8 + (lane >> 3), ch = lane & 7; const v4u v = *(const LAS v4u*)(stg + row * 64 + ch * 8); *(v4u*)(Ow + (long)row * PITCH + ch * 8) = v; } }
    asm volatile("s_waitcnt lgkmcnt(0)\n\ts_barrier" ::: "memory");
#undef DMA_K
#undef DMA_V
#undef CIN
#undef FUT
#undef NEARB
#undef RESC
#undef ROT
#undef SBAR
#undef PKW
#undef PAF
#undef VFR
#undef PIN
#undef MX3
#undef GAPA
#undef EX
#undef GAPB
#undef VRD
#undef KRD
#undef STEP
#undef ENDW
}
}

struct Args { const float* in[20]; float* out; unsigned char* ws; int ph_lo, ph_hi; };
struct Frame {
    LAS unsigned char* lds; gu32* ctl; int tid, lane, wave, vcu, G;
};
#define FRESH(F) do { (F).tid = otid(); (F).lane = (F).tid & 63; (F).wave = __builtin_amdgcn_readfirstlane((F).tid >> 6); } while (0)
__device__ __forceinline__ float wave_sum(float v, int lane) {
#pragma unroll
    for (int o = 1; o < 64; o <<= 1) v += shx(v, o, lane);
    return v;
}
__device__ __forceinline__ void transpose_item(const float* W, int K, int N, bf16* WT, int mode, LAS float* scr, int item, int lane) {
    const int nblk = N / 32, kb = item / nblk, nb = item % nblk, k0 = 64 * kb, n0 = 32 * nb;
    const int rbase = (mode == 0) ? n0 : (256 * (n0 >> 7) + (n0 & 127) + (mode == 2 ? 128 : 0));
    { float tv[32];
#pragma unroll
      for (int i = 0; i < 32; ++i) tv[i] = W[(size_t)(k0 + 2 * i + (lane >> 5)) * N + n0 + (lane & 31)];
#pragma unroll
      for (int i = 0; i < 32; ++i) scr[(2 * i + (lane >> 5)) * 33 + (lane & 31)] = tv[i]; }
    LDS_WAIT(); asm volatile("" ::: "memory");
    const int c = lane & 7;
#pragma unroll
    for (int j = 0; j < 4; ++j) { const int n = (lane >> 3) + 8 * j; const LAS float* s = scr + (8 * c) * 33 + n;
        v4u o; o.x = pk2(s[0 * 33], s[1 * 33]); o.y = pk2(s[2 * 33], s[3 * 33]); o.z = pk2(s[4 * 33], s[5 * 33]); o.w = pk2(s[6 * 33], s[7 * 33]);
        *(GAS v4u*)(WT + (size_t)(rbase + n) * K + k0 + 8 * c) = o; }
    LDS_WAIT(); asm volatile("" ::: "memory");
}

__device__ __forceinline__ unsigned pk4_i8(float a, float b, float c, float d) { const int ia = (int)__builtin_rintf(a), ib = (int)__builtin_rintf(b), ic = (int)__builtin_rintf(c), id = (int)__builtin_rintf(d);
    return (unsigned)(ia & 0xff) | ((unsigned)(ib & 0xff) << 8) | ((unsigned)(ic & 0xff) << 16) | ((unsigned)(id & 0xff) << 24); }
template <bool I8>
__device__ __forceinline__ void transpose_item8w(const float* W, int K, int N, unsigned char* WT, int mode, float scale, LAS float* scr, int item, int lane) {
    const int nblk = N / 32, kb = item / nblk, nb = item % nblk, k0 = 128 * kb, n0 = 32 * nb;
    const int rbase = (mode == 0) ? n0 : (256 * (n0 >> 7) + (n0 & 127) + (mode == 2 ? 128 : 0));
    { float tv[64];
#pragma unroll
      for (int i = 0; i < 64; ++i) tv[i] = W[(size_t)(k0 + 2 * i + (lane >> 5)) * N + n0 + (lane & 31)];
#pragma unroll
      for (int i = 0; i < 64; ++i) scr[(2 * i + (lane >> 5)) * 33 + (lane & 31)] = tv[i]; }
    LDS_WAIT(); asm volatile("" ::: "memory");
    const int c = (lane & 3) + 4 * (lane >> 5);
#pragma unroll
    for (int j = 0; j < 4; ++j) { const int n = ((lane >> 2) & 7) + 8 * j; const LAS float* sp = scr + (16 * c) * 33 + n; v4u o;
        if (I8) { o.x = pk4_i8(sp[0 * 33] * scale, sp[1 * 33] * scale, sp[2 * 33] * scale, sp[3 * 33] * scale); o.y = pk4_i8(sp[4 * 33] * scale, sp[5 * 33] * scale, sp[6 * 33] * scale, sp[7 * 33] * scale);
                  o.z = pk4_i8(sp[8 * 33] * scale, sp[9 * 33] * scale, sp[10 * 33] * scale, sp[11 * 33] * scale); o.w = pk4_i8(sp[12 * 33] * scale, sp[13 * 33] * scale, sp[14 * 33] * scale, sp[15 * 33] * scale); }
        else { o.x = pk4_fp8(sp[0 * 33] * scale, sp[1 * 33] * scale, sp[2 * 33] * scale, sp[3 * 33] * scale); o.y = pk4_fp8(sp[4 * 33] * scale, sp[5 * 33] * scale, sp[6 * 33] * scale, sp[7 * 33] * scale);
               o.z = pk4_fp8(sp[8 * 33] * scale, sp[9 * 33] * scale, sp[10 * 33] * scale, sp[11 * 33] * scale); o.w = pk4_fp8(sp[12 * 33] * scale, sp[13 * 33] * scale, sp[14 * 33] * scale, sp[15 * 33] * scale); }
        *(GAS v4u*)(WT + (size_t)(rbase + n) * K + k0 + 16 * c) = o; }
    LDS_WAIT(); asm volatile("" ::: "memory");
}

__device__ __forceinline__ void copy_i8_strip(const float* W, int N, unsigned char* WT, int mode, float* wcs, int nb, LAS unsigned char* lds, int wave, int lane) {
    LAS float* scr = (LAS float*)(lds + wave * 16896); LAS float* CM = (LAS float*)(lds + 8 * 16896);
    const int n0 = 32 * nb, k0 = 128 * wave;
    const int rbase = (mode == 0) ? n0 : (256 * (n0 >> 7) + (n0 & 127) + (mode == 2 ? 128 : 0));
    float cm = 0.f;
    { float tv[64];
#pragma unroll
      for (int i = 0; i < 64; ++i) tv[i] = W[(size_t)(k0 + 2 * i + (lane >> 5)) * N + n0 + (lane & 31)];
#pragma unroll
      for (int i = 0; i < 64; ++i) { cm = fmaxf(cm, fabsf(tv[i])); scr[(2 * i + (lane >> 5)) * 33 + (lane & 31)] = tv[i]; } }
    { const unsigned u_ = __builtin_bit_cast(unsigned, cm); const auto rr = __builtin_amdgcn_permlane32_swap(u_, u_, false, false); cm = fmaxf(__builtin_bit_cast(float, (unsigned)rr[0]), __builtin_bit_cast(float, (unsigned)rr[1])); }
    if (lane < 32) CM[wave * 32 + lane] = cm;
    __syncthreads();
    float ca = 0.f;
#pragma unroll
    for (int w = 0; w < 8; ++w) ca = fmaxf(ca, CM[w * 32 + (lane & 31)]);
    ca = fmaxf(ca, 1e-30f);
    if (wave == 0 && lane < 32) wcs[rbase + lane] = ca * (1.0f / 127.0f);
    const int c = (lane & 3) + 4 * (lane >> 5);
#pragma unroll
    for (int j = 0; j < 4; ++j) { const int n = ((lane >> 2) & 7) + 8 * j; const LAS float* sp = scr + (16 * c) * 33 + n; v4u o;
        const float inv = 127.0f / __builtin_bit_cast(float, __builtin_amdgcn_ds_bpermute(n << 2, __builtin_bit_cast(int, ca)));
        o.x = pk4_i8(sp[0 * 33] * inv, sp[1 * 33] * inv, sp[2 * 33] * inv, sp[3 * 33] * inv); o.y = pk4_i8(sp[4 * 33] * inv, sp[5 * 33] * inv, sp[6 * 33] * inv, sp[7 * 33] * inv);
        o.z = pk4_i8(sp[8 * 33] * inv, sp[9 * 33] * inv, sp[10 * 33] * inv, sp[11 * 33] * inv); o.w = pk4_i8(sp[12 * 33] * inv, sp[13 * 33] * inv, sp[14 * 33] * inv, sp[15 * 33] * inv);
        *(GAS v4u*)(WT + (size_t)(rbase + n) * 1024 + k0 + 16 * c) = o; }
    __syncthreads();
}

struct RowArgs { const void* xin; void* xout;
                  const bf16* Y; const float2* tokw_in; const float* gpost; const float* gate; const float* gpre; const float* shift; const float* scale; bf16* H; float* hscale;
                 const float* wrouter; int* lists; float2* tokw_out; unsigned* cnt; };
template <bool HAS_Y, bool PAIR, bool WRITE_H, bool ROUTER, int HMODE, bool XIN16, bool XOUT16>
__device__ __forceinline__ void row_phase(Frame& F, const void* a_xin, void* a_xout, const bf16* a_Y, const float2* a_tokw_in, const float* a_gpost, const float* a_gate, const float* a_gpre, const float* a_shift, const float* a_scale,
                                          bf16* a_H, float* a_hscale, const float* a_wrouter, int* a_lists, float2* a_tokw_out, unsigned* a_cnt) {
    FRESH(F);
    const int lane = F.lane; const int gw = F.vcu * NWAVES + F.wave; const int rows_per_wave = M / (F.G * NWAVES);
    const int m0 = gw * rows_per_wave; const int b = (F.vcu * NWAVES * rows_per_wave) / SEQ;
    LAS float* wr = (LAS float*)F.lds;
    LAS float* vec = (LAS float*)(F.lds + 32768);
    int my_e0 = -1, my_e1 = -1; float my_w0 = 0.f, my_w1 = 0.f;
    f32x4 rx[4]; v2u rx16[4], ry0[4], ry1[4]; float2 rw = make_float2(0.f, 0.f);
#define ROW_LOAD(mm) do { _Pragma("unroll") for (int j = 0; j < 4; ++j) { \
        if constexpr (XIN16) rx16[j] = *(const v2u*)((const bf16*)a_xin + (size_t)(mm) * D + 256 * j + 4 * lane); else rx[j] = *(const f32x4*)((const float*)a_xin + (size_t)(mm) * D + 256 * j + 4 * lane); \
        if constexpr (HAS_Y) { if (MK_Y8 && PAIR) { const unsigned char* y8_ = (const unsigned char*)a_Y; \
                                   if constexpr (PAIR) { ry0[j].x = *(const unsigned*)(y8_ + (size_t)(2 * (mm)) * D + 256 * j + 4 * lane); ry1[j].x = *(const unsigned*)(y8_ + (size_t)(2 * (mm) + 1) * D + 256 * j + 4 * lane); } \
                                   else ry0[j].x = *(const unsigned*)(y8_ + (size_t)(mm) * D + 256 * j + 4 * lane); } \
                               else if constexpr (PAIR) { ry0[j] = *(const v2u*)(a_Y + (size_t)(2 * (mm)) * D + 256 * j + 4 * lane); ry1[j] = *(const v2u*)(a_Y + (size_t)(2 * (mm) + 1) * D + 256 * j + 4 * lane); } \
                               else ry0[j] = *(const v2u*)(a_Y + (size_t)(mm) * D + 256 * j + 4 * lane); } } \
        if constexpr (HAS_Y && PAIR) rw = a_tokw_in[(mm)]; } while (0)
    ROW_LOAD(m0);
    if constexpr (ROUTER) { for (int i = F.tid; i < D * NE / 4; i += NTHREADS) { const f32x4 v = ((const f32x4*)a_wrouter)[i]; const int col = i >> 1, e0 = (i & 1) * 4;
            wr[(e0 + 0) * D + col] = v.x; wr[(e0 + 1) * D + col] = v.y; wr[(e0 + 2) * D + col] = v.z; wr[(e0 + 3) * D + col] = v.w; } }
    for (int i = F.tid; i < D; i += NTHREADS) {
        if (HAS_Y) { vec[i] = a_gpost[i]; vec[D + i] = a_gate[(size_t)b * NMOD + i]; }
        if (WRITE_H) { vec[2 * D + i] = a_gpre[i]; vec[3 * D + i] = a_shift[(size_t)b * NMOD + i]; vec[4 * D + i] = a_scale[(size_t)b * NMOD + i] + 1.0f; } }
    __syncthreads();
    for (int i = 0; i < rows_per_wave; ++i) { const int m = m0 + i;
        f32x4 x[4];
#pragma unroll
        for (int j = 0; j < 4; ++j) { if constexpr (XIN16) x[j] = (f32x4){bf_lo(rx16[j].x), bf_hi(rx16[j].x), bf_lo(rx16[j].y), bf_hi(rx16[j].y)}; else x[j] = rx[j]; }
        f32x4 y[4];
        if constexpr (HAS_Y) {
            if constexpr (PAIR) { const float2 w = rw;
#pragma unroll
                for (int j = 0; j < 4; ++j) { const v2u u0 = ry0[j], u1 = ry1[j];
                    if (MK_Y8) { const f32x2 a0 = __builtin_amdgcn_cvt_pk_f32_fp8((int)u0.x, false), a1 = __builtin_amdgcn_cvt_pk_f32_fp8((int)u0.x, true), b0 = __builtin_amdgcn_cvt_pk_f32_fp8((int)u1.x, false), b1 = __builtin_amdgcn_cvt_pk_f32_fp8((int)u1.x, true);
                        y[j] = (f32x4){w.x * a0.x + w.y * b0.x, w.x * a0.y + w.y * b0.y, w.x * a1.x + w.y * b1.x, w.x * a1.y + w.y * b1.y}; }
                    else y[j] = (f32x4){w.x * bf_lo(u0.x) + w.y * bf_lo(u1.x), w.x * bf_hi(u0.x) + w.y * bf_hi(u1.x), w.x * bf_lo(u0.y) + w.y * bf_lo(u1.y), w.x * bf_hi(u0.y) + w.y * bf_hi(u1.y)}; }
            } else {
#pragma unroll
                for (int j = 0; j < 4; ++j) { const v2u u0 = ry0[j];
                    y[j] = (f32x4){bf_lo(u0.x), bf_hi(u0.x), bf_lo(u0.y), bf_hi(u0.y)}; }
            }
        }
        if (i + 1 < rows_per_wave) ROW_LOAD(m + 1);
        if constexpr (HAS_Y) {
            float s = 0.f;
#pragma unroll
            for (int j = 0; j < 4; ++j) s += (y[j].x * y[j].x + y[j].y * y[j].y) + (y[j].z * y[j].z + y[j].w * y[j].w);
            const float rstd = 1.0f / sqrtf(wave_sum(s, lane) * (1.0f / D) + EPS);
#pragma unroll
            for (int j = 0; j < 4; ++j) { const f32x4 gp = *(const LAS f32x4*)(vec + 256 * j + 4 * lane), gt = *(const LAS f32x4*)(vec + D + 256 * j + 4 * lane);
                x[j] = x[j] + gt * ((y[j] * rstd) * gp);
                if constexpr (XOUT16) { v2u o; o.x = pk2(x[j].x, x[j].y); o.y = pk2(x[j].z, x[j].w); *(v2u*)((bf16*)a_xout + (size_t)m * D + 256 * j + 4 * lane) = o; }
                else *(f32x4*)((float*)a_xout + (size_t)m * D + 256 * j + 4 * lane) = x[j]; }
        }
        if constexpr (WRITE_H) {
            float s = 0.f;
#pragma unroll
            for (int j = 0; j < 4; ++j) s += (x[j].x * x[j].x + x[j].y * x[j].y) + (x[j].z * x[j].z + x[j].w * x[j].w);
            const float rstd = 1.0f / sqrtf(wave_sum(s, lane) * (1.0f / D) + EPS);
#pragma unroll
            for (int j = 0; j < 4; ++j) { const f32x4 gp = *(const LAS f32x4*)(vec + 2 * D + 256 * j + 4 * lane), sh = *(const LAS f32x4*)(vec + 3 * D + 256 * j + 4 * lane), sc = *(const LAS f32x4*)(vec + 4 * D + 256 * j + 4 * lane);
                x[j] = ((x[j] * rstd) * gp) * sc + sh; }
            if constexpr (HMODE == 2) {
                float am = 0.f;
#pragma unroll
                for (int j = 0; j < 4; ++j) am = fmaxf(fmaxf(am, fmaxf(fabsf(x[j].x), fabsf(x[j].y))), fmaxf(fabsf(x[j].z), fabsf(x[j].w)));
#pragma unroll
                for (int o = 1; o < 64; o <<= 1) am = fmaxf(am, shx(am, o, lane));
                am = fmaxf(am, 1e-30f); const float inv = 127.0f / am;
                if (lane == 0) a_hscale[m] = am * (1.0f / 127.0f);
#pragma unroll
                for (int j = 0; j < 4; ++j) *(unsigned*)((unsigned char*)a_H + (size_t)m * D + 256 * j + 4 * lane) = pk4_i8(x[j].x * inv, x[j].y * inv, x[j].z * inv, x[j].w * inv);
            } else {
#pragma unroll
            for (int j = 0; j < 4; ++j) {
                if constexpr (HMODE == 1) { *(unsigned*)((unsigned char*)a_H + (size_t)m * D + 256 * j + 4 * lane) = pk4_fp8(x[j].x, x[j].y, x[j].z, x[j].w); }
                else { v2u o; o.x = pk2(x[j].x, x[j].y); o.y = pk2(x[j].z, x[j].w); *(v2u*)(a_H + (size_t)m * D + 256 * j + 4 * lane) = o; } } }
            if constexpr (ROUTER) {
                float lg[NE];
#pragma unroll
                for (int e = 0; e < NE; ++e) lg[e] = 0.f;
#pragma unroll
                for (int j = 0; j < 4; ++j) {
#pragma unroll
                    for (int e = 0; e < NE; ++e) { const f32x4 w = *(const LAS f32x4*)(wr + e * D + 256 * j + 4 * lane);
                        lg[e] += (x[j].x * w.x + x[j].y * w.y) + (x[j].z * w.z + x[j].w * w.w); }
                    asm volatile("" ::: "memory"); }
#pragma unroll
                for (int e = 0; e < NE; ++e) lg[e] = wave_sum(lg[e], lane);
                int e0 = 0; float v0 = lg[0];
#pragma unroll
                for (int e = 1; e < NE; ++e) if (lg[e] > v0) { v0 = lg[e]; e0 = e; }
                int e1 = -1; float v1 = -INFINITY;
#pragma unroll
                for (int e = 0; e < NE; ++e) if (e != e0 && lg[e] > v1) { v1 = lg[e]; e1 = e; }
                const float t = fast_exp2((v1 - v0) * LOG2E); const float w0 = 1.0f / (1.0f + t), w1 = t / (1.0f + t);
                if (lane == i) { my_e0 = e0; my_e1 = e1; my_w0 = w0; my_w1 = w1; }
            }
        }
    }
    if constexpr (ROUTER) {
        const bool act = lane < rows_per_wave; int pos0 = 0, pos1 = 0;
        const unsigned long long lt = (1ull << lane) - 1ull;
#pragma unroll
        for (int e = 0; e < NE; ++e) { const unsigned long long b0 = __ballot(act && my_e0 == e), b1 = __ballot(act && my_e1 == e);
            const int n0 = __popcll(b0), n1 = __popcll(b1); int base = 0;
            if (n0 + n1 > 0) { if (lane == 0) base = (int)__hip_atomic_fetch_add(a_cnt + 64 * e, (unsigned)(n0 + n1), RLX_AGENT); base = __builtin_amdgcn_readfirstlane(base); }
            if (act && my_e0 == e) pos0 = base + __popcll(b0 & lt);
            if (act && my_e1 == e) pos1 = base + n0 + __popcll(b1 & lt); }
        if (act) { const int m = m0 + lane; a_lists[my_e0 * M + pos0] = 2 * m; a_lists[my_e1 * M + pos1] = 2 * m + 1; a_tokw_out[m] = make_float2(my_w0, my_w1); }
    }
    __syncthreads();
}

#undef ROW_LOAD
template <class Sched>
__device__ __forceinline__ void moe_tables(Frame& F, const Sched& S, const int* lists, int panel0) {
    FRESH(F);
    LAS int* seg = (LAS int*)(F.lds + LDS_SEG); LAS unsigned short* tok = (LAS unsigned short*)(F.lds + LDS_TOK);
    if (F.tid < NE) seg[16 + F.tid] = (int)__hip_atomic_load((unsigned*)(F.ctl + CW_CNT + 64 * F.tid), RLX_AGENT);
    __syncthreads();
    if (F.tid == 0) { int acc = 0;
        for (int e = 0; e < NE; ++e) { seg[e] = acc; acc += (seg[16 + e] + 255) & ~255; }
        seg[8] = acc; }
    __syncthreads();
    Sched S2 = S; S2.c = obid(); pg8::Unit u;
#pragma unroll 1
    for (int ui = F.wave; ui < LDS_TOK_UNITS; ui += NWAVES) {
        if (!S2.next(ui, u)) break;
        const int prow = (panel0 + u.pm) * 256; int e = 0;
#pragma unroll
        for (int j = 1; j < NE; ++j) e += (prow >= seg[j]) ? 1 : 0;
        const int pos0 = prow - seg[e], cnt_e = seg[16 + e]; int v[4];
#pragma unroll
        for (int j = 0; j < 4; ++j) { const int pos = pos0 + F.lane + 64 * j; v[j] = (pos < cnt_e) ? lists[e * M + pos] : 0; }
#pragma unroll
        for (int j = 0; j < 4; ++j) tok[ui * 256 + F.lane + 64 * j] = (unsigned short)v[j];
    }
    __syncthreads();
}

constexpr int PH_LAYER0 = 3, PH_STRIDE = 16, PH_END = PH_LAYER0 + 2 * PH_STRIDE;
__global__ void __launch_bounds__(NTHREADS, 2) mega_fwd(Args args) {
    extern __shared__ __attribute__((aligned(16))) unsigned char lds_raw[];
    Frame F; F.lds = (LAS unsigned char*)lds_raw; F.tid = threadIdx.x; F.lane = F.tid & 63; F.wave = __builtin_amdgcn_readfirstlane(F.tid >> 6);
    F.G = gridDim.x; { const int bx = blockIdx.x; F.vcu = (F.G % 8 == 0) ? (bx % 8) * (F.G / 8) + bx / 8 : bx; }
    unsigned char* ws = args.ws; F.ctl = (gu32*)(ws + WS_CTL);
    volatile LAS unsigned* MISC = (volatile LAS unsigned*)(F.lds + LDS_MISC);
    if (F.tid < 16) MISC[F.tid] = 0u;
    __syncthreads();
    XcdBarrier bar; bar.bar = (unsigned*)(F.ctl + CW_BAR); bar.x = 0; bar.st = nullptr;
    if (MK_ONE_LAUNCH) bar = xcd_barrier_post((unsigned*)(F.ctl + CW_BAR), MISC);
    const int lo = args.ph_lo, hi = args.ph_hi;
#define IN(k) (lo <= (k) && (k) < hi)
#define SEAM(k, knext) do { if (IN(k) && IN(knext)) xcd_barrier(bar); } while (0)
    const float* x_in = args.in[0]; const float* c_in = args.in[1]; const float* w_mod = args.in[2]; const float* b_mod = args.in[3];
    const float* g_mix_pre = args.in[4]; const float* g_mix_post = args.in[5]; const float* g_ffn_pre = args.in[6]; const float* g_ffn_post = args.in[7];
    const float* w_in = args.in[8]; const float* w_psb = args.in[9]; const float* w_pmb = args.in[10]; const float* w_out = args.in[11]; const float* rel_bias = args.in[12];
    const float* w1d = args.in[13]; const float* w3d = args.in[14]; const float* w2d = args.in[15]; const float* w_router = args.in[16];
    const float* w1m = args.in[17]; const float* w3m = args.in[18]; const float* w2m = args.in[19];
    float* xout = args.out;
    bf16* XB1 = (bf16*)args.out; bf16* XB2 = (bf16*)args.out + (size_t)M * D; bf16* XB3 = (bf16*)(ws + WS_H + 32 * MiB);
    float* MOD = (float*)(ws + WS_MOD); int* LISTS = (int*)(ws + WS_LIST); float2* TOKW = (float2*)(ws + WS_TOKW);
    unsigned char* WIN = ws + WS_WIN; float* HSCALE = (float*)(ws + WS_HSCALE); bf16* WPSB = (bf16*)(ws + WS_WPSB); bf16* WPMB = (bf16*)(ws + WS_WPMB); bf16* WOUT = (bf16*)(ws + WS_WOUT);
    unsigned char* W13D = ws + WS_W13D; unsigned char* W2D = ws + WS_W2D; unsigned char* W13M = ws + WS_W13M; unsigned char* W2M = ws + WS_W2M;
    bf16* H = (bf16*)(ws + WS_H); bf16* BIG = (bf16*)(ws + WS_BIG);

#if defined(MK_PROBE_PRO2)
    for (int prep_ = 0; prep_ < 2; ++prep_) {
#endif
    if (!SK(0) && IN(0)) {
        FRESH(F);
        if ((int)blockIdx.x < 192) {
            LAS float* cond = (LAS float*)F.lds;
            LAS float* part = (LAS float*)(F.lds + 65536);
            { static_assert(NB * D == 32 * NTHREADS, "cond fill"); float cv[32];
#pragma unroll
              for (int t = 0; t < 32; ++t) cv[t] = c_in[F.tid + t * NTHREADS];
#pragma unroll
              for (int t = 0; t < 32; ++t) { const int i = F.tid + t * NTHREADS, bb = i / D, k = i % D; cond[k * 16 + bb] = cv[t] * sigmoidf_(cv[t]); } }
            __syncthreads();
            const int l = (int)blockIdx.x / 96, n0 = ((int)blockIdx.x % 96) * 64;
            float acc[16];
#pragma unroll
            for (int bb = 0; bb < 16; ++bb) acc[bb] = 0.f;
            const float* wp = w_mod + (size_t)l * D * NMOD + n0 + F.lane;
            float wnx[16];
#pragma unroll
            for (int j = 0; j < 16; ++j) wnx[j] = wp[(size_t)(F.wave * 128 + j) * NMOD];
#pragma unroll
            for (int k8 = 0; k8 < 128; k8 += 16) { float wv16[16];
#pragma unroll
              for (int j = 0; j < 16; ++j) wv16[j] = wnx[j];
              if (k8 + 16 < 128) {
#pragma unroll
                for (int j = 0; j < 16; ++j) wnx[j] = wp[(size_t)(F.wave * 128 + k8 + 16 + j) * NMOD]; }
#pragma unroll 4
              for (int j = 0; j < 16; ++j) { const int k = F.wave * 128 + k8 + j; const float wv = wv16[j];
                const LAS f32x4* cp = (const LAS f32x4*)(cond + k * 16); const f32x4 c0 = cp[0], c1 = cp[1], c2 = cp[2], c3 = cp[3];
                acc[0] += c0.x * wv; acc[1] += c0.y * wv; acc[2] += c0.z * wv; acc[3] += c0.w * wv; acc[4] += c1.x * wv; acc[5] += c1.y * wv; acc[6] += c1.z * wv; acc[7] += c1.w * wv;
                acc[8] += c2.x * wv; acc[9] += c2.y * wv; acc[10] += c2.z * wv; acc[11] += c2.w * wv; acc[12] += c3.x * wv; acc[13] += c3.y * wv; acc[14] += c3.z * wv; acc[15] += c3.w * wv; } }
#pragma unroll
            for (int bb = 0; bb < 16; ++bb) part[(F.wave * 16 + bb) * 64 + F.lane] = acc[bb];
            __syncthreads();
            for (int i = F.tid; i < 16 * 64; i += NTHREADS) { const int bb = i >> 6, n = i & 63; float s = b_mod[(size_t)l * NMOD + n0 + n];
#pragma unroll
                for (int w = 0; w < 8; ++w) s += part[(w * 16 + bb) * 64 + n];
                MOD[((size_t)l * NB + bb) * NMOD + n0 + n] = s; }
            __syncthreads();
            if (F.tid == 0) { __builtin_amdgcn_fence(__ATOMIC_RELEASE, "agent"); asm volatile("s_waitcnt vmcnt(0)" ::: "memory"); (void)xb_add((unsigned*)(F.ctl + CW_MODF), 1u); }
        }
    }
    if (!SK(0) && IN(1)) {
        FRESH(F);
        LAS float* scr = (LAS float*)(F.lds + F.wave * 16896);
        const int gw = F.vcu * NWAVES + F.wave, NGW = F.G * NWAVES;
        constexpr int I_IN = (D / 128) * (INCOLS / 32), I_P = (WH / 64) * (D / 32), I_O = (D / 128) * (D / 32), I_13 = (D / 128) * (FF / 32), I_2 = (FF / 128) * (D / 32);
        constexpr int N_P = 4 * I_P, N_O = 2 * I_O, N_13 = 16 * I_13, N_2 = 9 * I_2, NITEMS = N_P + N_O + N_13 + N_2; (void)I_IN;
        { constexpr int S_IN = INCOLS / 32, S_13 = FF / 32, NSTRIP = 2 * S_IN + 2 * S_13;
          float* WCS = (float*)(ws + WS_WCS);
          for (int si = F.vcu; si < NSTRIP; si += F.G) {
              const float* W_; int N_, mode_, nb_; unsigned char* WT_; float* wc_;
              if (si < 2 * S_IN) { const int l = si / S_IN; W_ = w_in + (size_t)l * D * INCOLS; N_ = INCOLS; WT_ = WIN + (size_t)l * INCOLS * D; mode_ = 0; wc_ = WCS + (size_t)l * INCOLS; nb_ = si % S_IN; }
              else { const int r_ = si - 2 * S_IN, q = r_ / S_13; W_ = q == 0 ? w1d : w3d; N_ = FF; WT_ = W13D; mode_ = 1 + q; wc_ = WCS + 16384; nb_ = r_ % S_13; }
              copy_i8_strip(W_, N_, WT_, mode_, wc_, nb_, F.lds, F.wave, F.lane); } }
        const bool freewg = MK_ONE_LAUNCH && F.G == 256 && (int)blockIdx.x >= 192;
        const int XH = (MK_ONE_LAUNCH && F.G == 256) ? MK_HEAD : 0, fw = ((int)blockIdx.x - 192) * NWAVES + F.wave, nh = freewg ? XH / (64 * NWAVES) : 0;
#pragma unroll 1
        for (int j = 0; ; ++j) {
            const int it = j < nh ? fw + j * (64 * NWAVES) : XH + gw + (j - nh) * NGW; if (it >= NITEMS) break;
            int r = it;
            if (r < N_P) { const int q = r / I_P, l = q & 1; const float* src = (q < 2 ? w_psb : w_pmb) + (size_t)l * WH * D; bf16* dst = (q < 2 ? WPSB : WPMB) + (size_t)l * D * WH; transpose_item(src, WH, D, dst, 0, scr, r % I_P, F.lane); continue; } r -= N_P;
            if (r < N_O) { const int l = r / I_O; transpose_item8w<false>(w_out + (size_t)l * D * D, D, D, (unsigned char*)WOUT + (size_t)l * D * D, 0, WO_SCALE, scr, r % I_O, F.lane); continue; } r -= N_O;
            if (r < N_13) { const int q = 2 + r / I_13; const float* src; unsigned char* dst; int mode;
                if (q < 10) { src = w1m + (size_t)(q - 2) * D * FF; dst = W13M + (size_t)(q - 2) * 2 * FF * D; mode = 1; }
                else { src = w3m + (size_t)(q - 10) * D * FF; dst = W13M + (size_t)(q - 10) * 2 * FF * D; mode = 2; }
                transpose_item8w<false>(src, D, FF, dst, mode, W13_SCALE, scr, r % I_13, F.lane); continue; } r -= N_13;
            { const int q = r / I_2; const float* src = (q == 0) ? w2d : w2m + (size_t)(q - 1) * FF * D; unsigned char* dst = (q == 0) ? W2D : W2M + (size_t)(q - 1) * D * FF; transpose_item8w<false>(src, FF, D, dst, 0, W2_SCALE, scr, r % I_2, F.lane); }
        }
    }
    if (IN(0) && IN(2) && F.tid == 0) { unsigned sp_ = 0; while (xb_ld((unsigned*)(F.ctl + CW_MODF)) < 192u) { __builtin_amdgcn_s_sleep(1); if (++sp_ > XB_SPIN_CAP) break; }
        __builtin_amdgcn_fence(__ATOMIC_ACQUIRE, "agent"); asm volatile("s_waitcnt vmcnt(0)" ::: "memory"); }
    __syncthreads();
    if (!SK(1) && IN(2)) {
        RowArgs a{}; a.xin = x_in; a.gpre = g_mix_pre; a.shift = MOD + 0 * D; a.scale = MOD + 1 * D; a.H = H; a.hscale = HSCALE;
        row_phase<false, false, true, false, 2, false, false>(F, a.xin, a.xout, a.Y, a.tokw_in, a.gpost, a.gate, a.gpre, a.shift, a.scale, a.H, a.hscale, a.wrouter, a.lists, a.tokw_out, a.cnt);
    }
    SEAM(2, PH_LAYER0);
#if defined(MK_PROBE_BAR)
    for (int rep_ = 0; rep_ < MK_PROBE_BAR; ++rep_) xcd_barrier(bar);
#endif
#if defined(MK_PROBE_PRO2)
    }
#endif


    for (int l = 0; l < 2; ++l) {
        const int pb = PH_LAYER0 + PH_STRIDE * l;
        const float* modl = MOD + (size_t)l * NB * NMOD;
        if (!SK(2) && IN(pb + 0)) {
            pg8::SchedPlain S; S.init(M / 256, INCOLS / 256, F.G, (int)blockIdx.x); S.A = (const char*)H; S.B = (const char*)(WIN + (size_t)l * INCOLS * D); S.tA = S.tB = (size_t)256 * D;
            { FRESH(F); LAS float* rowf = (LAS float*)(F.lds + LDS_TOK); LAS float* colf = (LAS float*)(F.lds + LDS_COLF);
              const float* wcs = (const float*)(ws + WS_WCS) + (size_t)l * INCOLS;
              pg8::SchedPlain S2 = S; S2.c = obid(); pg8::Unit u;
#pragma unroll 1
              for (int ui = F.wave; ui < 15; ui += NWAVES) { if (!S2.next(ui, u)) break; float v[4], c_[4];
#pragma unroll
                  for (int j = 0; j < 4; ++j) { v[j] = HSCALE[u.pm * 256 + F.lane + 64 * j]; c_[j] = wcs[u.pn * 256 + F.lane + 64 * j]; }
#pragma unroll
                  for (int j = 0; j < 4; ++j) { rowf[ui * 256 + F.lane + 64 * j] = v[j]; colf[ui * 256 + F.lane + 64 * j] = c_[j]; } }
              __syncthreads(); }
            pg8::EpiInProj E{BIG, (const LAS float*)(F.lds + LDS_TOK), 0, (const LAS float*)(F.lds + LDS_COLF)};
#if defined(MK_SKEW_INPROJ)
            { const unsigned long long t0_ = __builtin_amdgcn_s_memrealtime(); const unsigned long long d_ = (unsigned long long)(F.vcu & 7) * MK_SKEW_INPROJ;
              while (__builtin_amdgcn_s_memrealtime() - t0_ < d_) __builtin_amdgcn_s_sleep(8); }
#endif
#if defined(MK_PROBE_INPROJ2)
            for (int rep_ = 0; rep_ < 2; ++rep_) { E.nostore = (rep_ == 1) ? MK_PROBE_INPROJ2 - 1 : 0;
#endif
            pg8::gemm_phase<pg8::EpiInProj, pg8::SchedPlain, true, 2>(F.lds, D / 2, S, E);
#if defined(MK_PROBE_INPROJ2)
            }
#endif
        }
        SEAM(pb + 0, pb + 1);
        if (!SK(3) && IN(pb + 1)) {
            bf16* QA = BIG + BIG_QA / 2; bf16* KA = BIG + BIG_KA / 2; bf16* VA = BIG + BIG_VA / 2; bf16* QB = BIG + BIG_QB / 2; bf16* KB = BIG + BIG_KB / 2; bf16* VB = BIG + BIG_VB / 2;
            for (int v = F.vcu; v < 256; v += F.G) { const int bh = v >> 1, set = v & 1;
                for (int i = 0; i < 8; ++i) { const int k = i & 3; const int qb = set == 0 ? (k == 0 ? 0 : k == 1 ? 7 : k == 2 ? 1 : 6) : (k == 0 ? 2 : k == 1 ? 5 : k == 2 ? 3 : 4);
#if defined(MK_PROBE_ATTN2)
                    const int pass0 = (i < 4) ? (MK_PROBE_ATTN2 != 3 ? 0 : 1) : (MK_PROBE_ATTN2 != 2 ? 0 : 1);
#else
                    const int pass0 = 1;
#endif
                    for (int pass = pass0; pass < 2; ++pass) {
                        if (i < 4) att::attn_unit<false>(bh >> 3, bh & 7, qb, QA, KA, VA, pass == 0 ? H : QA, rel_bias, F.lds, false);
                        else att::moba_unit2(bh >> 3, bh & 7, qb, QB, KB, VB, pass == 0 ? H : QB, rel_bias, F.lds, i == 4 && pass == pass0); } } }
        }
        SEAM(pb + 1, pb + 2);
        if (!SK(4) && IN(pb + 2)) {
            const unsigned char* GA8 = (const unsigned char*)BIG + BIG_GA; const unsigned char* GB8 = GA8 + (size_t)M * D; bf16* TM = BIG + BIG_GB / 2;
            { pg8::SchedPlain S; S.init(M / 256, D / 256, F.G, (int)blockIdx.x); S.A = (const char*)(BIG + BIG_QA / 2); S.B = (const char*)(WPSB + (size_t)l * D * WH); S.tA = S.tB = (size_t)256 * WH * 2;
              pg8::EpiGate<false> E{GA8, TM, (unsigned char*)BIG + BIG_KA}; pg8::gemm_phase<pg8::EpiGate<false>, pg8::SchedPlain, true, 0>(F.lds, WH, S, E); }
            VM_WAIT(); __syncthreads();
            { pg8::SchedPlain S; S.init(M / 256, D / 256, F.G, (int)blockIdx.x); S.A = (const char*)(BIG + BIG_QB / 2); S.B = (const char*)(WPMB + (size_t)l * D * WH); S.tA = S.tB = (size_t)256 * WH * 2;
              pg8::EpiGate<true> E{GB8, TM, (unsigned char*)BIG + BIG_KA}; pg8::gemm_phase<pg8::EpiGate<true>, pg8::SchedPlain, true, 0>(F.lds, WH, S, E); }
        }
        SEAM(pb + 2, pb + 3);
        if (!SK(5) && IN(pb + 3)) {
            pg8::SchedPlain S; S.init(M / 256, D / 256, F.G, (int)blockIdx.x); S.A = (const char*)BIG + BIG_KA; S.B = (const char*)WOUT + (size_t)l * D * D; S.tA = S.tB = (size_t)256 * D;
            pg8::EpiBf16 E{BIG + BIG_Y / 2, D, 1.0f / (WO_SCALE * MG_SCALE)};
#if defined(MK_PROBE_G3)
            for (int rep_ = 0; rep_ < ((MK_PROBE_G3 & 1) ? 2 : 1); ++rep_)
#endif
            pg8::gemm_phase<pg8::EpiBf16, pg8::SchedPlain, true, 1>(F.lds, D / 2, S, E);
        }
        SEAM(pb + 3, pb + 4);
        if (!SK(6) && IN(pb + 4)) {
            RowArgs a{}; if (l == 0) { a.xin = x_in; a.xout = XB1; } else { a.xin = XB2; a.xout = XB3; } a.Y = BIG + BIG_Y / 2; a.gpost = g_mix_post + (size_t)l * D; a.gate = modl + 2 * D;
            a.gpre = g_ffn_pre + (size_t)l * D; a.shift = modl + 3 * D; a.scale = modl + 4 * D; a.H = H;
            a.wrouter = w_router; a.lists = LISTS; a.tokw_out = TOKW; a.cnt = (unsigned*)(F.ctl + CW_CNT);
            a.hscale = HSCALE;
#if defined(MK_PROBE_ROW2)
            if (l == 0) for (int rep_ = 0; rep_ < MK_PROBE_ROW2; ++rep_)
                row_phase<true, false, true, false, 2, false, true>(F, a.xin, a.xout, a.Y, a.tokw_in, a.gpost, a.gate, a.gpre, a.shift, a.scale, a.H, a.hscale, a.wrouter, a.lists, a.tokw_out, a.cnt);
#endif
            if (l == 0) row_phase<true, false, true, false, 2, false, true>(F, a.xin, a.xout, a.Y, a.tokw_in, a.gpost, a.gate, a.gpre, a.shift, a.scale, a.H, a.hscale, a.wrouter, a.lists, a.tokw_out, a.cnt); else row_phase<true, false, true, true, 1, true, true>(F, a.xin, a.xout, a.Y, a.tokw_in, a.gpost, a.gate, a.gpre, a.shift, a.scale, a.H, a.hscale, a.wrouter, a.lists, a.tokw_out, a.cnt);
        }
        SEAM(pb + 4, pb + 5);
        if (l == 0) {
            if (!SK(7) && IN(pb + 5)) {
                pg8::SchedPlain S; S.init(M / 256, 2 * FF / 256, F.G, (int)blockIdx.x); S.A = (const char*)H; S.B = (const char*)W13D; S.tA = S.tB = (size_t)256 * D;
                { FRESH(F); LAS float* rowf = (LAS float*)(F.lds + LDS_TOK); LAS float* colf = (LAS float*)(F.lds + LDS_COLF);
                  const float* wcs = (const float*)(ws + WS_WCS) + 16384;
                  pg8::SchedPlain S2 = S; S2.c = obid(); pg8::Unit u;
#pragma unroll 1
                  for (int ui = F.wave; ui < 15; ui += NWAVES) { if (!S2.next(ui, u)) break; float v[4], c_[4];
#pragma unroll
                      for (int j = 0; j < 4; ++j) { v[j] = HSCALE[u.pm * 256 + F.lane + 64 * j]; c_[j] = wcs[u.pn * 256 + F.lane + 64 * j]; }
#pragma unroll
                      for (int j = 0; j < 4; ++j) { rowf[ui * 256 + F.lane + 64 * j] = v[j]; colf[ui * 256 + F.lane + 64 * j] = c_[j]; } }
                  __syncthreads(); }
                pg8::EpiSwiGLUi8 E{(unsigned char*)BIG + BIG_ACT, (const LAS float*)(F.lds + LDS_TOK), (const LAS float*)(F.lds + LDS_COLF)};
#if defined(MK_PROBE_G3)
                for (int rep_ = 0; rep_ < ((MK_PROBE_G3 & 2) ? 2 : 1); ++rep_)
#endif
                pg8::gemm_phase<pg8::EpiSwiGLUi8, pg8::SchedPlain, true, 2>(F.lds, D / 2, S, E);
            }
            SEAM(pb + 5, pb + 6);
            if (!SK(8) && IN(pb + 6)) {
                pg8::SchedPlain S; S.init(M / 256, D / 256, F.G, (int)blockIdx.x); S.A = (const char*)BIG + BIG_ACT; S.B = (const char*)W2D; S.tA = S.tB = (size_t)256 * FF;
                pg8::EpiBf16 E{BIG + BIG_YF / 2, D, 1.0f / W2_SCALE};
#if defined(MK_PROBE_G3)
                for (int rep_ = 0; rep_ < ((MK_PROBE_G3 & 4) ? 2 : 1); ++rep_)
#endif
                pg8::gemm_phase<pg8::EpiBf16, pg8::SchedPlain, true, 1>(F.lds, FF / 2, S, E);
            }
            SEAM(pb + 6, pb + 11);
        } else {
            for (int c = 0; c < MOE_NCHUNK; ++c) {
                const int panel0 = c * MOE_CHUNK_PANELS;
                int npan = 0;
                if (IN(pb + 5 + 2 * c) || IN(pb + 6 + 2 * c)) { int tot = 0;
                    for (int e = 0; e < NE; ++e) tot += ((int)__hip_atomic_load((unsigned*)(F.ctl + CW_CNT + 64 * e), RLX_AGENT) + 255) >> 8;
                    npan = tot - panel0; npan = npan < 0 ? 0 : (npan > MOE_CHUNK_PANELS ? MOE_CHUNK_PANELS : npan); }
                if (!SK(9) && IN(pb + 5 + 2 * c)) {
                    pg8::SchedMoeUp S; S.init(npan, 2 * FF / 256, F.G, (int)blockIdx.x); S.wsh = MK_WSH_MOEUP; S.A = (const char*)H; S.B = (const char*)W13M; S.tA = 0; S.tB = (size_t)256 * D; S.eB = (size_t)2 * FF * D;
                    S.panel0 = panel0; S.seg = (const LAS int*)(F.lds + LDS_SEG); S.tok = (const LAS unsigned short*)(F.lds + LDS_TOK);
                    moe_tables(F, S, LISTS, panel0);
                    pg8::EpiSwiGLU E{(unsigned char*)BIG + BIG_HID, 1.0f / W13_SCALE};
#if defined(MK_PROBE_MOEUP2)
                    for (int rep_ = 0; rep_ < 2; ++rep_)
#endif
                    pg8::gemm_phase<pg8::EpiSwiGLU, pg8::SchedMoeUp, true, 1>(F.lds, D / 2, S, E);
                }
                SEAM(pb + 5 + 2 * c, pb + 6 + 2 * c);
                if (!SK(10) && IN(pb + 6 + 2 * c)) {
                    pg8::SchedMoeDown S; S.init(npan, D / 256, F.G, (int)blockIdx.x); S.wsh = MK_WSH_MOEDN; S.A = (const char*)BIG + BIG_HID; S.B = (const char*)W2M; S.tA = S.tB = (size_t)256 * FF; S.eB = (size_t)D * FF;
                    S.panel0 = panel0; S.seg = (const LAS int*)(F.lds + LDS_SEG); S.tok = (const LAS unsigned short*)(F.lds + LDS_TOK);
                    int nfull = (S.nwg / F.G) * F.G, ntail = S.nwg - nfull;
                    if (F.G < 128 || ntail > 32 || !MK_SPLIT_TAIL) { nfull = S.nwg; ntail = 0; }
                    S.nwg = nfull;
                    moe_tables(F, S, LISTS, panel0);
                    pg8::EpiMoeDown E{BIG + BIG_YP / 2, (const LAS unsigned short*)(F.lds + LDS_TOK), (const LAS int*)(F.lds + LDS_SEG), 1.0f / W2_SCALE};
#if defined(MK_PROBE_MOEDOWN2)
                    for (int rep_ = 0; rep_ < 2; ++rep_)
#endif
                    pg8::gemm_phase<pg8::EpiMoeDown, pg8::SchedMoeDown, true, 1>(F.lds, FF / 2, S, E);
                    if (MK_SPLIT_TAIL) {
                        pg8::SchedMoeDownTail T; T.init(npan, D / 256, F.G, (int)blockIdx.x); T.wsh = MK_WSH_MOEDN; T.A = S.A; T.B = S.B; T.tA = S.tA; T.tB = S.tB; T.eB = S.eB; T.panel0 = panel0; T.seg = S.seg; T.tok = S.tok; T.nfull = nfull;
                        const int bx = obid(), p = (bx >> 5) * 8 + (bx & 7), sl = (bx >> 3) & 3;
                        T.pidx = (bx < 128 && p < ntail) ? p : -1;
                        const int kt0 = sl == 0 ? 0 : sl == 1 ? 8 : sl == 2 ? 14 : 22, ntk = (sl & 1) ? 6 : 8;
                        T.koff = (size_t)kt0 * 128;
                        moe_tables(F, T, LISTS, panel0);
                        pg8::EpiMoeDownTail ET{BIG + BIG_YP / 2, (const LAS unsigned short*)(F.lds + LDS_TOK), (const LAS int*)(F.lds + LDS_SEG), 1.0f / W2_SCALE, (f32x4*)(ws + WS_H), (unsigned*)(F.ctl + CW_XF), p, sl};
                        pg8::gemm_phase<pg8::EpiMoeDownTail, pg8::SchedMoeDownTail, true, 1>(F.lds, FF / 2, T, ET, ntk);
                    }
                }
                SEAM(pb + 6 + 2 * c, (c + 1 < MOE_NCHUNK) ? pb + 7 + 2 * c : pb + 11);
            }
        }
        if (!SK(11) && IN(pb + 11)) {
            RowArgs a{}; if (l == 0) { a.xin = XB1; a.xout = XB2; } else { a.xin = XB3; a.xout = xout; } a.gpost = g_ffn_post + (size_t)l * D; a.gate = modl + 5 * D; a.H = H;
            if (l == 0) { a.Y = BIG + BIG_YF / 2; a.gpre = g_mix_pre + (size_t)(l + 1) * D; a.shift = MOD + (size_t)(l + 1) * NB * NMOD + 0 * D; a.scale = MOD + (size_t)(l + 1) * NB * NMOD + 1 * D; a.hscale = HSCALE;
                row_phase<true, false, true, false, 2, true, true>(F, a.xin, a.xout, a.Y, a.tokw_in, a.gpost, a.gate, a.gpre, a.shift, a.scale, a.H, a.hscale, a.wrouter, a.lists, a.tokw_out, a.cnt); }
            else { a.Y = BIG + BIG_YP / 2; a.tokw_in = TOKW; row_phase<true, true, false, false, 0, true, false>(F, a.xin, a.xout, a.Y, a.tokw_in, a.gpost, a.gate, a.gpre, a.shift, a.scale, a.H, a.hscale, a.wrouter, a.lists, a.tokw_out, a.cnt); }
        }
        if (l == 0) SEAM(pb + 11, pb + PH_STRIDE);
    }
#undef IN
#undef SEAM
}

extern "C" void kernel_launch(void* const* d_in, const int* in_sizes, int n_in, void* d_out, int out_size, void* d_ws, size_t ws_size, hipStream_t stream) {
    static int grid = 0;
    if (grid == 0) {
        if (n_in != 20 || in_sizes[0] != M * D || out_size != M * D || ws_size < WS_END) { fprintf(stderr, "kernel_launch: unexpected shapes (n_in %d, ws %zu)\n", n_in, ws_size); grid = -1; return; }
        int dev = 0, cus = 0;
        if (hipGetDevice(&dev) != hipSuccess || hipDeviceGetAttribute(&cus, hipDeviceAttributeMultiprocessorCount, dev) != hipSuccess) { grid = -1; return; }
        if (hipFuncSetAttribute((const void*)mega_fwd, hipFuncAttributeMaxDynamicSharedMemorySize, LDS_BYTES) != hipSuccess) { fprintf(stderr, "kernel_launch: hipFuncSetAttribute failed\n"); grid = -1; return; }
        int per_cu = 0;
        if (hipOccupancyMaxActiveBlocksPerMultiprocessor(&per_cu, (const void*)mega_fwd, NTHREADS, LDS_BYTES) != hipSuccess || per_cu < 1) fprintf(stderr, "kernel_launch: occupancy query reports %d\n", per_cu);
        (void)hipGetLastError();
        grid = cus;
        if (grid != 256) { fprintf(stderr, "kernel_launch: built for 256 CUs, found %d\n", cus); grid = -1; return; }
    }
    if (grid < 0) return;
    if (hipMemsetAsync((char*)d_ws + WS_CTL, 0, CTL_ZERO_BYTES, stream) != hipSuccess) return;
    Args a{};
    for (int i = 0; i < 20; ++i) a.in[i] = (const float*)d_in[i];
    a.out = (float*)d_out; a.ws = (unsigned char*)d_ws;
#if MK_ONE_LAUNCH
    a.ph_lo = 0; a.ph_hi = PH_END;
    hipLaunchKernelGGL(mega_fwd, dim3(grid), dim3(NTHREADS), LDS_BYTES, stream, a);
#else
    for (int p = 0; p < PH_END; ++p) {
        const int rel = p < PH_LAYER0 ? -1 : (p - PH_LAYER0) % PH_STRIDE, l = p < PH_LAYER0 ? 0 : (p - PH_LAYER0) / PH_STRIDE;
        if (rel >= 0) { if (l == 0 && rel > 6 && rel != 11) continue; if (rel > 11) continue; }
        a.ph_lo = p; a.ph_hi = p + 1;
        hipLaunchKernelGGL(mega_fwd, dim3(grid), dim3(NTHREADS), LDS_BYTES, stream, a);
    }
#endif
}
```

```cpp
#include <hip/hip_runtime.h>
#include <hip/hip_bf16.h>
#include <cstdio>
#include <cstdint>
#include <cmath>

#ifndef MK_ONE_LAUNCH
#define MK_ONE_LAUNCH 1
#endif
#ifndef MK_WSH_MOEUP
#define MK_WSH_MOEUP 3
#endif
#ifndef MK_WSH_MOEDN
#define MK_WSH_MOEDN 3
#endif
#ifndef MK_OUT8
#define MK_OUT8 1
#endif
#ifndef MK_Y8
#define MK_Y8 1
#endif
#ifndef MK_SKIP
#define MK_SKIP 0
#endif
#define SK(b) ((MK_SKIP >> (b)) & 1)

#define GAS __attribute__((address_space(1)))
#define LAS __attribute__((address_space(3)))
typedef unsigned short bf16;
typedef unsigned v4u __attribute__((ext_vector_type(4)));
typedef unsigned v2u __attribute__((ext_vector_type(2)));
typedef float f32x4 __attribute__((ext_vector_type(4)));
typedef float f32x2 __attribute__((ext_vector_type(2)));
typedef float f32x16 __attribute__((ext_vector_type(16)));
typedef short bf16x8 __attribute__((ext_vector_type(8)));
typedef short s16x4 __attribute__((ext_vector_type(4)));
typedef GAS unsigned gu32;
#define RLX_AGENT __ATOMIC_RELAXED, __HIP_MEMORY_SCOPE_AGENT
#define LDS_WAIT() asm volatile("s_waitcnt lgkmcnt(0)" ::: "memory")
#define VM_WAIT() asm volatile("s_waitcnt vmcnt(0)" ::: "memory")

constexpr int NB = 16, SEQ = 2048, D = 1024, M = NB * SEQ, NH = 8, HD = 64, WH = 512, INCOLS = 5120, FF = 3584, NE = 8, NMOD = 6 * D;
constexpr float EPS = 1e-6f;
constexpr float LOG2E = 1.4426950408889634f;
constexpr float C2 = 0.125f * LOG2E;
constexpr int NWAVES = 8, NTHREADS = 512;

constexpr size_t MiB = 1u << 20;
constexpr size_t WS_CTL = 0, CTL_ZERO_BYTES = 1 * MiB;
constexpr size_t WS_MOD = 1 * MiB;
constexpr size_t WS_LIST = 2 * MiB;
constexpr size_t WS_TOKW = 3 * MiB;
constexpr size_t WS_HSCALE = 3 * MiB + 512 * 1024;
constexpr size_t WS_WCS = 3 * MiB + 768 * 1024;
constexpr size_t WS_WIN = 4 * MiB;
constexpr size_t WS_WPSB = 24 * MiB;
constexpr size_t WS_WPMB = 26 * MiB;
constexpr size_t WS_WOUT = 28 * MiB;
constexpr size_t WS_W13D = 32 * MiB;
constexpr size_t WS_W2D = 39 * MiB;
constexpr size_t WS_W13M = 43 * MiB;
constexpr size_t WS_W2M = 99 * MiB;
constexpr size_t WS_H = 127 * MiB;
constexpr size_t WS_BIG = 191 * MiB;
constexpr size_t WS_END = 605 * MiB;
constexpr float W13_SCALE = 32.f, W2_SCALE = 64.f, WO_SCALE = 32.f, MG_SCALE = 16.f;
constexpr size_t PLANE = (size_t)M * WH * 2;
constexpr size_t BIG_QA = 0, BIG_KA = PLANE, BIG_VA = 2 * PLANE, BIG_QB = 3 * PLANE, BIG_KB = 4 * PLANE, BIG_VB = 5 * PLANE, BIG_GA = 6 * PLANE, BIG_GB = 8 * PLANE;
constexpr size_t BIG_Y = 2 * PLANE;
constexpr size_t BIG_ACT = 0, BIG_YF = 112 * MiB;
constexpr int MOE_CHUNK_PANELS = 264, MOE_NCHUNK = 1;
constexpr size_t BIG_HID = 32 * MiB, BIG_YP = 264 * MiB;
static_assert(BIG_YP + (size_t)M * 2 * D * 2 <= 414 * MiB && BIG_HID + (size_t)MOE_CHUNK_PANELS * 256 * FF <= BIG_YP && BIG_YF + (size_t)M * D * 2 <= 414 * MiB, "BIG map");
constexpr int CW_TMO = 0, CW_CODE = 1, CW_BAR = 4096, CW_CNT = 16384, CW_WMAX = 20480, CW_MODF = 24576, CW_XF = 32768;

constexpr int RING_BYTES = 131072;
constexpr int LDS_TOK = RING_BYTES;
constexpr int LDS_TOK_UNITS = 30;
constexpr int LDS_SEG = LDS_TOK + LDS_TOK_UNITS * 512;
constexpr int LDS_MISC = LDS_SEG + 128;
constexpr int LDS_COLF = LDS_MISC + 64;
constexpr int LDS_BYTES = LDS_COLF + 15 * 1024;
static_assert(LDS_BYTES <= 160 * 1024, "LDS");

__device__ __forceinline__ unsigned f2bf(float f) { unsigned u = __builtin_bit_cast(unsigned, f); return (u + 0x7fffu + ((u >> 16) & 1u)) >> 16; }
__device__ __forceinline__ unsigned pk2(float lo, float hi) { return f2bf(lo) | (f2bf(hi) << 16); }
__device__ __forceinline__ float bf_lo(unsigned w) { return __builtin_bit_cast(float, w << 16); }
__device__ __forceinline__ float bf_hi(unsigned w) { return __builtin_bit_cast(float, w & 0xffff0000u); }
__device__ __forceinline__ unsigned cvt_pk_bf16(float lo, float hi) { typedef __bf16 bf2 __attribute__((ext_vector_type(2))); f32x2 v = {lo, hi}; bf2 b = __builtin_convertvector(v, bf2); return __builtin_bit_cast(unsigned, b); }
__device__ __forceinline__ unsigned pk4_fp8(float a, float b, float c, float d) {
    a = __builtin_amdgcn_fmed3f(a, -448.f, 448.f); b = __builtin_amdgcn_fmed3f(b, -448.f, 448.f); c = __builtin_amdgcn_fmed3f(c, -448.f, 448.f); d = __builtin_amdgcn_fmed3f(d, -448.f, 448.f);
    int r = __builtin_amdgcn_cvt_pk_fp8_f32(a, b, 0, false); r = __builtin_amdgcn_cvt_pk_fp8_f32(c, d, r, true); return (unsigned)r; }
__device__ __forceinline__ void unpack8_fp8(v2u w, f32x4& v0, f32x4& v1) {
    const f32x2 a = __builtin_amdgcn_cvt_pk_f32_fp8((int)w.x, false), b = __builtin_amdgcn_cvt_pk_f32_fp8((int)w.x, true), c = __builtin_amdgcn_cvt_pk_f32_fp8((int)w.y, false), d = __builtin_amdgcn_cvt_pk_f32_fp8((int)w.y, true);
    v0 = (f32x4){a.x, a.y, b.x, b.y}; v1 = (f32x4){c.x, c.y, d.x, d.y}; }
__device__ __forceinline__ float fast_exp2(float x) { return __builtin_amdgcn_exp2f(x); }
__device__ __forceinline__ float fast_log2(float x) { return __builtin_amdgcn_logf(x); }
__device__ __forceinline__ float fast_rcp(float x) { return __builtin_amdgcn_rcpf(x); }
__device__ __forceinline__ int obid() { int b = blockIdx.x; asm volatile("" : "+s"(b)); return b; }
__device__ __forceinline__ int otid() { int t = threadIdx.x; asm volatile("" : "+v"(t)); return t; }
__device__ __forceinline__ float shx(float v, int o, int lane) { return __builtin_bit_cast(float, __builtin_amdgcn_ds_bpermute((lane ^ o) << 2, __builtin_bit_cast(int, v))); }
__device__ __forceinline__ float shl(float v, int src) { return __builtin_bit_cast(float, __builtin_amdgcn_ds_bpermute(src << 2, __builtin_bit_cast(int, v))); }
__device__ __forceinline__ float sigmoidf_(float x) { return fast_rcp(1.0f + fast_exp2(-x * LOG2E)); }

#define XB_TMO      128
#define XB_XCNT(j)  (256  + 64 * (j))
#define XB_XSUB(j)  (1280 + 64 * (j))
#define XB_XGEN(j)  (2304 + 64 * (j))
#define XB_TOP      3328
#define XB_TOPGEN   3392
#define XCD_BAR_WORDS 3456
#define XB_SPIN_CAP (1u << 18)
__device__ __forceinline__ unsigned xb_ld(unsigned* p)              { return __hip_atomic_load(p, __ATOMIC_RELAXED, __HIP_MEMORY_SCOPE_AGENT); }
__device__ __forceinline__ unsigned xb_add(unsigned* p, unsigned v) { return __hip_atomic_fetch_add(p, v, __ATOMIC_RELAXED, __HIP_MEMORY_SCOPE_AGENT); }
__device__ __forceinline__ unsigned xb_xcc_id() { return (unsigned)__builtin_amdgcn_s_getreg((3 << 11) | 20) & 0xFu; }
#define XB_SPIN(cond, bar) do { unsigned _sp = 0; while (cond) { __builtin_amdgcn_s_sleep(1); \
    if ((++_sp & 255u) == 0u) { if (xb_ld(&(bar)[XB_TMO])) break; if (_sp > XB_SPIN_CAP) { atomicAdd(&(bar)[XB_TMO], 1u); break; } } } } while (0)
struct XcdBarrier { unsigned* bar; unsigned x; volatile LAS unsigned* st; };
__device__ __forceinline__ XcdBarrier xcd_barrier_post(unsigned* bar, volatile LAS unsigned* st) {
    XcdBarrier b; b.bar = bar; b.x = xb_xcc_id(); b.st = st;
    if (threadIdx.x == 0) (void)xb_add(&bar[XB_XCNT(b.x)], 1u);
    return b;
}
__device__ __forceinline__ void xcd_barrier_complete(unsigned* bar, unsigned x, unsigned& nloc, unsigned& nx) {
    const unsigned G = gridDim.x * gridDim.y * gridDim.z;
    unsigned sum, cnt, mine, sp = 0u;
    for (;;) {
        sum = 0u; cnt = 0u; mine = 0u;
#pragma unroll
        for (unsigned j = 0; j < 16; ++j) { const unsigned c = xb_ld(&bar[XB_XCNT(j)]); sum += c; cnt += (c > 0u) ? 1u : 0u; mine = (j == x) ? c : mine; }
        if (sum == G) break;
        __builtin_amdgcn_s_sleep(1);
        if ((++sp & 255u) == 0u) { if (xb_ld(&bar[XB_TMO])) break; if (sp > XB_SPIN_CAP) { atomicAdd(&bar[XB_TMO], 1u); break; } }
    }
    nloc = mine > 0u ? mine : 1u; nx = cnt > 0u ? cnt : 1u;
}
__device__ __forceinline__ void xcd_barrier(const XcdBarrier& b) {
    asm volatile("s_waitcnt vmcnt(0)" ::: "memory");
    __syncthreads();
    if (threadIdx.x == 0) {
        unsigned* bar = b.bar;
        __builtin_amdgcn_s_waitcnt(0);
        unsigned nloc = b.st[0], nx = b.st[1];
        if (nloc == 0u) { xcd_barrier_complete(bar, b.x, nloc, nx); b.st[0] = nloc; b.st[1] = nx; }
        const unsigned old = xb_add(&bar[XB_XSUB(b.x)], 1u);
        const unsigned gen = old / nloc;
        if (old + 1u == (gen + 1u) * nloc) {
            __builtin_amdgcn_fence(__ATOMIC_RELEASE, "agent");
            asm volatile("s_waitcnt vmcnt(0)" ::: "memory");
            const unsigned og = xb_add(&bar[XB_TOP], 1u);
            const unsigned tg = og / nx;
            if (og + 1u == (tg + 1u) * nx) xb_add(&bar[XB_TOPGEN], 1u);
            else XB_SPIN(xb_ld(&bar[XB_TOPGEN]) == tg, bar);
            __builtin_amdgcn_fence(__ATOMIC_ACQUIRE, "agent");
            xb_add(&bar[XB_XGEN(b.x)], 1u);
            asm volatile("s_waitcnt vmcnt(0)" ::: "memory");
        } else {
            XB_SPIN(xb_ld(&bar[XB_XGEN(b.x)]) == gen, bar);
            __builtin_amdgcn_fence(__ATOMIC_ACQUIRE, "agent");
            asm volatile("s_waitcnt vmcnt(0)" ::: "memory");
        }
    }
    __syncthreads();
}

namespace pg8 {
typedef int v4i_t __attribute__((ext_vector_type(4)));
constexpr int BM = 256, BK = 64, HALF = 128, HTB = HALF * BK * 2, STAGE_BYTES = 8 * HTB, NXCD = 8, WGM = 4;
__host__ __device__ __forceinline__ int lds_byte(int r, int c) { const int st = (r >> 4) * 2 + (c >> 5), rr = r & 15, cc = c & 31, ob = rr * 64 + cc * 2; return st * 1024 + (ob ^ (((ob >> 9) & 1) << 5)); }
__host__ __device__ __forceinline__ void stage_rc(int b, int& R, int& C) { const int st = b / 1024, sb = b % 1024, swz = sb ^ (((sb >> 9) & 1) << 5); R = (st >> 1) * 16 + swz / 64; C = (st & 1) * 32 + (swz % 64) / 2; }
__host__ __device__ __forceinline__ int perm32(int rho) { const int n = rho >> 4, i = rho & 15; return 8 * (i >> 2) + 4 * n + (i & 3); }
struct Unit { int pm, pn; };
struct StaticOrder {
    int nM, nN, nwg, G, c, wsh;
    __host__ __device__ __forceinline__ void init(int nM_, int nN_, int G_, int c_) { nM = nM_; nN = nN_; nwg = nM * nN; G = G_; c = c_; wsh = 2; }
    __host__ __device__ __forceinline__ bool next(int i, Unit& u) const {
        const long L = (long)i * G + c; if (L >= nwg) return false;
        int wgid = (int)L; { const int q = nwg / NXCD, r = nwg % NXCD, xcd = wgid % NXCD, off = wgid / NXCD; wgid = (xcd < r ? xcd * (q + 1) : r * (q + 1) + (xcd - r) * q) + off; }
        const int wg_ = 1 << wsh, nig = nN << wsh, gid = wgid / nig, fm = gid << wsh, gsz = (nM - fm) < wg_ ? (nM - fm) : wg_;
        const int w_ = wgid % nig;
        if (gsz == wg_) { u.pm = fm + (w_ & (wg_ - 1)); u.pn = w_ >> wsh; }
        else { u.pm = fm + (w_ % gsz); u.pn = w_ / gsz; }
        return true;
    }
};
template <class Epi, class Sched, bool ALIGN_EPI, int MODE>
__device__ __forceinline__ void gemm_phase(LAS unsigned char* lds, const int K, const Sched& S, const Epi& E, const int nt_ov = 0) {
    const int tid = otid(), wid = __builtin_amdgcn_readfirstlane(tid >> 6), lane = tid & 63, wr = wid >> 2, wc = wid & 3, fr = lane & 15, fq = lane >> 4;
    const int nt = nt_ov ? nt_ov : K / BK;
    unsigned voffA[2], voffB[2];
#pragma unroll
    for (int i = 0; i < 2; ++i) { int R, C; stage_rc(tid * 16 + i * 8192, R, C); const int Rb = Epi::PERM ? ((R & ~31) + perm32(R & 31)) : R;
        voffA[i] = (unsigned)(R * K + C) * 2u; voffB[i] = (unsigned)(Rb * K + C) * 2u; }
#define PG8_GVOFF(uix) do { _Pragma("unroll") for (int _h = 0; _h < 2; ++_h) _Pragma("unroll") for (int _i = 0; _i < 2; ++_i) { int R_, C_; stage_rc(tid * 16 + _i * 8192, R_, C_); vg[_h][_i] = S.gvoff((uix), _h * HALF + R_, C_, K); } } while (0)
    const size_t kstep = (size_t)(BK * 2);
    const size_t hstep = (size_t)HALF * K * 2;
    const unsigned ldsw = (unsigned)wid * 1024u;
    const int aoff = lds_byte(wr * 64 + fr, fq * 8), boff = lds_byte(wc * 32 + fr, fq * 8);
#define PG8_SA(b, h) (((b) * 2 + (h)) * HTB)
#define PG8_SB(b, h) ((4 + (b) * 2 + (h)) * HTB)
#define PG8_STAGE(bufoff, gbase, voff) do { _Pragma("unroll") for (int _i = 0; _i < 2; ++_i) \
        __builtin_amdgcn_global_load_lds((const unsigned*)((const char*)(gbase) + (voff)[_i]), (LAS unsigned*)(lds + (bufoff) + ldsw + _i * 8192), 16, 0, 0); } while (0)
#define PG8_STAGE_A(bufoff, kp, h) do { if constexpr (Sched::GATHER) { PG8_STAGE(bufoff, kp, vg[h]); } else { PG8_STAGE(bufoff, (kp) + (h) * hstep, voffA); } } while (0)
#define PG8_LDA(dst, b, h) do { _Pragma("unroll") for (int m = 0; m < 4; ++m) _Pragma("unroll") for (int k = 0; k < 2; ++k) dst[m][k] = *(const LAS bf16x8*)(lds + PG8_SA(b, h) + aoff + m * 2048 + k * 1024); } while (0)
#define PG8_LDB(dst, b, h) do { _Pragma("unroll") for (int n = 0; n < 2; ++n) _Pragma("unroll") for (int k = 0; k < 2; ++k) dst[n][k] = *(const LAS bf16x8*)(lds + PG8_SB(b, h) + boff + n * 2048 + k * 1024); } while (0)
#define PG8_CAT8(x) __builtin_shufflevector(__builtin_bit_cast(v4i_t, (x)[0]), __builtin_bit_cast(v4i_t, (x)[1]), 0, 1, 2, 3, 4, 5, 6, 7)
#define PG8_MMA(ai, bj, At, Bt) do { __builtin_amdgcn_s_setprio(1); if constexpr (MODE == 1) { _Pragma("unroll") for (int m = 0; m < 4; ++m) _Pragma("unroll") for (int n = 0; n < 2; ++n) \
        asm volatile("v_mfma_f32_16x16x128_f8f6f4 %0, %1, %2, %0" : "+v"(acc[ai][bj][m][n]) : "v"(PG8_CAT8(Bt[n])), "v"(PG8_CAT8(At[m]))); } else if constexpr (MODE == 2) { \
        _Pragma("unroll") for (int m = 0; m < 4; ++m) _Pragma("unroll") for (int n = 0; n < 2; ++n) _Pragma("unroll") for (int k = 0; k < 2; ++k) \
        asm volatile("v_mfma_i32_16x16x64_i8 %0, %1, %2, %0" : "+v"(acc[ai][bj][m][n]) : "v"(Bt[n][k]), "v"(At[m][k])); } else { \
        _Pragma("unroll") for (int m = 0; m < 4; ++m) _Pragma("unroll") for (int n = 0; n < 2; ++n) _Pragma("unroll") for (int k = 0; k < 2; ++k) \
        acc[ai][bj][m][n] = __builtin_amdgcn_mfma_f32_16x16x32_bf16(Bt[n][k], At[m][k], acc[ai][bj][m][n], 0, 0, 0); } __builtin_amdgcn_s_setprio(0); } while (0)
#define PG8_WAIT_V(n) asm volatile("s_waitcnt vmcnt(" #n ")" ::: "memory")
#define PG8_WAIT_L(n) asm volatile("s_waitcnt lgkmcnt(" #n ")" ::: "memory")
#define PG8_BAR __builtin_amdgcn_s_barrier()
#define PG8_SCHED __builtin_amdgcn_sched_barrier(0)
    Unit cur, nxt; int ui = 0;
    if (!S.next(0, cur)) return;
    f32x4 acc[2][2][4][2];
#pragma unroll
    for (int a = 0; a < 2; ++a)
#pragma unroll
        for (int b = 0; b < 2; ++b)
#pragma unroll
            for (int m = 0; m < 4; ++m)
#pragma unroll
                for (int n = 0; n < 2; ++n) acc[a][b][m][n] = (f32x4){0.f, 0.f, 0.f, 0.f};
    bf16x8 At[4][2], B0[2][2], B1[2][2];
    unsigned vg[2][2];
    if constexpr (Sched::GATHER) PG8_GVOFF(0);
    const char* cA = S.a_base(cur); const char* cB = S.b_base(cur);
    PG8_STAGE(PG8_SB(0, 0), cB, voffB); PG8_STAGE(PG8_SB(0, 1), cB + hstep, voffB); PG8_STAGE_A(PG8_SA(0, 0), cA, 0); PG8_STAGE_A(PG8_SA(0, 1), cA, 1);
    if (wr == 1) PG8_BAR;
    PG8_WAIT_V(2); PG8_BAR;
    PG8_STAGE(PG8_SB(1, 0), cB + kstep, voffB); PG8_STAGE_A(PG8_SA(1, 0), cA + kstep, 0); PG8_STAGE(PG8_SB(1, 1), cB + hstep + kstep, voffB);
    PG8_WAIT_V(6); PG8_BAR;
    for (;;) {
        const bool has_next = S.next(ui + 1, nxt);
        const char* nA = has_next ? S.a_base(nxt) : cA; const char* nB = has_next ? S.b_base(nxt) : cB;
        for (int t = 0; t < nt; t += 2) {
            const bool last = (t == nt - 2);
            const char* a1 = cA + (size_t)(t + 1) * kstep;
            const char* a2 = last ? nA : cA + (size_t)(t + 2) * kstep; const char* b2 = last ? nB : cB + (size_t)(t + 2) * kstep;
            const char* a3 = a2 + kstep; const char* b3 = b2 + kstep;
            PG8_LDB(B0, 0, 0); PG8_LDB(B1, 0, 1); PG8_SCHED; PG8_LDA(At, 0, 0); PG8_STAGE_A(PG8_SA(1, 1), a1, 1);
            if constexpr (Sched::GATHER) { if (last && has_next) PG8_GVOFF(ui + 1); }
            const bool seam = (t == 0) && (ui > 0);
#define PG8_WAIT_SEAM() do { if constexpr (MODE != 0 && Epi::NSTORE > 0) { if (seam) { if constexpr (Epi::NSTORE == 16) PG8_WAIT_V(24); else PG8_WAIT_V(16); } else PG8_WAIT_V(8); } else PG8_WAIT_V(8); } while (0)
            PG8_WAIT_SEAM(); PG8_WAIT_L(0); PG8_BAR; PG8_MMA(0, 0, At, B0); PG8_MMA(0, 1, At, B1); PG8_BAR; PG8_SCHED;
            PG8_LDA(At, 0, 1); PG8_STAGE(PG8_SB(0, 0), b2, voffB); PG8_STAGE(PG8_SB(0, 1), b2 + hstep, voffB); PG8_STAGE_A(PG8_SA(0, 0), a2, 0);
            PG8_WAIT_SEAM(); PG8_WAIT_L(0); PG8_BAR; PG8_MMA(1, 0, At, B0); PG8_MMA(1, 1, At, B1); PG8_BAR; PG8_SCHED;
            PG8_LDB(B0, 1, 0); PG8_LDB(B1, 1, 1); PG8_SCHED; PG8_LDA(At, 1, 0); PG8_STAGE_A(PG8_SA(0, 1), a2, 1);
            PG8_WAIT_V(8); PG8_WAIT_L(0); PG8_BAR; PG8_MMA(0, 0, At, B0); PG8_MMA(0, 1, At, B1); PG8_BAR; PG8_SCHED;
            PG8_LDA(At, 1, 1); PG8_STAGE(PG8_SB(1, 0), b3, voffB); PG8_STAGE(PG8_SB(1, 1), b3 + hstep, voffB); PG8_STAGE_A(PG8_SA(1, 0), a3, 0);
            PG8_WAIT_V(8); PG8_WAIT_L(0); PG8_BAR; PG8_MMA(1, 0, At, B0); PG8_MMA(1, 1, At, B1); PG8_BAR; PG8_SCHED;
        }
        if constexpr (ALIGN_EPI) { if (wr == 0) PG8_BAR; }
        if constexpr (MODE != 0) asm volatile("s_nop 15\n\ts_nop 15" : "+v"(acc[1][1][0][0]), "+v"(acc[1][1][0][1]), "+v"(acc[1][1][1][0]), "+v"(acc[1][1][1][1]), "+v"(acc[1][1][2][0]), "+v"(acc[1][1][2][1]), "+v"(acc[1][1][3][0]), "+v"(acc[1][1][3][1]) :: "memory");
        E(acc, cur, ui, wr, wc, fr, fq);
        if (!has_next) break;
#pragma unroll
        for (int a = 0; a < 2; ++a)
#pragma unroll
            for (int b = 0; b < 2; ++b)
#pragma unroll
                for (int m = 0; m < 4; ++m)
#pragma unroll
                    for (int n = 0; n < 2; ++n) acc[a][b][m][n] = (f32x4){0.f, 0.f, 0.f, 0.f};
        cur = nxt; cA = nA; cB = nB; ++ui;
        if constexpr (ALIGN_EPI) { if (wr == 1) PG8_BAR; }
    }
    PG8_WAIT_V(0);
    if constexpr (!ALIGN_EPI) { if (wr == 0) PG8_BAR; }
    PG8_BAR;
#undef PG8_SA
#undef PG8_SB
#undef PG8_STAGE
#undef PG8_STAGE_A
#undef PG8_WAIT_SEAM
#undef PG8_GVOFF
#undef PG8_LDA
#undef PG8_LDB
#undef PG8_MMA
#undef PG8_CAT8
#undef PG8_WAIT_V
#undef PG8_WAIT_L
#undef PG8_BAR
#undef PG8_SCHED
}

struct SchedPlain : StaticOrder {
    static constexpr bool GATHER = false;
    const char* A; const char* B; size_t tA, tB;
    __device__ __forceinline__ const char* a_base(const Unit& u) const { return A + (size_t)u.pm * tA; }
    __device__ __forceinline__ const char* b_base(const Unit& u) const { return B + (size_t)u.pn * tB; }
    __device__ __forceinline__ unsigned gvoff(int, int, int, int) const { return 0u; }
};
struct SchedMoe : StaticOrder {
    const char* A; const char* B; size_t tA, tB, eB; int panel0; const LAS int* seg; const LAS unsigned short* tok;
    __device__ __forceinline__ int expert(const Unit& u) const { const int row = (panel0 + u.pm) * 256; int e = 0;
#pragma unroll
        for (int j = 1; j < NE; ++j) e += (row >= seg[j]) ? 1 : 0;
        return e; }
    __device__ __forceinline__ const char* b_base(const Unit& u) const { return B + (size_t)expert(u) * eB + (size_t)u.pn * tB; }
};
struct SchedMoeUp : SchedMoe {
    static constexpr bool GATHER = true;
    __device__ __forceinline__ const char* a_base(const Unit&) const { return A; }
    __device__ __forceinline__ unsigned gvoff(int ui, int row, int col, int K) const { const int t = (int)tok[ui * 256 + row] >> 1; return (unsigned)(t * K + col) * 2u; }
};
struct SchedMoeDown : SchedMoe {
    static constexpr bool GATHER = false;
    __device__ __forceinline__ const char* a_base(const Unit& u) const { return A + (size_t)u.pm * tA; }
    __device__ __forceinline__ unsigned gvoff(int, int, int, int) const { return 0u; }
};
struct SchedMoeDownTail : SchedMoe {
    static constexpr bool GATHER = false;
    int nfull, pidx; size_t koff;
    __device__ __forceinline__ bool next(int i, Unit& u) const {
        if (i != 0 || pidx < 0) return false;
        const int wg_ = 1 << wsh, wgid = nfull + pidx, nig = nN << wsh, gid = wgid / nig, fm = gid << wsh, gsz = (nM - fm) < wg_ ? (nM - fm) : wg_, w_ = wgid % nig;
        u.pm = fm + (w_ % gsz); u.pn = w_ / gsz; return true; }
    __device__ __forceinline__ const char* a_base(const Unit& u) const { return A + (size_t)u.pm * tA + koff; }
    __device__ __forceinline__ const char* b_base(const Unit& u) const { return SchedMoe::b_base(u) + koff; }
    __device__ __forceinline__ unsigned gvoff(int, int, int, int) const { return 0u; }
};

typedef f32x4 Acc[2][2][4][2];
__device__ __forceinline__ v4u pack8(f32x4 v0, f32x4 v1) { v4u w; w.x = cvt_pk_bf16(v0[0], v0[1]); w.y = cvt_pk_bf16(v0[2], v0[3]); w.z = cvt_pk_bf16(v1[0], v1[1]); w.w = cvt_pk_bf16(v1[2], v1[3]); return w; }
__device__ __forceinline__ void unpack8(v4u w, f32x4& v0, f32x4& v1) { v0 = (f32x4){bf_lo(w.x), bf_hi(w.x), bf_lo(w.y), bf_hi(w.y)}; v1 = (f32x4){bf_lo(w.z), bf_hi(w.z), bf_lo(w.w), bf_hi(w.w)}; }

#ifndef MK_EPI_NT
#define MK_EPI_NT 0
#endif
#ifndef MK_HEAD
#define MK_HEAD 1536
#endif
#ifndef MK_SPLIT_TAIL
#define MK_SPLIT_TAIL 1
#endif
#if MK_EPI_NT
#define EPI_ST(T, p, v) __builtin_nontemporal_store((v), (T*)(p))
#else
#define EPI_ST(T, p, v) (*(T*)(p) = (v))
#endif
struct EpiInProj {
    static constexpr bool PERM = true; static constexpr int NSTORE = 16;
    bf16* big; const LAS float* rowf; int nostore; const LAS float* colf;
    __device__ __forceinline__ void operator()(const Acc& acc, const Unit& u, int ui, int wr, int wc, int fr, int fq) const {
        const int t = u.pn; bf16* base; int ldc, colt; float sc = 1.f;
        if (t < 12) { const int pl = t >> 1; base = big + (size_t)pl * ((size_t)M * WH); ldc = WH; colt = (t & 1) * 256; if (pl == 0 || pl == 3) sc = C2; }
        else { const int g = (t - 12) >> 2; base = big + (size_t)6 * ((size_t)M * WH) + (size_t)g * ((size_t)M * D / 2); ldc = D; colt = ((t - 12) & 3) * 256; }
        const int row0 = u.pm * BM + wr * 64 + fr, col0 = colt + wc * 32 + 8 * fq;
        const LAS float* cf_ = colf + ui * 256 + wc * 32 + 8 * fq; f32x4 cs[2][2];
#pragma unroll
        for (int bj = 0; bj < 2; ++bj) { cs[bj][0] = *(const LAS f32x4*)(cf_ + bj * HALF); cs[bj][1] = *(const LAS f32x4*)(cf_ + bj * HALF + 4); }
#pragma unroll
        for (int ai = 0; ai < 2; ++ai)
#pragma unroll
            for (int m = 0; m < 4; ++m) { bf16* rowp = base + (size_t)(row0 + ai * HALF + m * 16) * ldc + col0; const float rf = rowf[ui * 256 + wr * 64 + fr + ai * HALF + m * 16] * sc;
#pragma unroll
                for (int bj = 0; bj < 2; ++bj) { const v4i_t i0 = __builtin_bit_cast(v4i_t, acc[ai][bj][m][0]), i1 = __builtin_bit_cast(v4i_t, acc[ai][bj][m][1]);
                    const f32x4 v0 = (f32x4){(float)i0[0] * rf, (float)i0[1] * rf, (float)i0[2] * rf, (float)i0[3] * rf} * cs[bj][0], v1 = (f32x4){(float)i1[0] * rf, (float)i1[1] * rf, (float)i1[2] * rf, (float)i1[3] * rf} * cs[bj][1];
                    if (t >= 12) { v2u w8; w8.x = pk4_fp8(v0[0], v0[1], v0[2], v0[3]); w8.y = pk4_fp8(v1[0], v1[1], v1[2], v1[3]);
                        if (!nostore) EPI_ST(v2u, (unsigned char*)base + (size_t)(row0 + ai * HALF + m * 16) * D + col0 + bj * HALF, w8); else asm volatile("" :: "v"(w8)); }
                    else { const v4u pk_ = pack8(v0, v1); if (!nostore) EPI_ST(v4u, rowp + bj * HALF, pk_); else asm volatile("" :: "v"(pk_)); } } }
    }
};
struct EpiBf16 {
    static constexpr bool PERM = true; static constexpr int NSTORE = 16;
    bf16* O; int ldc; float sc;
    __device__ __forceinline__ void operator()(const Acc& acc, const Unit& u, int, int wr, int wc, int fr, int fq) const {
        const int row0 = u.pm * BM + wr * 64 + fr, col0 = u.pn * BM + wc * 32 + 8 * fq;
#pragma unroll
        for (int ai = 0; ai < 2; ++ai)
#pragma unroll
            for (int m = 0; m < 4; ++m) { bf16* rowp = O + (size_t)(row0 + ai * HALF + m * 16) * ldc + col0;
#pragma unroll
                for (int bj = 0; bj < 2; ++bj) { const f32x4 v0 = acc[ai][bj][m][0] * sc, v1 = acc[ai][bj][m][1] * sc;
                    EPI_ST(v4u, rowp + bj * HALF, pack8(v0, v1)); } }
    }
};
template <bool ADD> struct EpiGate {
    static constexpr bool PERM = true; static constexpr int NSTORE = 16;
    const unsigned char* G; bf16* T; unsigned char* T8;
    __device__ __forceinline__ void operator()(const Acc& acc, const Unit& u, int, int wr, int wc, int fr, int fq) const {
        const int row0 = u.pm * BM + wr * 64 + fr, col0 = u.pn * BM + wc * 32 + 8 * fq;
        constexpr int NB = ADD ? 1 : 2;
#pragma unroll
        for (int a0 = 0; a0 < 2; a0 += NB) {
            v2u gw[NB][4][2]; v4u tw[4][2];
#pragma unroll
            for (int ab = 0; ab < NB; ++ab)
#pragma unroll
                for (int m = 0; m < 4; ++m)
#pragma unroll
                    for (int bj = 0; bj < 2; ++bj) { const size_t off = (size_t)(row0 + (a0 + ab) * HALF + m * 16) * D + col0 + bj * HALF; gw[ab][m][bj] = *(const v2u*)(G + off); if (ADD) tw[m][bj] = *(const v4u*)(T + off); }
#pragma unroll
            for (int ab = 0; ab < NB; ++ab) { const int ai = a0 + ab;
#pragma unroll
            for (int m = 0; m < 4; ++m) { const size_t off = (size_t)(row0 + ai * HALF + m * 16) * D + col0;
#pragma unroll
                for (int bj = 0; bj < 2; ++bj) { f32x4 g0, g1; unpack8_fp8(gw[ab][m][bj], g0, g1);
                    f32x4 t0 = {0.f, 0.f, 0.f, 0.f}, t1 = {0.f, 0.f, 0.f, 0.f};
                    if (ADD) unpack8(tw[m][bj], t0, t1);
                    f32x4 e0 = g0 * (-LOG2E), e1 = g1 * (-LOG2E);
#pragma unroll
                    for (int c = 0; c < 4; ++c) { e0[c] = fast_exp2(e0[c]); e1[c] = fast_exp2(e1[c]); }
                    e0 = e0 + 1.0f; e1 = e1 + 1.0f;
#pragma unroll
                    for (int c = 0; c < 4; ++c) { e0[c] = fast_rcp(e0[c]); e1[c] = fast_rcp(e1[c]); }
                    const f32x4 o0 = t0 + e0 * acc[ai][bj][m][0], o1 = t1 + e1 * acc[ai][bj][m][1];
                    if (ADD && MK_OUT8) { const f32x4 q0 = o0 * MG_SCALE, q1 = o1 * MG_SCALE; v2u w8; w8.x = pk4_fp8(q0[0], q0[1], q0[2], q0[3]); w8.y = pk4_fp8(q1[0], q1[1], q1[2], q1[3]);
                        EPI_ST(v2u, (unsigned char*)T8 + off + bj * HALF, w8); }
                    else EPI_ST(v4u, T + off + bj * HALF, pack8(o0, o1)); } } } }
    }
};
__device__ __forceinline__ v2u swiglu8_fp8(f32x4 a0, f32x4 a1, f32x4 b0, f32x4 b1) {
    f32x4 t0 = a0 * (-LOG2E), t1 = a1 * (-LOG2E);
#pragma unroll
    for (int c = 0; c < 4; ++c) { t0[c] = fast_exp2(t0[c]); t1[c] = fast_exp2(t1[c]); }
    t0 = t0 + 1.0f; t1 = t1 + 1.0f;
#pragma unroll
    for (int c = 0; c < 4; ++c) { t0[c] = fast_rcp(t0[c]); t1[c] = fast_rcp(t1[c]); }
    f32x4 u0 = (a0 * b0) * t0, u1 = (a1 * b1) * t1;
    v2u w; w.x = pk4_fp8(u0[0], u0[1], u0[2], u0[3]); w.y = pk4_fp8(u1[0], u1[1], u1[2], u1[3]); return w;
}
struct EpiSwiGLU {
    static constexpr bool PERM = true; static constexpr int NSTORE = 8;
    unsigned char* O; float sc;
    __device__ __forceinline__ void operator()(const Acc& acc, const Unit& u, int, int wr, int wc, int fr, int fq) const {
        const int row0 = u.pm * BM + wr * 64 + fr, col0 = u.pn * HALF + wc * 32 + 8 * fq;
#pragma unroll
        for (int ai = 0; ai < 2; ++ai)
#pragma unroll
            for (int m = 0; m < 4; ++m) { const v2u w = swiglu8_fp8(acc[ai][0][m][0] * sc, acc[ai][0][m][1] * sc, acc[ai][1][m][0] * sc, acc[ai][1][m][1] * sc);
                EPI_ST(v2u, O + (size_t)(row0 + ai * HALF + m * 16) * FF + col0, w); }
    }
};
struct EpiSwiGLUi8 {
    static constexpr bool PERM = true; static constexpr int NSTORE = 8;
    unsigned char* O; const LAS float* rowf; const LAS float* colf;
    __device__ __forceinline__ void operator()(const Acc& acc, const Unit& u, int ui, int wr, int wc, int fr, int fq) const {
        const int row0 = u.pm * BM + wr * 64 + fr, col0 = u.pn * HALF + wc * 32 + 8 * fq;
        const LAS float* cf_ = colf + ui * 256 + wc * 32 + 8 * fq;
        const f32x4 ca0 = *(const LAS f32x4*)cf_, ca1 = *(const LAS f32x4*)(cf_ + 4), cb0 = *(const LAS f32x4*)(cf_ + HALF), cb1 = *(const LAS f32x4*)(cf_ + HALF + 4);
#pragma unroll
        for (int ai = 0; ai < 2; ++ai)
#pragma unroll
            for (int m = 0; m < 4; ++m) { const float rf = rowf[ui * 256 + wr * 64 + fr + ai * HALF + m * 16];
                const v4i_t a0 = __builtin_bit_cast(v4i_t, acc[ai][0][m][0]), a1 = __builtin_bit_cast(v4i_t, acc[ai][0][m][1]), b0 = __builtin_bit_cast(v4i_t, acc[ai][1][m][0]), b1 = __builtin_bit_cast(v4i_t, acc[ai][1][m][1]);
                const v2u w = swiglu8_fp8(__builtin_convertvector(a0, f32x4) * rf * ca0, __builtin_convertvector(a1, f32x4) * rf * ca1, __builtin_convertvector(b0, f32x4) * rf * cb0, __builtin_convertvector(b1, f32x4) * rf * cb1);
                EPI_ST(v2u, O + (size_t)(row0 + ai * HALF + m * 16) * FF + col0, w); }
    }
};
struct EpiMoeDown {
    static constexpr bool PERM = true; static constexpr int NSTORE = 0;
    bf16* YP; const LAS unsigned short* tok; const LAS int* seg; float sc;
    __device__ __forceinline__ void operator()(const Acc& acc, const Unit& u, int ui, int wr, int wc, int fr, int fq) const {
        const int r0 = wr * 64 + fr, col0 = u.pn * BM + wc * 32 + 8 * fq;
        const int prow = u.pm * 256; int e = 0;
#pragma unroll
        for (int j = 1; j < NE; ++j) e += (prow >= seg[j]) ? 1 : 0;
        const int nvalid = seg[16 + e] - (prow - seg[e]);
        const LAS unsigned short* tp = tok + ui * 256 + r0; asm volatile("" : "+v"(tp));
#pragma unroll
        for (int ai = 0; ai < 2; ++ai)
#pragma unroll
            for (int m = 0; m < 4; ++m) { const int r = r0 + ai * HALF + m * 16;
                if (r < nvalid) { bf16* rowp = YP + (size_t)tp[ai * HALF + m * 16] * D + col0;
#pragma unroll
                    for (int bj = 0; bj < 2; ++bj) { const f32x4 v0 = acc[ai][bj][m][0] * sc, v1 = acc[ai][bj][m][1] * sc;
                        if (MK_Y8) { v2u w8; w8.x = pk4_fp8(v0[0], v0[1], v0[2], v0[3]); w8.y = pk4_fp8(v1[0], v1[1], v1[2], v1[3]); EPI_ST(v2u, (unsigned char*)YP + (size_t)tp[ai * HALF + m * 16] * D + col0 + bj * HALF, w8); }
                        else EPI_ST(v4u, rowp + bj * HALF, pack8(v0, v1)); } } }
    }
};
struct EpiMoeDownTail {
    static constexpr bool PERM = true; static constexpr int NSTORE = 0;
    bf16* YP; const LAS unsigned short* tok; const LAS int* seg; float sc; f32x4* xbuf; unsigned* flg; int pidx, slice;
    template <int S_> __device__ __forceinline__ void fin(const Acc& acc, const Unit& u, int wr, int wc, int fr, int fq, int tid) const {
        constexpr int ai = S_ >> 1, bj = S_ & 1;
        f32x4 v[4][2];
#pragma unroll
        for (int m = 0; m < 4; ++m) { v[m][0] = acc[ai][bj][m][0]; v[m][1] = acc[ai][bj][m][1]; }
#pragma unroll
        for (int k = 1; k < 4; ++k) { const f32x4* src = xbuf + ((size_t)((pidx * 4 + S_) * 3 + (k - 1)) * 8) * 512 + tid;
#pragma unroll
            for (int m = 0; m < 4; ++m) { v[m][0] += src[(m * 2 + 0) * 512]; v[m][1] += src[(m * 2 + 1) * 512]; } }
        const int r0 = wr * 64 + fr, col0 = u.pn * BM + wc * 32 + 8 * fq + bj * HALF;
        const int prow = u.pm * 256; int e = 0;
#pragma unroll
        for (int j = 1; j < NE; ++j) e += (prow >= seg[j]) ? 1 : 0;
        const int nvalid = seg[16 + e] - (prow - seg[e]);
#pragma unroll
        for (int m = 0; m < 4; ++m) { const int r = r0 + ai * HALF + m * 16;
            if (r < nvalid) { const size_t t = tok[r]; const f32x4 v0 = v[m][0] * sc, v1 = v[m][1] * sc;
                if (MK_Y8) { v2u w8; w8.x = pk4_fp8(v0[0], v0[1], v0[2], v0[3]); w8.y = pk4_fp8(v1[0], v1[1], v1[2], v1[3]); EPI_ST(v2u, (unsigned char*)YP + t * D + col0, w8); }
                else EPI_ST(v4u, YP + t * D + col0, pack8(v0, v1)); } }
    }
    __device__ __forceinline__ void operator()(const Acc& acc, const Unit& u, int, int wr, int wc, int fr, int fq) const {
        const int tid = otid(), lane = tid & 63, wid = __builtin_amdgcn_readfirstlane(tid >> 6);
#pragma unroll
        for (int d = 0; d < 4; ++d) if (d != slice) { const int k = (slice - d) & 3;
            f32x4* dst = xbuf + ((size_t)((pidx * 4 + d) * 3 + (k - 1)) * 8) * 512 + tid;
#pragma unroll
            for (int m = 0; m < 4; ++m) { dst[(m * 2 + 0) * 512] = acc[d >> 1][d & 1][m][0]; dst[(m * 2 + 1) * 512] = acc[d >> 1][d & 1][m][1]; } }
        asm volatile("s_waitcnt vmcnt(0)" ::: "memory");
        __builtin_amdgcn_fence(__ATOMIC_RELEASE, "agent");
        asm volatile("s_waitcnt vmcnt(0)" ::: "memory");
        if (lane == 0) __hip_atomic_store(flg + ((pidx * 4 + slice) * 8 + wid) * 16, 1u, RLX_AGENT);
#pragma unroll 1
        for (int k = 1; k < 4; ++k) { unsigned* w = flg + ((pidx * 4 + ((slice + k) & 3)) * 8 + wid) * 16; unsigned sp = 0;
            while (__builtin_amdgcn_readfirstlane(__hip_atomic_load(w, RLX_AGENT)) == 0u) { __builtin_amdgcn_s_sleep(1); if (++sp > (1u << 16)) break; } }
        __builtin_amdgcn_fence(__ATOMIC_ACQUIRE, "agent");
        asm volatile("s_waitcnt vmcnt(0)" ::: "memory");
        if (slice == 0) fin<0>(acc, u, wr, wc, fr, fq, tid); else if (slice == 1) fin<1>(acc, u, wr, wc, fr, fq, tid); else if (slice == 2) fin<2>(acc, u, wr, wc, fr, fq, tid); else fin<3>(acc, u, wr, wc, fr, fq, tid);
    }
};
}

namespace att {
constexpr int PITCH = WH;
constexpr int SLOTB = 8192;
#ifndef MK_ATT_NSLOT
#define MK_ATT_NSLOT 4
#endif
constexpr int NSLOT = MK_ATT_NSLOT;
constexpr int L_K = 0, L_V = NSLOT * SLOTB, L_WS = 2 * NSLOT * SLOTB, L_OST = L_WS + NWAVES * 64 * 4, L_KPART = L_OST  , L_KMEAN = L_OST + NWAVES * 4096, L_SEL = L_KMEAN + 8 * 64 * 4, L_LUT = L_SEL + 256, L_DONE = L_LUT + 1536, L_END = L_DONE + 64;
static_assert(L_END <= LDS_SEG && 8 * 8 * 64 * 4 <= NWAVES * 4096, "attention LDS (it may use the MoE table region, not the segment / barrier words)");
__device__ __forceinline__ int crow(int r, int hi) { return (r & 3) + 8 * (r >> 2) + 4 * hi; }
__device__ __forceinline__ void glds16(const void* gsrc, unsigned lds_dst) { unsigned keep;
    asm volatile("s_mov_b32 %0, m0\n\ts_mov_b32 m0, %2\n\ts_nop 0\n\tglobal_load_lds_dwordx4 %1, off\n\ts_mov_b32 m0, %0" : "=&s"(keep) : "v"(gsrc), "s"(lds_dst) : "memory"); }
#define ATT_WAIT_BAR(N) asm volatile("s_waitcnt vmcnt(" #N ") lgkmcnt(0)\n\ts_barrier" ::: "memory")
constexpr float SB_DONE_THR = 64.f;
__device__ const unsigned char REL_BUCKET_LUT[128] = {0, 1, 2, 3, 4, 5, 6, 7, 8, 9, 10, 11, 12, 13, 14, 15, 16, 16, 16, 17, 17, 18, 18, 18, 19, 19, 19, 20, 20, 20, 20, 21, 21, 21, 21, 22, 22, 22, 22, 22, 23, 23, 23, 23, 23, 23, 24, 24, 24, 24, 24, 24, 25, 25, 25, 25, 25, 25, 25, 26, 26, 26, 26, 26, 26, 26, 26, 27, 27, 27, 27, 27, 27, 27, 27, 27, 27, 28, 28, 28, 28, 28, 28, 28, 28, 28, 28, 29, 29, 29, 29, 29, 29, 29, 29, 29, 29, 29, 29, 30, 30, 30, 30, 30, 30, 30, 30, 30, 30, 30, 30, 30, 30, 31, 31, 31, 31, 31, 31, 31, 31, 31, 31, 31, 31, 31, 31, 31};

__device__ __forceinline__ void qkt(f32x16& p0, f32x16& p1, const LAS char* Kslot, const bf16x8* qr, const f32x16& cinit, int r32, int hi) {
    const LAS char* kb = Kslot + hi * 1024 + r32 * 16;
    bf16x8 kf[8];
#pragma unroll
    for (int d0 = 0; d0 < 4; ++d0) { kf[2 * d0] = *(const LAS bf16x8*)(kb + d0 * 2048); kf[2 * d0 + 1] = *(const LAS bf16x8*)(kb + d0 * 2048 + 512); }
    __builtin_amdgcn_sched_barrier(0);
    p0 = __builtin_amdgcn_mfma_f32_32x32x16_bf16(kf[0], qr[0], cinit, 0, 0, 0); p1 = __builtin_amdgcn_mfma_f32_32x32x16_bf16(kf[1], qr[0], cinit, 0, 0, 0);
#pragma unroll
    for (int d0 = 1; d0 < 4; ++d0) { p0 = __builtin_amdgcn_mfma_f32_32x32x16_bf16(kf[2 * d0], qr[d0], p0, 0, 0, 0); p1 = __builtin_amdgcn_mfma_f32_32x32x16_bf16(kf[2 * d0 + 1], qr[d0], p1, 0, 0, 0); }
    asm volatile("s_nop 15\n\ts_nop 7" : "+v"(p0), "+v"(p1));
}
__device__ __forceinline__ float max3f(float a, float b, float c) { float r; asm("v_max3_f32 %0, %1, %2, %3" : "=v"(r) : "v"(a), "v"(b), "v"(c)); return r; }
__device__ __forceinline__ float max2f(float a, float b) { float r; asm("v_max_f32_e32 %0, %1, %2" : "=v"(r) : "v"(a), "v"(b)); return r; }
__device__ __forceinline__ float min2f(float a, float b) { float r; asm("v_min_f32_e32 %0, %1, %2" : "=v"(r) : "v"(a), "v"(b)); return r; }
__device__ __forceinline__ void pv(f32x16* o, int vb, bf16x8 pa0, bf16x8 pa1, bf16x8 pa2, bf16x8 pa3) {
#pragma unroll
    for (int d0 = 0; d0 < 2; ++d0) { s16x4 lo[4], hi[4];
#pragma unroll
        for (int ks = 0; ks < 4; ++ks) {
            asm volatile("ds_read_b64_tr_b16 %0,%1 offset:%c2" : "=&v"(lo[ks]) : "v"(vb), "i"(d0 * 4096 + ks * 1024) : "memory");
            asm volatile("ds_read_b64_tr_b16 %0,%1 offset:%c2" : "=&v"(hi[ks]) : "v"(vb), "i"(d0 * 4096 + ks * 1024 + 512) : "memory"); }
        asm volatile("s_waitcnt lgkmcnt(0)" ::: "memory"); __builtin_amdgcn_sched_barrier(0);
#define ATT_PK(k) (bf16x8){lo[k][0], lo[k][1], lo[k][2], lo[k][3], hi[k][0], hi[k][1], hi[k][2], hi[k][3]}
        o[d0] = __builtin_amdgcn_mfma_f32_32x32x16_bf16(pa0, ATT_PK(0), o[d0], 0, 0, 0);
        o[d0] = __builtin_amdgcn_mfma_f32_32x32x16_bf16(pa1, ATT_PK(1), o[d0], 0, 0, 0);
        o[d0] = __builtin_amdgcn_mfma_f32_32x32x16_bf16(pa2, ATT_PK(2), o[d0], 0, 0, 0);
        o[d0] = __builtin_amdgcn_mfma_f32_32x32x16_bf16(pa3, ATT_PK(3), o[d0], 0, 0, 0);
#undef ATT_PK
    }
}
__device__ __forceinline__ bf16x8 pack8r(const f32x16& p, int b);
template <bool SUB> __device__ __forceinline__ float exp_pv(f32x16* o, int vb, f32x16& p0, f32x16& p1, const f32x16& w0, const f32x16& w1) {
    s16x4 lo[8], hi[8];
#pragma unroll
    for (int d0 = 0; d0 < 2; ++d0)
#pragma unroll
        for (int ks = 0; ks < 4; ++ks) {
            asm volatile("ds_read_b64_tr_b16 %0,%1 offset:%c2" : "=&v"(lo[d0 * 4 + ks]) : "v"(vb), "i"(d0 * 4096 + ks * 1024) : "memory");
            asm volatile("ds_read_b64_tr_b16 %0,%1 offset:%c2" : "=&v"(hi[d0 * 4 + ks]) : "v"(vb), "i"(d0 * 4096 + ks * 1024 + 512) : "memory"); }
    float ls = 0.f;
#define EPV_PK(k) (bf16x8){lo[k][0], lo[k][1], lo[k][2], lo[k][3], hi[k][0], hi[k][1], hi[k][2], hi[k][3]}
#define EPV_GROUP(P, WW, B, K) do { _Pragma("unroll") for (int r = 0; r < 8; ++r) P[(B) + r] = fast_exp2(SUB ? P[(B) + r] - WW[(B) + r] : P[(B) + r]); \
        ls += ((P[(B)] + P[(B) + 1]) + (P[(B) + 2] + P[(B) + 3])) + ((P[(B) + 4] + P[(B) + 5]) + (P[(B) + 6] + P[(B) + 7])); \
        const bf16x8 pa_ = pack8r(P, (B)); \
        if ((K) == 0) asm volatile("s_waitcnt lgkmcnt(0)" : "+v"(lo[0]), "+v"(hi[0]), "+v"(lo[1]), "+v"(hi[1]), "+v"(lo[2]), "+v"(hi[2]), "+v"(lo[3]), "+v"(hi[3]), "+v"(lo[4]), "+v"(hi[4]), "+v"(lo[5]), "+v"(hi[5]), "+v"(lo[6]), "+v"(hi[6]), "+v"(lo[7]), "+v"(hi[7]) :: "memory"); \
        o[0] = __builtin_amdgcn_mfma_f32_32x32x16_bf16(pa_, EPV_PK(K), o[0], 0, 0, 0); o[1] = __builtin_amdgcn_mfma_f32_32x32x16_bf16(pa_, EPV_PK((K) + 4), o[1], 0, 0, 0); \
        __builtin_amdgcn_sched_barrier(0); } while (0)
    EPV_GROUP(p0, w0, 0, 0); EPV_GROUP(p0, w0, 8, 1); EPV_GROUP(p1, w1, 0, 2); EPV_GROUP(p1, w1, 8, 3);
#undef EPV_GROUP
#undef EPV_PK
    return ls;
}
__device__ __forceinline__ bf16x8 pack8r(const f32x16& p, int b) { v4u w; w.x = cvt_pk_bf16(p[b], p[b + 1]); w.y = cvt_pk_bf16(p[b + 2], p[b + 3]); w.z = cvt_pk_bf16(p[b + 4], p[b + 5]); w.w = cvt_pk_bf16(p[b + 6], p[b + 7]); return __builtin_bit_cast(bf16x8, w); }
__device__ __forceinline__ f32x16 splat16(float v) { f32x16 r;
#pragma unroll
    for (int i = 0; i < 16; ++i) r[i] = v;
    return r; }

template <bool MOBA>
__device__ __forceinline__ void attn_unit(int b, int h, int qb, const bf16* Q, const bf16* __restrict__ Kp, const bf16* __restrict__ Vp, bf16* O, const float* rel_bias, LAS unsigned char* shm, bool prep) {
    const int tid = otid(), lane = tid & 63, r32 = lane & 31, hi = lane >> 5; const int wid = __builtin_amdgcn_readfirstlane(tid >> 6);
    const long rowbase = (long)b * SEQ; const int q0 = qb * 256;
    const bf16* Qw = Q + (rowbase + q0 + wid * 32) * PITCH + h * HD;
    const bf16* Kh = Kp + rowbase * PITCH + h * HD; const bf16* Vh = Vp + rowbase * PITCH + h * HD;
    const unsigned lds0 = (unsigned)(uintptr_t)shm;
    LAS float* wsf = (LAS float*)(shm + L_WS) + wid * 64;
    const bf16* ksrc = Kh + (long)lane * PITCH + wid * 8;
    const bf16* vsrc = Vh + (long)(16 * (wid & 3) + (lane >> 2)) * PITCH + (wid >> 2) * 32 + (lane & 3) * 8;
    const unsigned kdst = lds0 + L_K + wid * 1024, vdst = lds0 + L_V + wid * 1024;
#define DMA_K(t, slot) glds16(ksrc + (long)(t) * 64 * PITCH, (unsigned)__builtin_amdgcn_readfirstlane(kdst + (slot)))
#define DMA_V(t, slot) glds16(vsrc + (long)(t) * 64 * PITCH, (unsigned)__builtin_amdgcn_readfirstlane(vdst + (slot)))
    const int vb0 = (int)(lds0 + L_V) + ((lane >> 4) & 1) * 32 + (lane & 3) * 8 + (4 * hi + ((lane & 15) >> 2)) * 64;
    const LAS char* Kbase = (const LAS char*)(shm + L_K);
    const int NT = 4 * (qb + 1);
    const int qrel = wid * 32 + r32;
#pragma unroll
    for (int w = 0; w < NSLOT - 1; ++w) if (w < NT) { DMA_K(NT - 1 - w, w * SLOTB); DMA_V(NT - 1 - w, w * SLOTB); }
    LAS int* doneAt = (LAS int*)(shm + L_DONE);
    if (!MOBA) { if (tid < 8) doneAt[tid] = 0x7fffffff; }
    bf16x8 qr[4];
#pragma unroll
    for (int d0 = 0; d0 < 4; ++d0) qr[d0] = *(const bf16x8*)(&Qw[(long)r32 * PITCH + d0 * 16 + hi * 8]);
    float biasfar = 0.f; unsigned selmask = 0u;
    if constexpr (MOBA) {
        LAS float* KPART = (LAS float*)(shm + L_KPART); LAS float* KMEAN = (LAS float*)(shm + L_KMEAN); LAS unsigned char* SEL = (LAS unsigned char*)(shm + L_SEL); LAS float* LUT = (LAS float*)(shm + L_LUT);
        if (prep) {
        if (tid < 384) { const int d = 319 - tid; LUT[tid] = d < 0 ? -INFINITY : rel_bias[REL_BUCKET_LUT[d > 127 ? 127 : d] * NH + h] * LOG2E; }
        const int dch = lane & 7, rs = lane >> 3;
        for (int mb = 0; mb < 7; ++mb) {
            float s[8];
#pragma unroll
            for (int c = 0; c < 8; ++c) s[c] = 0.f;
#pragma unroll
            for (int j = 0; j < 4; ++j) { const v4u w = *(const v4u*)(Kh + (long)(mb * 256 + wid * 32 + j * 8 + rs) * PITCH + dch * 8);
                s[0] += bf_lo(w.x); s[1] += bf_hi(w.x); s[2] += bf_lo(w.y); s[3] += bf_hi(w.y); s[4] += bf_lo(w.z); s[5] += bf_hi(w.z); s[6] += bf_lo(w.w); s[7] += bf_hi(w.w); }
#pragma unroll
            for (int c = 0; c < 8; ++c) { s[c] += shx(s[c], 8, lane); s[c] += shx(s[c], 16, lane); s[c] += shx(s[c], 32, lane); }
            if (rs == 0) {
#pragma unroll
                for (int c = 0; c < 8; ++c) KPART[(mb * 8 + wid) * 64 + dch * 8 + c] = s[c]; }
        }
        __syncthreads();
        { const int mb = tid >> 6, d = tid & 63; if (mb < 7) { float t = 0.f;
#pragma unroll
            for (int w = 0; w < 8; ++w) t += KPART[(mb * 8 + w) * 64 + d];
            KMEAN[mb * 64 + d] = t * (1.0f / 256.0f); } }
        __syncthreads();
        }
        { const int q = tid >> 1, dh = tid & 1; const bf16* qp = Q + (rowbase + q0 + q) * PITCH + h * HD + dh * 32; float qv[32];
#pragma unroll
            for (int j = 0; j < 4; ++j) { const v4u w = *(const v4u*)(qp + j * 8); qv[j * 8 + 0] = bf_lo(w.x); qv[j * 8 + 1] = bf_hi(w.x); qv[j * 8 + 2] = bf_lo(w.y); qv[j * 8 + 3] = bf_hi(w.y); qv[j * 8 + 4] = bf_lo(w.z); qv[j * 8 + 5] = bf_hi(w.z); qv[j * 8 + 6] = bf_lo(w.w); qv[j * 8 + 7] = bf_hi(w.w); }
            float g[7];
#pragma unroll
            for (int mb = 0; mb < 7; ++mb) { float a = 0.f; if (mb < qb) {
#pragma unroll
                    for (int d = 0; d < 32; ++d) a += qv[d] * KMEAN[mb * 64 + dh * 32 + d]; }
                a += shx(a, 1, lane); g[mb] = a; }
            unsigned mask = 0u;
            if (qb <= 3) mask = (1u << qb) - 1u;
            else {
#pragma unroll
                for (int pass = 0; pass < 3; ++pass) { float best = -INFINITY; int bi = 0;
#pragma unroll
                    for (int mb = 0; mb < 7; ++mb) if (mb < qb && !((mask >> mb) & 1u) && g[mb] > best) { best = g[mb]; bi = mb; }
                    mask |= 1u << bi; } }
            if (dh == 0) SEL[q] = (unsigned char)mask; }
        __syncthreads();
        selmask = SEL[qrel]; biasfar = LUT[319 - 127];
    }
    f32x16 o[2]; o[0] = splat16(0.f); o[1] = splat16(0.f);
    float m_run = 0.f, l_run = 0.f, carry = 0.f; bool first = true;
    bf16x8 tri0, tri1, ones;
#pragma unroll
    for (int jj = 0; jj < 8; ++jj) { const int j0 = 8 * (jj >> 2) + 4 * hi + (jj & 3); tri0[jj] = (j0 >= r32) ? (short)0x3F80 : (short)0; tri1[jj] = (16 + j0 >= r32) ? (short)0x3F80 : (short)0; ones[jj] = (short)0x3F80; }
    const int jd = wid >> 1;
    bool mydone = false;
    for (int i = 0; i < NT; ++i) {
        const int kt = NT - 1 - i; const int slot = (i % NSLOT) * SLOTB;
        { const int n = (NT - 1 - i) < (NSLOT - 2) ? (NT - 1 - i) : (NSLOT - 2);
          if (n >= 6) ATT_WAIT_BAR(12); else if (n == 5) ATT_WAIT_BAR(10); else if (n == 4) ATT_WAIT_BAR(8); else if (n == 3) ATT_WAIT_BAR(6); else if (n == 2) ATT_WAIT_BAR(4); else if (n == 1) ATT_WAIT_BAR(2); else ATT_WAIT_BAR(0); }
        if constexpr (!MOBA) { if (i >= 1) { const v4u d0 = *(const LAS v4u*)doneAt, d1 = *(const LAS v4u*)(doneAt + 4); const int lim = i - 1;
                bool all = ((int)d0.x <= lim) && ((int)d0.y <= lim) && ((int)d0.z <= lim) && ((int)d0.w <= lim) && ((int)d1.x <= lim) && ((int)d1.y <= lim) && ((int)d1.z <= lim) && ((int)d1.w <= lim);
                if (__builtin_amdgcn_readfirstlane(all ? 1 : 0)) break; } }
        if (i + NSLOT - 1 < NT) { DMA_K(kt - (NSLOT - 1), ((i + NSLOT - 1) % NSLOT) * SLOTB); DMA_V(kt - (NSLOT - 1), ((i + NSLOT - 1) % NSLOT) * SLOTB); }
        if constexpr (!MOBA) { if (mydone) continue; }
        const int jb = kt - (NT - 4);
        if (jb > jd) continue;
        const bool diag = (jb == jd);
        f32x16 p0, p1;
        if constexpr (MOBA) {
            const bool band = jb >= 0; const int mblk = kt >> 2;
            const bool sel = band || ((selmask >> mblk) & 1u);
            if (!__any(sel)) continue;
            const int dmin = (q0 + wid * 32) - (64 * kt + 63);
            const bool near = dmin < 113;
            const float ci = sel ? ((near ? 0.f : biasfar) - m_run) : -INFINITY;
            const f32x16 cinit = splat16(ci);
            qkt(p0, p1, Kbase + slot, qr, cinit, r32, hi);
            if (near) { const LAS float* rl = (const LAS float*)(shm + L_LUT) + (319 - ((q0 + qrel) - 64 * kt) + 4 * hi);
                asm volatile("" : "+v"(rl));
#pragma unroll
                for (int r = 0; r < 16; ++r) { p0[r] += rl[(r & 3) + 8 * (r >> 2)]; p1[r] += rl[(r & 3) + 8 * (r >> 2) + 32]; } }
            float rma = max3f(p0[0], p0[1], p1[0]), rmb = max3f(p0[2], p0[3], p1[1]); rma = max3f(rma, p1[2], p1[3]);
#pragma unroll
            for (int r = 4; r < 16; r += 4) { rma = max3f(rma, p0[r], p0[r + 1]); rmb = max3f(rmb, p0[r + 2], p0[r + 3]); rma = max3f(rma, p1[r], p1[r + 1]); rmb = max3f(rmb, p1[r + 2], p1[r + 3]); }
            float rm = max2f(rma, rmb);
            { const unsigned rb_ = __builtin_bit_cast(unsigned, rm);
              const auto sw_ = __builtin_amdgcn_permlane32_swap(rb_, rb_, false, false);
              rm = __builtin_fmaxf(__builtin_bit_cast(float, (unsigned)sw_[0]), __builtin_bit_cast(float, (unsigned)sw_[1])); }
            const bool grow = first || (rm > 8.0f);
            if (__any(grow)) { const float dl = grow ? rm : 0.f; m_run += dl; const float alpha = fast_exp2(-dl); l_run = first ? 0.f : l_run * alpha;
#pragma unroll
                for (int r = 0; r < 16; ++r) { p0[r] -= dl; p1[r] -= dl; }
                if (!first) { if (hi == 0) wsf[r32] = alpha; LDS_WAIT();
#pragma unroll
                    for (int d_ = 0; d_ < 2; ++d_)
#pragma unroll
                        for (int r = 0; r < 16; ++r) o[d_][r] *= wsf[crow(r, hi)];
                    LDS_WAIT(); } }
            first = false;
            l_run += exp_pv<false>(o, vb0 + slot, p0, p1, p0, p1);
            continue;
        } else {
            const f32x16 zero = splat16(0.f);
            qkt(p0, p1, Kbase + slot, qr, zero, r32, hi);
            f32x16 s0, s1;
            const int kq = qrel - 64 * (jb < 0 ? 0 : jb);
            if (diag) {
#pragma unroll
                for (int r = 0; r < 16; ++r) { const int kv = crow(r, hi); if (kv >= kq) p0[r] = -1e30f; if (kv + 32 >= kq) p1[r] = -1e30f; } }
#pragma unroll
            for (int r = 0; r < 16; ++r) { const float z0 = p0[r], z1 = p1[r];
                const float c0 = min2f(z0, 64.f), c1 = min2f(z1, 64.f);
                s0[r] = fast_log2(1.0f + fast_exp2(c0)) + (z0 - c0); s1[r] = fast_log2(1.0f + fast_exp2(c1)) + (z1 - c1); }
            const bf16x8 L0 = pack8r(s0, 0), L1 = pack8r(s0, 8), L2 = pack8r(s1, 0), L3 = pack8r(s1, 8);
            const f32x16 c16 = splat16(carry);
            f32x16 W0 = __builtin_amdgcn_mfma_f32_32x32x16_bf16(tri0, L0, c16, 0, 0, 0);
            W0 = __builtin_amdgcn_mfma_f32_32x32x16_bf16(tri1, L1, W0, 0, 0, 0);
            W0 = __builtin_amdgcn_mfma_f32_32x32x16_bf16(ones, L2, W0, 0, 0, 0);
            W0 = __builtin_amdgcn_mfma_f32_32x32x16_bf16(ones, L3, W0, 0, 0, 0);
            f32x16 W1 = __builtin_amdgcn_mfma_f32_32x32x16_bf16(tri0, L2, c16, 0, 0, 0);
            W1 = __builtin_amdgcn_mfma_f32_32x32x16_bf16(tri1, L3, W1, 0, 0, 0);
            carry = shl(W0[0], r32);
            if (__all(carry > SB_DONE_THR)) { mydone = true; if (lane == 0) doneAt[wid] = i; }
            (void)exp_pv<true>(o, vb0 + slot, p0, p1, W0, W1);
        }
    }
    asm volatile("s_waitcnt vmcnt(0)" ::: "memory");
    float rli[16];
    if constexpr (MOBA) {
        l_run += shx(l_run, 32, lane);
        if (hi == 0) wsf[32 + r32] = l_run; LDS_WAIT();
#pragma unroll
        for (int r = 0; r < 16; ++r) rli[r] = fast_rcp(wsf[32 + crow(r, hi)]);
    } else {
#pragma unroll
        for (int r = 0; r < 16; ++r) rli[r] = 1.f;
    }
    bf16* Ow = O + (rowbase + q0 + wid * 32) * PITCH + h * HD;
    { LAS bf16* stg = (LAS bf16*)(shm + L_OST) + wid * 2048;
#pragma unroll
        for (int r = 0; r < 16; ++r) { const int orow = crow(r, hi);
#pragma unroll
            for (int d0 = 0; d0 < 2; ++d0) stg[orow * 64 + d0 * 32 + r32] = (bf16)f2bf(o[d0][r] * rli[r]); }
        LDS_WAIT();
#pragma unroll
        for (int i = 0; i < 4; ++i) { const int row = i * 8 + (lane >> 3), ch = lane & 7; const v4u v = *(const LAS v4u*)(stg + row * 64 + ch * 8); *(v4u*)(Ow + (long)row * PITCH + ch * 8) = v; } }
    asm volatile("s_waitcnt lgkmcnt(0)\n\ts_barrier" ::: "memory");
#undef DMA_K
#undef DMA_V
}

typedef float f32x2_t __attribute__((ext_vector_type(2))); typedef __bf16 bf16x2_t __attribute__((ext_vector_type(2)));
__device__ __forceinline__ unsigned cvtpk_s(float lo, float hi) { f32x2_t v = {lo, hi}; bf16x2_t bb = __builtin_convertvector(v, bf16x2_t); return __builtin_bit_cast(unsigned, bb); }
typedef short v4i16_t __attribute__((ext_vector_type(4)));
__device__ __forceinline__ s16x4 vtr(const LAS char* p) { return __builtin_bit_cast(s16x4, __builtin_amdgcn_ds_read_tr16_b64_v4i16((LAS v4i16_t*)p)); }
__device__ __forceinline__ void kload8f(bf16x8* kf, const LAS char* kp) {
    kf[0] = *(const LAS bf16x8*)(kp);        kf[1] = *(const LAS bf16x8*)(kp + 512);  kf[2] = *(const LAS bf16x8*)(kp + 2048); kf[3] = *(const LAS bf16x8*)(kp + 2560);
    kf[4] = *(const LAS bf16x8*)(kp + 4096); kf[5] = *(const LAS bf16x8*)(kp + 4608); kf[6] = *(const LAS bf16x8*)(kp + 6144); kf[7] = *(const LAS bf16x8*)(kp + 6656); }
__device__ __forceinline__ void kload2f(bf16x8* kf, const LAS char* kp, int j) { kf[2 * j] = *(const LAS bf16x8*)(kp + j * 2048); kf[2 * j + 1] = *(const LAS bf16x8*)(kp + j * 2048 + 512); }
__device__ __forceinline__ void moba_unit2(int b, int h, int qb, const bf16* Q, const bf16* __restrict__ Kp, const bf16* __restrict__ Vp, bf16* O, const float* rel_bias, LAS unsigned char* shm, bool prep) {
    constexpr bool MOBA = true; constexpr int NS3 = 3;
    const int tid = otid(), lane = tid & 63, r32 = lane & 31, hi = lane >> 5; const int wid = __builtin_amdgcn_readfirstlane(tid >> 6);
    const long rowbase = (long)b * SEQ; const int q0 = qb * 256;
    const bf16* Qw = Q + (rowbase + q0 + wid * 32) * PITCH + h * HD;
    const bf16* Kh = Kp + rowbase * PITCH + h * HD; const bf16* Vh = Vp + rowbase * PITCH + h * HD;
    const unsigned lds0 = (unsigned)(uintptr_t)shm;
    LAS float* wsf = (LAS float*)(shm + L_WS) + wid * 64;
    const bf16* ksrc = Kh + (long)lane * PITCH + wid * 8;
    const bf16* vsrc = Vh + (long)(16 * (wid & 3) + (lane >> 2)) * PITCH + (wid >> 2) * 32 + (lane & 3) * 8;
    const unsigned kdst = lds0 + L_K + wid * 1024, vdst = lds0 + L_V + wid * 1024;
#define DMA_K(t, slot) glds16(ksrc + (long)(t) * 64 * PITCH, (unsigned)__builtin_amdgcn_readfirstlane(kdst + (slot)))
#define DMA_V(t, slot) glds16(vsrc + (long)(t) * 64 * PITCH, (unsigned)__builtin_amdgcn_readfirstlane(vdst + (slot)))
    const int vb0 = (int)(lds0 + L_V) + ((lane >> 4) & 1) * 32 + (lane & 3) * 8 + (4 * hi + ((lane & 15) >> 2)) * 64;
    const LAS char* Kbase = (const LAS char*)(shm + L_K);
    const LAS char* kp0 = (const LAS char*)(shm + L_K) + hi * 1024 + r32 * 16; const LAS char* vp0 = (const LAS char*)(shm + L_V) + ((lane >> 4) & 1) * 32 + (lane & 3) * 8 + (4 * hi + ((lane & 15) >> 2)) * 64;
    const int NT = 4 * (qb + 1);
    const int qrel = wid * 32 + r32;
    DMA_K(0, 0); DMA_V(0, 0); DMA_K(1, SLOTB);
    bf16x8 qr[4];
#pragma unroll
    for (int d0 = 0; d0 < 4; ++d0) qr[d0] = *(const bf16x8*)(&Qw[(long)r32 * PITCH + d0 * 16 + hi * 8]);
    float biasfar = 0.f; unsigned selmask = 0u;
    {
        LAS float* KPART = (LAS float*)(shm + L_KPART); LAS float* KMEAN = (LAS float*)(shm + L_KMEAN); LAS unsigned char* SEL = (LAS unsigned char*)(shm + L_SEL); LAS float* LUT = (LAS float*)(shm + L_LUT);
        if (prep) {
        if (tid < 384) { const int d = 319 - tid; LUT[tid] = d < 0 ? -INFINITY : rel_bias[REL_BUCKET_LUT[d > 127 ? 127 : d] * NH + h] * LOG2E; }
        const int dch = lane & 7, rs = lane >> 3;
        for (int mb = 0; mb < 7; ++mb) {
            float s[8];
#pragma unroll
            for (int c = 0; c < 8; ++c) s[c] = 0.f;
#pragma unroll
            for (int j = 0; j < 4; ++j) { const v4u w = *(const v4u*)(Kh + (long)(mb * 256 + wid * 32 + j * 8 + rs) * PITCH + dch * 8);
                s[0] += bf_lo(w.x); s[1] += bf_hi(w.x); s[2] += bf_lo(w.y); s[3] += bf_hi(w.y); s[4] += bf_lo(w.z); s[5] += bf_hi(w.z); s[6] += bf_lo(w.w); s[7] += bf_hi(w.w); }
#pragma unroll
            for (int c = 0; c < 8; ++c) { s[c] += shx(s[c], 8, lane); s[c] += shx(s[c], 16, lane); s[c] += shx(s[c], 32, lane); }
            if (rs == 0) {
#pragma unroll
                for (int c = 0; c < 8; ++c) KPART[(mb * 8 + wid) * 64 + dch * 8 + c] = s[c]; }
        }
        __syncthreads();
        { const int mb = tid >> 6, d = tid & 63; if (mb < 7) { float t = 0.f;
#pragma unroll
            for (int w = 0; w < 8; ++w) t += KPART[(mb * 8 + w) * 64 + d];
            KMEAN[mb * 64 + d] = t * (1.0f / 256.0f); } }
        __syncthreads();
        }
        { const int q = tid >> 1, dh = tid & 1; const bf16* qp = Q + (rowbase + q0 + q) * PITCH + h * HD + dh * 32; float qv[32];
#pragma unroll
            for (int j = 0; j < 4; ++j) { const v4u w = *(const v4u*)(qp + j * 8); qv[j * 8 + 0] = bf_lo(w.x); qv[j * 8 + 1] = bf_hi(w.x); qv[j * 8 + 2] = bf_lo(w.y); qv[j * 8 + 3] = bf_hi(w.y); qv[j * 8 + 4] = bf_lo(w.z); qv[j * 8 + 5] = bf_hi(w.z); qv[j * 8 + 6] = bf_lo(w.w); qv[j * 8 + 7] = bf_hi(w.w); }
            float g[7];
#pragma unroll
            for (int mb = 0; mb < 7; ++mb) { float a = 0.f; if (mb < qb) {
#pragma unroll
                    for (int d = 0; d < 32; ++d) a += qv[d] * KMEAN[mb * 64 + dh * 32 + d]; }
                a += shx(a, 1, lane); g[mb] = a; }
            unsigned mask = 0u;
            if (qb <= 3) mask = (1u << qb) - 1u;
            else {
#pragma unroll
                for (int pass = 0; pass < 3; ++pass) { float best = -INFINITY; int bi = 0;
#pragma unroll
                    for (int mb = 0; mb < 7; ++mb) if (mb < qb && !((mask >> mb) & 1u) && g[mb] > best) { best = g[mb]; bi = mb; }
                    mask |= 1u << bi; } }
            if (dh == 0) SEL[q] = (unsigned char)mask; }
        __syncthreads();
        selmask = SEL[qrel]; biasfar = LUT[319 - 127];
    }
    (void)Kbase; (void)vb0;
    float mhat = 0.f, l_reg = 0.f; f32x16 o[2]; o[0] = splat16(0.f); o[1] = splat16(0.f); bf16x8 kf[8];
#define FUT(t) ((((t) - (NT - 4)) > (wid >> 1)))
#define CIN(t) splat16(FUT(t) ? -INFINITY : (((t) >= NT - 4) || ((selmask >> ((t) >> 2)) & 1u)) ? (((((q0 + wid * 32) - (64 * (t) + 63)) < 113) ? 0.f : biasfar) - mhat) : -INFINITY)
#define NEARB(P0, P1, t) do { if ((((q0 + wid * 32) - (64 * (t) + 63)) < 113) && !FUT(t)) { const LAS float* rl = (const LAS float*)(shm + L_LUT) + (319 - ((q0 + qrel) - 64 * (t)) + 4 * hi); asm volatile("" : "+v"(rl)); \
        _Pragma("unroll") for (int r = 0; r < 16; ++r) { P0[r] += rl[(r & 3) + 8 * (r >> 2)]; P1[r] += rl[(r & 3) + 8 * (r >> 2) + 32]; } } } while (0)
    bool resc = false;
#define RESC() do { if (resc) { asm volatile("s_waitcnt lgkmcnt(0)" ::: "memory"); \
        _Pragma("unroll") for (int d_ = 0; d_ < 2; ++d_) _Pragma("unroll") for (int r = 0; r < 16; ++r) o[d_][r] *= wsf[crow(r, hi)]; } } while (0)
    f32x16 pA0, pA1, pB0, pB1;
    int sl_prev = 0, sl_cur = 0, sl_next = SLOTB;
#define ROT() do { sl_prev = sl_cur; sl_cur = sl_next; sl_next = (sl_next == (NS3 - 1) * SLOTB) ? 0 : sl_next + SLOTB; } while (0)
    DMA_K(2, 2 * SLOTB);
    ATT_WAIT_BAR(3);
    { const f32x16 c0_ = CIN(0); qkt(pA0, pA1, (const LAS char*)(shm + L_K), qr, c0_, r32, hi); }
    NEARB(pA0, pA1, 0);
    { float rm = max3f(pA0[0], pA0[1], pA1[0]), rb = max3f(pA0[2], pA0[3], pA1[1]); rm = max3f(rm, pA1[2], pA1[3]);
#pragma unroll
      for (int r = 4; r < 16; r += 4) { rm = max3f(rm, pA0[r], pA0[r + 1]); rb = max3f(rb, pA0[r + 2], pA0[r + 3]); rm = max3f(rm, pA1[r], pA1[r + 1]); rb = max3f(rb, pA1[r + 2], pA1[r + 3]); }
      float m_ = __builtin_fmaxf(rm, rb);
      { const unsigned u_ = __builtin_bit_cast(unsigned, m_); const auto rr = __builtin_amdgcn_permlane32_swap(u_, u_, false, false); m_ = __builtin_fmaxf(__builtin_bit_cast(float, (unsigned)rr[0]), __builtin_bit_cast(float, (unsigned)rr[1])); }
      const float dl = __builtin_fmaxf(m_, -64.f); mhat += dl;
#pragma unroll
      for (int r = 0; r < 16; ++r) { pA0[r] = fast_exp2(pA0[r] - dl); pA1[r] = fast_exp2(pA1[r] - dl); } }
    ATT_WAIT_BAR(0);
    if (3 < NT) DMA_K(3, 0); if (1 < NT) DMA_V(1, SLOTB);
    ROT();
    kload8f(kf, kp0 + sl_cur);
    ATT_WAIT_BAR(2);
    s16x4 vlo[8], vhi[8]; v4u pw0, pw1, pw2, pw3;
#define SBAR() __builtin_amdgcn_sched_barrier(0)
#define PKW(P, B) cvtpk_s(P[B], P[B + 1])
#define PAF(k) __builtin_bit_cast(bf16x8, pw##k)
#define VFR(i) (bf16x8){vlo[i][0], vlo[i][1], vlo[i][2], vlo[i][3], vhi[i][0], vhi[i][1], vhi[i][2], vhi[i][3]}
#define PIN(x) asm volatile("" : "+v"(x))
#define MX3(a, b, c) __builtin_fmaxf(__builtin_fmaxf((a), (b)), (c))
#define GAPA(MF, A0, A1, A2, A3, W0, W1, PW) do { MF; sacc += A0; sacc += A1; sacc += A2; sacc += A3; PIN(sacc); W0; W1; PIN(PW); SBAR(); } while (0)
#define EX(v) __builtin_amdgcn_exp2f(v)
#define GAPB(MF, X, B) do { MF; X[B] = EX(X[B]); X[B + 1] = EX(X[B + 1]); X[B + 2] = EX(X[B + 2]); X[B + 3] = EX(X[B + 3]); PIN(X); SBAR(); } while (0)
#define VRD(i) do { vlo[i] = vtr(vp_ + (((i) >> 2) * 4096 + ((i) & 3) * 1024)); vhi[i] = vtr(vp_ + (((i) >> 2) * 4096 + ((i) & 3) * 1024 + 512)); } while (0)
#define KRD(G, j) do { if (G) { kload2f(kf, kp0 + sl_next, j); SBAR(); } } while (0)
#define STEP(C0, C1, P0, P1, t, GK, GV, GL, NEARH) do { SBAR(); \
    const LAS char* vp_ = vp0 + sl_prev; const f32x16 cin_ = CIN(t); \
    VRD(0); SBAR(); float sacc = (P0[0] + P0[1]); \
    GAPA(C0 = __builtin_amdgcn_mfma_f32_32x32x16_bf16(kf[0], qr[0], cin_, 0, 0, 0), P0[2], P0[3], P0[4], P0[5],     pw0[0] = PKW(P0, 0), pw0[1] = PKW(P0, 2), pw0); \
    VRD(4); SBAR(); GAPA(C1 = __builtin_amdgcn_mfma_f32_32x32x16_bf16(kf[1], qr[0], cin_, 0, 0, 0), P0[6], P0[7], P0[8], P0[9],     pw0[2] = PKW(P0, 4), pw0[3] = PKW(P0, 6), pw0); \
    VRD(1); SBAR(); GAPA(C0 = __builtin_amdgcn_mfma_f32_32x32x16_bf16(kf[2], qr[1], C0, 0, 0, 0),   P0[10], P0[11], P0[12], P0[13], pw1[0] = PKW(P0, 8), pw1[1] = PKW(P0, 10), pw1); \
    VRD(5); SBAR(); GAPA(C1 = __builtin_amdgcn_mfma_f32_32x32x16_bf16(kf[3], qr[1], C1, 0, 0, 0),   P0[14], P0[15], P1[0], P1[1],   pw1[2] = PKW(P0, 12), pw1[3] = PKW(P0, 14), pw1); \
    VRD(2); SBAR(); GAPA(C0 = __builtin_amdgcn_mfma_f32_32x32x16_bf16(kf[4], qr[2], C0, 0, 0, 0),   P1[2], P1[3], P1[4], P1[5],     pw2[0] = PKW(P1, 0), pw2[1] = PKW(P1, 2), pw2); \
    VRD(6); SBAR(); GAPA(C1 = __builtin_amdgcn_mfma_f32_32x32x16_bf16(kf[5], qr[2], C1, 0, 0, 0),   P1[6], P1[7], P1[8], P1[9],     pw2[2] = PKW(P1, 4), pw2[3] = PKW(P1, 6), pw2); \
    VRD(3); SBAR(); GAPA(C0 = __builtin_amdgcn_mfma_f32_32x32x16_bf16(kf[6], qr[3], C0, 0, 0, 0),   P1[10], P1[11], P1[12], P1[13], pw3[0] = PKW(P1, 8), pw3[1] = PKW(P1, 10), pw3); \
    VRD(7); SBAR(); GAPA(C1 = __builtin_amdgcn_mfma_f32_32x32x16_bf16(kf[7], qr[3], C1, 0, 0, 0),   P1[14], P1[15], 0.f, 0.f,       pw3[2] = PKW(P1, 12), pw3[3] = PKW(P1, 14), pw3); \
    l_reg += sacc; \
    if (GK) { DMA_K((t) + 3, sl_cur); } if (GV) { DMA_V((t) + 1, sl_next); } \
    if (NEARH) NEARB(C0, C1, t); \
    { float a = MX3(C0[0], C0[1], C1[0]), bq = MX3(C0[2], C0[3], C1[1]); a = MX3(a, C1[2], C1[3]); \
      _Pragma("unroll") for (int r = 4; r < 16; r += 4) { a = MX3(a, C0[r], C0[r + 1]); bq = MX3(bq, C0[r + 2], C0[r + 3]); a = MX3(a, C1[r], C1[r + 1]); bq = MX3(bq, C1[r + 2], C1[r + 3]); } \
      float rm = __builtin_fmaxf(a, bq); { const unsigned u_ = __builtin_bit_cast(unsigned, rm); const auto rr = __builtin_amdgcn_permlane32_swap(u_, u_, false, false); rm = __builtin_fmaxf(__builtin_bit_cast(float, (unsigned)rr[0]), __builtin_bit_cast(float, (unsigned)rr[1])); } \
      resc = false; \
      if (__builtin_expect(__any(rm > 8.0f), 0)) { const float dl = __builtin_fmaxf(rm, 0.f); mhat += dl; \
        _Pragma("unroll") for (int r = 0; r < 16; ++r) { C0[r] -= dl; C1[r] -= dl; } \
        const float f = __builtin_amdgcn_exp2f(-dl); l_reg *= f; if (hi == 0) wsf[r32] = f; resc = true; } } \
    SBAR(); \
    GAPB(o[0] = __builtin_amdgcn_mfma_f32_32x32x16_bf16(PAF(0), VFR(0), o[0], 0, 0, 0), C0, 0); \
    GAPB(o[1] = __builtin_amdgcn_mfma_f32_32x32x16_bf16(PAF(0), VFR(4), o[1], 0, 0, 0), C0, 4); \
    KRD(GL, 0); GAPB(o[0] = __builtin_amdgcn_mfma_f32_32x32x16_bf16(PAF(1), VFR(1), o[0], 0, 0, 0), C0, 8); \
    KRD(GL, 1); GAPB(o[1] = __builtin_amdgcn_mfma_f32_32x32x16_bf16(PAF(1), VFR(5), o[1], 0, 0, 0), C0, 12); \
    KRD(GL, 2); GAPB(o[0] = __builtin_amdgcn_mfma_f32_32x32x16_bf16(PAF(2), VFR(2), o[0], 0, 0, 0), C1, 0); \
    KRD(GL, 3); GAPB(o[1] = __builtin_amdgcn_mfma_f32_32x32x16_bf16(PAF(2), VFR(6), o[1], 0, 0, 0), C1, 4); \
    GAPB(o[0] = __builtin_amdgcn_mfma_f32_32x32x16_bf16(PAF(3), VFR(3), o[0], 0, 0, 0), C1, 8); \
    GAPB(o[1] = __builtin_amdgcn_mfma_f32_32x32x16_bf16(PAF(3), VFR(7), o[1], 0, 0, 0), C1, 12); \
    } while (0)
    int t = 1;
    for (; t + 7 < NT; t += 2) {
        STEP(pB0, pB1, pA0, pA1, t, true, true, true, false);     ATT_WAIT_BAR(2); RESC(); ROT();
        STEP(pA0, pA1, pB0, pB1, t + 1, true, true, true, false); ATT_WAIT_BAR(2); RESC(); ROT();
    }
#define ENDW(tt) do { if ((tt) + 3 < NT) { ATT_WAIT_BAR(2); } else if ((tt) + 2 < NT) { ATT_WAIT_BAR(1); } else { ATT_WAIT_BAR(0); } } while (0)
    for (; t + 1 < NT; t += 2) {
        STEP(pB0, pB1, pA0, pA1, t, (t + 3 < NT), (t + 1 < NT), (t + 1 < NT), true);           ENDW(t);     RESC(); ROT();
        STEP(pA0, pA1, pB0, pB1, t + 1, (t + 4 < NT), (t + 2 < NT), (t + 2 < NT), true);       ENDW(t + 1); RESC(); ROT();
    }
    STEP(pB0, pB1, pA0, pA1, NT - 1, false, false, false, true); RESC();
    { float sacc = pB0[0] + pB0[1];
#pragma unroll
      for (int r = 2; r < 16; ++r) sacc += pB0[r];
#pragma unroll
      for (int r = 0; r < 16; ++r) sacc += pB1[r];
      l_reg += sacc;
      pw0 = (v4u){PKW(pB0, 0), PKW(pB0, 2), PKW(pB0, 4), PKW(pB0, 6)}; pw1 = (v4u){PKW(pB0, 8), PKW(pB0, 10), PKW(pB0, 12), PKW(pB0, 14)}; pw2 = (v4u){PKW(pB1, 0), PKW(pB1, 2), PKW(pB1, 4), PKW(pB1, 6)}; pw3 = (v4u){PKW(pB1, 8), PKW(pB1, 10), PKW(pB1, 12), PKW(pB1, 14)};
      SBAR(); pv(o, (int)(lds0 + L_V) + ((lane >> 4) & 1) * 32 + (lane & 3) * 8 + (4 * hi + ((lane & 15) >> 2)) * 64 + sl_cur, PAF(0), PAF(1), PAF(2), PAF(3)); }
    { const unsigned u_ = __builtin_bit_cast(unsigned, l_reg); const auto rr = __builtin_amdgcn_permlane32_swap(u_, u_, false, false); l_reg = __builtin_bit_cast(float, (unsigned)rr[0]) + __builtin_bit_cast(float, (unsigned)rr[1]); }
    if (hi == 0) wsf[32 + r32] = l_reg; LDS_WAIT();
    float rli[16];
#pragma unroll
    for (int r = 0; r < 16; ++r) rli[r] = fast_rcp(wsf[32 + crow(r, hi)]);
    bf16* Ow = O + (rowbase + q0 + wid * 32) * PITCH + h * HD;
    { LAS bf16* stg = (LAS bf16*)(shm + L_OST) + wid * 2048;
#pragma unroll
        for (int r = 0; r < 16; ++r) { const int orow = crow(r, hi);
#pragma unroll
            for (int d0 = 0; d0 < 2; ++d0) stg[orow * 64 + d0 * 32 + r32] = (bf16)f2bf(o[d0][r] * rli[r]); }
        LDS_WAIT();
#pragma unroll
        for (int i = 0; i < 4; ++i) { const int row = i * 8 + (lane >> 3), ch = lane & 7; const v4u v = *(const LAS v4u*)(stg + row * 64 + ch * 8); *(v4u*)(Ow + (long)row * PITCH + ch * 8) = v; } }
    asm volatile("s_waitcnt lgkmcnt(0)\n\ts_barrier" ::: "memory");
#undef DMA_K
#undef DMA_V
#undef CIN
#undef FUT
#undef NEARB
#undef RESC
#undef ROT
#undef SBAR
#undef PKW
#undef PAF
#undef VFR
#undef PIN
#undef MX3
#undef GAPA
#undef EX
#undef GAPB
#undef VRD
#undef KRD
#undef STEP
#undef ENDW
}
}

struct Args { const float* in[20]; float* out; unsigned char* ws; int ph_lo, ph_hi; };
struct Frame {
    LAS unsigned char* lds; gu32* ctl; int tid, lane, wave, vcu, G;
};
#define FRESH(F) do { (F).tid = otid(); (F).lane = (F).tid & 63; (F).wave = __builtin_amdgcn_readfirstlane((F).tid >> 6); } while (0)
__device__ __forceinline__ float wave_sum(float v, int lane) {
#pragma unroll
    for (int o = 1; o < 64; o <<= 1) v += shx(v, o, lane);
    return v;
}
__device__ __forceinline__ void transpose_item(const float* W, int K, int N, bf16* WT, int mode, LAS float* scr, int item, int lane) {
    const int nblk = N / 32, kb = item / nblk, nb = item % nblk, k0 = 64 * kb, n0 = 32 * nb;
    const int rbase = (mode == 0) ? n0 : (256 * (n0 >> 7) + (n0 & 127) + (mode == 2 ? 128 : 0));
    { float tv[32];
#pragma unroll
      for (int i = 0; i < 32; ++i) tv[i] = W[(size_t)(k0 + 2 * i + (lane >> 5)) * N + n0 + (lane & 31)];
#pragma unroll
      for (int i = 0; i < 32; ++i) scr[(2 * i + (lane >> 5)) * 33 + (lane & 31)] = tv[i]; }
    LDS_WAIT(); asm volatile("" ::: "memory");
    const int c = lane & 7;
#pragma unroll
    for (int j = 0; j < 4; ++j) { const int n = (lane >> 3) + 8 * j; const LAS float* s = scr + (8 * c) * 33 + n;
        v4u o; o.x = pk2(s[0 * 33], s[1 * 33]); o.y = pk2(s[2 * 33], s[3 * 33]); o.z = pk2(s[4 * 33], s[5 * 33]); o.w = pk2(s[6 * 33], s[7 * 33]);
        *(GAS v4u*)(WT + (size_t)(rbase + n) * K + k0 + 8 * c) = o; }
    LDS_WAIT(); asm volatile("" ::: "memory");
}

__device__ __forceinline__ unsigned pk4_i8(float a, float b, float c, float d) { const int ia = (int)__builtin_rintf(a), ib = (int)__builtin_rintf(b), ic = (int)__builtin_rintf(c), id = (int)__builtin_rintf(d);
    return (unsigned)(ia & 0xff) | ((unsigned)(ib & 0xff) << 8) | ((unsigned)(ic & 0xff) << 16) | ((unsigned)(id & 0xff) << 24); }
template <bool I8>
__device__ __forceinline__ void transpose_item8w(const float* W, int K, int N, unsigned char* WT, int mode, float scale, LAS float* scr, int item, int lane) {
    const int nblk = N / 32, kb = item / nblk, nb = item % nblk, k0 = 128 * kb, n0 = 32 * nb;
    const int rbase = (mode == 0) ? n0 : (256 * (n0 >> 7) + (n0 & 127) + (mode == 2 ? 128 : 0));
    { float tv[64];
#pragma unroll
      for (int i = 0; i < 64; ++i) tv[i] = W[(size_t)(k0 + 2 * i + (lane >> 5)) * N + n0 + (lane & 31)];
#pragma unroll
      for (int i = 0; i < 64; ++i) scr[(2 * i + (lane >> 5)) * 33 + (lane & 31)] = tv[i]; }
    LDS_WAIT(); asm volatile("" ::: "memory");
    const int c = (lane & 3) + 4 * (lane >> 5);
#pragma unroll
    for (int j = 0; j < 4; ++j) { const int n = ((lane >> 2) & 7) + 8 * j; const LAS float* sp = scr + (16 * c) * 33 + n; v4u o;
        if (I8) { o.x = pk4_i8(sp[0 * 33] * scale, sp[1 * 33] * scale, sp[2 * 33] * scale, sp[3 * 33] * scale); o.y = pk4_i8(sp[4 * 33] * scale, sp[5 * 33] * scale, sp[6 * 33] * scale, sp[7 * 33] * scale);
                  o.z = pk4_i8(sp[8 * 33] * scale, sp[9 * 33] * scale, sp[10 * 33] * scale, sp[11 * 33] * scale); o.w = pk4_i8(sp[12 * 33] * scale, sp[13 * 33] * scale, sp[14 * 33] * scale, sp[15 * 33] * scale); }
        else { o.x = pk4_fp8(sp[0 * 33] * scale, sp[1 * 33] * scale, sp[2 * 33] * scale, sp[3 * 33] * scale); o.y = pk4_fp8(sp[4 * 33] * scale, sp[5 * 33] * scale, sp[6 * 33] * scale, sp[7 * 33] * scale);
               o.z = pk4_fp8(sp[8 * 33] * scale, sp[9 * 33] * scale, sp[10 * 33] * scale, sp[11 * 33] * scale); o.w = pk4_fp8(sp[12 * 33] * scale, sp[13 * 33] * scale, sp[14 * 33] * scale, sp[15 * 33] * scale); }
        *(GAS v4u*)(WT + (size_t)(rbase + n) * K + k0 + 16 * c) = o; }
    LDS_WAIT(); asm volatile("" ::: "memory");
}

__device__ __forceinline__ void copy_i8_strip(const float* W, int N, unsigned char* WT, int mode, float* wcs, int nb, LAS unsigned char* lds, int wave, int lane) {
    LAS float* scr = (LAS float*)(lds + wave * 16896); LAS float* CM = (LAS float*)(lds + 8 * 16896);
    const int n0 = 32 * nb, k0 = 128 * wave;
    const int rbase = (mode == 0) ? n0 : (256 * (n0 >> 7) + (n0 & 127) + (mode == 2 ? 128 : 0));
    float cm = 0.f;
    { float tv[64];
#pragma unroll
      for (int i = 0; i < 64; ++i) tv[i] = W[(size_t)(k0 + 2 * i + (lane >> 5)) * N + n0 + (lane & 31)];
#pragma unroll
      for (int i = 0; i < 64; ++i) { cm = fmaxf(cm, fabsf(tv[i])); scr[(2 * i + (lane >> 5)) * 33 + (lane & 31)] = tv[i]; } }
    { const unsigned u_ = __builtin_bit_cast(unsigned, cm); const auto rr = __builtin_amdgcn_permlane32_swap(u_, u_, false, false); cm = fmaxf(__builtin_bit_cast(float, (unsigned)rr[0]), __builtin_bit_cast(float, (unsigned)rr[1])); }
    if (lane < 32) CM[wave * 32 + lane] = cm;
    __syncthreads();
    float ca = 0.f;
#pragma unroll
    for (int w = 0; w < 8; ++w) ca = fmaxf(ca, CM[w * 32 + (lane & 31)]);
    ca = fmaxf(ca, 1e-30f);
    if (wave == 0 && lane < 32) wcs[rbase + lane] = ca * (1.0f / 127.0f);
    const int c = (lane & 3) + 4 * (lane >> 5);
#pragma unroll
    for (int j = 0; j < 4; ++j) { const int n = ((lane >> 2) & 7) + 8 * j; const LAS float* sp = scr + (16 * c) * 33 + n; v4u o;
        const float inv = 127.0f / __builtin_bit_cast(float, __builtin_amdgcn_ds_bpermute(n << 2, __builtin_bit_cast(int, ca)));
        o.x = pk4_i8(sp[0 * 33] * inv, sp[1 * 33] * inv, sp[2 * 33] * inv, sp[3 * 33] * inv); o.y = pk4_i8(sp[4 * 33] * inv, sp[5 * 33] * inv, sp[6 * 33] * inv, sp[7 * 33] * inv);
        o.z = pk4_i8(sp[8 * 33] * inv, sp[9 * 33] * inv, sp[10 * 33] * inv, sp[11 * 33] * inv); o.w = pk4_i8(sp[12 * 33] * inv, sp[13 * 33] * inv, sp[14 * 33] * inv, sp[15 * 33] * inv);
        *(GAS v4u*)(WT + (size_t)(rbase + n) * 1024 + k0 + 16 * c) = o; }
    __syncthreads();
}

struct RowArgs { const void* xin; void* xout;
                  const bf16* Y; const float2* tokw_in; const float* gpost; const float* gate; const float* gpre; const float* shift; const float* scale; bf16* H; float* hscale;
                 const float* wrouter; int* lists; float2* tokw_out; unsigned* cnt; };
template <bool HAS_Y, bool PAIR, bool WRITE_H, bool ROUTER, int HMODE, bool XIN16, bool XOUT16>
__device__ __forceinline__ void row_phase(Frame& F, const void* a_xin, void* a_xout, const bf16* a_Y, const float2* a_tokw_in, const float* a_gpost, const float* a_gate, const float* a_gpre, const float* a_shift, const float* a_scale,
                                          bf16* a_H, float* a_hscale, const float* a_wrouter, int* a_lists, float2* a_tokw_out, unsigned* a_cnt) {
    FRESH(F);
    const int lane = F.lane; const int gw = F.vcu * NWAVES + F.wave; const int rows_per_wave = M / (F.G * NWAVES);
    const int m0 = gw * rows_per_wave; const int b = (F.vcu * NWAVES * rows_per_wave) / SEQ;
    LAS float* wr = (LAS float*)F.lds;
    LAS float* vec = (LAS float*)(F.lds + 32768);
    int my_e0 = -1, my_e1 = -1; float my_w0 = 0.f, my_w1 = 0.f;
    f32x4 rx[4]; v2u rx16[4], ry0[4], ry1[4]; float2 rw = make_float2(0.f, 0.f);
#define ROW_LOAD(mm) do { _Pragma("unroll") for (int j = 0; j < 4; ++j) { \
        if constexpr (XIN16) rx16[j] = *(const v2u*)((const bf16*)a_xin + (size_t)(mm) * D + 256 * j + 4 * lane); else rx[j] = *(const f32x4*)((const float*)a_xin + (size_t)(mm) * D + 256 * j + 4 * lane); \
        if constexpr (HAS_Y) { if (MK_Y8 && PAIR) { const unsigned char* y8_ = (const unsigned char*)a_Y; \
                                   if constexpr (PAIR) { ry0[j].x = *(const unsigned*)(y8_ + (size_t)(2 * (mm)) * D + 256 * j + 4 * lane); ry1[j].x = *(const unsigned*)(y8_ + (size_t)(2 * (mm) + 1) * D + 256 * j + 4 * lane); } \
                                   else ry0[j].x = *(const unsigned*)(y8_ + (size_t)(mm) * D + 256 * j + 4 * lane); } \
                               else if constexpr (PAIR) { ry0[j] = *(const v2u*)(a_Y + (size_t)(2 * (mm)) * D + 256 * j + 4 * lane); ry1[j] = *(const v2u*)(a_Y + (size_t)(2 * (mm) + 1) * D + 256 * j + 4 * lane); } \
                               else ry0[j] = *(const v2u*)(a_Y + (size_t)(mm) * D + 256 * j + 4 * lane); } } \
        if constexpr (HAS_Y && PAIR) rw = a_tokw_in[(mm)]; } while (0)
    ROW_LOAD(m0);
    if constexpr (ROUTER) { for (int i = F.tid; i < D * NE / 4; i += NTHREADS) { const f32x4 v = ((const f32x4*)a_wrouter)[i]; const int col = i >> 1, e0 = (i & 1) * 4;
            wr[(e0 + 0) * D + col] = v.x; wr[(e0 + 1) * D + col] = v.y; wr[(e0 + 2) * D + col] = v.z; wr[(e0 + 3) * D + col] = v.w; } }
    for (int i = F.tid; i < D; i += NTHREADS) {
        if (HAS_Y) { vec[i] = a_gpost[i]; vec[D + i] = a_gate[(size_t)b * NMOD + i]; }
        if (WRITE_H) { vec[2 * D + i] = a_gpre[i]; vec[3 * D + i] = a_shift[(size_t)b * NMOD + i]; vec[4 * D + i] = a_scale[(size_t)b * NMOD + i] + 1.0f; } }
    __syncthreads();
    for (int i = 0; i < rows_per_wave; ++i) { const int m = m0 + i;
        f32x4 x[4];
#pragma unroll
        for (int j = 0; j < 4; ++j) { if constexpr (XIN16) x[j] = (f32x4){bf_lo(rx16[j].x), bf_hi(rx16[j].x), bf_lo(rx16[j].y), bf_hi(rx16[j].y)}; else x[j] = rx[j]; }
        f32x4 y[4];
        if constexpr (HAS_Y) {
            if constexpr (PAIR) { const float2 w = rw;
#pragma unroll
                for (int j = 0; j < 4; ++j) { const v2u u0 = ry0[j], u1 = ry1[j];
                    if (MK_Y8) { const f32x2 a0 = __builtin_amdgcn_cvt_pk_f32_fp8((int)u0.x, false), a1 = __builtin_amdgcn_cvt_pk_f32_fp8((int)u0.x, true), b0 = __builtin_amdgcn_cvt_pk_f32_fp8((int)u1.x, false), b1 = __builtin_amdgcn_cvt_pk_f32_fp8((int)u1.x, true);
                        y[j] = (f32x4){w.x * a0.x + w.y * b0.x, w.x * a0.y + w.y * b0.y, w.x * a1.x + w.y * b1.x, w.x * a1.y + w.y * b1.y}; }
                    else y[j] = (f32x4){w.x * bf_lo(u0.x) + w.y * bf_lo(u1.x), w.x * bf_hi(u0.x) + w.y * bf_hi(u1.x), w.x * bf_lo(u0.y) + w.y * bf_lo(u1.y), w.x * bf_hi(u0.y) + w.y * bf_hi(u1.y)}; }
            } else {
#pragma unroll
                for (int j = 0; j < 4; ++j) { const v2u u0 = ry0[j];
                    y[j] = (f32x4){bf_lo(u0.x), bf_hi(u0.x), bf_lo(u0.y), bf_hi(u0.y)}; }
            }
        }
        if (i + 1 < rows_per_wave) ROW_LOAD(m + 1);
        if constexpr (HAS_Y) {
            float s = 0.f;
#pragma unroll
            for (int j = 0; j < 4; ++j) s += (y[j].x * y[j].x + y[j].y * y[j].y) + (y[j].z * y[j].z + y[j].w * y[j].w);
            const float rstd = 1.0f / sqrtf(wave_sum(s, lane) * (1.0f / D) + EPS);
#pragma unroll
            for (int j = 0; j < 4; ++j) { const f32x4 gp = *(const LAS f32x4*)(vec + 256 * j + 4 * lane), gt = *(const LAS f32x4*)(vec + D + 256 * j + 4 * lane);
                x[j] = x[j] + gt * ((y[j] * rstd) * gp);
                if constexpr (XOUT16) { v2u o; o.x = pk2(x[j].x, x[j].y); o.y = pk2(x[j].z, x[j].w); *(v2u*)((bf16*)a_xout + (size_t)m * D + 256 * j + 4 * lane) = o; }
                else *(f32x4*)((float*)a_xout + (size_t)m * D + 256 * j + 4 * lane) = x[j]; }
        }
        if constexpr (WRITE_H) {
            float s = 0.f;
#pragma unroll
            for (int j = 0; j < 4; ++j) s += (x[j].x * x[j].x + x[j].y * x[j].y) + (x[j].z * x[j].z + x[j].w * x[j].w);
            const float rstd = 1.0f / sqrtf(wave_sum(s, lane) * (1.0f / D) + EPS);
#pragma unroll
            for (int j = 0; j < 4; ++j) { const f32x4 gp = *(const LAS f32x4*)(vec + 2 * D + 256 * j + 4 * lane), sh = *(const LAS f32x4*)(vec + 3 * D + 256 * j + 4 * lane), sc = *(const LAS f32x4*)(vec + 4 * D + 256 * j + 4 * lane);
                x[j] = ((x[j] * rstd) * gp) * sc + sh; }
            if constexpr (HMODE == 2) {
                float am = 0.f;
#pragma unroll
                for (int j = 0; j < 4; ++j) am = fmaxf(fmaxf(am, fmaxf(fabsf(x[j].x), fabsf(x[j].y))), fmaxf(fabsf(x[j].z), fabsf(x[j].w)));
#pragma unroll
                for (int o = 1; o < 64; o <<= 1) am = fmaxf(am, shx(am, o, lane));
                am = fmaxf(am, 1e-30f); const float inv = 127.0f / am;
                if (lane == 0) a_hscale[m] = am * (1.0f / 127.0f);
#pragma unroll
                for (int j = 0; j < 4; ++j) *(unsigned*)((unsigned char*)a_H + (size_t)m * D + 256 * j + 4 * lane) = pk4_i8(x[j].x * inv, x[j].y * inv, x[j].z * inv, x[j].w * inv);
            } else {
#pragma unroll
            for (int j = 0; j < 4; ++j) {
                if constexpr (HMODE == 1) { *(unsigned*)((unsigned char*)a_H + (size_t)m * D + 256 * j + 4 * lane) = pk4_fp8(x[j].x, x[j].y, x[j].z, x[j].w); }
                else { v2u o; o.x = pk2(x[j].x, x[j].y); o.y = pk2(x[j].z, x[j].w); *(v2u*)(a_H + (size_t)m * D + 256 * j + 4 * lane) = o; } } }
            if constexpr (ROUTER) {
                float lg[NE];
#pragma unroll
                for (int e = 0; e < NE; ++e) lg[e] = 0.f;
#pragma unroll
                for (int j = 0; j < 4; ++j) {
#pragma unroll
                    for (int e = 0; e < NE; ++e) { const f32x4 w = *(const LAS f32x4*)(wr + e * D + 256 * j + 4 * lane);
                        lg[e] += (x[j].x * w.x + x[j].y * w.y) + (x[j].z * w.z + x[j].w * w.w); }
                    asm volatile("" ::: "memory"); }
#pragma unroll
                for (int e = 0; e < NE; ++e) lg[e] = wave_sum(lg[e], lane);
                int e0 = 0; float v0 = lg[0];
#pragma unroll
                for (int e = 1; e < NE; ++e) if (lg[e] > v0) { v0 = lg[e]; e0 = e; }
                int e1 = -1; float v1 = -INFINITY;
#pragma unroll
                for (int e = 0; e < NE; ++e) if (e != e0 && lg[e] > v1) { v1 = lg[e]; e1 = e; }
                const float t = fast_exp2((v1 - v0) * LOG2E); const float w0 = 1.0f / (1.0f + t), w1 = t / (1.0f + t);
                if (lane == i) { my_e0 = e0; my_e1 = e1; my_w0 = w0; my_w1 = w1; }
            }
        }
    }
    if constexpr (ROUTER) {
        const bool act = lane < rows_per_wave; int pos0 = 0, pos1 = 0;
        const unsigned long long lt = (1ull << lane) - 1ull;
#pragma unroll
        for (int e = 0; e < NE; ++e) { const unsigned long long b0 = __ballot(act && my_e0 == e), b1 = __ballot(act && my_e1 == e);
            const int n0 = __popcll(b0), n1 = __popcll(b1); int base = 0;
            if (n0 + n1 > 0) { if (lane == 0) base = (int)__hip_atomic_fetch_add(a_cnt + 64 * e, (unsigned)(n0 + n1), RLX_AGENT); base = __builtin_amdgcn_readfirstlane(base); }
            if (act && my_e0 == e) pos0 = base + __popcll(b0 & lt);
            if (act && my_e1 == e) pos1 = base + n0 + __popcll(b1 & lt); }
        if (act) { const int m = m0 + lane; a_lists[my_e0 * M + pos0] = 2 * m; a_lists[my_e1 * M + pos1] = 2 * m + 1; a_tokw_out[m] = make_float2(my_w0, my_w1); }
    }
    __syncthreads();
}

#undef ROW_LOAD
template <class Sched>
__device__ __forceinline__ void moe_tables(Frame& F, const Sched& S, const int* lists, int panel0) {
    FRESH(F);
    LAS int* seg = (LAS int*)(F.lds + LDS_SEG); LAS unsigned short* tok = (LAS unsigned short*)(F.lds + LDS_TOK);
    if (F.tid < NE) seg[16 + F.tid] = (int)__hip_atomic_load((unsigned*)(F.ctl + CW_CNT + 64 * F.tid), RLX_AGENT);
    __syncthreads();
    if (F.tid == 0) { int acc = 0;
        for (int e = 0; e < NE; ++e) { seg[e] = acc; acc += (seg[16 + e] + 255) & ~255; }
        seg[8] = acc; }
    __syncthreads();
    Sched S2 = S; S2.c = obid(); pg8::Unit u;
#pragma unroll 1
    for (int ui = F.wave; ui < LDS_TOK_UNITS; ui += NWAVES) {
        if (!S2.next(ui, u)) break;
        const int prow = (panel0 + u.pm) * 256; int e = 0;
#pragma unroll
        for (int j = 1; j < NE; ++j) e += (prow >= seg[j]) ? 1 : 0;
        const int pos0 = prow - seg[e], cnt_e = seg[16 + e]; int v[4];
#pragma unroll
        for (int j = 0; j < 4; ++j) { const int pos = pos0 + F.lane + 64 * j; v[j] = (pos < cnt_e) ? lists[e * M + pos] : 0; }
#pragma unroll
        for (int j = 0; j < 4; ++j) tok[ui * 256 + F.lane + 64 * j] = (unsigned short)v[j];
    }
    __syncthreads();
}

constexpr int PH_LAYER0 = 3, PH_STRIDE = 16, PH_END = PH_LAYER0 + 2 * PH_STRIDE;
__global__ void __launch_bounds__(NTHREADS, 2) mega_fwd(Args args) {
    extern __shared__ __attribute__((aligned(16))) unsigned char lds_raw[];
    Frame F; F.lds = (LAS unsigned char*)lds_raw; F.tid = threadIdx.x; F.lane = F.tid & 63; F.wave = __builtin_amdgcn_readfirstlane(F.tid >> 6);
    F.G = gridDim.x; { const int bx = blockIdx.x; F.vcu = (F.G % 8 == 0) ? (bx % 8) * (F.G / 8) + bx / 8 : bx; }
    unsigned char* ws = args.ws; F.ctl = (gu32*)(ws + WS_CTL);
    volatile LAS unsigned* MISC = (volatile LAS unsigned*)(F.lds + LDS_MISC);
    if (F.tid < 16) MISC[F.tid] = 0u;
    __syncthreads();
    XcdBarrier bar; bar.bar = (unsigned*)(F.ctl + CW_BAR); bar.x = 0; bar.st = nullptr;
    if (MK_ONE_LAUNCH) bar = xcd_barrier_post((unsigned*)(F.ctl + CW_BAR), MISC);
    const int lo = args.ph_lo, hi = args.ph_hi;
#define IN(k) (lo <= (k) && (k) < hi)
#define SEAM(k, knext) do { if (IN(k) && IN(knext)) xcd_barrier(bar); } while (0)
    const float* x_in = args.in[0]; const float* c_in = args.in[1]; const float* w_mod = args.in[2]; const float* b_mod = args.in[3];
    const float* g_mix_pre = args.in[4]; const float* g_mix_post = args.in[5]; const float* g_ffn_pre = args.in[6]; const float* g_ffn_post = args.in[7];
    const float* w_in = args.in[8]; const float* w_psb = args.in[9]; const float* w_pmb = args.in[10]; const float* w_out = args.in[11]; const float* rel_bias = args.in[12];
    const float* w1d = args.in[13]; const float* w3d = args.in[14]; const float* w2d = args.in[15]; const float* w_router = args.in[16];
    const float* w1m = args.in[17]; const float* w3m = args.in[18]; const float* w2m = args.in[19];
    float* xout = args.out;
    bf16* XB1 = (bf16*)args.out; bf16* XB2 = (bf16*)args.out + (size_t)M * D; bf16* XB3 = (bf16*)(ws + WS_H + 32 * MiB);
    float* MOD = (float*)(ws + WS_MOD); int* LISTS = (int*)(ws + WS_LIST); float2* TOKW = (float2*)(ws + WS_TOKW);
    unsigned char* WIN = ws + WS_WIN; float* HSCALE = (float*)(ws + WS_HSCALE); bf16* WPSB = (bf16*)(ws + WS_WPSB); bf16* WPMB = (bf16*)(ws + WS_WPMB); bf16* WOUT = (bf16*)(ws + WS_WOUT);
    unsigned char* W13D = ws + WS_W13D; unsigned char* W2D = ws + WS_W2D; unsigned char* W13M = ws + WS_W13M; unsigned char* W2M = ws + WS_W2M;
    bf16* H = (bf16*)(ws + WS_H); bf16* BIG = (bf16*)(ws + WS_BIG);

#if defined(MK_PROBE_PRO2)
    for (int prep_ = 0; prep_ < 2; ++prep_) {
#endif
    if (!SK(0) && IN(0)) {
        FRESH(F);
        if ((int)blockIdx.x < 192) {
            LAS float* cond = (LAS float*)F.lds;
            LAS float* part = (LAS float*)(F.lds + 65536);
            { static_assert(NB * D == 32 * NTHREADS, "cond fill"); float cv[32];
#pragma unroll
              for (int t = 0; t < 32; ++t) cv[t] = c_in[F.tid + t * NTHREADS];
#pragma unroll
              for (int t = 0; t < 32; ++t) { const int i = F.tid + t * NTHREADS, bb = i / D, k = i % D; cond[k * 16 + bb] = cv[t] * sigmoidf_(cv[t]); } }
            __syncthreads();
            const int l = (int)blockIdx.x / 96, n0 = ((int)blockIdx.x % 96) * 64;
            float acc[16];
#pragma unroll
            for (int bb = 0; bb < 16; ++bb) acc[bb] = 0.f;
            const float* wp = w_mod + (size_t)l * D * NMOD + n0 + F.lane;
            float wnx[16];
#pragma unroll
            for (int j = 0; j < 16; ++j) wnx[j] = wp[(size_t)(F.wave * 128 + j) * NMOD];
#pragma unroll
            for (int k8 = 0; k8 < 128; k8 += 16) { float wv16[16];
#pragma unroll
              for (int j = 0; j < 16; ++j) wv16[j] = wnx[j];
              if (k8 + 16 < 128) {
#pragma unroll
                for (int j = 0; j < 16; ++j) wnx[j] = wp[(size_t)(F.wave * 128 + k8 + 16 + j) * NMOD]; }
#pragma unroll 4
              for (int j = 0; j < 16; ++j) { const int k = F.wave * 128 + k8 + j; const float wv = wv16[j];
                const LAS f32x4* cp = (const LAS f32x4*)(cond + k * 16); const f32x4 c0 = cp[0], c1 = cp[1], c2 = cp[2], c3 = cp[3];
                acc[0] += c0.x * wv; acc[1] += c0.y * wv; acc[2] += c0.z * wv; acc[3] += c0.w * wv; acc[4] += c1.x * wv; acc[5] += c1.y * wv; acc[6] += c1.z * wv; acc[7] += c1.w * wv;
                acc[8] += c2.x * wv; acc[9] += c2.y * wv; acc[10] += c2.z * wv; acc[11] += c2.w * wv; acc[12] += c3.x * wv; acc[13] += c3.y * wv; acc[14] += c3.z * wv; acc[15] += c3.w * wv; } }
#pragma unroll
            for (int bb = 0; bb < 16; ++bb) part[(F.wave * 16 + bb) * 64 + F.lane] = acc[bb];
            __syncthreads();
            for (int i = F.tid; i < 16 * 64; i += NTHREADS) { const int bb = i >> 6, n = i & 63; float s = b_mod[(size_t)l * NMOD + n0 + n];
#pragma unroll
                for (int w = 0; w < 8; ++w) s += part[(w * 16 + bb) * 64 + n];
                MOD[((size_t)l * NB + bb) * NMOD + n0 + n] = s; }
            __syncthreads();
            if (F.tid == 0) { __builtin_amdgcn_fence(__ATOMIC_RELEASE, "agent"); asm volatile("s_waitcnt vmcnt(0)" ::: "memory"); (void)xb_add((unsigned*)(F.ctl + CW_MODF), 1u); }
        }
    }
    if (!SK(0) && IN(1)) {
        FRESH(F);
        LAS float* scr = (LAS float*)(F.lds + F.wave * 16896);
        const int gw = F.vcu * NWAVES + F.wave, NGW = F.G * NWAVES;
        constexpr int I_IN = (D / 128) * (INCOLS / 32), I_P = (WH / 64) * (D / 32), I_O = (D / 128) * (D / 32), I_13 = (D / 128) * (FF / 32), I_2 = (FF / 128) * (D / 32);
        constexpr int N_P = 4 * I_P, N_O = 2 * I_O, N_13 = 16 * I_13, N_2 = 9 * I_2, NITEMS = N_P + N_O + N_13 + N_2; (void)I_IN;
        { constexpr int S_IN = INCOLS / 32, S_13 = FF / 32, NSTRIP = 2 * S_IN + 2 * S_13;
          float* WCS = (float*)(ws + WS_WCS);
          for (int si = F.vcu; si < NSTRIP; si += F.G) {
              const float* W_; int N_, mode_, nb_; unsigned char* WT_; float* wc_;
              if (si < 2 * S_IN) { const int l = si / S_IN; W_ = w_in + (size_t)l * D * INCOLS; N_ = INCOLS; WT_ = WIN + (size_t)l * INCOLS * D; mode_ = 0; wc_ = WCS + (size_t)l * INCOLS; nb_ = si % S_IN; }
              else { const int r_ = si - 2 * S_IN, q = r_ / S_13; W_ = q == 0 ? w1d : w3d; N_ = FF; WT_ = W13D; mode_ = 1 + q; wc_ = WCS + 16384; nb_ = r_ % S_13; }
              copy_i8_strip(W_, N_, WT_, mode_, wc_, nb_, F.lds, F.wave, F.lane); } }
        const bool freewg = MK_ONE_LAUNCH && F.G == 256 && (int)blockIdx.x >= 192;
        const int XH = (MK_ONE_LAUNCH && F.G == 256) ? MK_HEAD : 0, fw = ((int)blockIdx.x - 192) * NWAVES + F.wave, nh = freewg ? XH / (64 * NWAVES) : 0;
#pragma unroll 1
        for (int j = 0; ; ++j) {
            const int it = j < nh ? fw + j * (64 * NWAVES) : XH + gw + (j - nh) * NGW; if (it >= NITEMS) break;
            int r = it;
            if (r < N_P) { const int q = r / I_P, l = q & 1; const float* src = (q < 2 ? w_psb : w_pmb) + (size_t)l * WH * D; bf16* dst = (q < 2 ? WPSB : WPMB) + (size_t)l * D * WH; transpose_item(src, WH, D, dst, 0, scr, r % I_P, F.lane); continue; } r -= N_P;
            if (r < N_O) { const int l = r / I_O; transpose_item8w<false>(w_out + (size_t)l * D * D, D, D, (unsigned char*)WOUT + (size_t)l * D * D, 0, WO_SCALE, scr, r % I_O, F.lane); continue; } r -= N_O;
            if (r < N_13) { const int q = 2 + r / I_13; const float* src; unsigned char* dst; int mode;
                if (q < 10) { src = w1m + (size_t)(q - 2) * D * FF; dst = W13M + (size_t)(q - 2) * 2 * FF * D; mode = 1; }
                else { src = w3m + (size_t)(q - 10) * D * FF; dst = W13M + (size_t)(q - 10) * 2 * FF * D; mode = 2; }
                transpose_item8w<false>(src, D, FF, dst, mode, W13_SCALE, scr, r % I_13, F.lane); continue; } r -= N_13;
            { const int q = r / I_2; const float* src = (q == 0) ? w2d : w2m + (size_t)(q - 1) * FF * D; unsigned char* dst = (q == 0) ? W2D : W2M + (size_t)(q - 1) * D * FF; transpose_item8w<false>(src, FF, D, dst, 0, W2_SCALE, scr, r % I_2, F.lane); }
        }
    }
    if (IN(0) && IN(2) && F.tid == 0) { unsigned sp_ = 0; while (xb_ld((unsigned*)(F.ctl + CW_MODF)) < 192u) { __builtin_amdgcn_s_sleep(1); if (++sp_ > XB_SPIN_CAP) break; }
        __builtin_amdgcn_fence(__ATOMIC_ACQUIRE, "agent"); asm volatile("s_waitcnt vmcnt(0)" ::: "memory"); }
    __syncthreads();
    if (!SK(1) && IN(2)) {
        RowArgs a{}; a.xin = x_in; a.gpre = g_mix_pre; a.shift = MOD + 0 * D; a.scale = MOD + 1 * D; a.H = H; a.hscale = HSCALE;
        row_phase<false, false, true, false, 2, false, false>(F, a.xin, a.xout, a.Y, a.tokw_in, a.gpost, a.gate, a.gpre, a.shift, a.scale, a.H, a.hscale, a.wrouter, a.lists, a.tokw_out, a.cnt);
    }
    SEAM(2, PH_LAYER0);
#if defined(MK_PROBE_BAR)
    for (int rep_ = 0; rep_ < MK_PROBE_BAR; ++rep_) xcd_barrier(bar);
#endif
#if defined(MK_PROBE_PRO2)
    }
#endif


    for (int l = 0; l < 2; ++l) {
        const int pb = PH_LAYER0 + PH_STRIDE * l;
        const float* modl = MOD + (size_t)l * NB * NMOD;
        if (!SK(2) && IN(pb + 0)) {
            pg8::SchedPlain S; S.init(M / 256, INCOLS / 256, F.G, (int)blockIdx.x); S.A = (const char*)H; S.B = (const char*)(WIN + (size_t)l * INCOLS * D); S.tA = S.tB = (size_t)256 * D;
            { FRESH(F); LAS float* rowf = (LAS float*)(F.lds + LDS_TOK); LAS float* colf = (LAS float*)(F.lds + LDS_COLF);
              const float* wcs = (const float*)(ws + WS_WCS) + (size_t)l * INCOLS;
              pg8::SchedPlain S2 = S; S2.c = obid(); pg8::Unit u;
#pragma unroll 1
              for (int ui = F.wave; ui < 15; ui += NWAVES) { if (!S2.next(ui, u)) break; float v[4], c_[4];
#pragma unroll
                  for (int j = 0; j < 4; ++j) { v[j] = HSCALE[u.pm * 256 + F.lane + 64 * j]; c_[j] = wcs[u.pn * 256 + F.lane + 64 * j]; }
#pragma unroll
                  for (int j = 0; j < 4; ++j) { rowf[ui * 256 + F.lane + 64 * j] = v[j]; colf[ui * 256 + F.lane + 64 * j] = c_[j]; } }
              __syncthreads(); }
            pg8::EpiInProj E{BIG, (const LAS float*)(F.lds + LDS_TOK), 0, (const LAS float*)(F.lds + LDS_COLF)};
#if defined(MK_SKEW_INPROJ)
            { const unsigned long long t0_ = __builtin_amdgcn_s_memrealtime(); const unsigned long long d_ = (unsigned long long)(F.vcu & 7) * MK_SKEW_INPROJ;
              while (__builtin_amdgcn_s_memrealtime() - t0_ < d_) __builtin_amdgcn_s_sleep(8); }
#endif
#if defined(MK_PROBE_INPROJ2)
            for (int rep_ = 0; rep_ < 2; ++rep_) { E.nostore = (rep_ == 1) ? MK_PROBE_INPROJ2 - 1 : 0;
#endif
            pg8::gemm_phase<pg8::EpiInProj, pg8::SchedPlain, true, 2>(F.lds, D / 2, S, E);
#if defined(MK_PROBE_INPROJ2)
            }
#endif
        }
        SEAM(pb + 0, pb + 1);
        if (!SK(3) && IN(pb + 1)) {
            bf16* QA = BIG + BIG_QA / 2; bf16* KA = BIG + BIG_KA / 2; bf16* VA = BIG + BIG_VA / 2; bf16* QB = BIG + BIG_QB / 2; bf16* KB = BIG + BIG_KB / 2; bf16* VB = BIG + BIG_VB / 2;
            for (int v = F.vcu; v < 256; v += F.G) { const int bh = v >> 1, set = v & 1;
                for (int i = 0; i < 8; ++i) { const int k = i & 3; const int qb = set == 0 ? (k == 0 ? 0 : k == 1 ? 7 : k == 2 ? 1 : 6) : (k == 0 ? 2 : k == 1 ? 5 : k == 2 ? 3 : 4);
#if defined(MK_PROBE_ATTN2)
                    const int pass0 = (i < 4) ? (MK_PROBE_ATTN2 != 3 ? 0 : 1) : (MK_PROBE_ATTN2 != 2 ? 0 : 1);
#else
                    const int pass0 = 1;
#endif
                    for (int pass = pass0; pass < 2; ++pass) {
                        if (i < 4) att::attn_unit<false>(bh >> 3, bh & 7, qb, QA, KA, VA, pass == 0 ? H : QA, rel_bias, F.lds, false);
                        else att::moba_unit2(bh >> 3, bh & 7, qb, QB, KB, VB, pass == 0 ? H : QB, rel_bias, F.lds, i == 4 && pass == pass0); } } }
        }
        SEAM(pb + 1, pb + 2);
        if (!SK(4) && IN(pb + 2)) {
            const unsigned char* GA8 = (const unsigned char*)BIG + BIG_GA; const unsigned char* GB8 = GA8 + (size_t)M * D; bf16* TM = BIG + BIG_GB / 2;
            { pg8::SchedPlain S; S.init(M / 256, D / 256, F.G, (int)blockIdx.x); S.A = (const char*)(BIG + BIG_QA / 2); S.B = (const char*)(WPSB + (size_t)l * D * WH); S.tA = S.tB = (size_t)256 * WH * 2;
              pg8::EpiGate<false> E{GA8, TM, (unsigned char*)BIG + BIG_KA}; pg8::gemm_phase<pg8::EpiGate<false>, pg8::SchedPlain, true, 0>(F.lds, WH, S, E); }
            VM_WAIT(); __syncthreads();
            { pg8::SchedPlain S; S.init(M / 256, D / 256, F.G, (int)blockIdx.x); S.A = (const char*)(BIG + BIG_QB / 2); S.B = (const char*)(WPMB + (size_t)l * D * WH); S.tA = S.tB = (size_t)256 * WH * 2;
              pg8::EpiGate<true> E{GB8, TM, (unsigned char*)BIG + BIG_KA}; pg8::gemm_phase<pg8::EpiGate<true>, pg8::SchedPlain, true, 0>(F.lds, WH, S, E); }
        }
        SEAM(pb + 2, pb + 3);
        if (!SK(5) && IN(pb + 3)) {
            pg8::SchedPlain S; S.init(M / 256, D / 256, F.G, (int)blockIdx.x); S.A = (const char*)BIG + BIG_KA; S.B = (const char*)WOUT + (size_t)l * D * D; S.tA = S.tB = (size_t)256 * D;
            pg8::EpiBf16 E{BIG + BIG_Y / 2, D, 1.0f / (WO_SCALE * MG_SCALE)};
#if defined(MK_PROBE_G3)
            for (int rep_ = 0; rep_ < ((MK_PROBE_G3 & 1) ? 2 : 1); ++rep_)
#endif
            pg8::gemm_phase<pg8::EpiBf16, pg8::SchedPlain, true, 1>(F.lds, D / 2, S, E);
        }
        SEAM(pb + 3, pb + 4);
        if (!SK(6) && IN(pb + 4)) {
            RowArgs a{}; if (l == 0) { a.xin = x_in; a.xout = XB1; } else { a.xin = XB2; a.xout = XB3; } a.Y = BIG + BIG_Y / 2; a.gpost = g_mix_post + (size_t)l * D; a.gate = modl + 2 * D;
            a.gpre = g_ffn_pre + (size_t)l * D; a.shift = modl + 3 * D; a.scale = modl + 4 * D; a.H = H;
            a.wrouter = w_router; a.lists = LISTS; a.tokw_out = TOKW; a.cnt = (unsigned*)(F.ctl + CW_CNT);
            a.hscale = HSCALE;
#if defined(MK_PROBE_ROW2)
            if (l == 0) for (int rep_ = 0; rep_ < MK_PROBE_ROW2; ++rep_)
                row_phase<true, false, true, false, 2, false, true>(F, a.xin, a.xout, a.Y, a.tokw_in, a.gpost, a.gate, a.gpre, a.shift, a.scale, a.H, a.hscale, a.wrouter, a.lists, a.tokw_out, a.cnt);
#endif
            if (l == 0) row_phase<true, false, true, false, 2, false, true>(F, a.xin, a.xout, a.Y, a.tokw_in, a.gpost, a.gate, a.gpre, a.shift, a.scale, a.H, a.hscale, a.wrouter, a.lists, a.tokw_out, a.cnt); else row_phase<true, false, true, true, 1, true, true>(F, a.xin, a.xout, a.Y, a.tokw_in, a.gpost, a.gate, a.gpre, a.shift, a.scale, a.H, a.hscale, a.wrouter, a.lists, a.tokw_out, a.cnt);
        }
        SEAM(pb + 4, pb + 5);
        if (l == 0) {
            if (!SK(7) && IN(pb + 5)) {
                pg8::SchedPlain S; S.init(M / 256, 2 * FF / 256, F.G, (int)blockIdx.x); S.A = (const char*)H; S.B = (const char*)W13D; S.tA = S.tB = (size_t)256 * D;
                { FRESH(F); LAS float* rowf = (LAS float*)(F.lds + LDS_TOK); LAS float* colf = (LAS float*)(F.lds + LDS_COLF);
                  const float* wcs = (const float*)(ws + WS_WCS) + 16384;
                  pg8::SchedPlain S2 = S; S2.c = obid(); pg8::Unit u;
#pragma unroll 1
                  for (int ui = F.wave; ui < 15; ui += NWAVES) { if (!S2.next(ui, u)) break; float v[4], c_[4];
#pragma unroll
                      for (int j = 0; j < 4; ++j) { v[j] = HSCALE[u.pm * 256 + F.lane + 64 * j]; c_[j] = wcs[u.pn * 256 + F.lane + 64 * j]; }
#pragma unroll
                      for (int j = 0; j < 4; ++j) { rowf[ui * 256 + F.lane + 64 * j] = v[j]; colf[ui * 256 + F.lane + 64 * j] = c_[j]; } }
                  __syncthreads(); }
                pg8::EpiSwiGLUi8 E{(unsigned char*)BIG + BIG_ACT, (const LAS float*)(F.lds + LDS_TOK), (const LAS float*)(F.lds + LDS_COLF)};
#if defined(MK_PROBE_G3)
                for (int rep_ = 0; rep_ < ((MK_PROBE_G3 & 2) ? 2 : 1); ++rep_)
#endif
                pg8::gemm_phase<pg8::EpiSwiGLUi8, pg8::SchedPlain, true, 2>(F.lds, D / 2, S, E);
            }
            SEAM(pb + 5, pb + 6);
            if (!SK(8) && IN(pb + 6)) {
                pg8::SchedPlain S; S.init(M / 256, D / 256, F.G, (int)blockIdx.x); S.A = (const char*)BIG + BIG_ACT; S.B = (const char*)W2D; S.tA = S.tB = (size_t)256 * FF;
                pg8::EpiBf16 E{BIG + BIG_YF / 2, D, 1.0f / W2_SCALE};
#if defined(MK_PROBE_G3)
                for (int rep_ = 0; rep_ < ((MK_PROBE_G3 & 4) ? 2 : 1); ++rep_)
#endif
                pg8::gemm_phase<pg8::EpiBf16, pg8::SchedPlain, true, 1>(F.lds, FF / 2, S, E);
            }
            SEAM(pb + 6, pb + 11);
        } else {
            for (int c = 0; c < MOE_NCHUNK; ++c) {
                const int panel0 = c * MOE_CHUNK_PANELS;
                int npan = 0;
                if (IN(pb + 5 + 2 * c) || IN(pb + 6 + 2 * c)) { int tot = 0;
                    for (int e = 0; e < NE; ++e) tot += ((int)__hip_atomic_load((unsigned*)(F.ctl + CW_CNT + 64 * e), RLX_AGENT) + 255) >> 8;
                    npan = tot - panel0; npan = npan < 0 ? 0 : (npan > MOE_CHUNK_PANELS ? MOE_CHUNK_PANELS : npan); }
                if (!SK(9) && IN(pb + 5 + 2 * c)) {
                    pg8::SchedMoeUp S; S.init(npan, 2 * FF / 256, F.G, (int)blockIdx.x); S.wsh = MK_WSH_MOEUP; S.A = (const char*)H; S.B = (const char*)W13M; S.tA = 0; S.tB = (size_t)256 * D; S.eB = (size_t)2 * FF * D;
                    S.panel0 = panel0; S.seg = (const LAS int*)(F.lds + LDS_SEG); S.tok = (const LAS unsigned short*)(F.lds + LDS_TOK);
                    moe_tables(F, S, LISTS, panel0);
                    pg8::EpiSwiGLU E{(unsigned char*)BIG + BIG_HID, 1.0f / W13_SCALE};
#if defined(MK_PROBE_MOEUP2)
                    for (int rep_ = 0; rep_ < 2; ++rep_)
#endif
                    pg8::gemm_phase<pg8::EpiSwiGLU, pg8::SchedMoeUp, true, 1>(F.lds, D / 2, S, E);
                }
                SEAM(pb + 5 + 2 * c, pb + 6 + 2 * c);
                if (!SK(10) && IN(pb + 6 + 2 * c)) {
                    pg8::SchedMoeDown S; S.init(npan, D / 256, F.G, (int)blockIdx.x); S.wsh = MK_WSH_MOEDN; S.A = (const char*)BIG + BIG_HID; S.B = (const char*)W2M; S.tA = S.tB = (size_t)256 * FF; S.eB = (size_t)D * FF;
                    S.panel0 = panel0; S.seg = (const LAS int*)(F.lds + LDS_SEG); S.tok = (const LAS unsigned short*)(F.lds + LDS_TOK);
                    int nfull = (S.nwg / F.G) * F.G, ntail = S.nwg - nfull;
                    if (F.G < 128 || ntail > 32 || !MK_SPLIT_TAIL) { nfull = S.nwg; ntail = 0; }
                    S.nwg = nfull;
                    moe_tables(F, S, LISTS, panel0);
                    pg8::EpiMoeDown E{BIG + BIG_YP / 2, (const LAS unsigned short*)(F.lds + LDS_TOK), (const LAS int*)(F.lds + LDS_SEG), 1.0f / W2_SCALE};
#if defined(MK_PROBE_MOEDOWN2)
                    for (int rep_ = 0; rep_ < 2; ++rep_)
#endif
                    pg8::gemm_phase<pg8::EpiMoeDown, pg8::SchedMoeDown, true, 1>(F.lds, FF / 2, S, E);
                    if (MK_SPLIT_TAIL) {
                        pg8::SchedMoeDownTail T; T.init(npan, D / 256, F.G, (int)blockIdx.x); T.wsh = MK_WSH_MOEDN; T.A = S.A; T.B = S.B; T.tA = S.tA; T.tB = S.tB; T.eB = S.eB; T.panel0 = panel0; T.seg = S.seg; T.tok = S.tok; T.nfull = nfull;
                        const int bx = obid(), p = (bx >> 5) * 8 + (bx & 7), sl = (bx >> 3) & 3;
                        T.pidx = (bx < 128 && p < ntail) ? p : -1;
                        const int kt0 = sl == 0 ? 0 : sl == 1 ? 8 : sl == 2 ? 14 : 22, ntk = (sl & 1) ? 6 : 8;
                        T.koff = (size_t)kt0 * 128;
                        moe_tables(F, T, LISTS, panel0);
                        pg8::EpiMoeDownTail ET{BIG + BIG_YP / 2, (const LAS unsigned short*)(F.lds + LDS_TOK), (const LAS int*)(F.lds + LDS_SEG), 1.0f / W2_SCALE, (f32x4*)(ws + WS_H), (unsigned*)(F.ctl + CW_XF), p, sl};
                        pg8::gemm_phase<pg8::EpiMoeDownTail, pg8::SchedMoeDownTail, true, 1>(F.lds, FF / 2, T, ET, ntk);
                    }
                }
                SEAM(pb + 6 + 2 * c, (c + 1 < MOE_NCHUNK) ? pb + 7 + 2 * c : pb + 11);
            }
        }
        if (!SK(11) && IN(pb + 11)) {
            RowArgs a{}; if (l == 0) { a.xin = XB1; a.xout = XB2; } else { a.xin = XB3; a.xout = xout; } a.gpost = g_ffn_post + (size_t)l * D; a.gate = modl + 5 * D; a.H = H;
            if (l == 0) { a.Y = BIG + BIG_YF / 2; a.gpre = g_mix_pre + (size_t)(l + 1) * D; a.shift = MOD + (size_t)(l + 1) * NB * NMOD + 0 * D; a.scale = MOD + (size_t)(l + 1) * NB * NMOD + 1 * D; a.hscale = HSCALE;
                row_phase<true, false, true, false, 2, true, true>(F, a.xin, a.xout, a.Y, a.tokw_in, a.gpost, a.gate, a.gpre, a.shift, a.scale, a.H, a.hscale, a.wrouter, a.lists, a.tokw_out, a.cnt); }
            else { a.Y = BIG + BIG_YP / 2; a.tokw_in = TOKW; row_phase<true, true, false, false, 0, true, false>(F, a.xin, a.xout, a.Y, a.tokw_in, a.gpost, a.gate, a.gpre, a.shift, a.scale, a.H, a.hscale, a.wrouter, a.lists, a.tokw_out, a.cnt); }
        }
        if (l == 0) SEAM(pb + 11, pb + PH_STRIDE);
    }
#undef IN
#undef SEAM
}

extern "C" void kernel_launch(void* const* d_in, const int* in_sizes, int n_in, void* d_out, int out_size, void* d_ws, size_t ws_size, hipStream_t stream) {
    static int grid = 0;
    if (grid == 0) {
        if (n_in != 20 || in_sizes[0] != M * D || out_size != M * D || ws_size < WS_END) { fprintf(stderr, "kernel_launch: unexpected shapes (n_in %d, ws %zu)\n", n_in, ws_size); grid = -1; return; }
        int dev = 0, cus = 0;
        if (hipGetDevice(&dev) != hipSuccess || hipDeviceGetAttribute(&cus, hipDeviceAttributeMultiprocessorCount, dev) != hipSuccess) { grid = -1; return; }
        if (hipFuncSetAttribute((const void*)mega_fwd, hipFuncAttributeMaxDynamicSharedMemorySize, LDS_BYTES) != hipSuccess) { fprintf(stderr, "kernel_launch: hipFuncSetAttribute failed\n"); grid = -1; return; }
        int per_cu = 0;
        if (hipOccupancyMaxActiveBlocksPerMultiprocessor(&per_cu, (const void*)mega_fwd, NTHREADS, LDS_BYTES) != hipSuccess || per_cu < 1) fprintf(stderr, "kernel_launch: occupancy query reports %d\n", per_cu);
        (void)hipGetLastError();
        grid = cus;
        if (grid != 256) { fprintf(stderr, "kernel_launch: built for 256 CUs, found %d\n", cus); grid = -1; return; }
    }
    if (grid < 0) return;
    if (hipMemsetAsync((char*)d_ws + WS_CTL, 0, CTL_ZERO_BYTES, stream) != hipSuccess) return;
    Args a{};
    for (int i = 0; i < 20; ++i) a.in[i] = (const float*)d_in[i];
    a.out = (float*)d_out; a.ws = (unsigned char*)d_ws;
#if MK_ONE_LAUNCH
    a.ph_lo = 0; a.ph_hi = PH_END;
    hipLaunchKernelGGL(mega_fwd, dim3(grid), dim3(NTHREADS), LDS_BYTES, stream, a);
#else
    for (int p = 0; p < PH_END; ++p) {
        const int rel = p < PH_LAYER0 ? -1 : (p - PH_LAYER0) % PH_STRIDE, l = p < PH_LAYER0 ? 0 : (p - PH_LAYER0) / PH_STRIDE;
        if (rel >= 0) { if (l == 0 && rel > 6 && rel != 11) continue; if (rel > 11) continue; }
        a.ph_lo = p; a.ph_hi = p + 1;
        hipLaunchKernelGGL(mega_fwd, dim3(grid), dim3(NTHREADS), LDS_BYTES, stream, a);
    }
#endif
}
```

```cpp
#include <hip/hip_runtime.h>
#include <hip/hip_bf16.h>
#include <cstdio>
#include <cstdint>
#include <cmath>

#ifndef MK_ONE_LAUNCH
#define MK_ONE_LAUNCH 1
#endif
#ifndef MK_WSH_MOEUP
#define MK_WSH_MOEUP 3
#endif
#ifndef MK_WSH_MOEDN
#define MK_WSH_MOEDN 3
#endif
#ifndef MK_OUT8
#define MK_OUT8 1
#endif
#ifndef MK_Y8
#define MK_Y8 1
#endif
#ifndef MK_SKIP
#define MK_SKIP 0
#endif
#define SK(b) ((MK_SKIP >> (b)) & 1)

#define GAS __attribute__((address_space(1)))
#define LAS __attribute__((address_space(3)))
typedef unsigned short bf16;
typedef unsigned v4u __attribute__((ext_vector_type(4)));
typedef unsigned v2u __attribute__((ext_vector_type(2)));
typedef float f32x4 __attribute__((ext_vector_type(4)));
typedef float f32x2 __attribute__((ext_vector_type(2)));
typedef float f32x16 __attribute__((ext_vector_type(16)));
typedef short bf16x8 __attribute__((ext_vector_type(8)));
typedef short s16x4 __attribute__((ext_vector_type(4)));
typedef GAS unsigned gu32;
#define RLX_AGENT __ATOMIC_RELAXED, __HIP_MEMORY_SCOPE_AGENT
#define LDS_WAIT() asm volatile("s_waitcnt lgkmcnt(0)" ::: "memory")
#define VM_WAIT() asm volatile("s_waitcnt vmcnt(0)" ::: "memory")

constexpr int NB = 16, SEQ = 2048, D = 1024, M = NB * SEQ, NH = 8, HD = 64, WH = 512, INCOLS = 5120, FF = 3584, NE = 8, NMOD = 6 * D;
constexpr float EPS = 1e-6f;
constexpr float LOG2E = 1.4426950408889634f;
constexpr float C2 = 0.125f * LOG2E;
constexpr int NWAVES = 8, NTHREADS = 512;

constexpr size_t MiB = 1u << 20;
constexpr size_t WS_CTL = 0, CTL_ZERO_BYTES = 1 * MiB;
constexpr size_t WS_MOD = 1 * MiB;
constexpr size_t WS_LIST = 2 * MiB;
constexpr size_t WS_TOKW = 3 * MiB;
constexpr size_t WS_HSCALE = 3 * MiB + 512 * 1024;
constexpr size_t WS_WCS = 3 * MiB + 768 * 1024;
constexpr size_t WS_WIN = 4 * MiB;
constexpr size_t WS_WPSB = 24 * MiB;
constexpr size_t WS_WPMB = 26 * MiB;
constexpr size_t WS_WOUT = 28 * MiB;
constexpr size_t WS_W13D = 32 * MiB;
constexpr size_t WS_W2D = 39 * MiB;
constexpr size_t WS_W13M = 43 * MiB;
constexpr size_t WS_W2M = 99 * MiB;
constexpr size_t WS_H = 127 * MiB;
constexpr size_t WS_BIG = 191 * MiB;
constexpr size_t WS_END = 605 * MiB;
constexpr float W13_SCALE = 32.f, W2_SCALE = 64.f, WO_SCALE = 32.f, MG_SCALE = 16.f;
constexpr size_t PLANE = (size_t)M * WH * 2;
constexpr size_t BIG_QA = 0, BIG_KA = PLANE, BIG_VA = 2 * PLANE, BIG_QB = 3 * PLANE, BIG_KB = 4 * PLANE, BIG_VB = 5 * PLANE, BIG_GA = 6 * PLANE, BIG_GB = 8 * PLANE;
constexpr size_t BIG_Y = 2 * PLANE;
constexpr size_t BIG_ACT = 0, BIG_YF = 112 * MiB;
constexpr int MOE_CHUNK_PANELS = 264, MOE_NCHUNK = 1;
constexpr size_t BIG_HID = 32 * MiB, BIG_YP = 264 * MiB;
static_assert(BIG_YP + (size_t)M * 2 * D * 2 <= 414 * MiB && BIG_HID + (size_t)MOE_CHUNK_PANELS * 256 * FF <= BIG_YP && BIG_YF + (size_t)M * D * 2 <= 414 * MiB, "BIG map");
constexpr int CW_TMO = 0, CW_CODE = 1, CW_BAR = 4096, CW_CNT = 16384, CW_WMAX = 20480, CW_XF = 32768;

constexpr int RING_BYTES = 131072;
constexpr int LDS_TOK = RING_BYTES;
constexpr int LDS_TOK_UNITS = 30;
constexpr int LDS_SEG = LDS_TOK + LDS_TOK_UNITS * 512;
constexpr int LDS_MISC = LDS_SEG + 128;
constexpr int LDS_COLF = LDS_MISC + 64;
constexpr int LDS_BYTES = LDS_COLF + 15 * 1024;
static_assert(LDS_BYTES <= 160 * 1024, "LDS");

__device__ __forceinline__ unsigned f2bf(float f) { unsigned u = __builtin_bit_cast(unsigned, f); return (u + 0x7fffu + ((u >> 16) & 1u)) >> 16; }
__device__ __forceinline__ unsigned pk2(float lo, float hi) { return f2bf(lo) | (f2bf(hi) << 16); }
__device__ __forceinline__ float bf_lo(unsigned w) { return __builtin_bit_cast(float, w << 16); }
__device__ __forceinline__ float bf_hi(unsigned w) { return __builtin_bit_cast(float, w & 0xffff0000u); }
__device__ __forceinline__ unsigned cvt_pk_bf16(float lo, float hi) { typedef __bf16 bf2 __attribute__((ext_vector_type(2))); f32x2 v = {lo, hi}; bf2 b = __builtin_convertvector(v, bf2); return __builtin_bit_cast(unsigned, b); }
__device__ __forceinline__ unsigned pk4_fp8(float a, float b, float c, float d) {
    a = __builtin_amdgcn_fmed3f(a, -448.f, 448.f); b = __builtin_amdgcn_fmed3f(b, -448.f, 448.f); c = __builtin_amdgcn_fmed3f(c, -448.f, 448.f); d = __builtin_amdgcn_fmed3f(d, -448.f, 448.f);
    int r = __builtin_amdgcn_cvt_pk_fp8_f32(a, b, 0, false); r = __builtin_amdgcn_cvt_pk_fp8_f32(c, d, r, true); return (unsigned)r; }
__device__ __forceinline__ void unpack8_fp8(v2u w, f32x4& v0, f32x4& v1) {
    const f32x2 a = __builtin_amdgcn_cvt_pk_f32_fp8((int)w.x, false), b = __builtin_amdgcn_cvt_pk_f32_fp8((int)w.x, true), c = __builtin_amdgcn_cvt_pk_f32_fp8((int)w.y, false), d = __builtin_amdgcn_cvt_pk_f32_fp8((int)w.y, true);
    v0 = (f32x4){a.x, a.y, b.x, b.y}; v1 = (f32x4){c.x, c.y, d.x, d.y}; }
__device__ __forceinline__ float fast_exp2(float x) { return __builtin_amdgcn_exp2f(x); }
__device__ __forceinline__ float fast_log2(float x) { return __builtin_amdgcn_logf(x); }
__device__ __forceinline__ float fast_rcp(float x) { return __builtin_amdgcn_rcpf(x); }
__device__ __forceinline__ int obid() { int b = blockIdx.x; asm volatile("" : "+s"(b)); return b; }
__device__ __forceinline__ int otid() { int t = threadIdx.x; asm volatile("" : "+v"(t)); return t; }
__device__ __forceinline__ float shx(float v, int o, int lane) { return __builtin_bit_cast(float, __builtin_amdgcn_ds_bpermute((lane ^ o) << 2, __builtin_bit_cast(int, v))); }
__device__ __forceinline__ float shl(float v, int src) { return __builtin_bit_cast(float, __builtin_amdgcn_ds_bpermute(src << 2, __builtin_bit_cast(int, v))); }
__device__ __forceinline__ float sigmoidf_(float x) { return fast_rcp(1.0f + fast_exp2(-x * LOG2E)); }

#define XB_TMO      128
#define XB_XCNT(j)  (256  + 64 * (j))
#define XB_XSUB(j)  (1280 + 64 * (j))
#define XB_XGEN(j)  (2304 + 64 * (j))
#define XB_TOP      3328
#define XB_TOPGEN   3392
#define XCD_BAR_WORDS 3456
#define XB_SPIN_CAP (1u << 18)
__device__ __forceinline__ unsigned xb_ld(unsigned* p)              { return __hip_atomic_load(p, __ATOMIC_RELAXED, __HIP_MEMORY_SCOPE_AGENT); }
__device__ __forceinline__ unsigned xb_add(unsigned* p, unsigned v) { return __hip_atomic_fetch_add(p, v, __ATOMIC_RELAXED, __HIP_MEMORY_SCOPE_AGENT); }
__device__ __forceinline__ unsigned xb_xcc_id() { return (unsigned)__builtin_amdgcn_s_getreg((3 << 11) | 20) & 0xFu; }
#define XB_SPIN(cond, bar) do { unsigned _sp = 0; while (cond) { __builtin_amdgcn_s_sleep(1); \
    if ((++_sp & 255u) == 0u) { if (xb_ld(&(bar)[XB_TMO])) break; if (_sp > XB_SPIN_CAP) { atomicAdd(&(bar)[XB_TMO], 1u); break; } } } } while (0)
struct XcdBarrier { unsigned* bar; unsigned x; volatile LAS unsigned* st; };
__device__ __forceinline__ XcdBarrier xcd_barrier_post(unsigned* bar, volatile LAS unsigned* st) {
    XcdBarrier b; b.bar = bar; b.x = xb_xcc_id(); b.st = st;
    if (threadIdx.x == 0) (void)xb_add(&bar[XB_XCNT(b.x)], 1u);
    return b;
}
__device__ __forceinline__ void xcd_barrier_complete(unsigned* bar, unsigned x, unsigned& nloc, unsigned& nx) {
    const unsigned G = gridDim.x * gridDim.y * gridDim.z;
    unsigned sum, cnt, mine, sp = 0u;
    for (;;) {
        sum = 0u; cnt = 0u; mine = 0u;
#pragma unroll
        for (unsigned j = 0; j < 16; ++j) { const unsigned c = xb_ld(&bar[XB_XCNT(j)]); sum += c; cnt += (c > 0u) ? 1u : 0u; mine = (j == x) ? c : mine; }
        if (sum == G) break;
        __builtin_amdgcn_s_sleep(1);
        if ((++sp & 255u) == 0u) { if (xb_ld(&bar[XB_TMO])) break; if (sp > XB_SPIN_CAP) { atomicAdd(&bar[XB_TMO], 1u); break; } }
    }
    nloc = mine > 0u ? mine : 1u; nx = cnt > 0u ? cnt : 1u;
}
__device__ __forceinline__ void xcd_barrier(const XcdBarrier& b) {
    asm volatile("s_waitcnt vmcnt(0)" ::: "memory");
    __syncthreads();
    if (threadIdx.x == 0) {
        unsigned* bar = b.bar;
        __builtin_amdgcn_s_waitcnt(0);
        unsigned nloc = b.st[0], nx = b.st[1];
        if (nloc == 0u) { xcd_barrier_complete(bar, b.x, nloc, nx); b.st[0] = nloc; b.st[1] = nx; }
        const unsigned old = xb_add(&bar[XB_XSUB(b.x)], 1u);
        const unsigned gen = old / nloc;
        if (old + 1u == (gen + 1u) * nloc) {
            __builtin_amdgcn_fence(__ATOMIC_RELEASE, "agent");
            asm volatile("s_waitcnt vmcnt(0)" ::: "memory");
            const unsigned og = xb_add(&bar[XB_TOP], 1u);
            const unsigned tg = og / nx;
            if (og + 1u == (tg + 1u) * nx) xb_add(&bar[XB_TOPGEN], 1u);
            else XB_SPIN(xb_ld(&bar[XB_TOPGEN]) == tg, bar);
            __builtin_amdgcn_fence(__ATOMIC_ACQUIRE, "agent");
            xb_add(&bar[XB_XGEN(b.x)], 1u);
            asm volatile("s_waitcnt vmcnt(0)" ::: "memory");
        } else {
            XB_SPIN(xb_ld(&bar[XB_XGEN(b.x)]) == gen, bar);
            __builtin_amdgcn_fence(__ATOMIC_ACQUIRE, "agent");
            asm volatile("s_waitcnt vmcnt(0)" ::: "memory");
        }
    }
    __syncthreads();
}

namespace pg8 {
typedef int v4i_t __attribute__((ext_vector_type(4)));
constexpr int BM = 256, BK = 64, HALF = 128, HTB = HALF * BK * 2, STAGE_BYTES = 8 * HTB, NXCD = 8, WGM = 4;
__host__ __device__ __forceinline__ int lds_byte(int r, int c) { const int st = (r >> 4) * 2 + (c >> 5), rr = r & 15, cc = c & 31, ob = rr * 64 + cc * 2; return st * 1024 + (ob ^ (((ob >> 9) & 1) << 5)); }
__host__ __device__ __forceinline__ void stage_rc(int b, int& R, int& C) { const int st = b / 1024, sb = b % 1024, swz = sb ^ (((sb >> 9) & 1) << 5); R = (st >> 1) * 16 + swz / 64; C = (st & 1) * 32 + (swz % 64) / 2; }
__host__ __device__ __forceinline__ int perm32(int rho) { const int n = rho >> 4, i = rho & 15; return 8 * (i >> 2) + 4 * n + (i & 3); }
struct Unit { int pm, pn; };
struct StaticOrder {
    int nM, nN, nwg, G, c, wsh;
    __host__ __device__ __forceinline__ void init(int nM_, int nN_, int G_, int c_) { nM = nM_; nN = nN_; nwg = nM * nN; G = G_; c = c_; wsh = 2; }
    __host__ __device__ __forceinline__ bool next(int i, Unit& u) const {
        const long L = (long)i * G + c; if (L >= nwg) return false;
        int wgid = (int)L; { const int q = nwg / NXCD, r = nwg % NXCD, xcd = wgid % NXCD, off = wgid / NXCD; wgid = (xcd < r ? xcd * (q + 1) : r * (q + 1) + (xcd - r) * q) + off; }
        const int wg_ = 1 << wsh, nig = nN << wsh, gid = wgid / nig, fm = gid << wsh, gsz = (nM - fm) < wg_ ? (nM - fm) : wg_;
        const int w_ = wgid % nig;
        if (gsz == wg_) { u.pm = fm + (w_ & (wg_ - 1)); u.pn = w_ >> wsh; }
        else { u.pm = fm + (w_ % gsz); u.pn = w_ / gsz; }
        return true;
    }
};
template <class Epi, class Sched, bool ALIGN_EPI, int MODE>
__device__ __forceinline__ void gemm_phase(LAS unsigned char* lds, const int K, const Sched& S, const Epi& E, const int nt_ov = 0) {
    const int tid = otid(), wid = __builtin_amdgcn_readfirstlane(tid >> 6), lane = tid & 63, wr = wid >> 2, wc = wid & 3, fr = lane & 15, fq = lane >> 4;
    const int nt = nt_ov ? nt_ov : K / BK;
    unsigned voffA[2], voffB[2];
#pragma unroll
    for (int i = 0; i < 2; ++i) { int R, C; stage_rc(tid * 16 + i * 8192, R, C); const int Rb = Epi::PERM ? ((R & ~31) + perm32(R & 31)) : R;
        voffA[i] = (unsigned)(R * K + C) * 2u; voffB[i] = (unsigned)(Rb * K + C) * 2u; }
#define PG8_GVOFF(uix) do { _Pragma("unroll") for (int _h = 0; _h < 2; ++_h) _Pragma("unroll") for (int _i = 0; _i < 2; ++_i) { int R_, C_; stage_rc(tid * 16 + _i * 8192, R_, C_); vg[_h][_i] = S.gvoff((uix), _h * HALF + R_, C_, K); } } while (0)
    const size_t kstep = (size_t)(BK * 2);
    const size_t hstep = (size_t)HALF * K * 2;
    const unsigned ldsw = (unsigned)wid * 1024u;
    const int aoff = lds_byte(wr * 64 + fr, fq * 8), boff = lds_byte(wc * 32 + fr, fq * 8);
#define PG8_SA(b, h) (((b) * 2 + (h)) * HTB)
#define PG8_SB(b, h) ((4 + (b) * 2 + (h)) * HTB)
#define PG8_STAGE(bufoff, gbase, voff) do { _Pragma("unroll") for (int _i = 0; _i < 2; ++_i) \
        __builtin_amdgcn_global_load_lds((const unsigned*)((const char*)(gbase) + (voff)[_i]), (LAS unsigned*)(lds + (bufoff) + ldsw + _i * 8192), 16, 0, 0); } while (0)
#define PG8_STAGE_A(bufoff, kp, h) do { if constexpr (Sched::GATHER) { PG8_STAGE(bufoff, kp, vg[h]); } else { PG8_STAGE(bufoff, (kp) + (h) * hstep, voffA); } } while (0)
#define PG8_LDA(dst, b, h) do { _Pragma("unroll") for (int m = 0; m < 4; ++m) _Pragma("unroll") for (int k = 0; k < 2; ++k) dst[m][k] = *(const LAS bf16x8*)(lds + PG8_SA(b, h) + aoff + m * 2048 + k * 1024); } while (0)
#define PG8_LDB(dst, b, h) do { _Pragma("unroll") for (int n = 0; n < 2; ++n) _Pragma("unroll") for (int k = 0; k < 2; ++k) dst[n][k] = *(const LAS bf16x8*)(lds + PG8_SB(b, h) + boff + n * 2048 + k * 1024); } while (0)
#define PG8_CAT8(x) __builtin_shufflevector(__builtin_bit_cast(v4i_t, (x)[0]), __builtin_bit_cast(v4i_t, (x)[1]), 0, 1, 2, 3, 4, 5, 6, 7)
#define PG8_MMA(ai, bj, At, Bt) do { __builtin_amdgcn_s_setprio(1); if constexpr (MODE == 1) { _Pragma("unroll") for (int m = 0; m < 4; ++m) _Pragma("unroll") for (int n = 0; n < 2; ++n) \
        asm volatile("v_mfma_f32_16x16x128_f8f6f4 %0, %1, %2, %0" : "+v"(acc[ai][bj][m][n]) : "v"(PG8_CAT8(Bt[n])), "v"(PG8_CAT8(At[m]))); } else if constexpr (MODE == 2) { \
        _Pragma("unroll") for (int m = 0; m < 4; ++m) _Pragma("unroll") for (int n = 0; n < 2; ++n) _Pragma("unroll") for (int k = 0; k < 2; ++k) \
        asm volatile("v_mfma_i32_16x16x64_i8 %0, %1, %2, %0" : "+v"(acc[ai][bj][m][n]) : "v"(Bt[n][k]), "v"(At[m][k])); } else { \
        _Pragma("unroll") for (int m = 0; m < 4; ++m) _Pragma("unroll") for (int n = 0; n < 2; ++n) _Pragma("unroll") for (int k = 0; k < 2; ++k) \
        acc[ai][bj][m][n] = __builtin_amdgcn_mfma_f32_16x16x32_bf16(Bt[n][k], At[m][k], acc[ai][bj][m][n], 0, 0, 0); } __builtin_amdgcn_s_setprio(0); } while (0)
#define PG8_WAIT_V(n) asm volatile("s_waitcnt vmcnt(" #n ")" ::: "memory")
#define PG8_WAIT_L(n) asm volatile("s_waitcnt lgkmcnt(" #n ")" ::: "memory")
#define PG8_BAR __builtin_amdgcn_s_barrier()
#define PG8_SCHED __builtin_amdgcn_sched_barrier(0)
    Unit cur, nxt; int ui = 0;
    if (!S.next(0, cur)) return;
    f32x4 acc[2][2][4][2];
#pragma unroll
    for (int a = 0; a < 2; ++a)
#pragma unroll
        for (int b = 0; b < 2; ++b)
#pragma unroll
            for (int m = 0; m < 4; ++m)
#pragma unroll
                for (int n = 0; n < 2; ++n) acc[a][b][m][n] = (f32x4){0.f, 0.f, 0.f, 0.f};
    bf16x8 At[4][2], B0[2][2], B1[2][2];
    unsigned vg[2][2];
    if constexpr (Sched::GATHER) PG8_GVOFF(0);
    const char* cA = S.a_base(cur); const char* cB = S.b_base(cur);
    PG8_STAGE(PG8_SB(0, 0), cB, voffB); PG8_STAGE(PG8_SB(0, 1), cB + hstep, voffB); PG8_STAGE_A(PG8_SA(0, 0), cA, 0); PG8_STAGE_A(PG8_SA(0, 1), cA, 1);
    if (wr == 1) PG8_BAR;
    PG8_WAIT_V(2); PG8_BAR;
    PG8_STAGE(PG8_SB(1, 0), cB + kstep, voffB); PG8_STAGE_A(PG8_SA(1, 0), cA + kstep, 0); PG8_STAGE(PG8_SB(1, 1), cB + hstep + kstep, voffB);
    PG8_WAIT_V(6); PG8_BAR;
    for (;;) {
        const bool has_next = S.next(ui + 1, nxt);
        const char* nA = has_next ? S.a_base(nxt) : cA; const char* nB = has_next ? S.b_base(nxt) : cB;
        for (int t = 0; t < nt; t += 2) {
            const bool last = (t == nt - 2);
            const char* a1 = cA + (size_t)(t + 1) * kstep;
            const char* a2 = last ? nA : cA + (size_t)(t + 2) * kstep; const char* b2 = last ? nB : cB + (size_t)(t + 2) * kstep;
            const char* a3 = a2 + kstep; const char* b3 = b2 + kstep;
            PG8_LDB(B0, 0, 0); PG8_LDB(B1, 0, 1); PG8_SCHED; PG8_LDA(At, 0, 0); PG8_STAGE_A(PG8_SA(1, 1), a1, 1);
            if constexpr (Sched::GATHER) { if (last && has_next) PG8_GVOFF(ui + 1); }
            const bool seam = (t == 0) && (ui > 0);
#define PG8_WAIT_SEAM() do { if constexpr (MODE != 0 && Epi::NSTORE > 0) { if (seam) { if constexpr (Epi::NSTORE == 16) PG8_WAIT_V(24); else PG8_WAIT_V(16); } else PG8_WAIT_V(8); } else PG8_WAIT_V(8); } while (0)
            PG8_WAIT_SEAM(); PG8_WAIT_L(0); PG8_BAR; PG8_MMA(0, 0, At, B0); PG8_MMA(0, 1, At, B1); PG8_BAR; PG8_SCHED;
            PG8_LDA(At, 0, 1); PG8_STAGE(PG8_SB(0, 0), b2, voffB); PG8_STAGE(PG8_SB(0, 1), b2 + hstep, voffB); PG8_STAGE_A(PG8_SA(0, 0), a2, 0);
            PG8_WAIT_SEAM(); PG8_WAIT_L(0); PG8_BAR; PG8_MMA(1, 0, At, B0); PG8_MMA(1, 1, At, B1); PG8_BAR; PG8_SCHED;
            PG8_LDB(B0, 1, 0); PG8_LDB(B1, 1, 1); PG8_SCHED; PG8_LDA(At, 1, 0); PG8_STAGE_A(PG8_SA(0, 1), a2, 1);
            PG8_WAIT_V(8); PG8_WAIT_L(0); PG8_BAR; PG8_MMA(0, 0, At, B0); PG8_MMA(0, 1, At, B1); PG8_BAR; PG8_SCHED;
            PG8_LDA(At, 1, 1); PG8_STAGE(PG8_SB(1, 0), b3, voffB); PG8_STAGE(PG8_SB(1, 1), b3 + hstep, voffB); PG8_STAGE_A(PG8_SA(1, 0), a3, 0);
            PG8_WAIT_V(8); PG8_WAIT_L(0); PG8_BAR; PG8_MMA(1, 0, At, B0); PG8_MMA(1, 1, At, B1); PG8_BAR; PG8_SCHED;
        }
        if constexpr (ALIGN_EPI) { if (wr == 0) PG8_BAR; }
        if constexpr (MODE != 0) asm volatile("s_nop 15\n\ts_nop 15" : "+v"(acc[1][1][0][0]), "+v"(acc[1][1][0][1]), "+v"(acc[1][1][1][0]), "+v"(acc[1][1][1][1]), "+v"(acc[1][1][2][0]), "+v"(acc[1][1][2][1]), "+v"(acc[1][1][3][0]), "+v"(acc[1][1][3][1]) :: "memory");
        E(acc, cur, ui, wr, wc, fr, fq);
        if (!has_next) break;
#pragma unroll
        for (int a = 0; a < 2; ++a)
#pragma unroll
            for (int b = 0; b < 2; ++b)
#pragma unroll
                for (int m = 0; m < 4; ++m)
#pragma unroll
                    for (int n = 0; n < 2; ++n) acc[a][b][m][n] = (f32x4){0.f, 0.f, 0.f, 0.f};
        cur = nxt; cA = nA; cB = nB; ++ui;
        if constexpr (ALIGN_EPI) { if (wr == 1) PG8_BAR; }
    }
    PG8_WAIT_V(0);
    if constexpr (!ALIGN_EPI) { if (wr == 0) PG8_BAR; }
    PG8_BAR;
#undef PG8_SA
#undef PG8_SB
#undef PG8_STAGE
#undef PG8_STAGE_A
#undef PG8_WAIT_SEAM
#undef PG8_GVOFF
#undef PG8_LDA
#undef PG8_LDB
#undef PG8_MMA
#undef PG8_CAT8
#undef PG8_WAIT_V
#undef PG8_WAIT_L
#undef PG8_BAR
#undef PG8_SCHED
}

struct SchedPlain : StaticOrder {
    static constexpr bool GATHER = false;
    const char* A; const char* B; size_t tA, tB;
    __device__ __forceinline__ const char* a_base(const Unit& u) const { return A + (size_t)u.pm * tA; }
    __device__ __forceinline__ const char* b_base(const Unit& u) const { return B + (size_t)u.pn * tB; }
    __device__ __forceinline__ unsigned gvoff(int, int, int, int) const { return 0u; }
};
struct SchedMoe : StaticOrder {
    const char* A; const char* B; size_t tA, tB, eB; int panel0; const LAS int* seg; const LAS unsigned short* tok;
    __device__ __forceinline__ int expert(const Unit& u) const { const int row = (panel0 + u.pm) * 256; int e = 0;
#pragma unroll
        for (int j = 1; j < NE; ++j) e += (row >= seg[j]) ? 1 : 0;
        return e; }
    __device__ __forceinline__ const char* b_base(const Unit& u) const { return B + (size_t)expert(u) * eB + (size_t)u.pn * tB; }
};
struct SchedMoeUp : SchedMoe {
    static constexpr bool GATHER = true;
    __device__ __forceinline__ const char* a_base(const Unit&) const { return A; }
    __device__ __forceinline__ unsigned gvoff(int ui, int row, int col, int K) const { const int t = (int)tok[ui * 256 + row] >> 1; return (unsigned)(t * K + col) * 2u; }
};
struct SchedMoeDown : SchedMoe {
    static constexpr bool GATHER = false;
    __device__ __forceinline__ const char* a_base(const Unit& u) const { return A + (size_t)u.pm * tA; }
    __device__ __forceinline__ unsigned gvoff(int, int, int, int) const { return 0u; }
};
struct SchedMoeDownTail : SchedMoe {
    static constexpr bool GATHER = false;
    int nfull, pidx; size_t koff;
    __device__ __forceinline__ bool next(int i, Unit& u) const {
        if (i != 0 || pidx < 0) return false;
        const int wg_ = 1 << wsh, wgid = nfull + pidx, nig = nN << wsh, gid = wgid / nig, fm = gid << wsh, gsz = (nM - fm) < wg_ ? (nM - fm) : wg_, w_ = wgid % nig;
        u.pm = fm + (w_ % gsz); u.pn = w_ / gsz; return true; }
    __device__ __forceinline__ const char* a_base(const Unit& u) const { return A + (size_t)u.pm * tA + koff; }
    __device__ __forceinline__ const char* b_base(const Unit& u) const { return SchedMoe::b_base(u) + koff; }
    __device__ __forceinline__ unsigned gvoff(int, int, int, int) const { return 0u; }
};

typedef f32x4 Acc[2][2][4][2];
__device__ __forceinline__ v4u pack8(f32x4 v0, f32x4 v1) { v4u w; w.x = cvt_pk_bf16(v0[0], v0[1]); w.y = cvt_pk_bf16(v0[2], v0[3]); w.z = cvt_pk_bf16(v1[0], v1[1]); w.w = cvt_pk_bf16(v1[2], v1[3]); return w; }
__device__ __forceinline__ void unpack8(v4u w, f32x4& v0, f32x4& v1) { v0 = (f32x4){bf_lo(w.x), bf_hi(w.x), bf_lo(w.y), bf_hi(w.y)}; v1 = (f32x4){bf_lo(w.z), bf_hi(w.z), bf_lo(w.w), bf_hi(w.w)}; }

#ifndef MK_EPI_NT
#define MK_EPI_NT 0
#endif
#ifndef MK_SPLIT_TAIL
#define MK_SPLIT_TAIL 1
#endif
#if MK_EPI_NT
#define EPI_ST(T, p, v) __builtin_nontemporal_store((v), (T*)(p))
#else
#define EPI_ST(T, p, v) (*(T*)(p) = (v))
#endif
struct EpiInProj {
    static constexpr bool PERM = true; static constexpr int NSTORE = 16;
    bf16* big; const LAS float* rowf; int nostore; const LAS float* colf;
    __device__ __forceinline__ void operator()(const Acc& acc, const Unit& u, int ui, int wr, int wc, int fr, int fq) const {
        const int t = u.pn; bf16* base; int ldc, colt; float sc = 1.f;
        if (t < 12) { const int pl = t >> 1; base = big + (size_t)pl * ((size_t)M * WH); ldc = WH; colt = (t & 1) * 256; if (pl == 0 || pl == 3) sc = C2; }
        else { const int g = (t - 12) >> 2; base = big + (size_t)6 * ((size_t)M * WH) + (size_t)g * ((size_t)M * D / 2); ldc = D; colt = ((t - 12) & 3) * 256; }
        const int row0 = u.pm * BM + wr * 64 + fr, col0 = colt + wc * 32 + 8 * fq;
        const LAS float* cf_ = colf + ui * 256 + wc * 32 + 8 * fq; f32x4 cs[2][2];
#pragma unroll
        for (int bj = 0; bj < 2; ++bj) { cs[bj][0] = *(const LAS f32x4*)(cf_ + bj * HALF); cs[bj][1] = *(const LAS f32x4*)(cf_ + bj * HALF + 4); }
#pragma unroll
        for (int ai = 0; ai < 2; ++ai)
#pragma unroll
            for (int m = 0; m < 4; ++m) { bf16* rowp = base + (size_t)(row0 + ai * HALF + m * 16) * ldc + col0; const float rf = rowf[ui * 256 + wr * 64 + fr + ai * HALF + m * 16] * sc;
#pragma unroll
                for (int bj = 0; bj < 2; ++bj) { const v4i_t i0 = __builtin_bit_cast(v4i_t, acc[ai][bj][m][0]), i1 = __builtin_bit_cast(v4i_t, acc[ai][bj][m][1]);
                    const f32x4 v0 = (f32x4){(float)i0[0] * rf, (float)i0[1] * rf, (float)i0[2] * rf, (float)i0[3] * rf} * cs[bj][0], v1 = (f32x4){(float)i1[0] * rf, (float)i1[1] * rf, (float)i1[2] * rf, (float)i1[3] * rf} * cs[bj][1];
                    if (t >= 12) { v2u w8; w8.x = pk4_fp8(v0[0], v0[1], v0[2], v0[3]); w8.y = pk4_fp8(v1[0], v1[1], v1[2], v1[3]);
                        if (!nostore) EPI_ST(v2u, (unsigned char*)base + (size_t)(row0 + ai * HALF + m * 16) * D + col0 + bj * HALF, w8); else asm volatile("" :: "v"(w8)); }
                    else { const v4u pk_ = pack8(v0, v1); if (!nostore) EPI_ST(v4u, rowp + bj * HALF, pk_); else asm volatile("" :: "v"(pk_)); } } }
    }
};
struct EpiBf16 {
    static constexpr bool PERM = true; static constexpr int NSTORE = 16;
    bf16* O; int ldc; float sc;
    __device__ __forceinline__ void operator()(const Acc& acc, const Unit& u, int, int wr, int wc, int fr, int fq) const {
        const int row0 = u.pm * BM + wr * 64 + fr, col0 = u.pn * BM + wc * 32 + 8 * fq;
#pragma unroll
        for (int ai = 0; ai < 2; ++ai)
#pragma unroll
            for (int m = 0; m < 4; ++m) { bf16* rowp = O + (size_t)(row0 + ai * HALF + m * 16) * ldc + col0;
#pragma unroll
                for (int bj = 0; bj < 2; ++bj) { const f32x4 v0 = acc[ai][bj][m][0] * sc, v1 = acc[ai][bj][m][1] * sc;
                    EPI_ST(v4u, rowp + bj * HALF, pack8(v0, v1)); } }
    }
};
template <bool ADD> struct EpiGate {
    static constexpr bool PERM = true; static constexpr int NSTORE = 16;
    const unsigned char* G; bf16* T; unsigned char* T8;
    __device__ __forceinline__ void operator()(const Acc& acc, const Unit& u, int, int wr, int wc, int fr, int fq) const {
        const int row0 = u.pm * BM + wr * 64 + fr, col0 = u.pn * BM + wc * 32 + 8 * fq;
        constexpr int NB = ADD ? 1 : 2;
#pragma unroll
        for (int a0 = 0; a0 < 2; a0 += NB) {
            v2u gw[NB][4][2]; v4u tw[4][2];
#pragma unroll
            for (int ab = 0; ab < NB; ++ab)
#pragma unroll
                for (int m = 0; m < 4; ++m)
#pragma unroll
                    for (int bj = 0; bj < 2; ++bj) { const size_t off = (size_t)(row0 + (a0 + ab) * HALF + m * 16) * D + col0 + bj * HALF; gw[ab][m][bj] = *(const v2u*)(G + off); if (ADD) tw[m][bj] = *(const v4u*)(T + off); }
#pragma unroll
            for (int ab = 0; ab < NB; ++ab) { const int ai = a0 + ab;
#pragma unroll
            for (int m = 0; m < 4; ++m) { const size_t off = (size_t)(row0 + ai * HALF + m * 16) * D + col0;
#pragma unroll
                for (int bj = 0; bj < 2; ++bj) { f32x4 g0, g1; unpack8_fp8(gw[ab][m][bj], g0, g1);
                    f32x4 t0 = {0.f, 0.f, 0.f, 0.f}, t1 = {0.f, 0.f, 0.f, 0.f};
                    if (ADD) unpack8(tw[m][bj], t0, t1);
                    f32x4 e0 = g0 * (-LOG2E), e1 = g1 * (-LOG2E);
#pragma unroll
                    for (int c = 0; c < 4; ++c) { e0[c] = fast_exp2(e0[c]); e1[c] = fast_exp2(e1[c]); }
                    e0 = e0 + 1.0f; e1 = e1 + 1.0f;
#pragma unroll
                    for (int c = 0; c < 4; ++c) { e0[c] = fast_rcp(e0[c]); e1[c] = fast_rcp(e1[c]); }
                    const f32x4 o0 = t0 + e0 * acc[ai][bj][m][0], o1 = t1 + e1 * acc[ai][bj][m][1];
                    if (ADD && MK_OUT8) { const f32x4 q0 = o0 * MG_SCALE, q1 = o1 * MG_SCALE; v2u w8; w8.x = pk4_fp8(q0[0], q0[1], q0[2], q0[3]); w8.y = pk4_fp8(q1[0], q1[1], q1[2], q1[3]);
                        EPI_ST(v2u, (unsigned char*)T8 + off + bj * HALF, w8); }
                    else EPI_ST(v4u, T + off + bj * HALF, pack8(o0, o1)); } } } }
    }
};
__device__ __forceinline__ v2u swiglu8_fp8(f32x4 a0, f32x4 a1, f32x4 b0, f32x4 b1) {
    f32x4 t0 = a0 * (-LOG2E), t1 = a1 * (-LOG2E);
#pragma unroll
    for (int c = 0; c < 4; ++c) { t0[c] = fast_exp2(t0[c]); t1[c] = fast_exp2(t1[c]); }
    t0 = t0 + 1.0f; t1 = t1 + 1.0f;
#pragma unroll
    for (int c = 0; c < 4; ++c) { t0[c] = fast_rcp(t0[c]); t1[c] = fast_rcp(t1[c]); }
    f32x4 u0 = (a0 * b0) * t0, u1 = (a1 * b1) * t1;
    v2u w; w.x = pk4_fp8(u0[0], u0[1], u0[2], u0[3]); w.y = pk4_fp8(u1[0], u1[1], u1[2], u1[3]); return w;
}
struct EpiSwiGLU {
    static constexpr bool PERM = true; static constexpr int NSTORE = 8;
    unsigned char* O; float sc;
    __device__ __forceinline__ void operator()(const Acc& acc, const Unit& u, int, int wr, int wc, int fr, int fq) const {
        const int row0 = u.pm * BM + wr * 64 + fr, col0 = u.pn * HALF + wc * 32 + 8 * fq;
#pragma unroll
        for (int ai = 0; ai < 2; ++ai)
#pragma unroll
            for (int m = 0; m < 4; ++m) { const v2u w = swiglu8_fp8(acc[ai][0][m][0] * sc, acc[ai][0][m][1] * sc, acc[ai][1][m][0] * sc, acc[ai][1][m][1] * sc);
                EPI_ST(v2u, O + (size_t)(row0 + ai * HALF + m * 16) * FF + col0, w); }
    }
};
struct EpiSwiGLUi8 {
    static constexpr bool PERM = true; static constexpr int NSTORE = 8;
    unsigned char* O; const LAS float* rowf; const LAS float* colf;
    __device__ __forceinline__ void operator()(const Acc& acc, const Unit& u, int ui, int wr, int wc, int fr, int fq) const {
        const int row0 = u.pm * BM + wr * 64 + fr, col0 = u.pn * HALF + wc * 32 + 8 * fq;
        const LAS float* cf_ = colf + ui * 256 + wc * 32 + 8 * fq;
        const f32x4 ca0 = *(const LAS f32x4*)cf_, ca1 = *(const LAS f32x4*)(cf_ + 4), cb0 = *(const LAS f32x4*)(cf_ + HALF), cb1 = *(const LAS f32x4*)(cf_ + HALF + 4);
#pragma unroll
        for (int ai = 0; ai < 2; ++ai)
#pragma unroll
            for (int m = 0; m < 4; ++m) { const float rf = rowf[ui * 256 + wr * 64 + fr + ai * HALF + m * 16];
                const v4i_t a0 = __builtin_bit_cast(v4i_t, acc[ai][0][m][0]), a1 = __builtin_bit_cast(v4i_t, acc[ai][0][m][1]), b0 = __builtin_bit_cast(v4i_t, acc[ai][1][m][0]), b1 = __builtin_bit_cast(v4i_t, acc[ai][1][m][1]);
                const v2u w = swiglu8_fp8(__builtin_convertvector(a0, f32x4) * rf * ca0, __builtin_convertvector(a1, f32x4) * rf * ca1, __builtin_convertvector(b0, f32x4) * rf * cb0, __builtin_convertvector(b1, f32x4) * rf * cb1);
                EPI_ST(v2u, O + (size_t)(row0 + ai * HALF + m * 16) * FF + col0, w); }
    }
};
struct EpiMoeDown {
    static constexpr bool PERM = true; static constexpr int NSTORE = 0;
    bf16* YP; const LAS unsigned short* tok; const LAS int* seg; float sc;
    __device__ __forceinline__ void operator()(const Acc& acc, const Unit& u, int ui, int wr, int wc, int fr, int fq) const {
        const int r0 = wr * 64 + fr, col0 = u.pn * BM + wc * 32 + 8 * fq;
        const int prow = u.pm * 256; int e = 0;
#pragma unroll
        for (int j = 1; j < NE; ++j) e += (prow >= seg[j]) ? 1 : 0;
        const int nvalid = seg[16 + e] - (prow - seg[e]);
        const LAS unsigned short* tp = tok + ui * 256 + r0; asm volatile("" : "+v"(tp));
#pragma unroll
        for (int ai = 0; ai < 2; ++ai)
#pragma unroll
            for (int m = 0; m < 4; ++m) { const int r = r0 + ai * HALF + m * 16;
                if (r < nvalid) { bf16* rowp = YP + (size_t)tp[ai * HALF + m * 16] * D + col0;
#pragma unroll
                    for (int bj = 0; bj < 2; ++bj) { const f32x4 v0 = acc[ai][bj][m][0] * sc, v1 = acc[ai][bj][m][1] * sc;
                        if (MK_Y8) { v2u w8; w8.x = pk4_fp8(v0[0], v0[1], v0[2], v0[3]); w8.y = pk4_fp8(v1[0], v1[1], v1[2], v1[3]); EPI_ST(v2u, (unsigned char*)YP + (size_t)tp[ai * HALF + m * 16] * D + col0 + bj * HALF, w8); }
                        else EPI_ST(v4u, rowp + bj * HALF, pack8(v0, v1)); } } }
    }
};
struct EpiMoeDownTail {
    static constexpr bool PERM = true; static constexpr int NSTORE = 0;
    bf16* YP; const LAS unsigned short* tok; const LAS int* seg; float sc; f32x4* xbuf; unsigned* flg; int pidx, slice;
    template <int S_> __device__ __forceinline__ void fin(const Acc& acc, const Unit& u, int wr, int wc, int fr, int fq, int tid) const {
        constexpr int ai = S_ >> 1, bj = S_ & 1;
        f32x4 v[4][2];
#pragma unroll
        for (int m = 0; m < 4; ++m) { v[m][0] = acc[ai][bj][m][0]; v[m][1] = acc[ai][bj][m][1]; }
#pragma unroll
        for (int k = 1; k < 4; ++k) { const f32x4* src = xbuf + ((size_t)((pidx * 4 + S_) * 3 + (k - 1)) * 8) * 512 + tid;
#pragma unroll
            for (int m = 0; m < 4; ++m) { v[m][0] += src[(m * 2 + 0) * 512]; v[m][1] += src[(m * 2 + 1) * 512]; } }
        const int r0 = wr * 64 + fr, col0 = u.pn * BM + wc * 32 + 8 * fq + bj * HALF;
        const int prow = u.pm * 256; int e = 0;
#pragma unroll
        for (int j = 1; j < NE; ++j) e += (prow >= seg[j]) ? 1 : 0;
        const int nvalid = seg[16 + e] - (prow - seg[e]);
#pragma unroll
        for (int m = 0; m < 4; ++m) { const int r = r0 + ai * HALF + m * 16;
            if (r < nvalid) { const size_t t = tok[r]; const f32x4 v0 = v[m][0] * sc, v1 = v[m][1] * sc;
                if (MK_Y8) { v2u w8; w8.x = pk4_fp8(v0[0], v0[1], v0[2], v0[3]); w8.y = pk4_fp8(v1[0], v1[1], v1[2], v1[3]); EPI_ST(v2u, (unsigned char*)YP + t * D + col0, w8); }
                else EPI_ST(v4u, YP + t * D + col0, pack8(v0, v1)); } }
    }
    __device__ __forceinline__ void operator()(const Acc& acc, const Unit& u, int, int wr, int wc, int fr, int fq) const {
        const int tid = otid(), lane = tid & 63, wid = __builtin_amdgcn_readfirstlane(tid >> 6);
#pragma unroll
        for (int d = 0; d < 4; ++d) if (d != slice) { const int k = (slice - d) & 3;
            f32x4* dst = xbuf + ((size_t)((pidx * 4 + d) * 3 + (k - 1)) * 8) * 512 + tid;
#pragma unroll
            for (int m = 0; m < 4; ++m) { dst[(m * 2 + 0) * 512] = acc[d >> 1][d & 1][m][0]; dst[(m * 2 + 1) * 512] = acc[d >> 1][d & 1][m][1]; } }
        asm volatile("s_waitcnt vmcnt(0)" ::: "memory");
        __builtin_amdgcn_fence(__ATOMIC_RELEASE, "agent");
        asm volatile("s_waitcnt vmcnt(0)" ::: "memory");
        if (lane == 0) __hip_atomic_store(flg + ((pidx * 4 + slice) * 8 + wid) * 16, 1u, RLX_AGENT);
#pragma unroll 1
        for (int k = 1; k < 4; ++k) { unsigned* w = flg + ((pidx * 4 + ((slice + k) & 3)) * 8 + wid) * 16; unsigned sp = 0;
            while (__builtin_amdgcn_readfirstlane(__hip_atomic_load(w, RLX_AGENT)) == 0u) { __builtin_amdgcn_s_sleep(1); if (++sp > (1u << 16)) break; } }
        __builtin_amdgcn_fence(__ATOMIC_ACQUIRE, "agent");
        asm volatile("s_waitcnt vmcnt(0)" ::: "memory");
        if (slice == 0) fin<0>(acc, u, wr, wc, fr, fq, tid); else if (slice == 1) fin<1>(acc, u, wr, wc, fr, fq, tid); else if (slice == 2) fin<2>(acc, u, wr, wc, fr, fq, tid); else fin<3>(acc, u, wr, wc, fr, fq, tid);
    }
};
}

namespace att {
constexpr int PITCH = WH;
constexpr int SLOTB = 8192;
#ifndef MK_ATT_NSLOT
#define MK_ATT_NSLOT 4
#endif
constexpr int NSLOT = MK_ATT_NSLOT;
constexpr int L_K = 0, L_V = NSLOT * SLOTB, L_WS = 2 * NSLOT * SLOTB, L_OST = L_WS + NWAVES * 64 * 4, L_KPART = L_OST  , L_KMEAN = L_OST + NWAVES * 4096, L_SEL = L_KMEAN + 8 * 64 * 4, L_LUT = L_SEL + 256, L_DONE = L_LUT + 1536, L_END = L_DONE + 64;
static_assert(L_END <= LDS_SEG && 8 * 8 * 64 * 4 <= NWAVES * 4096, "attention LDS (it may use the MoE table region, not the segment / barrier words)");
__device__ __forceinline__ int crow(int r, int hi) { return (r & 3) + 8 * (r >> 2) + 4 * hi; }
__device__ __forceinline__ void glds16(const void* gsrc, unsigned lds_dst) { unsigned keep;
    asm volatile("s_mov_b32 %0, m0\n\ts_mov_b32 m0, %2\n\ts_nop 0\n\tglobal_load_lds_dwordx4 %1, off\n\ts_mov_b32 m0, %0" : "=&s"(keep) : "v"(gsrc), "s"(lds_dst) : "memory"); }
#define ATT_WAIT_BAR(N) asm volatile("s_waitcnt vmcnt(" #N ") lgkmcnt(0)\n\ts_barrier" ::: "memory")
constexpr float SB_DONE_THR = 64.f;
__device__ const unsigned char REL_BUCKET_LUT[128] = {0, 1, 2, 3, 4, 5, 6, 7, 8, 9, 10, 11, 12, 13, 14, 15, 16, 16, 16, 17, 17, 18, 18, 18, 19, 19, 19, 20, 20, 20, 20, 21, 21, 21, 21, 22, 22, 22, 22, 22, 23, 23, 23, 23, 23, 23, 24, 24, 24, 24, 24, 24, 25, 25, 25, 25, 25, 25, 25, 26, 26, 26, 26, 26, 26, 26, 26, 27, 27, 27, 27, 27, 27, 27, 27, 27, 27, 28, 28, 28, 28, 28, 28, 28, 28, 28, 28, 29, 29, 29, 29, 29, 29, 29, 29, 29, 29, 29, 29, 30, 30, 30, 30, 30, 30, 30, 30, 30, 30, 30, 30, 30, 30, 31, 31, 31, 31, 31, 31, 31, 31, 31, 31, 31, 31, 31, 31, 31};

__device__ __forceinline__ void qkt(f32x16& p0, f32x16& p1, const LAS char* Kslot, const bf16x8* qr, const f32x16& cinit, int r32, int hi) {
    const LAS char* kb = Kslot + hi * 1024 + r32 * 16;
    bf16x8 kf[8];
#pragma unroll
    for (int d0 = 0; d0 < 4; ++d0) { kf[2 * d0] = *(const LAS bf16x8*)(kb + d0 * 2048); kf[2 * d0 + 1] = *(const LAS bf16x8*)(kb + d0 * 2048 + 512); }
    __builtin_amdgcn_sched_barrier(0);
    p0 = __builtin_amdgcn_mfma_f32_32x32x16_bf16(kf[0], qr[0], cinit, 0, 0, 0); p1 = __builtin_amdgcn_mfma_f32_32x32x16_bf16(kf[1], qr[0], cinit, 0, 0, 0);
#pragma unroll
    for (int d0 = 1; d0 < 4; ++d0) { p0 = __builtin_amdgcn_mfma_f32_32x32x16_bf16(kf[2 * d0], qr[d0], p0, 0, 0, 0); p1 = __builtin_amdgcn_mfma_f32_32x32x16_bf16(kf[2 * d0 + 1], qr[d0], p1, 0, 0, 0); }
    asm volatile("s_nop 15\n\ts_nop 7" : "+v"(p0), "+v"(p1));
}
__device__ __forceinline__ float max3f(float a, float b, float c) { float r; asm("v_max3_f32 %0, %1, %2, %3" : "=v"(r) : "v"(a), "v"(b), "v"(c)); return r; }
__device__ __forceinline__ float max2f(float a, float b) { float r; asm("v_max_f32_e32 %0, %1, %2" : "=v"(r) : "v"(a), "v"(b)); return r; }
__device__ __forceinline__ float min2f(float a, float b) { float r; asm("v_min_f32_e32 %0, %1, %2" : "=v"(r) : "v"(a), "v"(b)); return r; }
__device__ __forceinline__ void pv(f32x16* o, int vb, bf16x8 pa0, bf16x8 pa1, bf16x8 pa2, bf16x8 pa3) {
#pragma unroll
    for (int d0 = 0; d0 < 2; ++d0) { s16x4 lo[4], hi[4];
#pragma unroll
        for (int ks = 0; ks < 4; ++ks) {
            asm volatile("ds_read_b64_tr_b16 %0,%1 offset:%c2" : "=&v"(lo[ks]) : "v"(vb), "i"(d0 * 4096 + ks * 1024) : "memory");
            asm volatile("ds_read_b64_tr_b16 %0,%1 offset:%c2" : "=&v"(hi[ks]) : "v"(vb), "i"(d0 * 4096 + ks * 1024 + 512) : "memory"); }
        asm volatile("s_waitcnt lgkmcnt(0)" ::: "memory"); __builtin_amdgcn_sched_barrier(0);
#define ATT_PK(k) (bf16x8){lo[k][0], lo[k][1], lo[k][2], lo[k][3], hi[k][0], hi[k][1], hi[k][2], hi[k][3]}
        o[d0] = __builtin_amdgcn_mfma_f32_32x32x16_bf16(pa0, ATT_PK(0), o[d0], 0, 0, 0);
        o[d0] = __builtin_amdgcn_mfma_f32_32x32x16_bf16(pa1, ATT_PK(1), o[d0], 0, 0, 0);
        o[d0] = __builtin_amdgcn_mfma_f32_32x32x16_bf16(pa2, ATT_PK(2), o[d0], 0, 0, 0);
        o[d0] = __builtin_amdgcn_mfma_f32_32x32x16_bf16(pa3, ATT_PK(3), o[d0], 0, 0, 0);
#undef ATT_PK
    }
}
__device__ __forceinline__ bf16x8 pack8r(const f32x16& p, int b);
template <bool SUB> __device__ __forceinline__ float exp_pv(f32x16* o, int vb, f32x16& p0, f32x16& p1, const f32x16& w0, const f32x16& w1) {
    s16x4 lo[8], hi[8];
#pragma unroll
    for (int d0 = 0; d0 < 2; ++d0)
#pragma unroll
        for (int ks = 0; ks < 4; ++ks) {
            asm volatile("ds_read_b64_tr_b16 %0,%1 offset:%c2" : "=&v"(lo[d0 * 4 + ks]) : "v"(vb), "i"(d0 * 4096 + ks * 1024) : "memory");
            asm volatile("ds_read_b64_tr_b16 %0,%1 offset:%c2" : "=&v"(hi[d0 * 4 + ks]) : "v"(vb), "i"(d0 * 4096 + ks * 1024 + 512) : "memory"); }
    float ls = 0.f;
#define EPV_PK(k) (bf16x8){lo[k][0], lo[k][1], lo[k][2], lo[k][3], hi[k][0], hi[k][1], hi[k][2], hi[k][3]}
#define EPV_GROUP(P, WW, B, K) do { _Pragma("unroll") for (int r = 0; r < 8; ++r) P[(B) + r] = fast_exp2(SUB ? P[(B) + r] - WW[(B) + r] : P[(B) + r]); \
        ls += ((P[(B)] + P[(B) + 1]) + (P[(B) + 2] + P[(B) + 3])) + ((P[(B) + 4] + P[(B) + 5]) + (P[(B) + 6] + P[(B) + 7])); \
        const bf16x8 pa_ = pack8r(P, (B)); \
        if ((K) == 0) asm volatile("s_waitcnt lgkmcnt(0)" : "+v"(lo[0]), "+v"(hi[0]), "+v"(lo[1]), "+v"(hi[1]), "+v"(lo[2]), "+v"(hi[2]), "+v"(lo[3]), "+v"(hi[3]), "+v"(lo[4]), "+v"(hi[4]), "+v"(lo[5]), "+v"(hi[5]), "+v"(lo[6]), "+v"(hi[6]), "+v"(lo[7]), "+v"(hi[7]) :: "memory"); \
        o[0] = __builtin_amdgcn_mfma_f32_32x32x16_bf16(pa_, EPV_PK(K), o[0], 0, 0, 0); o[1] = __builtin_amdgcn_mfma_f32_32x32x16_bf16(pa_, EPV_PK((K) + 4), o[1], 0, 0, 0); \
        __builtin_amdgcn_sched_barrier(0); } while (0)
    EPV_GROUP(p0, w0, 0, 0); EPV_GROUP(p0, w0, 8, 1); EPV_GROUP(p1, w1, 0, 2); EPV_GROUP(p1, w1, 8, 3);
#undef EPV_GROUP
#undef EPV_PK
    return ls;
}
__device__ __forceinline__ bf16x8 pack8r(const f32x16& p, int b) { v4u w; w.x = cvt_pk_bf16(p[b], p[b + 1]); w.y = cvt_pk_bf16(p[b + 2], p[b + 3]); w.z = cvt_pk_bf16(p[b + 4], p[b + 5]); w.w = cvt_pk_bf16(p[b + 6], p[b + 7]); return __builtin_bit_cast(bf16x8, w); }
__device__ __forceinline__ f32x16 splat16(float v) { f32x16 r;
#pragma unroll
    for (int i = 0; i < 16; ++i) r[i] = v;
    return r; }

template <bool MOBA>
__device__ __forceinline__ void attn_unit(int b, int h, int qb, const bf16* Q, const bf16* __restrict__ Kp, const bf16* __restrict__ Vp, bf16* O, const float* rel_bias, LAS unsigned char* shm, bool prep) {
    const int tid = otid(), lane = tid & 63, r32 = lane & 31, hi = lane >> 5; const int wid = __builtin_amdgcn_readfirstlane(tid >> 6);
    const long rowbase = (long)b * SEQ; const int q0 = qb * 256;
    const bf16* Qw = Q + (rowbase + q0 + wid * 32) * PITCH + h * HD;
    const bf16* Kh = Kp + rowbase * PITCH + h * HD; const bf16* Vh = Vp + rowbase * PITCH + h * HD;
    const unsigned lds0 = (unsigned)(uintptr_t)shm;
    LAS float* wsf = (LAS float*)(shm + L_WS) + wid * 64;
    const bf16* ksrc = Kh + (long)lane * PITCH + wid * 8;
    const bf16* vsrc = Vh + (long)(16 * (wid & 3) + (lane >> 2)) * PITCH + (wid >> 2) * 32 + (lane & 3) * 8;
    const unsigned kdst = lds0 + L_K + wid * 1024, vdst = lds0 + L_V + wid * 1024;
#define DMA_K(t, slot) glds16(ksrc + (long)(t) * 64 * PITCH, (unsigned)__builtin_amdgcn_readfirstlane(kdst + (slot)))
#define DMA_V(t, slot) glds16(vsrc + (long)(t) * 64 * PITCH, (unsigned)__builtin_amdgcn_readfirstlane(vdst + (slot)))
    const int vb0 = (int)(lds0 + L_V) + ((lane >> 4) & 1) * 32 + (lane & 3) * 8 + (4 * hi + ((lane & 15) >> 2)) * 64;
    const LAS char* Kbase = (const LAS char*)(shm + L_K);
    const int NT = 4 * (qb + 1);
    const int qrel = wid * 32 + r32;
#pragma unroll
    for (int w = 0; w < NSLOT - 1; ++w) if (w < NT) { DMA_K(NT - 1 - w, w * SLOTB); DMA_V(NT - 1 - w, w * SLOTB); }
    LAS int* doneAt = (LAS int*)(shm + L_DONE);
    if (!MOBA) { if (tid < 8) doneAt[tid] = 0x7fffffff; }
    bf16x8 qr[4];
#pragma unroll
    for (int d0 = 0; d0 < 4; ++d0) qr[d0] = *(const bf16x8*)(&Qw[(long)r32 * PITCH + d0 * 16 + hi * 8]);
    float biasfar = 0.f; unsigned selmask = 0u;
    if constexpr (MOBA) {
        LAS float* KPART = (LAS float*)(shm + L_KPART); LAS float* KMEAN = (LAS float*)(shm + L_KMEAN); LAS unsigned char* SEL = (LAS unsigned char*)(shm + L_SEL); LAS float* LUT = (LAS float*)(shm + L_LUT);
        if (prep) {
        if (tid < 384) { const int d = 319 - tid; LUT[tid] = d < 0 ? -INFINITY : rel_bias[REL_BUCKET_LUT[d > 127 ? 127 : d] * NH + h] * LOG2E; }
        const int dch = lane & 7, rs = lane >> 3;
        for (int mb = 0; mb < 7; ++mb) {
            float s[8];
#pragma unroll
            for (int c = 0; c < 8; ++c) s[c] = 0.f;
#pragma unroll
            for (int j = 0; j < 4; ++j) { const v4u w = *(const v4u*)(Kh + (long)(mb * 256 + wid * 32 + j * 8 + rs) * PITCH + dch * 8);
                s[0] += bf_lo(w.x); s[1] += bf_hi(w.x); s[2] += bf_lo(w.y); s[3] += bf_hi(w.y); s[4] += bf_lo(w.z); s[5] += bf_hi(w.z); s[6] += bf_lo(w.w); s[7] += bf_hi(w.w); }
#pragma unroll
            for (int c = 0; c < 8; ++c) { s[c] += shx(s[c], 8, lane); s[c] += shx(s[c], 16, lane); s[c] += shx(s[c], 32, lane); }
            if (rs == 0) {
#pragma unroll
                for (int c = 0; c < 8; ++c) KPART[(mb * 8 + wid) * 64 + dch * 8 + c] = s[c]; }
        }
        __syncthreads();
        { const int mb = tid >> 6, d = tid & 63; if (mb < 7) { float t = 0.f;
#pragma unroll
            for (int w = 0; w < 8; ++w) t += KPART[(mb * 8 + w) * 64 + d];
            KMEAN[mb * 64 + d] = t * (1.0f / 256.0f); } }
        __syncthreads();
        }
        { const int q = tid >> 1, dh = tid & 1; const bf16* qp = Q + (rowbase + q0 + q) * PITCH + h * HD + dh * 32; float qv[32];
#pragma unroll
            for (int j = 0; j < 4; ++j) { const v4u w = *(const v4u*)(qp + j * 8); qv[j * 8 + 0] = bf_lo(w.x); qv[j * 8 + 1] = bf_hi(w.x); qv[j * 8 + 2] = bf_lo(w.y); qv[j * 8 + 3] = bf_hi(w.y); qv[j * 8 + 4] = bf_lo(w.z); qv[j * 8 + 5] = bf_hi(w.z); qv[j * 8 + 6] = bf_lo(w.w); qv[j * 8 + 7] = bf_hi(w.w); }
            float g[7];
#pragma unroll
            for (int mb = 0; mb < 7; ++mb) { float a = 0.f; if (mb < qb) {
#pragma unroll
                    for (int d = 0; d < 32; ++d) a += qv[d] * KMEAN[mb * 64 + dh * 32 + d]; }
                a += shx(a, 1, lane); g[mb] = a; }
            unsigned mask = 0u;
            if (qb <= 3) mask = (1u << qb) - 1u;
            else {
#pragma unroll
                for (int pass = 0; pass < 3; ++pass) { float best = -INFINITY; int bi = 0;
#pragma unroll
                    for (int mb = 0; mb < 7; ++mb) if (mb < qb && !((mask >> mb) & 1u) && g[mb] > best) { best = g[mb]; bi = mb; }
                    mask |= 1u << bi; } }
            if (dh == 0) SEL[q] = (unsigned char)mask; }
        __syncthreads();
        selmask = SEL[qrel]; biasfar = LUT[319 - 127];
    }
    f32x16 o[2]; o[0] = splat16(0.f); o[1] = splat16(0.f);
    float m_run = 0.f, l_run = 0.f, carry = 0.f; bool first = true;
    bf16x8 tri0, tri1, ones;
#pragma unroll
    for (int jj = 0; jj < 8; ++jj) { const int j0 = 8 * (jj >> 2) + 4 * hi + (jj & 3); tri0[jj] = (j0 >= r32) ? (short)0x3F80 : (short)0; tri1[jj] = (16 + j0 >= r32) ? (short)0x3F80 : (short)0; ones[jj] = (short)0x3F80; }
    const int jd = wid >> 1;
    bool mydone = false;
    for (int i = 0; i < NT; ++i) {
        const int kt = NT - 1 - i; const int slot = (i % NSLOT) * SLOTB;
        { const int n = (NT - 1 - i) < (NSLOT - 2) ? (NT - 1 - i) : (NSLOT - 2);
          if (n >= 6) ATT_WAIT_BAR(12); else if (n == 5) ATT_WAIT_BAR(10); else if (n == 4) ATT_WAIT_BAR(8); else if (n == 3) ATT_WAIT_BAR(6); else if (n == 2) ATT_WAIT_BAR(4); else if (n == 1) ATT_WAIT_BAR(2); else ATT_WAIT_BAR(0); }
        if constexpr (!MOBA) { if (i >= 1) { const v4u d0 = *(const LAS v4u*)doneAt, d1 = *(const LAS v4u*)(doneAt + 4); const int lim = i - 1;
                bool all = ((int)d0.x <= lim) && ((int)d0.y <= lim) && ((int)d0.z <= lim) && ((int)d0.w <= lim) && ((int)d1.x <= lim) && ((int)d1.y <= lim) && ((int)d1.z <= lim) && ((int)d1.w <= lim);
                if (__builtin_amdgcn_readfirstlane(all ? 1 : 0)) break; } }
        if (i + NSLOT - 1 < NT) { DMA_K(kt - (NSLOT - 1), ((i + NSLOT - 1) % NSLOT) * SLOTB); DMA_V(kt - (NSLOT - 1), ((i + NSLOT - 1) % NSLOT) * SLOTB); }
        if constexpr (!MOBA) { if (mydone) continue; }
        const int jb = kt - (NT - 4);
        if (jb > jd) continue;
        const bool diag = (jb == jd);
        f32x16 p0, p1;
        if constexpr (MOBA) {
            const bool band = jb >= 0; const int mblk = kt >> 2;
            const bool sel = band || ((selmask >> mblk) & 1u);
            if (!__any(sel)) continue;
            const int dmin = (q0 + wid * 32) - (64 * kt + 63);
            const bool near = dmin < 113;
            const float ci = sel ? ((near ? 0.f : biasfar) - m_run) : -INFINITY;
            const f32x16 cinit = splat16(ci);
            qkt(p0, p1, Kbase + slot, qr, cinit, r32, hi);
            if (near) { const LAS float* rl = (const LAS float*)(shm + L_LUT) + (319 - ((q0 + qrel) - 64 * kt) + 4 * hi);
                asm volatile("" : "+v"(rl));
#pragma unroll
                for (int r = 0; r < 16; ++r) { p0[r] += rl[(r & 3) + 8 * (r >> 2)]; p1[r] += rl[(r & 3) + 8 * (r >> 2) + 32]; } }
            float rma = max3f(p0[0], p0[1], p1[0]), rmb = max3f(p0[2], p0[3], p1[1]); rma = max3f(rma, p1[2], p1[3]);
#pragma unroll
            for (int r = 4; r < 16; r += 4) { rma = max3f(rma, p0[r], p0[r + 1]); rmb = max3f(rmb, p0[r + 2], p0[r + 3]); rma = max3f(rma, p1[r], p1[r + 1]); rmb = max3f(rmb, p1[r + 2], p1[r + 3]); }
            float rm = max2f(rma, rmb);
            { const unsigned rb_ = __builtin_bit_cast(unsigned, rm);
              const auto sw_ = __builtin_amdgcn_permlane32_swap(rb_, rb_, false, false);
              rm = __builtin_fmaxf(__builtin_bit_cast(float, (unsigned)sw_[0]), __builtin_bit_cast(float, (unsigned)sw_[1])); }
            const bool grow = first || (rm > 8.0f);
            if (__any(grow)) { const float dl = grow ? rm : 0.f; m_run += dl; const float alpha = fast_exp2(-dl); l_run = first ? 0.f : l_run * alpha;
#pragma unroll
                for (int r = 0; r < 16; ++r) { p0[r] -= dl; p1[r] -= dl; }
                if (!first) { if (hi == 0) wsf[r32] = alpha; LDS_WAIT();
#pragma unroll
                    for (int d_ = 0; d_ < 2; ++d_)
#pragma unroll
                        for (int r = 0; r < 16; ++r) o[d_][r] *= wsf[crow(r, hi)];
                    LDS_WAIT(); } }
            first = false;
            l_run += exp_pv<false>(o, vb0 + slot, p0, p1, p0, p1);
            continue;
        } else {
            const f32x16 zero = splat16(0.f);
            qkt(p0, p1, Kbase + slot, qr, zero, r32, hi);
            f32x16 s0, s1;
            const int kq = qrel - 64 * (jb < 0 ? 0 : jb);
            if (diag) {
#pragma unroll
                for (int r = 0; r < 16; ++r) { const int kv = crow(r, hi); if (kv >= kq) p0[r] = -1e30f; if (kv + 32 >= kq) p1[r] = -1e30f; } }
#pragma unroll
            for (int r = 0; r < 16; ++r) { const float z0 = p0[r], z1 = p1[r];
                const float c0 = min2f(z0, 64.f), c1 = min2f(z1, 64.f);
                s0[r] = fast_log2(1.0f + fast_exp2(c0)) + (z0 - c0); s1[r] = fast_log2(1.0f + fast_exp2(c1)) + (z1 - c1); }
            const bf16x8 L0 = pack8r(s0, 0), L1 = pack8r(s0, 8), L2 = pack8r(s1, 0), L3 = pack8r(s1, 8);
            const f32x16 c16 = splat16(carry);
            f32x16 W0 = __builtin_amdgcn_mfma_f32_32x32x16_bf16(tri0, L0, c16, 0, 0, 0);
            W0 = __builtin_amdgcn_mfma_f32_32x32x16_bf16(tri1, L1, W0, 0, 0, 0);
            W0 = __builtin_amdgcn_mfma_f32_32x32x16_bf16(ones, L2, W0, 0, 0, 0);
            W0 = __builtin_amdgcn_mfma_f32_32x32x16_bf16(ones, L3, W0, 0, 0, 0);
            f32x16 W1 = __builtin_amdgcn_mfma_f32_32x32x16_bf16(tri0, L2, c16, 0, 0, 0);
            W1 = __builtin_amdgcn_mfma_f32_32x32x16_bf16(tri1, L3, W1, 0, 0, 0);
            carry = shl(W0[0], r32);
            if (__all(carry > SB_DONE_THR)) { mydone = true; if (lane == 0) doneAt[wid] = i; }
            (void)exp_pv<true>(o, vb0 + slot, p0, p1, W0, W1);
        }
    }
    asm volatile("s_waitcnt vmcnt(0)" ::: "memory");
    float rli[16];
    if constexpr (MOBA) {
        l_run += shx(l_run, 32, lane);
        if (hi == 0) wsf[32 + r32] = l_run; LDS_WAIT();
#pragma unroll
        for (int r = 0; r < 16; ++r) rli[r] = fast_rcp(wsf[32 + crow(r, hi)]);
    } else {
#pragma unroll
        for (int r = 0; r < 16; ++r) rli[r] = 1.f;
    }
    bf16* Ow = O + (rowbase + q0 + wid * 32) * PITCH + h * HD;
    { LAS bf16* stg = (LAS bf16*)(shm + L_OST) + wid * 2048;
#pragma unroll
        for (int r = 0; r < 16; ++r) { const int orow = crow(r, hi);
#pragma unroll
            for (int d0 = 0; d0 < 2; ++d0) stg[orow * 64 + d0 * 32 + r32] = (bf16)f2bf(o[d0][r] * rli[r]); }
        LDS_WAIT();
#pragma unroll
        for (int i = 0; i < 4; ++i) { const int row = i * 8 + (lane >> 3), ch = lane & 7; const v4u v = *(const LAS v4u*)(stg + row * 64 + ch * 8); *(v4u*)(Ow + (long)row * PITCH + ch * 8) = v; } }
    asm volatile("s_waitcnt lgkmcnt(0)\n\ts_barrier" ::: "memory");
#undef DMA_K
#undef DMA_V
}

typedef float f32x2_t __attribute__((ext_vector_type(2))); typedef __bf16 bf16x2_t __attribute__((ext_vector_type(2)));
__device__ __forceinline__ unsigned cvtpk_s(float lo, float hi) { f32x2_t v = {lo, hi}; bf16x2_t bb = __builtin_convertvector(v, bf16x2_t); return __builtin_bit_cast(unsigned, bb); }
typedef short v4i16_t __attribute__((ext_vector_type(4)));
__device__ __forceinline__ s16x4 vtr(const LAS char* p) { return __builtin_bit_cast(s16x4, __builtin_amdgcn_ds_read_tr16_b64_v4i16((LAS v4i16_t*)p)); }
__device__ __forceinline__ void kload8f(bf16x8* kf, const LAS char* kp) {
    kf[0] = *(const LAS bf16x8*)(kp);        kf[1] = *(const LAS bf16x8*)(kp + 512);  kf[2] = *(const LAS bf16x8*)(kp + 2048); kf[3] = *(const LAS bf16x8*)(kp + 2560);
    kf[4] = *(const LAS bf16x8*)(kp + 4096); kf[5] = *(const LAS bf16x8*)(kp + 4608); kf[6] = *(const LAS bf16x8*)(kp + 6144); kf[7] = *(const LAS bf16x8*)(kp + 6656); }
__device__ __forceinline__ void kload2f(bf16x8* kf, const LAS char* kp, int j) { kf[2 * j] = *(const LAS bf16x8*)(kp + j * 2048); kf[2 * j + 1] = *(const LAS bf16x8*)(kp + j * 2048 + 512); }
__device__ __forceinline__ void moba_unit2(int b, int h, int qb, const bf16* Q, const bf16* __restrict__ Kp, const bf16* __restrict__ Vp, bf16* O, const float* rel_bias, LAS unsigned char* shm, bool prep) {
    constexpr bool MOBA = true; constexpr int NS3 = 3;
    const int tid = otid(), lane = tid & 63, r32 = lane & 31, hi = lane >> 5; const int wid = __builtin_amdgcn_readfirstlane(tid >> 6);
    const long rowbase = (long)b * SEQ; const int q0 = qb * 256;
    const bf16* Qw = Q + (rowbase + q0 + wid * 32) * PITCH + h * HD;
    const bf16* Kh = Kp + rowbase * PITCH + h * HD; const bf16* Vh = Vp + rowbase * PITCH + h * HD;
    const unsigned lds0 = (unsigned)(uintptr_t)shm;
    LAS float* wsf = (LAS float*)(shm + L_WS) + wid * 64;
    const bf16* ksrc = Kh + (long)lane * PITCH + wid * 8;
    const bf16* vsrc = Vh + (long)(16 * (wid & 3) + (lane >> 2)) * PITCH + (wid >> 2) * 32 + (lane & 3) * 8;
    const unsigned kdst = lds0 + L_K + wid * 1024, vdst = lds0 + L_V + wid * 1024;
#define DMA_K(t, slot) glds16(ksrc + (long)(t) * 64 * PITCH, (unsigned)__builtin_amdgcn_readfirstlane(kdst + (slot)))
#define DMA_V(t, slot) glds16(vsrc + (long)(t) * 64 * PITCH, (unsigned)__builtin_amdgcn_readfirstlane(vdst + (slot)))
    const int vb0 = (int)(lds0 + L_V) + ((lane >> 4) & 1) * 32 + (lane & 3) * 8 + (4 * hi + ((lane & 15) >> 2)) * 64;
    const LAS char* Kbase = (const LAS char*)(shm + L_K);
    const LAS char* kp0 = (const LAS char*)(shm + L_K) + hi * 1024 + r32 * 16; const LAS char* vp0 = (const LAS char*)(shm + L_V) + ((lane >> 4) & 1) * 32 + (lane & 3) * 8 + (4 * hi + ((lane & 15) >> 2)) * 64;
    const int NT = 4 * (qb + 1);
    const int qrel = wid * 32 + r32;
    DMA_K(0, 0); DMA_V(0, 0); DMA_K(1, SLOTB);
    bf16x8 qr[4];
#pragma unroll
    for (int d0 = 0; d0 < 4; ++d0) qr[d0] = *(const bf16x8*)(&Qw[(long)r32 * PITCH + d0 * 16 + hi * 8]);
    float biasfar = 0.f; unsigned selmask = 0u;
    {
        LAS float* KPART = (LAS float*)(shm + L_KPART); LAS float* KMEAN = (LAS float*)(shm + L_KMEAN); LAS unsigned char* SEL = (LAS unsigned char*)(shm + L_SEL); LAS float* LUT = (LAS float*)(shm + L_LUT);
        if (prep) {
        if (tid < 384) { const int d = 319 - tid; LUT[tid] = d < 0 ? -INFINITY : rel_bias[REL_BUCKET_LUT[d > 127 ? 127 : d] * NH + h] * LOG2E; }
        const int dch = lane & 7, rs = lane >> 3;
        for (int mb = 0; mb < 7; ++mb) {
            float s[8];
#pragma unroll
            for (int c = 0; c < 8; ++c) s[c] = 0.f;
#pragma unroll
            for (int j = 0; j < 4; ++j) { const v4u w = *(const v4u*)(Kh + (long)(mb * 256 + wid * 32 + j * 8 + rs) * PITCH + dch * 8);
                s[0] += bf_lo(w.x); s[1] += bf_hi(w.x); s[2] += bf_lo(w.y); s[3] += bf_hi(w.y); s[4] += bf_lo(w.z); s[5] += bf_hi(w.z); s[6] += bf_lo(w.w); s[7] += bf_hi(w.w); }
#pragma unroll
            for (int c = 0; c < 8; ++c) { s[c] += shx(s[c], 8, lane); s[c] += shx(s[c], 16, lane); s[c] += shx(s[c], 32, lane); }
            if (rs == 0) {
#pragma unroll
                for (int c = 0; c < 8; ++c) KPART[(mb * 8 + wid) * 64 + dch * 8 + c] = s[c]; }
        }
        __syncthreads();
        { const int mb = tid >> 6, d = tid & 63; if (mb < 7) { float t = 0.f;
#pragma unroll
            for (int w = 0; w < 8; ++w) t += KPART[(mb * 8 + w) * 64 + d];
            KMEAN[mb * 64 + d] = t * (1.0f / 256.0f); } }
        __syncthreads();
        }
        { const int q = tid >> 1, dh = tid & 1; const bf16* qp = Q + (rowbase + q0 + q) * PITCH + h * HD + dh * 32; float qv[32];
#pragma unroll
            for (int j = 0; j < 4; ++j) { const v4u w = *(const v4u*)(qp + j * 8); qv[j * 8 + 0] = bf_lo(w.x); qv[j * 8 + 1] = bf_hi(w.x); qv[j * 8 + 2] = bf_lo(w.y); qv[j * 8 + 3] = bf_hi(w.y); qv[j * 8 + 4] = bf_lo(w.z); qv[j * 8 + 5] = bf_hi(w.z); qv[j * 8 + 6] = bf_lo(w.w); qv[j * 8 + 7] = bf_hi(w.w); }
            float g[7];
#pragma unroll
            for (int mb = 0; mb < 7; ++mb) { float a = 0.f; if (mb < qb) {
#pragma unroll
                    for (int d = 0; d < 32; ++d) a += qv[d] * KMEAN[mb * 64 + dh * 32 + d]; }
                a += shx(a, 1, lane); g[mb] = a; }
            unsigned mask = 0u;
            if (qb <= 3) mask = (1u << qb) - 1u;
            else {
#pragma unroll
                for (int pass = 0; pass < 3; ++pass) { float best = -INFINITY; int bi = 0;
#pragma unroll
                    for (int mb = 0; mb < 7; ++mb) if (mb < qb && !((mask >> mb) & 1u) && g[mb] > best) { best = g[mb]; bi = mb; }
                    mask |= 1u << bi; } }
            if (dh == 0) SEL[q] = (unsigned char)mask; }
        __syncthreads();
        selmask = SEL[qrel]; biasfar = LUT[319 - 127];
    }
    (void)Kbase; (void)vb0;
    float mhat = 0.f, l_reg = 0.f; f32x16 o[2]; o[0] = splat16(0.f); o[1] = splat16(0.f); bf16x8 kf[8];
#define FUT(t) ((((t) - (NT - 4)) > (wid >> 1)))
#define CIN(t) splat16(FUT(t) ? -INFINITY : (((t) >= NT - 4) || ((selmask >> ((t) >> 2)) & 1u)) ? (((((q0 + wid * 32) - (64 * (t) + 63)) < 113) ? 0.f : biasfar) - mhat) : -INFINITY)
#define NEARB(P0, P1, t) do { if ((((q0 + wid * 32) - (64 * (t) + 63)) < 113) && !FUT(t)) { const LAS float* rl = (const LAS float*)(shm + L_LUT) + (319 - ((q0 + qrel) - 64 * (t)) + 4 * hi); asm volatile("" : "+v"(rl)); \
        _Pragma("unroll") for (int r = 0; r < 16; ++r) { P0[r] += rl[(r & 3) + 8 * (r >> 2)]; P1[r] += rl[(r & 3) + 8 * (r >> 2) + 32]; } } } while (0)
    bool resc = false;
#define RESC() do { if (resc) { asm volatile("s_waitcnt lgkmcnt(0)" ::: "memory"); \
        _Pragma("unroll") for (int d_ = 0; d_ < 2; ++d_) _Pragma("unroll") for (int r = 0; r < 16; ++r) o[d_][r] *= wsf[crow(r, hi)]; } } while (0)
    f32x16 pA0, pA1, pB0, pB1;
    int sl_prev = 0, sl_cur = 0, sl_next = SLOTB;
#define ROT() do { sl_prev = sl_cur; sl_cur = sl_next; sl_next = (sl_next == (NS3 - 1) * SLOTB) ? 0 : sl_next + SLOTB; } while (0)
    DMA_K(2, 2 * SLOTB);
    ATT_WAIT_BAR(3);
    { const f32x16 c0_ = CIN(0); qkt(pA0, pA1, (const LAS char*)(shm + L_K), qr, c0_, r32, hi); }
    NEARB(pA0, pA1, 0);
    { float rm = max3f(pA0[0], pA0[1], pA1[0]), rb = max3f(pA0[2], pA0[3], pA1[1]); rm = max3f(rm, pA1[2], pA1[3]);
#pragma unroll
      for (int r = 4; r < 16; r += 4) { rm = max3f(rm, pA0[r], pA0[r + 1]); rb = max3f(rb, pA0[r + 2], pA0[r + 3]); rm = max3f(rm, pA1[r], pA1[r + 1]); rb = max3f(rb, pA1[r + 2], pA1[r + 3]); }
      float m_ = __builtin_fmaxf(rm, rb);
      { const unsigned u_ = __builtin_bit_cast(unsigned, m_); const auto rr = __builtin_amdgcn_permlane32_swap(u_, u_, false, false); m_ = __builtin_fmaxf(__builtin_bit_cast(float, (unsigned)rr[0]), __builtin_bit_cast(float, (unsigned)rr[1])); }
      const float dl = __builtin_fmaxf(m_, -64.f); mhat += dl;
#pragma unroll
      for (int r = 0; r < 16; ++r) { pA0[r] = fast_exp2(pA0[r] - dl); pA1[r] = fast_exp2(pA1[r] - dl); } }
    ATT_WAIT_BAR(0);
    if (3 < NT) DMA_K(3, 0); if (1 < NT) DMA_V(1, SLOTB);
    ROT();
    kload8f(kf, kp0 + sl_cur);
    ATT_WAIT_BAR(2);
    s16x4 vlo[8], vhi[8]; v4u pw0, pw1, pw2, pw3;
#define SBAR() __builtin_amdgcn_sched_barrier(0)
#define PKW(P, B) cvtpk_s(P[B], P[B + 1])
#define PAF(k) __builtin_bit_cast(bf16x8, pw##k)
#define VFR(i) (bf16x8){vlo[i][0], vlo[i][1], vlo[i][2], vlo[i][3], vhi[i][0], vhi[i][1], vhi[i][2], vhi[i][3]}
#define PIN(x) asm volatile("" : "+v"(x))
#define MX3(a, b, c) __builtin_fmaxf(__builtin_fmaxf((a), (b)), (c))
#define GAPA(MF, A0, A1, A2, A3, W0, W1, PW) do { MF; sacc += A0; sacc += A1; sacc += A2; sacc += A3; PIN(sacc); W0; W1; PIN(PW); SBAR(); } while (0)
#define EX(v) __builtin_amdgcn_exp2f(v)
#define GAPB(MF, X, B) do { MF; X[B] = EX(X[B]); X[B + 1] = EX(X[B + 1]); X[B + 2] = EX(X[B + 2]); X[B + 3] = EX(X[B + 3]); PIN(X); SBAR(); } while (0)
#define VRD(i) do { vlo[i] = vtr(vp_ + (((i) >> 2) * 4096 + ((i) & 3) * 1024)); vhi[i] = vtr(vp_ + (((i) >> 2) * 4096 + ((i) & 3) * 1024 + 512)); } while (0)
#define KRD(G, j) do { if (G) { kload2f(kf, kp0 + sl_next, j); SBAR(); } } while (0)
#define STEP(C0, C1, P0, P1, t, GK, GV, GL, NEARH) do { SBAR(); \
    const LAS char* vp_ = vp0 + sl_prev; const f32x16 cin_ = CIN(t); \
    VRD(0); SBAR(); float sacc = (P0[0] + P0[1]); \
    GAPA(C0 = __builtin_amdgcn_mfma_f32_32x32x16_bf16(kf[0], qr[0], cin_, 0, 0, 0), P0[2], P0[3], P0[4], P0[5],     pw0[0] = PKW(P0, 0), pw0[1] = PKW(P0, 2), pw0); \
    VRD(4); SBAR(); GAPA(C1 = __builtin_amdgcn_mfma_f32_32x32x16_bf16(kf[1], qr[0], cin_, 0, 0, 0), P0[6], P0[7], P0[8], P0[9],     pw0[2] = PKW(P0, 4), pw0[3] = PKW(P0, 6), pw0); \
    VRD(1); SBAR(); GAPA(C0 = __builtin_amdgcn_mfma_f32_32x32x16_bf16(kf[2], qr[1], C0, 0, 0, 0),   P0[10], P0[11], P0[12], P0[13], pw1[0] = PKW(P0, 8), pw1[1] = PKW(P0, 10), pw1); \
    VRD(5); SBAR(); GAPA(C1 = __builtin_amdgcn_mfma_f32_32x32x16_bf16(kf[3], qr[1], C1, 0, 0, 0),   P0[14], P0[15], P1[0], P1[1],   pw1[2] = PKW(P0, 12), pw1[3] = PKW(P0, 14), pw1); \
    VRD(2); SBAR(); GAPA(C0 = __builtin_amdgcn_mfma_f32_32x32x16_bf16(kf[4], qr[2], C0, 0, 0, 0),   P1[2], P1[3], P1[4], P1[5],     pw2[0] = PKW(P1, 0), pw2[1] = PKW(P1, 2), pw2); \
    VRD(6); SBAR(); GAPA(C1 = __builtin_amdgcn_mfma_f32_32x32x16_bf16(kf[5], qr[2], C1, 0, 0, 0),   P1[6], P1[7], P1[8], P1[9],     pw2[2] = PKW(P1, 4), pw2[3] = PKW(P1, 6), pw2); \
    VRD(3); SBAR(); GAPA(C0 = __builtin_amdgcn_mfma_f32_32x32x16_bf16(kf[6], qr[3], C0, 0, 0, 0),   P1[10], P1[11], P1[12], P1[13], pw3[0] = PKW(P1, 8), pw3[1] = PKW(P1, 10), pw3); \
    VRD(7); SBAR(); GAPA(C1 = __builtin_amdgcn_mfma_f32_32x32x16_bf16(kf[7], qr[3], C1, 0, 0, 0),   P1[14], P1[15], 0.f, 0.f,       pw3[2] = PKW(P1, 12), pw3[3] = PKW(P1, 14), pw3); \
    l_reg += sacc; \
    if (GK) { DMA_K((t) + 3, sl_cur); } if (GV) { DMA_V((t) + 1, sl_next); } \
    if (NEARH) NEARB(C0, C1, t); \
    { float a = MX3(C0[0], C0[1], C1[0]), bq = MX3(C0[2], C0[3], C1[1]); a = MX3(a, C1[2], C1[3]); \
      _Pragma("unroll") for (int r = 4; r < 16; r += 4) { a = MX3(a, C0[r], C0[r + 1]); bq = MX3(bq, C0[r + 2], C0[r + 3]); a = MX3(a, C1[r], C1[r + 1]); bq = MX3(bq, C1[r + 2], C1[r + 3]); } \
      float rm = __builtin_fmaxf(a, bq); { const unsigned u_ = __builtin_bit_cast(unsigned, rm); const auto rr = __builtin_amdgcn_permlane32_swap(u_, u_, false, false); rm = __builtin_fmaxf(__builtin_bit_cast(float, (unsigned)rr[0]), __builtin_bit_cast(float, (unsigned)rr[1])); } \
      resc = false; \
      if (__builtin_expect(__any(rm > 8.0f), 0)) { const float dl = __builtin_fmaxf(rm, 0.f); mhat += dl; \
        _Pragma("unroll") for (int r = 0; r < 16; ++r) { C0[r] -= dl; C1[r] -= dl; } \
        const float f = __builtin_amdgcn_exp2f(-dl); l_reg *= f; if (hi == 0) wsf[r32] = f; resc = true; } } \
    SBAR(); \
    GAPB(o[0] = __builtin_amdgcn_mfma_f32_32x32x16_bf16(PAF(0), VFR(0), o[0], 0, 0, 0), C0, 0); \
    GAPB(o[1] = __builtin_amdgcn_mfma_f32_32x32x16_bf16(PAF(0), VFR(4), o[1], 0, 0, 0), C0, 4); \
    KRD(GL, 0); GAPB(o[0] = __builtin_amdgcn_mfma_f32_32x32x16_bf16(PAF(1), VFR(1), o[0], 0, 0, 0), C0, 8); \
    KRD(GL, 1); GAPB(o[1] = __builtin_amdgcn_mfma_f32_32x32x16_bf16(PAF(1), VFR(5), o[1], 0, 0, 0), C0, 12); \
    KRD(GL, 2); GAPB(o[0] = __builtin_amdgcn_mfma_f32_32x32x16_bf16(PAF(2), VFR(2), o[0], 0, 0, 0), C1, 0); \
    KRD(GL, 3); GAPB(o[1] = __builtin_amdgcn_mfma_f32_32x32x16_bf16(PAF(2), VFR(6), o[1], 0, 0, 0), C1, 4); \
    GAPB(o[0] = __builtin_amdgcn_mfma_f32_32x32x16_bf16(PAF(3), VFR(3), o[0], 0, 0, 0), C1, 8); \
    GAPB(o[1] = __builtin_amdgcn_mfma_f32_32x32x16_bf16(PAF(3), VFR(7), o[1], 0, 0, 0), C1, 12); \
    } while (0)
    int t = 1;
    for (; t + 7 < NT; t += 2) {
        STEP(pB0, pB1, pA0, pA1, t, true, true, true, false);     ATT_WAIT_BAR(2); RESC(); ROT();
        STEP(pA0, pA1, pB0, pB1, t + 1, true, true, true, false); ATT_WAIT_BAR(2); RESC(); ROT();
    }
#define ENDW(tt) do { if ((tt) + 3 < NT) { ATT_WAIT_BAR(2); } else if ((tt) + 2 < NT) { ATT_WAIT_BAR(1); } else { ATT_WAIT_BAR(0); } } while (0)
    for (; t + 1 < NT; t += 2) {
        STEP(pB0, pB1, pA0, pA1, t, (t + 3 < NT), (t + 1 < NT), (t + 1 < NT), true);           ENDW(t);     RESC(); ROT();
        STEP(pA0, pA1, pB0, pB1, t + 1, (t + 4 < NT), (t + 2 < NT), (t + 2 < NT), true);       ENDW(t + 1); RESC(); ROT();
    }
    STEP(pB0, pB1, pA0, pA1, NT - 1, false, false, false, true); RESC();
    { float sacc = pB0[0] + pB0[1];
#pragma unroll
      for (int r = 2; r < 16; ++r) sacc += pB0[r];
#pragma unroll
      for (int r = 0; r < 16; ++r) sacc += pB1[r];
      l_reg += sacc;
      pw0 = (v4u){PKW(pB0, 0), PKW(pB0, 2), PKW(pB0, 4), PKW(pB0, 6)}; pw1 = (v4u){PKW(pB0, 8), PKW(pB0, 10), PKW(pB0, 12), PKW(pB0, 14)}; pw2 = (v4u){PKW(pB1, 0), PKW(pB1, 2), PKW(pB1, 4), PKW(pB1, 6)}; pw3 = (v4u){PKW(pB1, 8), PKW(pB1, 10), PKW(pB1, 12), PKW(pB1, 14)};
      SBAR(); pv(o, (int)(lds0 + L_V) + ((lane >> 4) & 1) * 32 + (lane & 3) * 8 + (4 * hi + ((lane & 15) >> 2)) * 64 + sl_cur, PAF(0), PAF(1), PAF(2), PAF(3)); }
    { const unsigned u_ = __builtin_bit_cast(unsigned, l_reg); const auto rr = __builtin_amdgcn_permlane32_swap(u_, u_, false, false); l_reg = __builtin_bit_cast(float, (unsigned)rr[0]) + __builtin_bit_cast(float, (unsigned)rr[1]); }
    if (hi == 0) wsf[32 + r32] = l_reg; LDS_WAIT();
    float rli[16];
#pragma unroll
    for (int r = 0; r < 16; ++r) rli[r] = fast_rcp(wsf[32 + crow(r, hi)]);
    bf16* Ow = O + (rowbase + q0 + wid * 32) * PITCH + h * HD;
    { LAS bf16* stg = (LAS bf16*)(shm + L_OST) + wid * 2048;
#pragma unroll
        for (int r = 0; r < 16; ++r) { const int orow = crow(r, hi);
#pragma unroll
            for (int d0 = 0; d0 < 2; ++d0) stg[orow * 64 + d0 * 32 + r32] = (bf16)f2bf(o[d0][r] * rli[r]); }
        LDS_WAIT();
#pragma unroll
        for (int i = 0; i < 4; ++i) { const int row = i * 8 + (lane >> 3), ch = lane & 7; const v4u v = *(const LAS v4u*)(stg + row * 64 + ch * 8); *(v4u*)(Ow + (long)row * PITCH + ch * 8) = v; } }
    asm volatile("s_waitcnt lgkmcnt(0)\n\ts_barrier" ::: "memory");
#undef DMA_K
#undef DMA_V
#undef CIN
#undef FUT
#undef NEARB
#undef RESC
#undef ROT
#undef SBAR
#undef PKW
#undef PAF
#undef VFR
#undef PIN
#undef MX3
#undef GAPA
#undef EX
#undef GAPB
#undef VRD
#undef KRD
#undef STEP
#undef ENDW
}
}

struct Args { const float* in[20]; float* out; unsigned char* ws; int ph_lo, ph_hi; };
struct Frame {
    LAS unsigned char* lds; gu32* ctl; int tid, lane, wave, vcu, G;
};
#define FRESH(F) do { (F).tid = otid(); (F).lane = (F).tid & 63; (F).wave = __builtin_amdgcn_readfirstlane((F).tid >> 6); } while (0)
__device__ __forceinline__ float wave_sum(float v, int lane) {
#pragma unroll
    for (int o = 1; o < 64; o <<= 1) v += shx(v, o, lane);
    return v;
}
__device__ __forceinline__ void transpose_item(const float* W, int K, int N, bf16* WT, int mode, LAS float* scr, int item, int lane) {
    const int nblk = N / 32, kb = item / nblk, nb = item % nblk, k0 = 64 * kb, n0 = 32 * nb;
    const int rbase = (mode == 0) ? n0 : (256 * (n0 >> 7) + (n0 & 127) + (mode == 2 ? 128 : 0));
    { float tv[32];
#pragma unroll
      for (int i = 0; i < 32; ++i) tv[i] = W[(size_t)(k0 + 2 * i + (lane >> 5)) * N + n0 + (lane & 31)];
#pragma unroll
      for (int i = 0; i < 32; ++i) scr[(2 * i + (lane >> 5)) * 33 + (lane & 31)] = tv[i]; }
    LDS_WAIT(); asm volatile("" ::: "memory");
    const int c = lane & 7;
#pragma unroll
    for (int j = 0; j < 4; ++j) { const int n = (lane >> 3) + 8 * j; const LAS float* s = scr + (8 * c) * 33 + n;
        v4u o; o.x = pk2(s[0 * 33], s[1 * 33]); o.y = pk2(s[2 * 33], s[3 * 33]); o.z = pk2(s[4 * 33], s[5 * 33]); o.w = pk2(s[6 * 33], s[7 * 33]);
        *(GAS v4u*)(WT + (size_t)(rbase + n) * K + k0 + 8 * c) = o; }
    LDS_WAIT(); asm volatile("" ::: "memory");
}

__device__ __forceinline__ unsigned pk4_i8(float a, float b, float c, float d) { const int ia = (int)__builtin_rintf(a), ib = (int)__builtin_rintf(b), ic = (int)__builtin_rintf(c), id = (int)__builtin_rintf(d);
    return (unsigned)(ia & 0xff) | ((unsigned)(ib & 0xff) << 8) | ((unsigned)(ic & 0xff) << 16) | ((unsigned)(id & 0xff) << 24); }
template <bool I8>
__device__ __forceinline__ void transpose_item8w(const float* W, int K, int N, unsigned char* WT, int mode, float scale, LAS float* scr, int item, int lane) {
    const int nblk = N / 32, kb = item / nblk, nb = item % nblk, k0 = 128 * kb, n0 = 32 * nb;
    const int rbase = (mode == 0) ? n0 : (256 * (n0 >> 7) + (n0 & 127) + (mode == 2 ? 128 : 0));
    { float tv[64];
#pragma unroll
      for (int i = 0; i < 64; ++i) tv[i] = W[(size_t)(k0 + 2 * i + (lane >> 5)) * N + n0 + (lane & 31)];
#pragma unroll
      for (int i = 0; i < 64; ++i) scr[(2 * i + (lane >> 5)) * 33 + (lane & 31)] = tv[i]; }
    LDS_WAIT(); asm volatile("" ::: "memory");
    const int c = (lane & 3) + 4 * (lane >> 5);
#pragma unroll
    for (int j = 0; j < 4; ++j) { const int n = ((lane >> 2) & 7) + 8 * j; const LAS float* sp = scr + (16 * c) * 33 + n; v4u o;
        if (I8) { o.x = pk4_i8(sp[0 * 33] * scale, sp[1 * 33] * scale, sp[2 * 33] * scale, sp[3 * 33] * scale); o.y = pk4_i8(sp[4 * 33] * scale, sp[5 * 33] * scale, sp[6 * 33] * scale, sp[7 * 33] * scale);
                  o.z = pk4_i8(sp[8 * 33] * scale, sp[9 * 33] * scale, sp[10 * 33] * scale, sp[11 * 33] * scale); o.w = pk4_i8(sp[12 * 33] * scale, sp[13 * 33] * scale, sp[14 * 33] * scale, sp[15 * 33] * scale); }
        else { o.x = pk4_fp8(sp[0 * 33] * scale, sp[1 * 33] * scale, sp[2 * 33] * scale, sp[3 * 33] * scale); o.y = pk4_fp8(sp[4 * 33] * scale, sp[5 * 33] * scale, sp[6 * 33] * scale, sp[7 * 33] * scale);
               o.z = pk4_fp8(sp[8 * 33] * scale, sp[9 * 33] * scale, sp[10 * 33] * scale, sp[11 * 33] * scale); o.w = pk4_fp8(sp[12 * 33] * scale, sp[13 * 33] * scale, sp[14 * 33] * scale, sp[15 * 33] * scale); }
        *(GAS v4u*)(WT + (size_t)(rbase + n) * K + k0 + 16 * c) = o; }
    LDS_WAIT(); asm volatile("" ::: "memory");
}

__device__ __forceinline__ void copy_i8_strip(const float* W, int N, unsigned char* WT, int mode, float* wcs, int nb, LAS unsigned char* lds, int wave, int lane) {
    LAS float* scr = (LAS float*)(lds + wave * 16896); LAS float* CM = (LAS float*)(lds + 8 * 16896);
    const int n0 = 32 * nb, k0 = 128 * wave;
    const int rbase = (mode == 0) ? n0 : (256 * (n0 >> 7) + (n0 & 127) + (mode == 2 ? 128 : 0));
    float cm = 0.f;
    { float tv[64];
#pragma unroll
      for (int i = 0; i < 64; ++i) tv[i] = W[(size_t)(k0 + 2 * i + (lane >> 5)) * N + n0 + (lane & 31)];
#pragma unroll
      for (int i = 0; i < 64; ++i) { cm = fmaxf(cm, fabsf(tv[i])); scr[(2 * i + (lane >> 5)) * 33 + (lane & 31)] = tv[i]; } }
    { const unsigned u_ = __builtin_bit_cast(unsigned, cm); const auto rr = __builtin_amdgcn_permlane32_swap(u_, u_, false, false); cm = fmaxf(__builtin_bit_cast(float, (unsigned)rr[0]), __builtin_bit_cast(float, (unsigned)rr[1])); }
    if (lane < 32) CM[wave * 32 + lane] = cm;
    __syncthreads();
    float ca = 0.f;
#pragma unroll
    for (int w = 0; w < 8; ++w) ca = fmaxf(ca, CM[w * 32 + (lane & 31)]);
    ca = fmaxf(ca, 1e-30f);
    if (wave == 0 && lane < 32) wcs[rbase + lane] = ca * (1.0f / 127.0f);
    const int c = (lane & 3) + 4 * (lane >> 5);
#pragma unroll
    for (int j = 0; j < 4; ++j) { const int n = ((lane >> 2) & 7) + 8 * j; const LAS float* sp = scr + (16 * c) * 33 + n; v4u o;
        const float inv = 127.0f / __builtin_bit_cast(float, __builtin_amdgcn_ds_bpermute(n << 2, __builtin_bit_cast(int, ca)));
        o.x = pk4_i8(sp[0 * 33] * inv, sp[1 * 33] * inv, sp[2 * 33] * inv, sp[3 * 33] * inv); o.y = pk4_i8(sp[4 * 33] * inv, sp[5 * 33] * inv, sp[6 * 33] * inv, sp[7 * 33] * inv);
        o.z = pk4_i8(sp[8 * 33] * inv, sp[9 * 33] * inv, sp[10 * 33] * inv, sp[11 * 33] * inv); o.w = pk4_i8(sp[12 * 33] * inv, sp[13 * 33] * inv, sp[14 * 33] * inv, sp[15 * 33] * inv);
        *(GAS v4u*)(WT + (size_t)(rbase + n) * 1024 + k0 + 16 * c) = o; }
    __syncthreads();
}

struct RowArgs { const void* xin; void* xout;
                  const bf16* Y; const float2* tokw_in; const float* gpost; const float* gate; const float* gpre; const float* shift; const float* scale; bf16* H; float* hscale;
                 const float* wrouter; int* lists; float2* tokw_out; unsigned* cnt; };
template <bool HAS_Y, bool PAIR, bool WRITE_H, bool ROUTER, int HMODE, bool XIN16, bool XOUT16>
__device__ __forceinline__ void row_phase(Frame& F, const void* a_xin, void* a_xout, const bf16* a_Y, const float2* a_tokw_in, const float* a_gpost, const float* a_gate, const float* a_gpre, const float* a_shift, const float* a_scale,
                                          bf16* a_H, float* a_hscale, const float* a_wrouter, int* a_lists, float2* a_tokw_out, unsigned* a_cnt) {
    FRESH(F);
    const int lane = F.lane; const int gw = F.vcu * NWAVES + F.wave; const int rows_per_wave = M / (F.G * NWAVES);
    const int m0 = gw * rows_per_wave; const int b = (F.vcu * NWAVES * rows_per_wave) / SEQ;
    LAS float* wr = (LAS float*)F.lds;
    LAS float* vec = (LAS float*)(F.lds + 32768);
    int my_e0 = -1, my_e1 = -1; float my_w0 = 0.f, my_w1 = 0.f;
    f32x4 rx[4]; v2u rx16[4], ry0[4], ry1[4]; float2 rw = make_float2(0.f, 0.f);
#define ROW_LOAD(mm) do { _Pragma("unroll") for (int j = 0; j < 4; ++j) { \
        if constexpr (XIN16) rx16[j] = *(const v2u*)((const bf16*)a_xin + (size_t)(mm) * D + 256 * j + 4 * lane); else rx[j] = *(const f32x4*)((const float*)a_xin + (size_t)(mm) * D + 256 * j + 4 * lane); \
        if constexpr (HAS_Y) { if (MK_Y8 && PAIR) { const unsigned char* y8_ = (const unsigned char*)a_Y; \
                                   if constexpr (PAIR) { ry0[j].x = *(const unsigned*)(y8_ + (size_t)(2 * (mm)) * D + 256 * j + 4 * lane); ry1[j].x = *(const unsigned*)(y8_ + (size_t)(2 * (mm) + 1) * D + 256 * j + 4 * lane); } \
                                   else ry0[j].x = *(const unsigned*)(y8_ + (size_t)(mm) * D + 256 * j + 4 * lane); } \
                               else if constexpr (PAIR) { ry0[j] = *(const v2u*)(a_Y + (size_t)(2 * (mm)) * D + 256 * j + 4 * lane); ry1[j] = *(const v2u*)(a_Y + (size_t)(2 * (mm) + 1) * D + 256 * j + 4 * lane); } \
                               else ry0[j] = *(const v2u*)(a_Y + (size_t)(mm) * D + 256 * j + 4 * lane); } } \
        if constexpr (HAS_Y && PAIR) rw = a_tokw_in[(mm)]; } while (0)
    ROW_LOAD(m0);
    if constexpr (ROUTER) { for (int i = F.tid; i < D * NE / 4; i += NTHREADS) { const f32x4 v = ((const f32x4*)a_wrouter)[i]; const int col = i >> 1, e0 = (i & 1) * 4;
            wr[(e0 + 0) * D + col] = v.x; wr[(e0 + 1) * D + col] = v.y; wr[(e0 + 2) * D + col] = v.z; wr[(e0 + 3) * D + col] = v.w; } }
    for (int i = F.tid; i < D; i += NTHREADS) {
        if (HAS_Y) { vec[i] = a_gpost[i]; vec[D + i] = a_gate[(size_t)b * NMOD + i]; }
        if (WRITE_H) { vec[2 * D + i] = a_gpre[i]; vec[3 * D + i] = a_shift[(size_t)b * NMOD + i]; vec[4 * D + i] = a_scale[(size_t)b * NMOD + i] + 1.0f; } }
    __syncthreads();
    for (int i = 0; i < rows_per_wave; ++i) { const int m = m0 + i;
        f32x4 x[4];
#pragma unroll
        for (int j = 0; j < 4; ++j) { if constexpr (XIN16) x[j] = (f32x4){bf_lo(rx16[j].x), bf_hi(rx16[j].x), bf_lo(rx16[j].y), bf_hi(rx16[j].y)}; else x[j] = rx[j]; }
        f32x4 y[4];
        if constexpr (HAS_Y) {
            if constexpr (PAIR) { const float2 w = rw;
#pragma unroll
                for (int j = 0; j < 4; ++j) { const v2u u0 = ry0[j], u1 = ry1[j];
                    if (MK_Y8) { const f32x2 a0 = __builtin_amdgcn_cvt_pk_f32_fp8((int)u0.x, false), a1 = __builtin_amdgcn_cvt_pk_f32_fp8((int)u0.x, true), b0 = __builtin_amdgcn_cvt_pk_f32_fp8((int)u1.x, false), b1 = __builtin_amdgcn_cvt_pk_f32_fp8((int)u1.x, true);
                        y[j] = (f32x4){w.x * a0.x + w.y * b0.x, w.x * a0.y + w.y * b0.y, w.x * a1.x + w.y * b1.x, w.x * a1.y + w.y * b1.y}; }
                    else y[j] = (f32x4){w.x * bf_lo(u0.x) + w.y * bf_lo(u1.x), w.x * bf_hi(u0.x) + w.y * bf_hi(u1.x), w.x * bf_lo(u0.y) + w.y * bf_lo(u1.y), w.x * bf_hi(u0.y) + w.y * bf_hi(u1.y)}; }
            } else {
#pragma unroll
                for (int j = 0; j < 4; ++j) { const v2u u0 = ry0[j];
                    y[j] = (f32x4){bf_lo(u0.x), bf_hi(u0.x), bf_lo(u0.y), bf_hi(u0.y)}; }
            }
        }
        if (i + 1 < rows_per_wave) ROW_LOAD(m + 1);
        if constexpr (HAS_Y) {
            float s = 0.f;
#pragma unroll
            for (int j = 0; j < 4; ++j) s += (y[j].x * y[j].x + y[j].y * y[j].y) + (y[j].z * y[j].z + y[j].w * y[j].w);
            const float rstd = 1.0f / sqrtf(wave_sum(s, lane) * (1.0f / D) + EPS);
#pragma unroll
            for (int j = 0; j < 4; ++j) { const f32x4 gp = *(const LAS f32x4*)(vec + 256 * j + 4 * lane), gt = *(const LAS f32x4*)(vec + D + 256 * j + 4 * lane);
                x[j] = x[j] + gt * ((y[j] * rstd) * gp);
                if constexpr (XOUT16) { v2u o; o.x = pk2(x[j].x, x[j].y); o.y = pk2(x[j].z, x[j].w); *(v2u*)((bf16*)a_xout + (size_t)m * D + 256 * j + 4 * lane) = o; }
                else *(f32x4*)((float*)a_xout + (size_t)m * D + 256 * j + 4 * lane) = x[j]; }
        }
        if constexpr (WRITE_H) {
            float s = 0.f;
#pragma unroll
            for (int j = 0; j < 4; ++j) s += (x[j].x * x[j].x + x[j].y * x[j].y) + (x[j].z * x[j].z + x[j].w * x[j].w);
            const float rstd = 1.0f / sqrtf(wave_sum(s, lane) * (1.0f / D) + EPS);
#pragma unroll
            for (int j = 0; j < 4; ++j) { const f32x4 gp = *(const LAS f32x4*)(vec + 2 * D + 256 * j + 4 * lane), sh = *(const LAS f32x4*)(vec + 3 * D + 256 * j + 4 * lane), sc = *(const LAS f32x4*)(vec + 4 * D + 256 * j + 4 * lane);
                x[j] = ((x[j] * rstd) * gp) * sc + sh; }
            if constexpr (HMODE == 2) {
                float am = 0.f;
#pragma unroll
                for (int j = 0; j < 4; ++j) am = fmaxf(fmaxf(am, fmaxf(fabsf(x[j].x), fabsf(x[j].y))), fmaxf(fabsf(x[j].z), fabsf(x[j].w)));
#pragma unroll
                for (int o = 1; o < 64; o <<= 1) am = fmaxf(am, shx(am, o, lane));
                am = fmaxf(am, 1e-30f); const float inv = 127.0f / am;
                if (lane == 0) a_hscale[m] = am * (1.0f / 127.0f);
#pragma unroll
                for (int j = 0; j < 4; ++j) *(unsigned*)((unsigned char*)a_H + (size_t)m * D + 256 * j + 4 * lane) = pk4_i8(x[j].x * inv, x[j].y * inv, x[j].z * inv, x[j].w * inv);
            } else {
#pragma unroll
            for (int j = 0; j < 4; ++j) {
                if constexpr (HMODE == 1) { *(unsigned*)((unsigned char*)a_H + (size_t)m * D + 256 * j + 4 * lane) = pk4_fp8(x[j].x, x[j].y, x[j].z, x[j].w); }
                else { v2u o; o.x = pk2(x[j].x, x[j].y); o.y = pk2(x[j].z, x[j].w); *(v2u*)(a_H + (size_t)m * D + 256 * j + 4 * lane) = o; } } }
            if constexpr (ROUTER) {
                float lg[NE];
#pragma unroll
                for (int e = 0; e < NE; ++e) lg[e] = 0.f;
#pragma unroll
                for (int j = 0; j < 4; ++j) {
#pragma unroll
                    for (int e = 0; e < NE; ++e) { const f32x4 w = *(const LAS f32x4*)(wr + e * D + 256 * j + 4 * lane);
                        lg[e] += (x[j].x * w.x + x[j].y * w.y) + (x[j].z * w.z + x[j].w * w.w); }
                    asm volatile("" ::: "memory"); }
#pragma unroll
                for (int e = 0; e < NE; ++e) lg[e] = wave_sum(lg[e], lane);
                int e0 = 0; float v0 = lg[0];
#pragma unroll
                for (int e = 1; e < NE; ++e) if (lg[e] > v0) { v0 = lg[e]; e0 = e; }
                int e1 = -1; float v1 = -INFINITY;
#pragma unroll
                for (int e = 0; e < NE; ++e) if (e != e0 && lg[e] > v1) { v1 = lg[e]; e1 = e; }
                const float t = fast_exp2((v1 - v0) * LOG2E); const float w0 = 1.0f / (1.0f + t), w1 = t / (1.0f + t);
                if (lane == i) { my_e0 = e0; my_e1 = e1; my_w0 = w0; my_w1 = w1; }
            }
        }
    }
    if constexpr (ROUTER) {
        const bool act = lane < rows_per_wave; int pos0 = 0, pos1 = 0;
        const unsigned long long lt = (1ull << lane) - 1ull;
#pragma unroll
        for (int e = 0; e < NE; ++e) { const unsigned long long b0 = __ballot(act && my_e0 == e), b1 = __ballot(act && my_e1 == e);
            const int n0 = __popcll(b0), n1 = __popcll(b1); int base = 0;
            if (n0 + n1 > 0) { if (lane == 0) base = (int)__hip_atomic_fetch_add(a_cnt + 64 * e, (unsigned)(n0 + n1), RLX_AGENT); base = __builtin_amdgcn_readfirstlane(base); }
            if (act && my_e0 == e) pos0 = base + __popcll(b0 & lt);
            if (act && my_e1 == e) pos1 = base + n0 + __popcll(b1 & lt); }
        if (act) { const int m = m0 + lane; a_lists[my_e0 * M + pos0] = 2 * m; a_lists[my_e1 * M + pos1] = 2 * m + 1; a_tokw_out[m] = make_float2(my_w0, my_w1); }
    }
    __syncthreads();
}

#undef ROW_LOAD
template <class Sched>
__device__ __forceinline__ void moe_tables(Frame& F, const Sched& S, const int* lists, int panel0) {
    FRESH(F);
    LAS int* seg = (LAS int*)(F.lds + LDS_SEG); LAS unsigned short* tok = (LAS unsigned short*)(F.lds + LDS_TOK);
    if (F.tid < NE) seg[16 + F.tid] = (int)__hip_atomic_load((unsigned*)(F.ctl + CW_CNT + 64 * F.tid), RLX_AGENT);
    __syncthreads();
    if (F.tid == 0) { int acc = 0;
        for (int e = 0; e < NE; ++e) { seg[e] = acc; acc += (seg[16 + e] + 255) & ~255; }
        seg[8] = acc; }
    __syncthreads();
    Sched S2 = S; S2.c = obid(); pg8::Unit u;
#pragma unroll 1
    for (int ui = F.wave; ui < LDS_TOK_UNITS; ui += NWAVES) {
        if (!S2.next(ui, u)) break;
        const int prow = (panel0 + u.pm) * 256; int e = 0;
#pragma unroll
        for (int j = 1; j < NE; ++j) e += (prow >= seg[j]) ? 1 : 0;
        const int pos0 = prow - seg[e], cnt_e = seg[16 + e]; int v[4];
#pragma unroll
        for (int j = 0; j < 4; ++j) { const int pos = pos0 + F.lane + 64 * j; v[j] = (pos < cnt_e) ? lists[e * M + pos] : 0; }
#pragma unroll
        for (int j = 0; j < 4; ++j) tok[ui * 256 + F.lane + 64 * j] = (unsigned short)v[j];
    }
    __syncthreads();
}

constexpr int PH_LAYER0 = 3, PH_STRIDE = 16, PH_END = PH_LAYER0 + 2 * PH_STRIDE;
__global__ void __launch_bounds__(NTHREADS, 2) mega_fwd(Args args) {
    extern __shared__ __attribute__((aligned(16))) unsigned char lds_raw[];
    Frame F; F.lds = (LAS unsigned char*)lds_raw; F.tid = threadIdx.x; F.lane = F.tid & 63; F.wave = __builtin_amdgcn_readfirstlane(F.tid >> 6);
    F.G = gridDim.x; { const int bx = blockIdx.x; F.vcu = (F.G % 8 == 0) ? (bx % 8) * (F.G / 8) + bx / 8 : bx; }
    unsigned char* ws = args.ws; F.ctl = (gu32*)(ws + WS_CTL);
    volatile LAS unsigned* MISC = (volatile LAS unsigned*)(F.lds + LDS_MISC);
    if (F.tid < 16) MISC[F.tid] = 0u;
    __syncthreads();
    XcdBarrier bar; bar.bar = (unsigned*)(F.ctl + CW_BAR); bar.x = 0; bar.st = nullptr;
    if (MK_ONE_LAUNCH) bar = xcd_barrier_post((unsigned*)(F.ctl + CW_BAR), MISC);
    const int lo = args.ph_lo, hi = args.ph_hi;
#define IN(k) (lo <= (k) && (k) < hi)
#define SEAM(k, knext) do { if (IN(k) && IN(knext)) xcd_barrier(bar); } while (0)
    const float* x_in = args.in[0]; const float* c_in = args.in[1]; const float* w_mod = args.in[2]; const float* b_mod = args.in[3];
    const float* g_mix_pre = args.in[4]; const float* g_mix_post = args.in[5]; const float* g_ffn_pre = args.in[6]; const float* g_ffn_post = args.in[7];
    const float* w_in = args.in[8]; const float* w_psb = args.in[9]; const float* w_pmb = args.in[10]; const float* w_out = args.in[11]; const float* rel_bias = args.in[12];
    const float* w1d = args.in[13]; const float* w3d = args.in[14]; const float* w2d = args.in[15]; const float* w_router = args.in[16];
    const float* w1m = args.in[17]; const float* w3m = args.in[18]; const float* w2m = args.in[19];
    float* xout = args.out;
    bf16* XB1 = (bf16*)args.out; bf16* XB2 = (bf16*)args.out + (size_t)M * D; bf16* XB3 = (bf16*)(ws + WS_H + 32 * MiB);
    float* MOD = (float*)(ws + WS_MOD); int* LISTS = (int*)(ws + WS_LIST); float2* TOKW = (float2*)(ws + WS_TOKW);
    unsigned char* WIN = ws + WS_WIN; float* HSCALE = (float*)(ws + WS_HSCALE); bf16* WPSB = (bf16*)(ws + WS_WPSB); bf16* WPMB = (bf16*)(ws + WS_WPMB); bf16* WOUT = (bf16*)(ws + WS_WOUT);
    unsigned char* W13D = ws + WS_W13D; unsigned char* W2D = ws + WS_W2D; unsigned char* W13M = ws + WS_W13M; unsigned char* W2M = ws + WS_W2M;
    bf16* H = (bf16*)(ws + WS_H); bf16* BIG = (bf16*)(ws + WS_BIG);

#if defined(MK_PROBE_PRO2)
    for (int prep_ = 0; prep_ < 2; ++prep_) {
#endif
    if (!SK(0) && IN(0)) {
        FRESH(F);
        if ((int)blockIdx.x < 192) {
            LAS float* cond = (LAS float*)F.lds;
            LAS float* part = (LAS float*)(F.lds + 65536);
            { static_assert(NB * D == 32 * NTHREADS, "cond fill"); float cv[32];
#pragma unroll
              for (int t = 0; t < 32; ++t) cv[t] = c_in[F.tid + t * NTHREADS];
#pragma unroll
              for (int t = 0; t < 32; ++t) { const int i = F.tid + t * NTHREADS, bb = i / D, k = i % D; cond[k * 16 + bb] = cv[t] * sigmoidf_(cv[t]); } }
            __syncthreads();
            const int l = (int)blockIdx.x / 96, n0 = ((int)blockIdx.x % 96) * 64;
            float acc[16];
#pragma unroll
            for (int bb = 0; bb < 16; ++bb) acc[bb] = 0.f;
            const float* wp = w_mod + (size_t)l * D * NMOD + n0 + F.lane;
            float wnx[16];
#pragma unroll
            for (int j = 0; j < 16; ++j) wnx[j] = wp[(size_t)(F.wave * 128 + j) * NMOD];
#pragma unroll
            for (int k8 = 0; k8 < 128; k8 += 16) { float wv16[16];
#pragma unroll
              for (int j = 0; j < 16; ++j) wv16[j] = wnx[j];
              if (k8 + 16 < 128) {
#pragma unroll
                for (int j = 0; j < 16; ++j) wnx[j] = wp[(size_t)(F.wave * 128 + k8 + 16 + j) * NMOD]; }
#pragma unroll 4
              for (int j = 0; j < 16; ++j) { const int k = F.wave * 128 + k8 + j; const float wv = wv16[j];
                const LAS f32x4* cp = (const LAS f32x4*)(cond + k * 16); const f32x4 c0 = cp[0], c1 = cp[1], c2 = cp[2], c3 = cp[3];
                acc[0] += c0.x * wv; acc[1] += c0.y * wv; acc[2] += c0.z * wv; acc[3] += c0.w * wv; acc[4] += c1.x * wv; acc[5] += c1.y * wv; acc[6] += c1.z * wv; acc[7] += c1.w * wv;
                acc[8] += c2.x * wv; acc[9] += c2.y * wv; acc[10] += c2.z * wv; acc[11] += c2.w * wv; acc[12] += c3.x * wv; acc[13] += c3.y * wv; acc[14] += c3.z * wv; acc[15] += c3.w * wv; } }
#pragma unroll
            for (int bb = 0; bb < 16; ++bb) part[(F.wave * 16 + bb) * 64 + F.lane] = acc[bb];
            __syncthreads();
            for (int i = F.tid; i < 16 * 64; i += NTHREADS) { const int bb = i >> 6, n = i & 63; float s = b_mod[(size_t)l * NMOD + n0 + n];
#pragma unroll
                for (int w = 0; w < 8; ++w) s += part[(w * 16 + bb) * 64 + n];
                MOD[((size_t)l * NB + bb) * NMOD + n0 + n] = s; }
            __syncthreads();
        }
    }
    SEAM(0, 1);
    if (!SK(0) && IN(1)) {
        FRESH(F);
        LAS float* scr = (LAS float*)(F.lds + F.wave * 16896);
        const int gw = F.vcu * NWAVES + F.wave, NGW = F.G * NWAVES;
        constexpr int I_IN = (D / 128) * (INCOLS / 32), I_P = (WH / 64) * (D / 32), I_O = (D / 128) * (D / 32), I_13 = (D / 128) * (FF / 32), I_2 = (FF / 128) * (D / 32);
        constexpr int N_P = 4 * I_P, N_O = 2 * I_O, N_13 = 16 * I_13, N_2 = 9 * I_2, NITEMS = N_P + N_O + N_13 + N_2; (void)I_IN;
        { constexpr int S_IN = INCOLS / 32, S_13 = FF / 32, NSTRIP = 2 * S_IN + 2 * S_13;
          float* WCS = (float*)(ws + WS_WCS);
          for (int si = F.vcu; si < NSTRIP; si += F.G) {
              const float* W_; int N_, mode_, nb_; unsigned char* WT_; float* wc_;
              if (si < 2 * S_IN) { const int l = si / S_IN; W_ = w_in + (size_t)l * D * INCOLS; N_ = INCOLS; WT_ = WIN + (size_t)l * INCOLS * D; mode_ = 0; wc_ = WCS + (size_t)l * INCOLS; nb_ = si % S_IN; }
              else { const int r_ = si - 2 * S_IN, q = r_ / S_13; W_ = q == 0 ? w1d : w3d; N_ = FF; WT_ = W13D; mode_ = 1 + q; wc_ = WCS + 16384; nb_ = r_ % S_13; }
              copy_i8_strip(W_, N_, WT_, mode_, wc_, nb_, F.lds, F.wave, F.lane); } }
        for (int it = gw; it < NITEMS; it += NGW) {
            int r = it;
            if (r < N_P) { const int q = r / I_P, l = q & 1; const float* src = (q < 2 ? w_psb : w_pmb) + (size_t)l * WH * D; bf16* dst = (q < 2 ? WPSB : WPMB) + (size_t)l * D * WH; transpose_item(src, WH, D, dst, 0, scr, r % I_P, F.lane); continue; } r -= N_P;
            if (r < N_O) { const int l = r / I_O; transpose_item8w<false>(w_out + (size_t)l * D * D, D, D, (unsigned char*)WOUT + (size_t)l * D * D, 0, WO_SCALE, scr, r % I_O, F.lane); continue; } r -= N_O;
            if (r < N_13) { const int q = 2 + r / I_13; const float* src; unsigned char* dst; int mode;
                if (q < 10) { src = w1m + (size_t)(q - 2) * D * FF; dst = W13M + (size_t)(q - 2) * 2 * FF * D; mode = 1; }
                else { src = w3m + (size_t)(q - 10) * D * FF; dst = W13M + (size_t)(q - 10) * 2 * FF * D; mode = 2; }
                transpose_item8w<false>(src, D, FF, dst, mode, W13_SCALE, scr, r % I_13, F.lane); continue; } r -= N_13;
            { const int q = r / I_2; const float* src = (q == 0) ? w2d : w2m + (size_t)(q - 1) * FF * D; unsigned char* dst = (q == 0) ? W2D : W2M + (size_t)(q - 1) * D * FF; transpose_item8w<false>(src, FF, D, dst, 0, W2_SCALE, scr, r % I_2, F.lane); }
        }
    }
    __syncthreads();
    if (!SK(1) && IN(2)) {
        RowArgs a{}; a.xin = x_in; a.gpre = g_mix_pre; a.shift = MOD + 0 * D; a.scale = MOD + 1 * D; a.H = H; a.hscale = HSCALE;
        row_phase<false, false, true, false, 2, false, false>(F, a.xin, a.xout, a.Y, a.tokw_in, a.gpost, a.gate, a.gpre, a.shift, a.scale, a.H, a.hscale, a.wrouter, a.lists, a.tokw_out, a.cnt);
    }
    SEAM(2, PH_LAYER0);
#if defined(MK_PROBE_BAR)
    for (int rep_ = 0; rep_ < MK_PROBE_BAR; ++rep_) xcd_barrier(bar);
#endif
#if defined(MK_PROBE_PRO2)
    }
#endif


    for (int l = 0; l < 2; ++l) {
        const int pb = PH_LAYER0 + PH_STRIDE * l;
        const float* modl = MOD + (size_t)l * NB * NMOD;
        if (!SK(2) && IN(pb + 0)) {
            pg8::SchedPlain S; S.init(M / 256, INCOLS / 256, F.G, (int)blockIdx.x); S.A = (const char*)H; S.B = (const char*)(WIN + (size_t)l * INCOLS * D); S.tA = S.tB = (size_t)256 * D;
            { FRESH(F); LAS float* rowf = (LAS float*)(F.lds + LDS_TOK); LAS float* colf = (LAS float*)(F.lds + LDS_COLF);
              const float* wcs = (const float*)(ws + WS_WCS) + (size_t)l * INCOLS;
              pg8::SchedPlain S2 = S; S2.c = obid(); pg8::Unit u;
#pragma unroll 1
              for (int ui = F.wave; ui < 15; ui += NWAVES) { if (!S2.next(ui, u)) break; float v[4], c_[4];
#pragma unroll
                  for (int j = 0; j < 4; ++j) { v[j] = HSCALE[u.pm * 256 + F.lane + 64 * j]; c_[j] = wcs[u.pn * 256 + F.lane + 64 * j]; }
#pragma unroll
                  for (int j = 0; j < 4; ++j) { rowf[ui * 256 + F.lane + 64 * j] = v[j]; colf[ui * 256 + F.lane + 64 * j] = c_[j]; } }
              __syncthreads(); }
            pg8::EpiInProj E{BIG, (const LAS float*)(F.lds + LDS_TOK), 0, (const LAS float*)(F.lds + LDS_COLF)};
#if defined(MK_SKEW_INPROJ)
            { const unsigned long long t0_ = __builtin_amdgcn_s_memrealtime(); const unsigned long long d_ = (unsigned long long)(F.vcu & 7) * MK_SKEW_INPROJ;
              while (__builtin_amdgcn_s_memrealtime() - t0_ < d_) __builtin_amdgcn_s_sleep(8); }
#endif
#if defined(MK_PROBE_INPROJ2)
            for (int rep_ = 0; rep_ < 2; ++rep_) { E.nostore = (rep_ == 1) ? MK_PROBE_INPROJ2 - 1 : 0;
#endif
            pg8::gemm_phase<pg8::EpiInProj, pg8::SchedPlain, true, 2>(F.lds, D / 2, S, E);
#if defined(MK_PROBE_INPROJ2)
            }
#endif
        }
        SEAM(pb + 0, pb + 1);
        if (!SK(3) && IN(pb + 1)) {
            bf16* QA = BIG + BIG_QA / 2; bf16* KA = BIG + BIG_KA / 2; bf16* VA = BIG + BIG_VA / 2; bf16* QB = BIG + BIG_QB / 2; bf16* KB = BIG + BIG_KB / 2; bf16* VB = BIG + BIG_VB / 2;
            for (int v = F.vcu; v < 256; v += F.G) { const int bh = v >> 1, set = v & 1;
                for (int i = 0; i < 8; ++i) { const int k = i & 3; const int qb = set == 0 ? (k == 0 ? 0 : k == 1 ? 7 : k == 2 ? 1 : 6) : (k == 0 ? 2 : k == 1 ? 5 : k == 2 ? 3 : 4);
#if defined(MK_PROBE_ATTN2)
                    const int pass0 = (i < 4) ? (MK_PROBE_ATTN2 != 3 ? 0 : 1) : (MK_PROBE_ATTN2 != 2 ? 0 : 1);
#else
                    const int pass0 = 1;
#endif
                    for (int pass = pass0; pass < 2; ++pass) {
                        if (i < 4) att::attn_unit<false>(bh >> 3, bh & 7, qb, QA, KA, VA, pass == 0 ? H : QA, rel_bias, F.lds, false);
                        else att::moba_unit2(bh >> 3, bh & 7, qb, QB, KB, VB, pass == 0 ? H : QB, rel_bias, F.lds, i == 4 && pass == pass0); } } }
        }
        SEAM(pb + 1, pb + 2);
        if (!SK(4) && IN(pb + 2)) {
            const unsigned char* GA8 = (const unsigned char*)BIG + BIG_GA; const unsigned char* GB8 = GA8 + (size_t)M * D; bf16* TM = BIG + BIG_GB / 2;
            { pg8::SchedPlain S; S.init(M / 256, D / 256, F.G, (int)blockIdx.x); S.A = (const char*)(BIG + BIG_QA / 2); S.B = (const char*)(WPSB + (size_t)l * D * WH); S.tA = S.tB = (size_t)256 * WH * 2;
              pg8::EpiGate<false> E{GA8, TM, (unsigned char*)BIG + BIG_KA}; pg8::gemm_phase<pg8::EpiGate<false>, pg8::SchedPlain, true, 0>(F.lds, WH, S, E); }
            VM_WAIT(); __syncthreads();
            { pg8::SchedPlain S; S.init(M / 256, D / 256, F.G, (int)blockIdx.x); S.A = (const char*)(BIG + BIG_QB / 2); S.B = (const char*)(WPMB + (size_t)l * D * WH); S.tA = S.tB = (size_t)256 * WH * 2;
              pg8::EpiGate<true> E{GB8, TM, (unsigned char*)BIG + BIG_KA}; pg8::gemm_phase<pg8::EpiGate<true>, pg8::SchedPlain, true, 0>(F.lds, WH, S, E); }
        }
        SEAM(pb + 2, pb + 3);
        if (!SK(5) && IN(pb + 3)) {
            pg8::SchedPlain S; S.init(M / 256, D / 256, F.G, (int)blockIdx.x); S.A = (const char*)BIG + BIG_KA; S.B = (const char*)WOUT + (size_t)l * D * D; S.tA = S.tB = (size_t)256 * D;
            pg8::EpiBf16 E{BIG + BIG_Y / 2, D, 1.0f / (WO_SCALE * MG_SCALE)};
#if defined(MK_PROBE_G3)
            for (int rep_ = 0; rep_ < ((MK_PROBE_G3 & 1) ? 2 : 1); ++rep_)
#endif
            pg8::gemm_phase<pg8::EpiBf16, pg8::SchedPlain, true, 1>(F.lds, D / 2, S, E);
        }
        SEAM(pb + 3, pb + 4);
        if (!SK(6) && IN(pb + 4)) {
            RowArgs a{}; if (l == 0) { a.xin = x_in; a.xout = XB1; } else { a.xin = XB2; a.xout = XB3; } a.Y = BIG + BIG_Y / 2; a.gpost = g_mix_post + (size_t)l * D; a.gate = modl + 2 * D;
            a.gpre = g_ffn_pre + (size_t)l * D; a.shift = modl + 3 * D; a.scale = modl + 4 * D; a.H = H;
            a.wrouter = w_router; a.lists = LISTS; a.tokw_out = TOKW; a.cnt = (unsigned*)(F.ctl + CW_CNT);
            a.hscale = HSCALE;
#if defined(MK_PROBE_ROW2)
            if (l == 0) for (int rep_ = 0; rep_ < MK_PROBE_ROW2; ++rep_)
                row_phase<true, false, true, false, 2, false, true>(F, a.xin, a.xout, a.Y, a.tokw_in, a.gpost, a.gate, a.gpre, a.shift, a.scale, a.H, a.hscale, a.wrouter, a.lists, a.tokw_out, a.cnt);
#endif
            if (l == 0) row_phase<true, false, true, false, 2, false, true>(F, a.xin, a.xout, a.Y, a.tokw_in, a.gpost, a.gate, a.gpre, a.shift, a.scale, a.H, a.hscale, a.wrouter, a.lists, a.tokw_out, a.cnt); else row_phase<true, false, true, true, 1, true, true>(F, a.xin, a.xout, a.Y, a.tokw_in, a.gpost, a.gate, a.gpre, a.shift, a.scale, a.H, a.hscale, a.wrouter, a.lists, a.tokw_out, a.cnt);
        }
        SEAM(pb + 4, pb + 5);
        if (l == 0) {
            if (!SK(7) && IN(pb + 5)) {
                pg8::SchedPlain S; S.init(M / 256, 2 * FF / 256, F.G, (int)blockIdx.x); S.A = (const char*)H; S.B = (const char*)W13D; S.tA = S.tB = (size_t)256 * D;
                { FRESH(F); LAS float* rowf = (LAS float*)(F.lds + LDS_TOK); LAS float* colf = (LAS float*)(F.lds + LDS_COLF);
                  const float* wcs = (const float*)(ws + WS_WCS) + 16384;
                  pg8::SchedPlain S2 = S; S2.c = obid(); pg8::Unit u;
#pragma unroll 1
                  for (int ui = F.wave; ui < 15; ui += NWAVES) { if (!S2.next(ui, u)) break; float v[4], c_[4];
#pragma unroll
                      for (int j = 0; j < 4; ++j) { v[j] = HSCALE[u.pm * 256 + F.lane + 64 * j]; c_[j] = wcs[u.pn * 256 + F.lane + 64 * j]; }
#pragma unroll
                      for (int j = 0; j < 4; ++j) { rowf[ui * 256 + F.lane + 64 * j] = v[j]; colf[ui * 256 + F.lane + 64 * j] = c_[j]; } }
                  __syncthreads(); }
                pg8::EpiSwiGLUi8 E{(unsigned char*)BIG + BIG_ACT, (const LAS float*)(F.lds + LDS_TOK), (const LAS float*)(F.lds + LDS_COLF)};
#if defined(MK_PROBE_G3)
                for (int rep_ = 0; rep_ < ((MK_PROBE_G3 & 2) ? 2 : 1); ++rep_)
#endif
                pg8::gemm_phase<pg8::EpiSwiGLUi8, pg8::SchedPlain, true, 2>(F.lds, D / 2, S, E);
            }
            SEAM(pb + 5, pb + 6);
            if (!SK(8) && IN(pb + 6)) {
                pg8::SchedPlain S; S.init(M / 256, D / 256, F.G, (int)blockIdx.x); S.A = (const char*)BIG + BIG_ACT; S.B = (const char*)W2D; S.tA = S.tB = (size_t)256 * FF;
                pg8::EpiBf16 E{BIG + BIG_YF / 2, D, 1.0f / W2_SCALE};
#if defined(MK_PROBE_G3)
                for (int rep_ = 0; rep_ < ((MK_PROBE_G3 & 4) ? 2 : 1); ++rep_)
#endif
                pg8::gemm_phase<pg8::EpiBf16, pg8::SchedPlain, true, 1>(F.lds, FF / 2, S, E);
            }
            SEAM(pb + 6, pb + 11);
        } else {
            for (int c = 0; c < MOE_NCHUNK; ++c) {
                const int panel0 = c * MOE_CHUNK_PANELS;
                int npan = 0;
                if (IN(pb + 5 + 2 * c) || IN(pb + 6 + 2 * c)) { int tot = 0;
                    for (int e = 0; e < NE; ++e) tot += ((int)__hip_atomic_load((unsigned*)(F.ctl + CW_CNT + 64 * e), RLX_AGENT) + 255) >> 8;
                    npan = tot - panel0; npan = npan < 0 ? 0 : (npan > MOE_CHUNK_PANELS ? MOE_CHUNK_PANELS : npan); }
                if (!SK(9) && IN(pb + 5 + 2 * c)) {
                    pg8::SchedMoeUp S; S.init(npan, 2 * FF / 256, F.G, (int)blockIdx.x); S.wsh = MK_WSH_MOEUP; S.A = (const char*)H; S.B = (const char*)W13M; S.tA = 0; S.tB = (size_t)256 * D; S.eB = (size_t)2 * FF * D;
                    S.panel0 = panel0; S.seg = (const LAS int*)(F.lds + LDS_SEG); S.tok = (const LAS unsigned short*)(F.lds + LDS_TOK);
                    moe_tables(F, S, LISTS, panel0);
                    pg8::EpiSwiGLU E{(unsigned char*)BIG + BIG_HID, 1.0f / W13_SCALE};
#if defined(MK_PROBE_MOEUP2)
                    for (int rep_ = 0; rep_ < 2; ++rep_)
#endif
                    pg8::gemm_phase<pg8::EpiSwiGLU, pg8::SchedMoeUp, true, 1>(F.lds, D / 2, S, E);
                }
                SEAM(pb + 5 + 2 * c, pb + 6 + 2 * c);
                if (!SK(10) && IN(pb + 6 + 2 * c)) {
                    pg8::SchedMoeDown S; S.init(npan, D / 256, F.G, (int)blockIdx.x); S.wsh = MK_WSH_MOEDN; S.A = (const char*)BIG + BIG_HID; S.B = (const char*)W2M; S.tA = S.tB = (size_t)256 * FF; S.eB = (size_t)D * FF;
                    S.panel0 = panel0; S.seg = (const LAS int*)(F.lds + LDS_SEG); S.tok = (const LAS unsigned short*)(F.lds + LDS_TOK);
                    int nfull = (S.nwg / F.G) * F.G, ntail = S.nwg - nfull;
                    if (F.G < 128 || ntail > 32 || !MK_SPLIT_TAIL) { nfull = S.nwg; ntail = 0; }
                    S.nwg = nfull;
                    moe_tables(F, S, LISTS, panel0);
                    pg8::EpiMoeDown E{BIG + BIG_YP / 2, (const LAS unsigned short*)(F.lds + LDS_TOK), (const LAS int*)(F.lds + LDS_SEG), 1.0f / W2_SCALE};
#if defined(MK_PROBE_MOEDOWN2)
                    for (int rep_ = 0; rep_ < 2; ++rep_)
#endif
                    pg8::gemm_phase<pg8::EpiMoeDown, pg8::SchedMoeDown, true, 1>(F.lds, FF / 2, S, E);
                    if (MK_SPLIT_TAIL) {
                        pg8::SchedMoeDownTail T; T.init(npan, D / 256, F.G, (int)blockIdx.x); T.wsh = MK_WSH_MOEDN; T.A = S.A; T.B = S.B; T.tA = S.tA; T.tB = S.tB; T.eB = S.eB; T.panel0 = panel0; T.seg = S.seg; T.tok = S.tok; T.nfull = nfull;
                        const int bx = obid(), p = (bx >> 5) * 8 + (bx & 7), sl = (bx >> 3) & 3;
                        T.pidx = (bx < 128 && p < ntail) ? p : -1;
                        const int kt0 = sl == 0 ? 0 : sl == 1 ? 8 : sl == 2 ? 14 : 22, ntk = (sl & 1) ? 6 : 8;
                        T.koff = (size_t)kt0 * 128;
                        moe_tables(F, T, LISTS, panel0);
                        pg8::EpiMoeDownTail ET{BIG + BIG_YP / 2, (const LAS unsigned short*)(F.lds + LDS_TOK), (const LAS int*)(F.lds + LDS_SEG), 1.0f / W2_SCALE, (f32x4*)(ws + WS_H), (unsigned*)(F.ctl + CW_XF), p, sl};
                        pg8::gemm_phase<pg8::EpiMoeDownTail, pg8::SchedMoeDownTail, true, 1>(F.lds, FF / 2, T, ET, ntk);
                    }
                }
                SEAM(pb + 6 + 2 * c, (c + 1 < MOE_NCHUNK) ? pb + 7 + 2 * c : pb + 11);
            }
        }
        if (!SK(11) && IN(pb + 11)) {
            RowArgs a{}; if (l == 0) { a.xin = XB1; a.xout = XB2; } else { a.xin = XB3; a.xout = xout; } a.gpost = g_ffn_post + (size_t)l * D; a.gate = modl + 5 * D; a.H = H;
            if (l == 0) { a.Y = BIG + BIG_YF / 2; a.gpre = g_mix_pre + (size_t)(l + 1) * D; a.shift = MOD + (size_t)(l + 1) * NB * NMOD + 0 * D; a.scale = MOD + (size_t)(l + 1) * NB * NMOD + 1 * D; a.hscale = HSCALE;
                row_phase<true, false, true, false, 2, true, true>(F, a.xin, a.xout, a.Y, a.tokw_in, a.gpost, a.gate, a.gpre, a.shift, a.scale, a.H, a.hscale, a.wrouter, a.lists, a.tokw_out, a.cnt); }
            else { a.Y = BIG + BIG_YP / 2; a.tokw_in = TOKW; row_phase<true, true, false, false, 0, true, false>(F, a.xin, a.xout, a.Y, a.tokw_in, a.gpost, a.gate, a.gpre, a.shift, a.scale, a.H, a.hscale, a.wrouter, a.lists, a.tokw_out, a.cnt); }
        }
        if (l == 0) SEAM(pb + 11, pb + PH_STRIDE);
    }
#undef IN
#undef SEAM
}

extern "C" void kernel_launch(void* const* d_in, const int* in_sizes, int n_in, void* d_out, int out_size, void* d_ws, size_t ws_size, hipStream_t stream) {
    static int grid = 0;
    if (grid == 0) {
        if (n_in != 20 || in_sizes[0] != M * D || out_size != M * D || ws_size < WS_END) { fprintf(stderr, "kernel_launch: unexpected shapes (n_in %d, ws %zu)\n", n_in, ws_size); grid = -1; return; }
        int dev = 0, cus = 0;
        if (hipGetDevice(&dev) != hipSuccess || hipDeviceGetAttribute(&cus, hipDeviceAttributeMultiprocessorCount, dev) != hipSuccess) { grid = -1; return; }
        if (hipFuncSetAttribute((const void*)mega_fwd, hipFuncAttributeMaxDynamicSharedMemorySize, LDS_BYTES) != hipSuccess) { fprintf(stderr, "kernel_launch: hipFuncSetAttribute failed\n"); grid = -1; return; }
        int per_cu = 0;
        if (hipOccupancyMaxActiveBlocksPerMultiprocessor(&per_cu, (const void*)mega_fwd, NTHREADS, LDS_BYTES) != hipSuccess || per_cu < 1) fprintf(stderr, "kernel_launch: occupancy query reports %d\n", per_cu);
        (void)hipGetLastError();
        grid = cus;
        if (grid != 256) { fprintf(stderr, "kernel_launch: built for 256 CUs, found %d\n", cus); grid = -1; return; }
    }
    if (grid < 0) return;
    if (hipMemsetAsync((char*)d_ws + WS_CTL, 0, CTL_ZERO_BYTES, stream) != hipSuccess) return;
    Args a{};
    for (int i = 0; i < 20; ++i) a.in[i] = (const float*)d_in[i];
    a.out = (float*)d_out; a.ws = (unsigned char*)d_ws;
#if MK_ONE_LAUNCH
    a.ph_lo = 0; a.ph_hi = PH_END;
    hipLaunchKernelGGL(mega_fwd, dim3(grid), dim3(NTHREADS), LDS_BYTES, stream, a);
#else
    for (int p = 0; p < PH_END; ++p) {
        const int rel = p < PH_LAYER0 ? -1 : (p - PH_LAYER0) % PH_STRIDE, l = p < PH_LAYER0 ? 0 : (p - PH_LAYER0) / PH_STRIDE;
        if (rel >= 0) { if (l == 0 && rel > 6 && rel != 11) continue; if (rel > 11) continue; }
        a.ph_lo = p; a.ph_hi = p + 1;
        hipLaunchKernelGGL(mega_fwd, dim3(grid), dim3(NTHREADS), LDS_BYTES, stream, a);
    }
#endif
}
```
